# Optimizing an MI355X kernel written in HIP

```python
import jax, jax.numpy as jnp
from jax import lax
import numpy as np

D_MODEL = 1024
BATCH = 2
SEQ = 16384
DEPTH = 4

D_MIX = D_MODEL
MLA_HEADS = 8
NOPE_DIM = 64
ROPE_DIM = 32
V_DIM = 64
QK_DIM = NOPE_DIM + ROPE_DIM
Q_RANK = 256
KV_RANK = 128
MLA_WIDTH = MLA_HEADS * V_DIM
LRU_WIDTH = D_MIX - MLA_WIDTH
LRU_BLOCKS = 8
LRU_BLOCK = LRU_WIDTH // LRU_BLOCKS
CONV_WIDTH = 4
LRU_C = 8.0
IN_SPLITS = (Q_RANK, Q_RANK + KV_RANK, Q_RANK + KV_RANK + ROPE_DIM,
             Q_RANK + KV_RANK + ROPE_DIM + LRU_WIDTH)
IN_COLS = Q_RANK + KV_RANK + ROPE_DIM + 2 * LRU_WIDTH
D_FF = 2816
N_EXPERTS = 8
TOP_K = 2
D_FF_EXPERT = 3584
N_DENSE = (DEPTH + 1) // 2
N_MOE = DEPTH // 2
ROPE_THETA = 10000.0
Q_BLOCK = 128
EPS = 1e-6

kernel_name = "hymba_mla_rglru_moe_adaln_trunk"


def _rms(x, gain):
    xf = x.astype(jnp.float32)
    y = xf * lax.rsqrt(jnp.mean(xf * xf, axis=-1, keepdims=True) + EPS)
    return (y * gain.astype(jnp.float32)).astype(x.dtype)


def _rope(x, cos, sin):
    x1, x2 = jnp.split(x, 2, axis=-1)
    return jnp.concatenate([x1 * cos - x2 * sin, x1 * sin + x2 * cos], axis=-1)


def _modulate(c_act, w, b):
    m = (c_act @ w + b)[:, None, :]
    shift, scale, gate = jnp.split(m, 3, axis=-1)
    return shift, scale, gate


def _causal_attention(q, k, v, positions):
    B, S, H, _ = q.shape
    nb = S // Q_BLOCK
    qb = q.reshape(B, nb, Q_BLOCK, H, QK_DIM).transpose(1, 0, 2, 3, 4)
    pb = positions.reshape(B, nb, Q_BLOCK).transpose(1, 0, 2)
    scale = QK_DIM ** -0.5
    neg = jnp.finfo(jnp.float32).min

    def one_block(args):
        q_blk, p_blk = args
        s = jnp.einsum('bqhd,bkhd->bhqk', q_blk, k,
                       preferred_element_type=jnp.float32) * scale
        mask = positions[:, None, None, :] <= p_blk[:, None, :, None]
        p = jax.nn.softmax(jnp.where(mask, s, neg), axis=-1).astype(v.dtype)
        return jnp.einsum('bhqk,bkhd->bqhd', p, v)

    o = lax.map(one_block, (qb, pb))
    return o.transpose(1, 0, 2, 3, 4).reshape(B, S, H * V_DIM)


def _causal_conv(x, w, b):
    y = lax.conv_general_dilated(
        x, w[:, None, :].astype(x.dtype), window_strides=(1,),
        padding=[(CONV_WIDTH - 1, 0)], dimension_numbers=('NWC', 'WIO', 'NWC'),
        feature_group_count=x.shape[-1])
    return y + b


def _rglru(x, w_a, b_a, w_x, b_x, lam):
    B, S, _ = x.shape
    xb = x.reshape(B, S, LRU_BLOCKS, LRU_BLOCK)
    r = jax.nn.sigmoid((jnp.einsum('bsgi,gij->bsgj', xb, w_a).reshape(B, S, LRU_WIDTH) + b_a).astype(jnp.float32))
    i = jax.nn.sigmoid((jnp.einsum('bsgi,gij->bsgj', xb, w_x).reshape(B, S, LRU_WIDTH) + b_x).astype(jnp.float32))
    log_a = LRU_C * r * jax.nn.log_sigmoid(lam.astype(jnp.float32))
    a = jnp.exp(log_a)
    u = jnp.sqrt(-jnp.expm1(2.0 * log_a)) * (i * x.astype(jnp.float32))

    def combine(left, right):
        a1, b1 = left
        a2, b2 = right
        return a1 * a2, a2 * b1 + b2

    _, h = lax.associative_scan(combine, (a, u), axis=1)
    return h.astype(x.dtype)


def _hybrid_mixer(h, positions, cos, sin, w_in, latent_gain, w_q_up, w_kv_up, q_gain, k_gain,
                  conv_w, conv_b, w_a, b_a, w_x, b_x, lam, out_gain, w_out):
    B, S, _ = h.shape
    z = h @ w_in
    c_q, c_kv, k_r, x_rec, g_rec = jnp.split(z, IN_SPLITS, axis=-1)
    c_q = _rms(c_q, latent_gain[:Q_RANK])
    c_kv = _rms(c_kv, latent_gain[Q_RANK:])
    q = (c_q @ w_q_up).reshape(B, S, MLA_HEADS, QK_DIM)
    kv = (c_kv @ w_kv_up).reshape(B, S, MLA_HEADS, NOPE_DIM + V_DIM)
    k_nope, v = kv[..., :NOPE_DIM], kv[..., NOPE_DIM:]
    q_nope = _rms(q[..., :NOPE_DIM], q_gain[:NOPE_DIM])
    q_rope = _rope(_rms(q[..., NOPE_DIM:], q_gain[NOPE_DIM:]), cos[:, :, None, :], sin[:, :, None, :])
    k_nope = _rms(k_nope, k_gain[:NOPE_DIM])
    k_rope = _rope(_rms(k_r, k_gain[NOPE_DIM:]), cos, sin)
    qf = jnp.concatenate([q_nope, q_rope], axis=-1)
    kf = jnp.concatenate([k_nope, jnp.broadcast_to(k_rope[:, :, None, :], (B, S, MLA_HEADS, ROPE_DIM))], axis=-1)
    attn = _causal_attention(qf, kf, v, positions)
    xr = _causal_conv(x_rec, conv_w, conv_b)
    rec = _rglru(xr, w_a, b_a, w_x, b_x, lam) * jax.nn.gelu(g_rec)
    y = jnp.concatenate([_rms(attn, out_gain[:MLA_WIDTH]), _rms(rec, out_gain[MLA_WIDTH:])], axis=-1)
    return y @ w_out


def _swiglu(h, wg, wu, wd):
    return (jax.nn.silu(h @ wg) * (h @ wu)) @ wd


def _moe(h, w_router, wg, wu, wd):
    B, S, D = h.shape
    t = h.reshape(B * S, D)
    logits = (t @ w_router).astype(jnp.float32)
    top_val, top_idx = lax.top_k(logits, TOP_K)
    top_w = jax.nn.softmax(top_val, axis=-1)
    combine = jnp.sum(jax.nn.one_hot(top_idx, N_EXPERTS, dtype=jnp.float32) * top_w[..., None], axis=1)
    combine = combine.astype(t.dtype)
    out = jnp.zeros_like(t)
    for e in range(N_EXPERTS):
        out = out + combine[:, e:e + 1] * _swiglu(t, wg[e], wu[e], wd[e])
    return out.reshape(B, S, D)


def setup_inputs(seed: int = 0) -> dict:
    key = jax.random.key(seed)
    ks = jax.random.split(key, 32)
    f32 = jnp.float32

    def nrm(k, shape, fan_in):
        return jax.random.normal(k, shape, f32) * (fan_in ** -0.5)

    def gain(k, shape):
        return 1.0 + 0.02 * jax.random.normal(k, shape, f32)

    x = jax.random.normal(ks[0], (BATCH, SEQ, D_MODEL), f32)
    c = jax.random.normal(ks[1], (BATCH, D_MODEL), f32)
    offset = jax.random.randint(ks[2], (BATCH, 1), 0, 1024, dtype=jnp.int32)
    positions = offset + jnp.arange(SEQ, dtype=jnp.int32)[None, :]

    w_ada = jax.random.normal(ks[3], (DEPTH, 2, D_MODEL, 3 * D_MODEL), f32) * (0.1 * D_MODEL ** -0.5)
    gate_offset = jnp.concatenate([jnp.zeros((2 * D_MODEL,), f32), jnp.ones((D_MODEL,), f32)])
    b_ada = 0.02 * jax.random.normal(ks[4], (DEPTH, 2, 3 * D_MODEL), f32) + gate_offset
    norm_gain = gain(ks[5], (DEPTH, 2, D_MODEL))

    w_in = nrm(ks[6], (DEPTH, D_MODEL, IN_COLS), D_MODEL)
    latent_gain = gain(ks[7], (DEPTH, Q_RANK + KV_RANK))
    w_q_up = nrm(ks[8], (DEPTH, Q_RANK, MLA_HEADS * QK_DIM), Q_RANK)
    w_kv_up = nrm(ks[9], (DEPTH, KV_RANK, MLA_HEADS * (NOPE_DIM + V_DIM)), KV_RANK)
    q_gain = gain(ks[10], (DEPTH, QK_DIM))
    k_gain = gain(ks[11], (DEPTH, QK_DIM))

    conv_w = nrm(ks[12], (DEPTH, CONV_WIDTH, LRU_WIDTH), CONV_WIDTH)
    conv_b = 0.01 * jax.random.normal(ks[13], (DEPTH, LRU_WIDTH), f32)
    w_a = nrm(ks[14], (DEPTH, LRU_BLOCKS, LRU_BLOCK, LRU_BLOCK), LRU_BLOCK)
    b_a = 0.01 * jax.random.normal(ks[15], (DEPTH, LRU_WIDTH), f32)
    w_x = nrm(ks[16], (DEPTH, LRU_BLOCKS, LRU_BLOCK, LRU_BLOCK), LRU_BLOCK)
    b_x = 0.01 * jax.random.normal(ks[17], (DEPTH, LRU_WIDTH), f32)
    a8 = jax.random.uniform(ks[18], (DEPTH, LRU_WIDTH), f32, minval=0.9, maxval=0.999)
    a0 = a8 ** (1.0 / LRU_C)
    lru_lambda = jnp.log(a0) - jnp.log1p(-a0)

    out_gain = gain(ks[19], (DEPTH, D_MIX))
    w_out = nrm(ks[20], (DEPTH, D_MIX, D_MODEL), D_MIX)

    ffn_w_gate = nrm(ks[21], (N_DENSE, D_MODEL, D_FF), D_MODEL)
    ffn_w_up = nrm(ks[22], (N_DENSE, D_MODEL, D_FF), D_MODEL)
    ffn_w_down = nrm(ks[23], (N_DENSE, D_FF, D_MODEL), D_FF)

    router_w = nrm(ks[24], (N_MOE, D_MODEL, N_EXPERTS), D_MODEL)
    moe_w_gate = nrm(ks[25], (N_MOE, N_EXPERTS, D_MODEL, D_FF_EXPERT), D_MODEL)
    moe_w_up = nrm(ks[26], (N_MOE, N_EXPERTS, D_MODEL, D_FF_EXPERT), D_MODEL)
    moe_w_down = nrm(ks[27], (N_MOE, N_EXPERTS, D_FF_EXPERT, D_MODEL), D_FF_EXPERT)

    return {"x": x, "c": c, "positions": positions, "w_ada": w_ada, "b_ada": b_ada,
            "norm_gain": norm_gain, "w_in": w_in, "latent_gain": latent_gain, "w_q_up": w_q_up,
            "w_kv_up": w_kv_up, "q_gain": q_gain, "k_gain": k_gain, "conv_w": conv_w, "conv_b": conv_b,
            "w_a": w_a, "b_a": b_a, "w_x": w_x, "b_x": b_x, "lru_lambda": lru_lambda,
            "out_gain": out_gain, "w_out": w_out, "ffn_w_gate": ffn_w_gate, "ffn_w_up": ffn_w_up,
            "ffn_w_down": ffn_w_down, "router_w": router_w, "moe_w_gate": moe_w_gate,
            "moe_w_up": moe_w_up, "moe_w_down": moe_w_down}


def reference(x, c, positions, w_ada, b_ada, norm_gain, w_in, latent_gain, w_q_up, w_kv_up, q_gain,
              k_gain, conv_w, conv_b, w_a, b_a, w_x, b_x, lru_lambda, out_gain, w_out, ffn_w_gate,
              ffn_w_up, ffn_w_down, router_w, moe_w_gate, moe_w_up, moe_w_down):
    c_act = jax.nn.silu(c)
    inv_freq = ROPE_THETA ** (-jnp.arange(0, ROPE_DIM, 2, dtype=jnp.float32) / ROPE_DIM)
    ang = positions.astype(jnp.float32)[..., None] * inv_freq
    cos = jnp.cos(ang).astype(x.dtype)
    sin = jnp.sin(ang).astype(x.dtype)
    for l in range(DEPTH):
        shift, scale, gate = _modulate(c_act, w_ada[l, 0], b_ada[l, 0])
        h = _rms(x, norm_gain[l, 0]) * (1.0 + scale) + shift
        x = x + gate * _hybrid_mixer(h, positions, cos, sin, w_in[l], latent_gain[l], w_q_up[l],
                                     w_kv_up[l], q_gain[l], k_gain[l], conv_w[l], conv_b[l], w_a[l],
                                     b_a[l], w_x[l], b_x[l], lru_lambda[l], out_gain[l], w_out[l])
        shift, scale, gate = _modulate(c_act, w_ada[l, 1], b_ada[l, 1])
        h = _rms(x, norm_gain[l, 1]) * (1.0 + scale) + shift
        if l % 2 == 0:
            j = l // 2
            f = _swiglu(h, ffn_w_gate[j], ffn_w_up[j], ffn_w_down[j])
        else:
            j = l // 2
            f = _moe(h, router_w[j], moe_w_gate[j], moe_w_up[j], moe_w_down[j])
        x = x + gate * f
    return x
```

```cpp
#include <hip/hip_runtime.h>
#include <cstdio>
#include <cstdint>
namespace pg8 {
#define PG8_LAS __attribute__((address_space(3)))
typedef unsigned short bf16_t;
typedef short bf16x8 __attribute__((ext_vector_type(8)));
typedef float f32x4 __attribute__((ext_vector_type(4)));
typedef unsigned u32x4 __attribute__((ext_vector_type(4)));
constexpr int BM = 256, BK = 64, HALF = 128, HTB = HALF * BK * 2  , STAGE_BYTES = 8 * HTB, NXCD = 8, WGM = 8;

__host__ __device__ __forceinline__ int lds_byte(int r, int c) { const int st = (r >> 4) * 2 + (c >> 5), rr = r & 15, cc = c & 31, ob = rr * 64 + cc * 2; return st * 1024 + (ob ^ (((ob >> 9) & 1) << 5)); }
__host__ __device__ __forceinline__ void stage_rc(int b, int& R, int& C) { const int st = b / 1024, sb = b % 1024, swz = sb ^ (((sb >> 9) & 1) << 5); R = (st >> 1) * 16 + swz / 64; C = (st & 1) * 32 + (swz % 64) / 2; }
__host__ __device__ __forceinline__ int perm32(int rho) { const int n = rho >> 4, i = rho & 15; return 8 * (i >> 2) + 4 * n + (i & 3); }

struct Unit { int pm, pn, pb; };
struct Gemm { const bf16_t* A; const bf16_t* Bt; int M, N, K; };

struct StaticOrder {
    int nM, nN, nwg, G, c;
    __host__ __device__ void init(int M, int N, int G_, int c_) { nM = M / BM; nN = N / BM; nwg = nM * nN; G = G_; c = c_; }
    __host__ __device__ bool next(int i, Unit& u) const {
        const long L = (long)i * G + c; if (L >= nwg) return false;
        int wgid = (int)L; { const int q = nwg / NXCD, r = nwg % NXCD, xcd = wgid % NXCD, off = wgid / NXCD; wgid = (xcd < r ? xcd * (q + 1) : r * (q + 1) + (xcd - r) * q) + off; }
        const int nig = WGM * nN, gid = wgid / nig, fm = gid * WGM, gsz = (nM - fm) < WGM ? (nM - fm) : WGM;
        u.pm = fm + ((wgid % nig) % gsz); u.pn = (wgid % nig) / gsz; u.pb = u.pn; return true;
    }
    __device__ __forceinline__ void a_ready(const Unit&) const {}
    __device__ __forceinline__ void done(const Unit&) const {}
};

__device__ __forceinline__ unsigned cvt_pk_bf16(float lo, float hi) { unsigned r; asm volatile("v_cvt_pk_bf16_f32 %0, %1, %2" : "=v"(r) : "v"(lo), "v"(hi)); return r; }
typedef float f32x2 __attribute__((ext_vector_type(2)));
__device__ __forceinline__ f32x2 gelu_pk(f32x2 v) {
    const f32x2 av = __builtin_elementwise_abs(v), d = av * 0.2316418882f + 1.0f;
    f32x2 t; t.x = __builtin_amdgcn_rcpf(d.x); t.y = __builtin_amdgcn_rcpf(d.y);
    f32x2 q = t * 0.5307027145f + (-0.7265760135f); q = q * t + 0.7107068705f; q = q * t + (-0.142248368f); q = q * t + 0.127414796f; q = q * t;
    const f32x2 s = (v * v) * (-0.72134752044f);
    f32x2 e; e.x = __builtin_amdgcn_exp2f(s.x); e.y = __builtin_amdgcn_exp2f(s.y);
    const f32x2 m = v * (q * e), r = v - m;
    f32x2 o; o.x = v.x < 0.f ? m.x : r.x; o.y = v.y < 0.f ? m.y : r.y; return o;
}

template <int ACT  > struct EpiBf16 {
    static constexpr bool PERM = true, AFTER_DRAIN = false; static_assert(ACT == 0 || ACT == 1, "EpiBf16: ACT is 0 (none) or 1 (gelu_pk)");
    bf16_t* O; int ldc; const float* bias; int split_cols; size_t split_stride; float scale0;
    __device__ __forceinline__ void operator()(const f32x4 (&acc)[2][2][4][2], const Unit& u, int wr, int wc, int fr, int fq) const {
        const int row0 = u.pm * BM + wr * 64 + fr; int colt = u.pn * BM; bf16_t* base = O;
        float sc = 1.f; if (split_cols) { const int t = colt / split_cols; base += (size_t)t * split_stride; colt -= t * split_cols; if (t == 0) sc = scale0; }
        const int col0 = colt + wc * 32 + 8 * fq, bcol0 = u.pn * BM + wc * 32 + 8 * fq;
        f32x4 bv[2][2];
#pragma unroll
        for (int bj = 0; bj < 2; ++bj)
#pragma unroll
            for (int n = 0; n < 2; ++n) bv[bj][n] = bias ? *(const f32x4*)(bias + bcol0 + bj * HALF + 4 * n) : (f32x4){0.f, 0.f, 0.f, 0.f};
#pragma unroll
        for (int ai = 0; ai < 2; ++ai)
#pragma unroll
            for (int m = 0; m < 4; ++m) { bf16_t* rowp = base + (size_t)(row0 + ai * HALF + m * 16) * ldc + col0;
#pragma unroll
                for (int bj = 0; bj < 2; ++bj) { f32x4 v0 = acc[ai][bj][m][0] + bv[bj][0], v1 = acc[ai][bj][m][1] + bv[bj][1];
                    if (ACT == 1) { f32x2 a = gelu_pk((f32x2){v0[0], v0[1]}), b = gelu_pk((f32x2){v0[2], v0[3]}), c = gelu_pk((f32x2){v1[0], v1[1]}), d = gelu_pk((f32x2){v1[2], v1[3]});
                        v0 = (f32x4){a.x, a.y, b.x, b.y}; v1 = (f32x4){c.x, c.y, d.x, d.y}; }
                    v0 = v0 * sc; v1 = v1 * sc; u32x4 w; w.x = cvt_pk_bf16(v0[0], v0[1]); w.y = cvt_pk_bf16(v0[2], v0[3]); w.z = cvt_pk_bf16(v1[0], v1[1]); w.w = cvt_pk_bf16(v1[2], v1[3]);
                    *(u32x4*)(rowp + bj * HALF) = w; } }
    }
};
__device__ __forceinline__ float bf2f(unsigned short v) { return __uint_as_float((unsigned)v << 16); }
__device__ __forceinline__ float sigmoidf_(float v) { return __builtin_amdgcn_rcpf(1.0f + __builtin_amdgcn_exp2f(-1.4426950408889634f * v)); }
struct EpiResid {
    static constexpr bool PERM = false, AFTER_DRAIN = false;
    const float* base; float* out; const float* gate;
    __device__ __forceinline__ void operator()(const f32x4 (&acc)[2][2][4][2], const Unit& u, int wr, int wc, int fr, int fq) const {
        const int row0 = u.pm * BM + wr * 64 + fr, col0 = u.pn * BM + wc * 32 + 4 * fq;
        const float* gp = gate + (u.pm >= 64 ? 3072 : 0) + col0;
        f32x4 gv[2][2];
#pragma unroll
        for (int bj = 0; bj < 2; ++bj)
#pragma unroll
            for (int n = 0; n < 2; ++n) gv[bj][n] = *(const f32x4*)(gp + bj * HALF + n * 16);
#pragma unroll
        for (int ai = 0; ai < 2; ++ai)
#pragma unroll
            for (int m = 0; m < 4; ++m) { const size_t off = (size_t)(row0 + ai * HALF + m * 16) * 1024 + col0;
#pragma unroll
                for (int bj = 0; bj < 2; ++bj)
#pragma unroll
                    for (int n = 0; n < 2; ++n) { const f32x4 bs = *(const f32x4*)(base + off + bj * HALF + n * 16); *(f32x4*)(out + off + bj * HALF + n * 16) = bs + gv[bj][n] * acc[ai][bj][m][n]; }
                if (m & 1) asm volatile("" ::: "memory"); }
    }
};
struct EpiSwiglu {
    static constexpr bool PERM = true, AFTER_DRAIN = false;
    bf16_t* O; int ldc;
    __device__ __forceinline__ void operator()(const f32x4 (&acc)[2][2][4][2], const Unit& u, int wr, int wc, int fr, int fq) const {
        const int row0 = u.pm * BM + wr * 64 + fr, col0 = u.pn * HALF + wc * 32 + 8 * fq;
#pragma unroll
        for (int ai = 0; ai < 2; ++ai)
#pragma unroll
            for (int m = 0; m < 4; ++m) { bf16_t* rowp = O + (size_t)(row0 + ai * HALF + m * 16) * ldc + col0;
                float hv[8];
#pragma unroll
                for (int n = 0; n < 2; ++n)
#pragma unroll
                    for (int e = 0; e < 4; ++e) { const float g = acc[ai][0][m][n][e], up = acc[ai][1][m][n][e]; hv[4 * n + e] = g * sigmoidf_(g) * up; }
                u32x4 w; w.x = cvt_pk_bf16(hv[0], hv[1]); w.y = cvt_pk_bf16(hv[2], hv[3]); w.z = cvt_pk_bf16(hv[4], hv[5]); w.w = cvt_pk_bf16(hv[6], hv[7]);
                *(u32x4*)rowp = w; }
    }
};
struct EpiGates {
    static constexpr bool PERM = true, AFTER_DRAIN = false;
    const bf16_t* xr; const float* ba; const float* bx; const float* lamc; float* la; float* uo;
    __device__ __forceinline__ void operator()(const f32x4 (&acc)[2][2][4][2], const Unit& u, int wr, int wc, int fr, int fq) const {
        const int row0 = u.pm * BM + wr * 64 + fr, ch0 = u.pn * HALF + wc * 32 + 8 * fq;
        f32x4 bav[2], bxv[2], lcv[2];
#pragma unroll
        for (int n = 0; n < 2; ++n) { bav[n] = *(const f32x4*)(ba + ch0 + 4 * n); bxv[n] = *(const f32x4*)(bx + ch0 + 4 * n); lcv[n] = *(const f32x4*)(lamc + ch0 + 4 * n); }
#pragma unroll
        for (int ai = 0; ai < 2; ++ai)
#pragma unroll
            for (int m = 0; m < 4; ++m) { const size_t off = (size_t)(row0 + ai * HALF + m * 16) * 512 + ch0;
                const u32x4 xw = *(const u32x4*)(xr + off);
                float xv[8]; xv[0] = __uint_as_float(xw.x << 16); xv[1] = __uint_as_float(xw.x & 0xffff0000u); xv[2] = __uint_as_float(xw.y << 16); xv[3] = __uint_as_float(xw.y & 0xffff0000u);
                xv[4] = __uint_as_float(xw.z << 16); xv[5] = __uint_as_float(xw.z & 0xffff0000u); xv[6] = __uint_as_float(xw.w << 16); xv[7] = __uint_as_float(xw.w & 0xffff0000u);
#pragma unroll
                for (int n = 0; n < 2; ++n) { f32x4 lo, uu;
#pragma unroll
                    for (int e = 0; e < 4; ++e) { const float r = sigmoidf_(acc[ai][0][m][n][e] + bav[n][e]), ig = sigmoidf_(acc[ai][1][m][n][e] + bxv[n][e]);
                        const float l2 = r * lcv[n][e];
                        const float xx = l2 * 1.3862943611198906f;
                        const float om = xx > -0.02f ? -xx * (1.0f + xx * (0.5f + xx * 0.16666667f)) : 1.0f - __builtin_amdgcn_exp2f(2.0f * l2);
                        lo[e] = l2; uu[e] = __builtin_sqrtf(om) * ig * xv[4 * n + e]; }
                    *(f32x4*)(la + off + 4 * n) = lo; *(f32x4*)(uo + off + 4 * n) = uu; } }
    }
};
template <class Epi, class Sched, bool ALIGN_EPI = false, bool SP2 = false>
__device__ __forceinline__ void gemm_phase(PG8_LAS unsigned char* lds, const Gemm g, const Sched& S, const Epi& E) {
    int tid_ = threadIdx.x; asm volatile("" : "+v"(tid_));
    const int tid = tid_, wid = __builtin_amdgcn_readfirstlane(tid >> 6), lane = tid & 63, wr = wid >> 2, wc = wid & 3, fr = lane & 15, fq = lane >> 4;
    const int K = g.K, nt = K / BK;
    unsigned voffA[2], voffB[2];
#pragma unroll
    for (int i = 0; i < 2; ++i) { int R, C; stage_rc(tid * 16 + i * 8192, R, C); const int Rb = Epi::PERM ? ((R & ~31) + perm32(R & 31)) : R;
        voffA[i] = (unsigned)(R * K + C) * 2u; voffB[i] = (unsigned)(Rb * K + C) * 2u; }
    const size_t kstep = (size_t)(BK * 2);
    const size_t hstep = (size_t)HALF * K * 2;
    const size_t tstep = 2 * hstep;
    const unsigned ldsw = (unsigned)wid * 1024u;
    const int aoff = lds_byte(wr * 64 + fr, fq * 8), boff = lds_byte(wc * 32 + fr, fq * 8);
#define PG8_SA(b, h) (((b) * 2 + (h)) * HTB)
#define PG8_SB(b, h) ((4 + (b) * 2 + (h)) * HTB)
#define PG8_STAGE(bufoff, gbase, voff) do { _Pragma("unroll") for (int _i = 0; _i < 2; ++_i) \
        __builtin_amdgcn_global_load_lds((const unsigned*)((const char*)(gbase) + (voff)[_i]), (PG8_LAS unsigned*)(lds + (bufoff) + ldsw + _i * 8192), 16, 0, 0); } while (0)
#define PG8_LDA(dst, b, h) do { _Pragma("unroll") for (int m = 0; m < 4; ++m) _Pragma("unroll") for (int k = 0; k < 2; ++k) dst[m][k] = *(const PG8_LAS bf16x8*)(lds + PG8_SA(b, h) + aoff + m * 2048 + k * 1024); } while (0)
#define PG8_LDB(dst, b, h) do { _Pragma("unroll") for (int n = 0; n < 2; ++n) _Pragma("unroll") for (int k = 0; k < 2; ++k) dst[n][k] = *(const PG8_LAS bf16x8*)(lds + PG8_SB(b, h) + boff + n * 2048 + k * 1024); } while (0)
#define PG8_MMA(ai, bj, At, Bt) do { __builtin_amdgcn_s_setprio(1); _Pragma("unroll") for (int m = 0; m < 4; ++m) _Pragma("unroll") for (int n = 0; n < 2; ++n) _Pragma("unroll") for (int k = 0; k < 2; ++k) \
        acc[ai][bj][m][n] = __builtin_amdgcn_mfma_f32_16x16x32_bf16(Bt[n][k], At[m][k], acc[ai][bj][m][n], 0, 0, 0); __builtin_amdgcn_s_setprio(0); } while (0)
#define PG8_WAIT_V(n) asm volatile("s_waitcnt vmcnt(" #n ")" ::: "memory")
#define PG8_WAIT_L(n) asm volatile("s_waitcnt lgkmcnt(" #n ")" ::: "memory")
#define PG8_BAR __builtin_amdgcn_s_barrier()
#define PG8_SCHED __builtin_amdgcn_sched_barrier(0)
    Unit cur, nxt; int ui = 0;
    if (!S.next(0, cur)) return;
    f32x4 acc[2][2][4][2];
#pragma unroll
    for (int a = 0; a < 2; ++a)
#pragma unroll
        for (int b = 0; b < 2; ++b)
#pragma unroll
            for (int m = 0; m < 4; ++m)
#pragma unroll
                for (int n = 0; n < 2; ++n) acc[a][b][m][n] = (f32x4){0.f, 0.f, 0.f, 0.f};
    bf16x8 At[4][2], B0[2][2], B1[2][2];
    const char* cA = (const char*)g.A + (size_t)cur.pm * tstep; const char* cB = (const char*)g.Bt + (size_t)cur.pb * tstep;
    S.a_ready(cur);
    if constexpr (SP2) {
        PG8_STAGE(PG8_SB(0, 0), cB, voffB); PG8_STAGE(PG8_SB(0, 1), cB + hstep, voffB); PG8_STAGE(PG8_SA(0, 0), cA, voffA); PG8_STAGE(PG8_SA(0, 1), cA + hstep, voffA);
        if (wr == 1) PG8_BAR;
        PG8_WAIT_V(2); PG8_BAR;
        PG8_STAGE(PG8_SB(1, 0), cB + kstep, voffB); PG8_STAGE(PG8_SA(1, 0), cA + kstep, voffA); PG8_STAGE(PG8_SB(1, 1), cB + hstep + kstep, voffB);
        PG8_WAIT_V(6); PG8_BAR;
    } else {
        PG8_STAGE(PG8_SB(0, 0), cB, voffB); PG8_STAGE(PG8_SA(0, 0), cA, voffA); PG8_STAGE(PG8_SB(0, 1), cB + hstep, voffB); PG8_STAGE(PG8_SA(0, 1), cA + hstep, voffA);
        if (wr == 1) PG8_BAR;
        PG8_WAIT_V(4); PG8_BAR;
        PG8_STAGE(PG8_SB(1, 0), cB + kstep, voffB); PG8_STAGE(PG8_SA(1, 0), cA + kstep, voffA); PG8_STAGE(PG8_SB(1, 1), cB + hstep + kstep, voffB);
        PG8_WAIT_V(6); PG8_BAR;
    }
    for (;;) {
        const bool has_next = S.next(ui + 1, nxt);
        const char* nA = has_next ? (const char*)g.A + (size_t)nxt.pm * tstep : cA; const char* nB = has_next ? (const char*)g.Bt + (size_t)nxt.pb * tstep : cB;
        for (int t = 0; t < nt; t += 2) {
            const bool last = (t == nt - 2);
            const char* a1 = cA + (size_t)(t + 1) * kstep;
            const char* a2 = last ? nA : cA + (size_t)(t + 2) * kstep; const char* b2 = last ? nB : cB + (size_t)(t + 2) * kstep;
            const char* a3 = a2 + kstep; const char* b3 = b2 + kstep;
            if (last && has_next) S.a_ready(nxt);
            if constexpr (SP2) {
            PG8_LDB(B0, 0, 0); PG8_LDB(B1, 0, 1); PG8_SCHED; PG8_LDA(At, 0, 0); PG8_STAGE(PG8_SA(1, 1), a1 + hstep, voffA);
            PG8_WAIT_V(8); PG8_WAIT_L(0); PG8_BAR; PG8_MMA(0, 0, At, B0); PG8_MMA(0, 1, At, B1); PG8_BAR; PG8_SCHED;
            PG8_LDA(At, 0, 1); PG8_STAGE(PG8_SB(0, 0), b2, voffB); PG8_STAGE(PG8_SB(0, 1), b2 + hstep, voffB); PG8_STAGE(PG8_SA(0, 0), a2, voffA);
            PG8_WAIT_V(8); PG8_WAIT_L(0); PG8_BAR; PG8_MMA(1, 0, At, B0); PG8_MMA(1, 1, At, B1); PG8_BAR; PG8_SCHED;
            PG8_LDB(B0, 1, 0); PG8_LDB(B1, 1, 1); PG8_SCHED; PG8_LDA(At, 1, 0); PG8_STAGE(PG8_SA(0, 1), a2 + hstep, voffA);
            PG8_WAIT_V(8); PG8_WAIT_L(0); PG8_BAR; PG8_MMA(0, 0, At, B0); PG8_MMA(0, 1, At, B1); PG8_BAR; PG8_SCHED;
            PG8_LDA(At, 1, 1); PG8_STAGE(PG8_SB(1, 0), b3, voffB); PG8_STAGE(PG8_SB(1, 1), b3 + hstep, voffB); PG8_STAGE(PG8_SA(1, 0), a3, voffA);
            PG8_WAIT_V(8); PG8_WAIT_L(0); PG8_BAR; PG8_MMA(1, 0, At, B0); PG8_MMA(1, 1, At, B1); PG8_BAR; PG8_SCHED;
            } else {
            PG8_LDB(B0, 0, 0); PG8_SCHED; PG8_LDA(At, 0, 0); PG8_STAGE(PG8_SA(1, 1), a1 + hstep, voffA);
            PG8_WAIT_L(8); PG8_BAR; PG8_WAIT_L(0); PG8_MMA(0, 0, At, B0); PG8_BAR; PG8_SCHED;
            PG8_LDB(B1, 0, 1); PG8_STAGE(PG8_SB(0, 0), b2, voffB);
            PG8_BAR; PG8_WAIT_L(0); PG8_MMA(0, 1, At, B1); PG8_BAR;
            PG8_LDA(At, 0, 1); PG8_STAGE(PG8_SA(0, 0), a2, voffA);
            PG8_BAR; PG8_WAIT_L(0); PG8_MMA(1, 0, At, B0); PG8_BAR; PG8_SCHED;
            PG8_STAGE(PG8_SB(0, 1), b2 + hstep, voffB);
            PG8_WAIT_V(6); PG8_BAR; PG8_MMA(1, 1, At, B1); PG8_BAR;
            PG8_LDB(B0, 1, 0); PG8_SCHED; PG8_LDA(At, 1, 0); PG8_STAGE(PG8_SA(0, 1), a2 + hstep, voffA);
            PG8_WAIT_L(8); PG8_BAR; PG8_WAIT_L(0); PG8_MMA(0, 0, At, B0); PG8_BAR; PG8_SCHED;
            PG8_LDB(B1, 1, 1); PG8_STAGE(PG8_SB(1, 0), b3, voffB);
            PG8_BAR; PG8_WAIT_L(0); PG8_MMA(0, 1, At, B1); PG8_BAR;
            PG8_LDA(At, 1, 1); PG8_STAGE(PG8_SA(1, 0), a3, voffA);
            PG8_BAR; PG8_WAIT_L(0); PG8_MMA(1, 0, At, B0); PG8_BAR; PG8_SCHED;
            PG8_STAGE(PG8_SB(1, 1), b3 + hstep, voffB);
            PG8_WAIT_V(6); PG8_BAR; PG8_MMA(1, 1, At, B1); PG8_BAR;
            }
        }
        if constexpr (ALIGN_EPI) { if (wr == 0) PG8_BAR; }
        if constexpr (!Epi::AFTER_DRAIN) { E(acc, cur, wr, wc, fr, fq); S.done(cur); }
        if (!has_next) break;
#pragma unroll
        for (int a = 0; a < 2; ++a)
#pragma unroll
            for (int b = 0; b < 2; ++b)
#pragma unroll
                for (int m = 0; m < 4; ++m)
#pragma unroll
                    for (int n = 0; n < 2; ++n) acc[a][b][m][n] = (f32x4){0.f, 0.f, 0.f, 0.f};
        cur = nxt; cA = nA; cB = nB; ++ui;
        if constexpr (ALIGN_EPI) { if (wr == 1) PG8_BAR; }
    }
    PG8_WAIT_V(0);
    if constexpr (!ALIGN_EPI) { if (wr == 0) PG8_BAR; }
    PG8_BAR;
    if constexpr (Epi::AFTER_DRAIN) { E.fused(acc, cur, wr, wc, fr, fq, lds, wid, lane); S.done(cur); }
#undef PG8_SA
#undef PG8_SB
#undef PG8_STAGE
#undef PG8_LDA
#undef PG8_LDB
#undef PG8_MMA
#undef PG8_WAIT_V
#undef PG8_WAIT_L
#undef PG8_BAR
#undef PG8_SCHED
}
}

#define GAS __attribute__((address_space(1)))
#define LAS __attribute__((address_space(3)))
typedef unsigned short bf16;
typedef unsigned v4u __attribute__((ext_vector_type(4)));
typedef float f32x4 __attribute__((ext_vector_type(4)));
typedef short bf16x8 __attribute__((ext_vector_type(8)));
typedef GAS unsigned gu32;
typedef GAS unsigned long long gu64;
#define RLX_AGENT __ATOMIC_RELAXED, __HIP_MEMORY_SCOPE_AGENT
#define LDS_WAIT() asm volatile("s_waitcnt lgkmcnt(0)" ::: "memory")
#define VM_WAIT() asm volatile("s_waitcnt vmcnt(0)" ::: "memory")
__device__ __forceinline__ unsigned long long rt() { return __builtin_amdgcn_s_memrealtime(); }
__device__ __forceinline__ unsigned f2bf(float f) { unsigned u = __builtin_bit_cast(unsigned, f); return (u + 0x7fffu + ((u >> 16) & 1u)) >> 16; }
__device__ __forceinline__ unsigned pk2(float lo, float hi) { return f2bf(lo) | (f2bf(hi) << 16); }

#define XB_TMO      128
#define XB_XCNT(j)  (256  + 64 * (j))
#define XB_XSUB(j)  (1280 + 64 * (j))
#define XB_XGEN(j)  (2304 + 64 * (j))
#define XB_TOP      3328
#define XB_TOPGEN   3392
#define XCD_BAR_WORDS 3456
#define XB_SPIN_CAP (1u << 18)

__device__ __forceinline__ unsigned xb_ld(unsigned* p)              { return __hip_atomic_load(p, __ATOMIC_RELAXED, __HIP_MEMORY_SCOPE_AGENT); }
__device__ __forceinline__ unsigned xb_add(unsigned* p, unsigned v) { return __hip_atomic_fetch_add(p, v, __ATOMIC_RELAXED, __HIP_MEMORY_SCOPE_AGENT); }
__device__ __forceinline__ unsigned xb_xcc_id() { return (unsigned)__builtin_amdgcn_s_getreg((3 << 11) | 20) & 0xFu; }
#define XB_SPIN(cond, bar) do { unsigned _sp = 0; while (cond) { __builtin_amdgcn_s_sleep(1); \
    if ((++_sp & 255u) == 0u) { if (xb_ld(&(bar)[XB_TMO])) break; if (_sp > XB_SPIN_CAP) { atomicAdd(&(bar)[XB_TMO], 1u); break; } } } } while (0)

struct XcdBarrier {
    unsigned* bar; unsigned x;
    volatile LAS unsigned* st;
};

__device__ __forceinline__ XcdBarrier xcd_barrier_post(unsigned* bar, volatile LAS unsigned* st) {
    XcdBarrier b; b.bar = bar; b.x = xb_xcc_id(); b.st = st;
    if (threadIdx.x == 0) (void)xb_add(&bar[XB_XCNT(b.x)], 1u);
    return b;
}
__device__ __forceinline__ void xcd_barrier_complete(unsigned* bar, unsigned x, unsigned& nloc, unsigned& nx) {
    const unsigned G = gridDim.x * gridDim.y * gridDim.z;
    unsigned sum, cnt, mine, sp = 0u;
    for (;;) {
        sum = 0u; cnt = 0u; mine = 0u;
#pragma unroll
        for (unsigned j = 0; j < 16; ++j) { const unsigned c = xb_ld(&bar[XB_XCNT(j)]); sum += c; cnt += (c > 0u) ? 1u : 0u; mine = (j == x) ? c : mine; }
        if (sum == G) break;
        __builtin_amdgcn_s_sleep(1);
        if ((++sp & 255u) == 0u) { if (xb_ld(&bar[XB_TMO])) break; if (sp > XB_SPIN_CAP) { atomicAdd(&bar[XB_TMO], 1u); break; } }
    }
    nloc = mine > 0u ? mine : 1u; nx = cnt > 0u ? cnt : 1u;
}

__device__ __forceinline__ void xcd_barrier(const XcdBarrier& b) {
    asm volatile("s_waitcnt vmcnt(0)" ::: "memory");
    __syncthreads();
    if (threadIdx.x == 0) {
        unsigned* bar = b.bar; unsigned bx = b.x;
        asm volatile("" : "+s"(bar), "+s"(bx));
        __builtin_amdgcn_s_waitcnt(0);
        unsigned nloc = b.st[0], nx = b.st[1];
        if (nloc == 0u) { xcd_barrier_complete(bar, bx, nloc, nx); b.st[0] = nloc; b.st[1] = nx; }
        const unsigned old = xb_add(&bar[XB_XSUB(bx)], 1u);
        const unsigned gen = old / nloc;
        if (old + 1u == (gen + 1u) * nloc) {
            __builtin_amdgcn_fence(__ATOMIC_RELEASE, "agent");
            asm volatile("s_waitcnt vmcnt(0)" ::: "memory");
            const unsigned og = xb_add(&bar[XB_TOP], 1u);
            const unsigned tg = og / nx;
            if (og + 1u == (tg + 1u) * nx) xb_add(&bar[XB_TOPGEN], 1u);
            else XB_SPIN(xb_ld(&bar[XB_TOPGEN]) == tg, bar);
            __builtin_amdgcn_fence(__ATOMIC_ACQUIRE, "agent");
            xb_add(&bar[XB_XGEN(bx)], 1u);
            asm volatile("s_waitcnt vmcnt(0)" ::: "memory");
        } else {
            XB_SPIN(xb_ld(&bar[XB_XGEN(bx)]) == gen, bar);
            __builtin_amdgcn_fence(__ATOMIC_ACQUIRE, "agent");
            asm volatile("s_waitcnt vmcnt(0)" ::: "memory");
        }
    }
    __syncthreads();
}

namespace att {
#define ALAS __attribute__((address_space(3)))
typedef unsigned short bf16;
typedef short bf16x8 __attribute__((ext_vector_type(8)));
typedef short s16x4 __attribute__((ext_vector_type(4)));
typedef float f32x16 __attribute__((ext_vector_type(16)));
typedef unsigned u32x4 __attribute__((ext_vector_type(4)));
constexpr int SEQ = 16384, NHEAD = 8;
constexpr int QP = 768, KP = 768, VP = 1792, OP = 1024;
constexpr int QHS = 96, KHS = 96, VHS = 128, OHS = 64;
constexpr int NW = 8, QBLK = 32, QB = QBLK * NW, KVBLK = 64, NQB = SEQ / QB;
constexpr int KSLOT = 12288, VSLOT = 8192;
constexpr int L_K = 0, L_V = 2 * KSLOT, L_WS = L_V + 2 * VSLOT, L_OST = L_WS + NW * 64 * 4, L_BYTES = L_OST + NW * 4096;
constexpr float THR = 8.0f;
__device__ __forceinline__ int crow(int r, int hi) { return (r & 3) + 8 * (r >> 2) + 4 * hi; }
__device__ __forceinline__ unsigned cvtpk(float lo, float hi) { unsigned r; asm volatile("v_cvt_pk_bf16_f32 %0, %1, %2" : "=v"(r) : "v"(lo), "v"(hi)); return r; }
__device__ __forceinline__ float pswap_max(float m) { auto rr = __builtin_amdgcn_permlane32_swap(__float_as_uint(m), __float_as_uint(m), false, false); return __builtin_fmaxf(__uint_as_float(rr[0]), __uint_as_float(rr[1])); }
__device__ __forceinline__ float pswap_sum(float m) { auto rr = __builtin_amdgcn_permlane32_swap(__float_as_uint(m), __float_as_uint(m), false, false); return __uint_as_float(rr[0]) + __uint_as_float(rr[1]); }

__device__ __forceinline__ void attn_unit(int b, int h, int qb, const bf16* Q, const bf16* K, const bf16* V, bf16* O, ALAS unsigned char* shm) {
    int tid_ = threadIdx.x; asm volatile("" : "+v"(tid_));
    const int tid = tid_, lane = tid & 63, r32 = lane & 31, hi = lane >> 5; const int wid = __builtin_amdgcn_readfirstlane(tid >> 6);
    const long rowbase = (long)b * SEQ; const int q0 = qb * QB;
    const bf16* Qw = Q + (rowbase + q0 + wid * QBLK) * QP + h * QHS;
    const bf16* Kh = K + rowbase * KP + h * KHS; const bf16* Vh = V + rowbase * VP + h * VHS;
    ALAS float* wsf = (ALAS float*)(shm + L_WS) + wid * 64;
    const bf16* ksrc = Kh + (long)lane * KP + wid * 8;
    const bf16* vsrc = Vh + (long)(16 * (wid & 3) + (lane >> 2)) * VP + (wid >> 2) * 32 + (lane & 3) * 8;
#define ATT_DMA(t, slot) do { \
        __builtin_amdgcn_global_load_lds((const unsigned*)(ksrc + (long)(t) * KVBLK * KP), (ALAS unsigned*)(shm + L_K + (slot) * KSLOT + wid * 1024), 16, 0, 0); \
        if (wid < 4) __builtin_amdgcn_global_load_lds((const unsigned*)(ksrc + (long)(t) * KVBLK * KP + 64), (ALAS unsigned*)(shm + L_K + (slot) * KSLOT + (8 + wid) * 1024), 16, 0, 0); \
        __builtin_amdgcn_global_load_lds((const unsigned*)(vsrc + (long)(t) * KVBLK * VP), (ALAS unsigned*)(shm + L_V + (slot) * VSLOT + wid * 1024), 16, 0, 0); } while (0)
    const int NT = (q0 + QB) / KVBLK;
    ATT_DMA(0, 0);
    bf16x8 qr[6];
#pragma unroll
    for (int d0 = 0; d0 < 6; ++d0) qr[d0] = *(const bf16x8*)(Qw + (long)r32 * QP + d0 * 16 + hi * 8);
    float mhat = 0.f, l_reg = 0.f; f32x16 o[2], negm;
#pragma unroll
    for (int r = 0; r < 16; ++r) { o[0][r] = 0.f; o[1][r] = 0.f; negm[r] = 0.f; }
    const int qrel = wid * QBLK + r32;
    const unsigned vb0 = (unsigned)(uintptr_t)(shm + L_V) + ((lane >> 4) & 1) * 32 + (lane & 3) * 8 + (4 * hi + ((lane & 15) >> 2)) * 64;
    for (int t = 0; t < NT; ++t) {
        const int cur = t & 1;
        asm volatile("s_waitcnt vmcnt(0)" ::: "memory"); __syncthreads();
        if (t + 1 < NT) ATT_DMA(t + 1, cur ^ 1);
        f32x16 p0, p1;
        { const ALAS unsigned char* kb = shm + L_K + cur * KSLOT + hi * 1024 + r32 * 16;
#pragma unroll
          for (int d0 = 0; d0 < 6; ++d0) {
              const bf16x8 b0 = *(const ALAS bf16x8*)(kb + d0 * 2048), b1 = *(const ALAS bf16x8*)(kb + d0 * 2048 + 512);
              if (d0 == 0) { p0 = __builtin_amdgcn_mfma_f32_32x32x16_bf16(b0, qr[0], negm, 0, 0, 0); p1 = __builtin_amdgcn_mfma_f32_32x32x16_bf16(b1, qr[0], negm, 0, 0, 0); }
              else { p0 = __builtin_amdgcn_mfma_f32_32x32x16_bf16(b0, qr[d0], p0, 0, 0, 0); p1 = __builtin_amdgcn_mfma_f32_32x32x16_bf16(b1, qr[d0], p1, 0, 0, 0); } } }
        const int jb = t - (NT - 4);
        if (jb >= 0) { const int kb0 = 64 * jb + 4 * hi;
#pragma unroll
            for (int r = 0; r < 16; ++r) { const int kv = kb0 + (r & 3) + 8 * (r >> 2); if (kv > qrel) p0[r] = -__builtin_inff(); if (kv + 32 > qrel) p1[r] = -__builtin_inff(); } }
        float rm = __builtin_fmaxf(p0[0], p1[0]);
#pragma unroll
        for (int r = 1; r < 16; ++r) rm = __builtin_fmaxf(rm, __builtin_fmaxf(p0[r], p1[r]));
        rm = pswap_max(rm);
        bool resc = false;
        if (t == 0 || __any(rm > THR)) {
            const float dl = (t == 0) ? rm : __builtin_fmaxf(rm, 0.f); mhat += dl;
#pragma unroll
            for (int r = 0; r < 16; ++r) { p0[r] -= dl; p1[r] -= dl; negm[r] = -mhat; }
            if (t != 0) { const float f = __builtin_amdgcn_exp2f(-dl); l_reg *= f; if (hi == 0) wsf[r32] = f; resc = true; }
        }
        float sacc = 0.f;
#pragma unroll
        for (int r = 0; r < 16; ++r) { p0[r] = __builtin_amdgcn_exp2f(p0[r]); p1[r] = __builtin_amdgcn_exp2f(p1[r]); sacc += p0[r] + p1[r]; }
        l_reg += sacc;
        if (resc) { asm volatile("s_waitcnt lgkmcnt(0)" ::: "memory");
#pragma unroll
            for (int r = 0; r < 16; ++r) { const float f = wsf[crow(r, hi)]; o[0][r] *= f; o[1][r] *= f; }
            asm volatile("s_waitcnt lgkmcnt(0)" ::: "memory"); }
        u32x4 pw[4];
#pragma unroll
        for (int k = 0; k < 2; ++k) { pw[k] = (u32x4){cvtpk(p0[8 * k], p0[8 * k + 1]), cvtpk(p0[8 * k + 2], p0[8 * k + 3]), cvtpk(p0[8 * k + 4], p0[8 * k + 5]), cvtpk(p0[8 * k + 6], p0[8 * k + 7])};
            pw[2 + k] = (u32x4){cvtpk(p1[8 * k], p1[8 * k + 1]), cvtpk(p1[8 * k + 2], p1[8 * k + 3]), cvtpk(p1[8 * k + 4], p1[8 * k + 5]), cvtpk(p1[8 * k + 6], p1[8 * k + 7])}; }
        { const unsigned vb = vb0 + cur * VSLOT;
#pragma unroll
          for (int d0 = 0; d0 < 2; ++d0) { s16x4 lo[4], hh[4];
#pragma unroll
              for (int ks = 0; ks < 4; ++ks) {
                  asm volatile("ds_read_b64_tr_b16 %0, %1 offset:%c2" : "=&v"(lo[ks]) : "v"(vb), "i"(d0 * 4096 + ks * 1024) : "memory");
                  asm volatile("ds_read_b64_tr_b16 %0, %1 offset:%c2" : "=&v"(hh[ks]) : "v"(vb), "i"(d0 * 4096 + ks * 1024 + 512) : "memory"); }
              asm volatile("s_waitcnt lgkmcnt(0)" : "+v"(lo[0]), "+v"(lo[1]), "+v"(lo[2]), "+v"(lo[3]), "+v"(hh[0]), "+v"(hh[1]), "+v"(hh[2]), "+v"(hh[3]) :: "memory");
#pragma unroll
              for (int ks = 0; ks < 4; ++ks) { const bf16x8 vf = (bf16x8){lo[ks][0], lo[ks][1], lo[ks][2], lo[ks][3], hh[ks][0], hh[ks][1], hh[ks][2], hh[ks][3]};
                  o[d0] = __builtin_amdgcn_mfma_f32_32x32x16_bf16(__builtin_bit_cast(bf16x8, pw[ks]), vf, o[d0], 0, 0, 0); } } }
    }
    l_reg = pswap_sum(l_reg);
    if (hi == 0) wsf[32 + r32] = l_reg;
    asm volatile("s_waitcnt lgkmcnt(0)" ::: "memory");
    float rli[16];
#pragma unroll
    for (int r = 0; r < 16; ++r) rli[r] = __builtin_amdgcn_rcpf(wsf[32 + crow(r, hi)]);
    bf16* Ow = O + (rowbase + q0 + wid * QBLK) * OP + h * OHS;
    { ALAS bf16* stg = (ALAS bf16*)(shm + L_OST) + wid * 2048;
#pragma unroll
      for (int r = 0; r < 16; ++r) { const int orow = crow(r, hi);
#pragma unroll
          for (int d0 = 0; d0 < 2; ++d0) { const float v = o[d0][r] * rli[r]; unsigned u = __float_as_uint(v); u = (u + 0x7fffu + ((u >> 16) & 1u)) >> 16; stg[orow * 64 + d0 * 32 + r32] = (bf16)u; } }
      asm volatile("s_waitcnt lgkmcnt(0)" ::: "memory");
#pragma unroll
      for (int i = 0; i < 4; ++i) { const int row = i * 8 + (lane >> 3), ch = lane & 7; const u32x4 v = *(const ALAS u32x4*)(stg + row * 64 + ch * 8); *(u32x4*)(Ow + (long)row * OP + ch * 8) = v; } }
    asm volatile("s_waitcnt lgkmcnt(0)" ::: "memory"); __syncthreads();
#undef ATT_DMA
}
#undef ALAS
}

constexpr int NB = 2, SEQ = 16384, D = 1024, NTOK = NB * SEQ, DEPTH = 4;
constexpr int INCOLS = 1440, INP = 1536;
constexpr int UPK = 384, UPN = 1792;
constexpr int LRUW = 512;
constexpr int DFF = 2816, NEXP = 8, DFE = 3584;
constexpr int MOE_TILES = (2 * NTOK) / 256 + NEXP;
constexpr int PASS_TILES = MOE_TILES / 2;
constexpr float EPS = 1e-6f;
constexpr int NWAVES = 8;

constexpr size_t MiB = 1u << 20;
constexpr size_t WS_CTL = 0, CTL_ZERO_BYTES = 1 * MiB;
constexpr size_t WS_MODP = 1 * MiB;
constexpr size_t WS_MOD = 1 * MiB + 768 * 1024;
constexpr size_t WS_COS = 2 * MiB, WS_SIN = 4 * MiB;
constexpr size_t WS_LAMC = 6 * MiB;
constexpr size_t WS_TOKE = 7 * MiB, WS_TOKR = WS_TOKE + 256 * 1024, WS_TOKW = WS_TOKR + 256 * 1024, WS_TOKP = WS_TOKW + 256 * 1024;
constexpr size_t WS_RTE = 8 * MiB;
constexpr size_t WS_PL = 9 * MiB, WS_HC = 9 * MiB + 512 * 1024;
constexpr size_t WS_WSMALL = 16 * MiB, WSMALL_STRIDE = 8 * MiB;
constexpr size_t WS_WDENSE = 48 * MiB, WDENSE_STRIDE = 17 * MiB;
constexpr size_t WS_WMOE_GU = 82 * MiB, WS_WMOE_D = 194 * MiB;
constexpr size_t WS_H = 250 * MiB;
constexpr size_t WS_Z = 314 * MiB, WS_A2 = 410 * MiB, WS_XR = 434 * MiB, WS_QKV = 466 * MiB, WS_Q = 578 * MiB, WS_K = 626 * MiB, WS_LA = 674 * MiB, WS_U = 738 * MiB, WS_Y = 802 * MiB;
constexpr size_t WS_HID = 314 * MiB;
constexpr size_t WS_HS = 314 * MiB, WS_MHID = 446 * MiB, WS_Y2 = 677 * MiB;
constexpr size_t WS_END = 866 * MiB;
static_assert(WS_MHID + (size_t)PASS_TILES * 256 * DFE * 2 <= WS_Y2 && WS_HS + (size_t)MOE_TILES * 256 * D * 2 <= WS_MHID && WS_Y2 + (size_t)MOE_TILES * 256 * D * 2 <= WS_END, "MoE map");
static_assert(WS_HID + (size_t)NTOK * DFF * 2 <= WS_END && WS_Y + (size_t)NTOK * D * 2 <= WS_END, "map");
constexpr int CW_TMO = 0, CW_CODE = 1, CW_BAR = 4096, CW_GCNT = 8192;

constexpr int RING_BYTES = 131072, LDSCTL_OFF = RING_BYTES, MISC_OFF = LDSCTL_OFF + 320, LDS_BYTES = 147456;

struct Frame {
    LAS unsigned char* lds; volatile LAS unsigned* MISC; gu32* ctl;
    int tid, lane, wave, vcu, G, gw, NGW;
    float* out; unsigned char* ws;
    __device__ __forceinline__ void refresh() { int t = threadIdx.x; asm volatile("" : "+v"(t)); tid = t; lane = t & 63; wave = __builtin_amdgcn_readfirstlane(t >> 6); gw = vcu * 8 + wave; }
};
template <int K> __device__ __forceinline__ const void* in_ptr() {
    unsigned long long p; const __attribute__((address_space(4))) void* ka = (const __attribute__((address_space(4))) void*)__builtin_amdgcn_kernarg_segment_ptr();
    asm volatile("s_load_dwordx2 %0, %1, %2\n\ts_waitcnt lgkmcnt(0)" : "=s"(p) : "s"(ka), "i"(8 * K) : "memory");
    return (const void*)p;
}
#define INF(K) ((const float*)in_ptr<K>())
template <class T> __device__ __forceinline__ T* wsp(const Frame& F, size_t off) { asm volatile("" : "+s"(off)); return (T*)(F.ws + off); }
enum { I_X = 0, I_C, I_POS, I_WADA, I_BADA, I_NGAIN, I_WIN, I_LGAIN, I_WQUP, I_WKVUP, I_QGAIN, I_KGAIN, I_CONVW, I_CONVB, I_WA, I_BA, I_WX, I_BX, I_LAM, I_OGAIN, I_WOUT, I_FWG, I_FWU, I_FWD, I_RW, I_MWG, I_MWU, I_MWD };

__device__ __forceinline__ float wave_sum(float v) {
#pragma unroll
    for (int o = 1; o < 64; o <<= 1) v += __shfl_xor(v, o);
    return v;
}
__device__ __forceinline__ float bflo(unsigned w) { return __uint_as_float(w << 16); }
__device__ __forceinline__ float bfhi(unsigned w) { return __uint_as_float(w & 0xffff0000u); }
__device__ __forceinline__ float bf1(bf16 v) { return __uint_as_float((unsigned)v << 16); }

__device__ __forceinline__ void transpose_item(const float* W, int ldw, int k0, int n0, bf16* WT, int ldt, int drow0, int dk0, LAS float* scr, int lane) {
#pragma unroll 8
    for (int i = 0; i < 32; ++i) { const int kk = 2 * i + (lane >> 5); scr[kk * 33 + (lane & 31)] = W[(size_t)(k0 + kk) * ldw + n0 + (lane & 31)]; }
    LDS_WAIT(); asm volatile("" ::: "memory");
    const int c = lane & 7;
#pragma unroll
    for (int j = 0; j < 4; ++j) { const int n = (lane >> 3) + 8 * j; const LAS float* s = scr + (8 * c) * 33 + n;
        v4u o; o.x = pk2(s[0 * 33], s[1 * 33]); o.y = pk2(s[2 * 33], s[3 * 33]); o.z = pk2(s[4 * 33], s[5 * 33]); o.w = pk2(s[6 * 33], s[7 * 33]);
        *(GAS v4u*)(WT + (size_t)(drow0 + n) * ldt + dk0 + k0 + 8 * c) = o; }
    LDS_WAIT(); asm volatile("" ::: "memory");
}
struct CDesc { const float* W; bf16* WT; int K, N, ldt, roff, dk0, map; };
__device__ __forceinline__ void conv_run(Frame& F, const CDesc& d) {
    LAS float* scr = (LAS float*)(F.lds + F.wave * 16384);
    const int nblk = d.N / 32, items = (d.K / 64) * nblk;
    for (int it = F.gw; it < items; it += F.NGW) { const int kb = it / nblk, nb = it % nblk, n0 = 32 * nb;
        const int drow0 = d.map == 0 ? n0 + d.roff : (d.map == 1 ? (n0 >= 416 ? n0 + 96 : n0) : 256 * (n0 / 128) + (n0 % 128) + d.roff);
        transpose_item(d.W, d.N, 64 * kb, n0, d.WT, d.ldt, drow0, d.dk0, scr, F.lane); }
}
__device__ __forceinline__ CDesc conv_desc(Frame& F, int idx, int moe_j) {
    CDesc d;
    if (idx < 16) { const int l = idx >> 2, m = idx & 3; bf16* base = wsp<bf16>(F, WS_WSMALL + (size_t)l * WSMALL_STRIDE);
        if (m == 0)      d = CDesc{INF(I_WIN) + (size_t)l * D * INCOLS, base, D, INCOLS, D, 0, 0, 1};
        else if (m == 1) d = CDesc{INF(I_WQUP) + (size_t)l * 256 * 768, base + 3 * MiB / 2, 256, 768, UPK, 0, 0, 0};
        else if (m == 2) d = CDesc{INF(I_WKVUP) + (size_t)l * 128 * 1024, base + 3 * MiB / 2, 128, 1024, UPK, 768, 256, 0};
        else             d = CDesc{INF(I_WOUT) + (size_t)l * D * D, base + 6 * MiB / 2, D, D, D, 0, 0, 0};
    } else if (idx < 22) { const int j = (idx - 16) / 3, m = (idx - 16) % 3; bf16* base = wsp<bf16>(F, WS_WDENSE + (size_t)j * WDENSE_STRIDE);
        if (m == 0)      d = CDesc{INF(I_FWG) + (size_t)j * D * DFF, base, D, DFF, D, 0, 0, 2};
        else if (m == 1) d = CDesc{INF(I_FWU) + (size_t)j * D * DFF, base, D, DFF, D, 128, 0, 2};
        else             d = CDesc{INF(I_FWD) + (size_t)j * DFF * D, base + (size_t)11 * MiB / 2, DFF, D, DFF, 0, 0, 0};
    } else { const int e = (idx - 22) / 3, m = (idx - 22) % 3; const size_t we = (size_t)(moe_j * NEXP + e) * D * DFE;
        if (m == 0)      d = CDesc{INF(I_MWG) + we, wsp<bf16>(F, WS_WMOE_GU) + (size_t)e * 2 * DFE * D, D, DFE, D, 0, 0, 2};
        else if (m == 1) d = CDesc{INF(I_MWU) + we, wsp<bf16>(F, WS_WMOE_GU) + (size_t)e * 2 * DFE * D, D, DFE, D, 128, 0, 2};
        else             d = CDesc{INF(I_MWD) + we, wsp<bf16>(F, WS_WMOE_D) + (size_t)e * D * DFE, DFE, D, DFE, 0, 0, 0};
    }
    return d;
}
__device__ __forceinline__ void convert_range(Frame& F, int lo, int hi, int moe_j) {
    F.refresh();
    for (int idx = lo; idx < hi; ++idx) { const CDesc d = conv_desc(F, idx, moe_j); conv_run(F, d); }
}
__device__ __forceinline__ void zero_block(Frame& F, bf16* WT, int ldt, int r0, int rows, int c0, int cols) {
    const int cpr = cols / 8, n = rows * cpr;
    for (int i = F.gw * 64 + F.lane; i < n; i += F.NGW * 64) { const int r = i / cpr, cc = i % cpr; *(GAS v4u*)(WT + (size_t)(r0 + r) * ldt + c0 + 8 * cc) = (v4u){0u, 0u, 0u, 0u}; }
}
__device__ __forceinline__ void p0_prologue(Frame& F) {
    F.refresh();
    {
      const float* w_ada = INF(I_WADA); const float* cc = INF(I_C); float* modp = wsp<float>(F, WS_MODP);
      for (int task = F.gw; task < 8 * 4 * 48; task += F.NGW) {
        const int jb = task % 48, kq = (task / 48) % 4, ls = task / 192, j = jb * 64 + F.lane;
        const float* W = w_ada + (size_t)ls * D * 3072 + j; float a0 = 0.f, a1 = 0.f;
#pragma unroll 8
        for (int k = kq * 256; k < kq * 256 + 256; ++k) { const float c0 = cc[k], c1 = cc[D + k]; const float w = W[(size_t)k * 3072];
            a0 += c0 * pg8::sigmoidf_(c0) * w; a1 += c1 * pg8::sigmoidf_(c1) * w; }
        modp[((size_t)(kq * 8 + ls) * 2 + 0) * 3072 + j] = a0; modp[((size_t)(kq * 8 + ls) * 2 + 1) * 3072 + j] = a1;
      } }
    {
      const int* positions = (const int*)in_ptr<I_POS>(); float* cosT = wsp<float>(F, WS_COS); float* sinT = wsp<float>(F, WS_SIN);
      for (int i = F.gw * 64 + F.lane; i < NTOK * 16; i += F.NGW * 64) { const int row = i >> 4, j = i & 15;
        const float invf = __builtin_amdgcn_exp2f(-(float)j * (13.287712379549449f / 16.0f));
        const float ang = (float)positions[row] * invf;
        const float rev = ang * 0.15915494309189535f; const float fr = rev - __builtin_floorf(rev);
        cosT[i] = __builtin_amdgcn_cosf(fr); sinT[i] = __builtin_amdgcn_sinf(fr); } }
    {
      const float* lam = INF(I_LAM); float* lamc = wsp<float>(F, WS_LAMC);
      for (int i = F.gw * 64 + F.lane; i < DEPTH * LRUW; i += F.NGW * 64) { const float t = __builtin_amdgcn_exp2f(-1.4426950408889634f * lam[i]); lamc[i] = t < 0.02f ? -8.0f * 1.4426950408889634f * t * (1.0f - t * (0.5f - t * (0.33333334f - 0.25f * t))) : -8.0f * __builtin_amdgcn_logf(1.0f + t); } }
    convert_range(F, 0, 46, 0);
    for (int l = 0; l < DEPTH; ++l) {
        bf16* Win_t = wsp<bf16>(F, WS_WSMALL + (size_t)l * WSMALL_STRIDE); bf16* Wup_t = Win_t + 3 * MiB / 2; bf16* Wg_t = Win_t + 5 * MiB / 2;
        zero_block(F, Win_t, D, 416, 96, 0, D);
        zero_block(F, Wup_t, UPK, 0, 768, 256, 128);
        zero_block(F, Wup_t, UPK, 768, 1024, 0, 256);
        const float* w_a = INF(I_WA); const float* w_x = INF(I_WX);
        for (int i = F.gw * 64 + F.lane; i < 1024 * 512; i += F.NGW * 64) { const int row = i >> 9, k = i & 511, pn = row >> 8, half = (row >> 7) & 1, ch = 128 * pn + (row & 127), g = ch >> 6;
            float v = 0.f; if ((k >> 6) == g) v = (half ? w_x : w_a)[(((size_t)l * 8 + g) * 64 + (k & 63)) * 64 + (ch & 63)];
            Wg_t[i] = (bf16)f2bf(v); }
    }
}
__device__ __forceinline__ void p0_finalise(Frame& F) {
    F.refresh();
    const float* b_ada = INF(I_BADA); const float* modp = wsp<float>(F, WS_MODP); float* mod = wsp<float>(F, WS_MOD);
    for (int i = F.gw * 64 + F.lane; i < 8 * 2 * 3072; i += F.NGW * 64) { const int j = i % 3072, ls = i / 6144;
        float v = b_ada[ls * 3072 + j];
#pragma unroll
        for (int kq = 0; kq < 4; ++kq) v += modp[(size_t)kq * 8 * 2 * 3072 + i];
        mod[i] = v; }
}

template <bool COMBINE, bool NORM, bool ROUTER>
__device__ __forceinline__ void norm_pass(Frame& F, const float* xin, float* xout, int ls, int ls_prev, int moe_j) {
    F.refresh();
    LAS float* gs = (LAS float*)(F.lds); LAS float* sh = gs + 2048;
    LAS int* lcnt = (LAS int*)(F.lds + 16384); LAS int* gbase = lcnt + 16; LAS int* ltab = lcnt + 32;
    const int lane = F.lane;
    const float* mod = wsp<float>(F, WS_MOD); bf16* hbuf = wsp<bf16>(F, WS_H);
    int* tok_e = wsp<int>(F, WS_TOKE); int* tok_r = wsp<int>(F, WS_TOKR); float* tok_w = wsp<float>(F, WS_TOKW); const int* tok_p = wsp<int>(F, WS_TOKP); const bf16* y2 = wsp<bf16>(F, WS_Y2);
    if (NORM) { const float* modl = mod + (size_t)ls * 2 * 3072; const float* ng = INF(I_NGAIN) + (size_t)ls * D;
        for (int i = F.tid; i < 2048; i += NWAVES * 64) { const int b = i >> 10, j = i & 1023; gs[i] = ng[j] * (1.0f + modl[b * 3072 + 1024 + j]); sh[i] = modl[b * 3072 + j]; } }
    const float* rw = ROUTER ? INF(I_RW) + (size_t)moe_j * D * 8 : nullptr;
    __syncthreads();
    for (int blk = F.vcu; blk < NTOK / 128; blk += F.G) {
        if (ROUTER) { if (F.tid < 8) lcnt[F.tid] = 0; __syncthreads(); }
        for (int i = 0; i < 16; ++i) {
            const int row = blk * 128 + F.wave * 16 + i, b = row >> 14;
            const GAS f32x4* xr = (const GAS f32x4*)(xin + (size_t)row * D) + lane;
            f32x4 v[4];
#pragma unroll
            for (int j = 0; j < 4; ++j) v[j] = xr[64 * j];
            if (COMBINE) {
                const int p0 = tok_p[row * 2], p1 = tok_p[row * 2 + 1]; const float w0 = tok_w[row * 2], w1 = tok_w[row * 2 + 1];
                const float* gp = mod + (size_t)ls_prev * 2 * 3072 + b * 3072 + 2048;
                GAS f32x4* xo = (GAS f32x4*)(xout + (size_t)row * D) + lane;
#pragma unroll
                for (int j = 0; j < 4; ++j) { const uint2 ya = *(const uint2*)(y2 + (size_t)p0 * D + 4 * lane + 256 * j), yb = *(const uint2*)(y2 + (size_t)p1 * D + 4 * lane + 256 * j);
                    const f32x4 g = *(const f32x4*)(gp + 4 * lane + 256 * j);
                    v[j].x += g.x * (w0 * bflo(ya.x) + w1 * bflo(yb.x)); v[j].y += g.y * (w0 * bfhi(ya.x) + w1 * bfhi(yb.x));
                    v[j].z += g.z * (w0 * bflo(ya.y) + w1 * bflo(yb.y)); v[j].w += g.w * (w0 * bfhi(ya.y) + w1 * bfhi(yb.y));
                    xo[64 * j] = v[j]; }
            }
            if (NORM) {
                float ss = 0.f;
#pragma unroll
                for (int j = 0; j < 4; ++j) ss += (v[j].x * v[j].x + v[j].y * v[j].y) + (v[j].z * v[j].z + v[j].w * v[j].w);
                const float rstd = 1.0f / sqrtf(wave_sum(ss) * (1.0f / D) + EPS);
                GAS unsigned long long* o8 = (GAS unsigned long long*)(hbuf + (size_t)row * D) + lane;
#pragma unroll
                for (int j = 0; j < 4; ++j) { const f32x4 g = *(const LAS f32x4*)(gs + b * 1024 + 4 * lane + 256 * j), s = *(const LAS f32x4*)(sh + b * 1024 + 4 * lane + 256 * j);
                    v[j] = v[j] * rstd * g + s;
                    o8[64 * j] = (unsigned long long)pk2(v[j].x, v[j].y) | ((unsigned long long)pk2(v[j].z, v[j].w) << 32); }
                if (ROUTER) {
                    float lg[8];
#pragma unroll
                    for (int e = 0; e < 8; ++e) lg[e] = 0.f;
#pragma unroll
                    for (int j = 0; j < 4; ++j)
#pragma unroll
                        for (int q = 0; q < 4; ++q) { const float hv = v[j][q]; const f32x4* wp = (const f32x4*)(rw + (size_t)(4 * lane + 256 * j + q) * 8); const f32x4 wa = wp[0], wb = wp[1];
                            lg[0] += hv * wa.x; lg[1] += hv * wa.y; lg[2] += hv * wa.z; lg[3] += hv * wa.w; lg[4] += hv * wb.x; lg[5] += hv * wb.y; lg[6] += hv * wb.z; lg[7] += hv * wb.w; }
#pragma unroll
                    for (int e = 0; e < 8; ++e) lg[e] = wave_sum(lg[e]);
                    int e0 = 0; float v0 = lg[0];
#pragma unroll
                    for (int e = 1; e < 8; ++e) if (lg[e] > v0) { v0 = lg[e]; e0 = e; }
                    int e1 = 0; float v1 = -__builtin_inff();
#pragma unroll
                    for (int e = 0; e < 8; ++e) if (e != e0 && lg[e] > v1) { v1 = lg[e]; e1 = e; }
                    const float w0 = 1.0f / (1.0f + __builtin_amdgcn_exp2f(1.4426950408889634f * (v1 - v0))), w1 = 1.0f - w0;
                    if (lane == 0) { const int r0 = __hip_atomic_fetch_add(lcnt + e0, 1, __ATOMIC_RELAXED, __HIP_MEMORY_SCOPE_WORKGROUP), r1 = __hip_atomic_fetch_add(lcnt + e1, 1, __ATOMIC_RELAXED, __HIP_MEMORY_SCOPE_WORKGROUP);
                        LAS int* lt = ltab + (F.wave * 16 + i) * 8; lt[0] = e0; lt[1] = e1; lt[2] = r0; lt[3] = r1; lt[4] = (int)__float_as_uint(w0); lt[5] = (int)__float_as_uint(w1); }
                }
            }
        }
        if (ROUTER) {
            __syncthreads();
            if (F.tid < 8) gbase[F.tid] = (int)__hip_atomic_fetch_add((unsigned*)(F.ctl + CW_GCNT + 64 * (8 * moe_j + F.tid)), (unsigned)lcnt[F.tid], RLX_AGENT);
            __syncthreads();
            if (F.tid < 128) { const int row = blk * 128 + F.tid; const LAS int* lt = ltab + F.tid * 8; const int e0 = lt[0], e1 = lt[1];
                tok_e[row * 2] = e0; tok_e[row * 2 + 1] = e1; tok_r[row * 2] = gbase[e0] + lt[2]; tok_r[row * 2 + 1] = gbase[e1] + lt[3];
                tok_w[row * 2] = __uint_as_float((unsigned)lt[4]); tok_w[row * 2 + 1] = __uint_as_float((unsigned)lt[5]); }
            __syncthreads();
        }
    }
    __syncthreads();
}

__device__ __forceinline__ void mid_pass(Frame& F, int l) {
    F.refresh();
    const int lane = F.lane;
    const bf16* z = wsp<bf16>(F, WS_Z); bf16* A2 = wsp<bf16>(F, WS_A2); bf16* Kb = wsp<bf16>(F, WS_K); bf16* xrb = wsp<bf16>(F, WS_XR);
    const float* cosT = wsp<float>(F, WS_COS); const float* sinT = wsp<float>(F, WS_SIN);
    const float* lg = INF(I_LGAIN) + l * 384; const f32x4 lgq = *(const f32x4*)(lg + 4 * lane); const f32x4 lgkv = *(const f32x4*)(lg + 256 + 4 * (lane & 31));
    const float* kg = INF(I_KGAIN) + l * 96; const float kg1 = kg[64 + (lane & 15)], kg2 = kg[80 + (lane & 15)];
    const float* conv_w = INF(I_CONVW); const float* conv_b = INF(I_CONVB);
    float cw[4][8], cb[8];
#pragma unroll
    for (int e = 0; e < 8; ++e) { cb[e] = conv_b[l * 512 + 8 * lane + e];
#pragma unroll
        for (int j = 0; j < 4; ++j) cw[j][e] = conv_w[(size_t)(l * 4 + j) * 512 + 8 * lane + e]; }
    for (int row = F.gw; row < NTOK; row += F.NGW) {
        const bf16* zr = z + (size_t)row * INP;
        const uint2 q2 = *(const uint2*)(zr + 4 * lane); const float q0 = bflo(q2.x), q1 = bfhi(q2.x), q2f = bflo(q2.y), q3 = bfhi(q2.y);
        float ssq = (q0 * q0 + q1 * q1) + (q2f * q2f + q3 * q3);
        const uint2 k2 = *(const uint2*)(zr + 256 + 4 * (lane & 31)); const float k0 = bflo(k2.x), k1 = bfhi(k2.x), k2f = bflo(k2.y), k3 = bfhi(k2.y);
        float sskv = lane < 32 ? (k0 * k0 + k1 * k1) + (k2f * k2f + k3 * k3) : 0.f;
        const float x1 = bf1(zr[384 + (lane & 15)]), x2 = bf1(zr[400 + (lane & 15)]);
        float ssr = lane < 16 ? x1 * x1 + x2 * x2 : 0.f;
        ssq = wave_sum(ssq); sskv = wave_sum(sskv); ssr = wave_sum(ssr);
        const float rq = 1.0f / sqrtf(ssq * (1.0f / 256.0f) + EPS), rkv = 1.0f / sqrtf(sskv * (1.0f / 128.0f) + EPS), rr = 1.0f / sqrtf(ssr * (1.0f / 32.0f) + EPS);
        bf16* a2 = A2 + (size_t)row * UPK;
        *(uint2*)(a2 + 4 * lane) = make_uint2(pk2(q0 * rq * lgq.x, q1 * rq * lgq.y), pk2(q2f * rq * lgq.z, q3 * rq * lgq.w));
        if (lane < 32) *(uint2*)(a2 + 256 + 4 * lane) = make_uint2(pk2(k0 * rkv * lgkv.x, k1 * rkv * lgkv.y), pk2(k2f * rkv * lgkv.z, k3 * rkv * lgkv.w));
        if (lane < 16) { const float cs = cosT[row * 16 + lane], sn = sinT[row * 16 + lane]; const float a = x1 * rr * kg1, bb = x2 * rr * kg2;
            const bf16 o1 = (bf16)f2bf(a * cs - bb * sn), o2 = (bf16)f2bf(a * sn + bb * cs); bf16* kr = Kb + (size_t)row * 768 + 64 + lane;
#pragma unroll
            for (int hh = 0; hh < 8; ++hh) { kr[hh * 96] = o1; kr[hh * 96 + 16] = o2; } }
        const int t = row & (SEQ - 1); float acc[8];
#pragma unroll
        for (int e = 0; e < 8; ++e) acc[e] = cb[e];
#pragma unroll
        for (int j = 0; j < 4; ++j) { if (t - 3 + j >= 0) { const v4u xw = *(const v4u*)(zr + (long)(j - 3) * INP + 512 + 8 * lane);
                acc[0] += cw[j][0] * bflo(xw.x); acc[1] += cw[j][1] * bfhi(xw.x); acc[2] += cw[j][2] * bflo(xw.y); acc[3] += cw[j][3] * bfhi(xw.y);
                acc[4] += cw[j][4] * bflo(xw.z); acc[5] += cw[j][5] * bfhi(xw.z); acc[6] += cw[j][6] * bflo(xw.w); acc[7] += cw[j][7] * bfhi(xw.w); } }
        *(v4u*)(xrb + (size_t)row * LRUW + 8 * lane) = (v4u){pk2(acc[0], acc[1]), pk2(acc[2], acc[3]), pk2(acc[4], acc[5]), pk2(acc[6], acc[7])};
    }
}

__device__ __forceinline__ void qk_pass(Frame& F, int l) {
    F.refresh();
    const int lane = F.lane, g8 = lane & 7, h8 = lane >> 3, g4 = lane & 3, h4 = (lane >> 2) & 7;
    const float C2 = 0.10206207261596577f * 1.4426950408889634f;
    const bf16* qkv = wsp<bf16>(F, WS_QKV); bf16* Qb = wsp<bf16>(F, WS_Q); bf16* Kb = wsp<bf16>(F, WS_K);
    const float* cosT = wsp<float>(F, WS_COS); const float* sinT = wsp<float>(F, WS_SIN);
    const float* q_gain = INF(I_QGAIN) + l * 96; const float* k_gain = INF(I_KGAIN) + l * 96;
    float qgn[8], kgn[8], qgr[8];
#pragma unroll
    for (int e = 0; e < 8; ++e) { qgn[e] = q_gain[g8 * 8 + e]; kgn[e] = k_gain[g8 * 8 + e]; qgr[e] = q_gain[64 + g4 * 8 + e]; }
    for (int row = F.gw; row < NTOK; row += F.NGW) {
        const bf16* qr = qkv + (size_t)row * UPN;
        float v[8], o[8];
#define LD8(dst, p) do { const v4u w_ = *(const v4u*)(p); dst[0] = bflo(w_.x); dst[1] = bfhi(w_.x); dst[2] = bflo(w_.y); dst[3] = bfhi(w_.y); dst[4] = bflo(w_.z); dst[5] = bfhi(w_.z); dst[6] = bflo(w_.w); dst[7] = bfhi(w_.w); } while (0)
#define ST8(p, s) do { *(v4u*)(p) = (v4u){pk2(s[0], s[1]), pk2(s[2], s[3]), pk2(s[4], s[5]), pk2(s[6], s[7])}; } while (0)
        LD8(v, qr + h8 * 96 + g8 * 8);
        { float ss = 0.f;
#pragma unroll
          for (int e = 0; e < 8; ++e) ss += v[e] * v[e];
          ss += __shfl_xor(ss, 1); ss += __shfl_xor(ss, 2); ss += __shfl_xor(ss, 4);
          const float rs = C2 / sqrtf(ss * (1.0f / 64.0f) + EPS);
#pragma unroll
          for (int e = 0; e < 8; ++e) o[e] = v[e] * rs * qgn[e];
          ST8(Qb + (size_t)row * 768 + h8 * 96 + g8 * 8, o); }
        LD8(v, qr + 768 + h8 * 128 + g8 * 8);
        { float ss = 0.f;
#pragma unroll
          for (int e = 0; e < 8; ++e) ss += v[e] * v[e];
          ss += __shfl_xor(ss, 1); ss += __shfl_xor(ss, 2); ss += __shfl_xor(ss, 4);
          const float rs = 1.0f / sqrtf(ss * (1.0f / 64.0f) + EPS);
#pragma unroll
          for (int e = 0; e < 8; ++e) o[e] = v[e] * rs * kgn[e];
          ST8(Kb + (size_t)row * 768 + h8 * 96 + g8 * 8, o); }
        LD8(v, qr + h4 * 96 + 64 + g4 * 8);
        { float ss = 0.f;
#pragma unroll
          for (int e = 0; e < 8; ++e) ss += v[e] * v[e];
          ss += __shfl_xor(ss, 1); ss += __shfl_xor(ss, 2);
          const float rs = 1.0f / sqrtf(ss * (1.0f / 32.0f) + EPS);
          const f32x4 ca = *(const f32x4*)(cosT + row * 16 + (g4 & 1) * 8), cb_ = *(const f32x4*)(cosT + row * 16 + (g4 & 1) * 8 + 4);
          const f32x4 sa = *(const f32x4*)(sinT + row * 16 + (g4 & 1) * 8), sb = *(const f32x4*)(sinT + row * 16 + (g4 & 1) * 8 + 4);
#pragma unroll
          for (int e = 0; e < 8; ++e) { const float vn = v[e] * rs * qgr[e]; const float pe = __shfl_xor(vn, 2);
              const float cs = e < 4 ? ca[e & 3] : cb_[e & 3], sn = e < 4 ? sa[e & 3] : sb[e & 3];
              o[e] = (g4 < 2 ? vn * cs - pe * sn : pe * sn + vn * cs) * C2; }
          if (lane < 32) ST8(Qb + (size_t)row * 768 + h4 * 96 + 64 + g4 * 8, o); }
#undef LD8
#undef ST8
    }
}

__device__ __forceinline__ void scan_a(Frame& F) {
    F.refresh();
    const int ch = F.tid;
    const float* la = wsp<float>(F, WS_LA); const float* ub = wsp<float>(F, WS_U); float* Pl = wsp<float>(F, WS_PL); float* Hc = wsp<float>(F, WS_HC);
    for (int un = F.vcu; un < 256; un += F.G) {
        const size_t r0 = (size_t)un * 128; float S = 0.f, H = 0.f;
#pragma unroll 8
        for (int t = 0; t < 128; ++t) { const float l2 = la[(r0 + t) * LRUW + ch], uu = ub[(r0 + t) * LRUW + ch]; H = __builtin_amdgcn_exp2f(l2) * H + uu; S += l2; }
        Pl[(size_t)un * LRUW + ch] = S; Hc[(size_t)un * LRUW + ch] = H;
    }
}
__device__ __forceinline__ float gelu_tanh(float x) {
    const float y = 0.7978845608028654f * (x + 0.044715f * x * x * x);
    return x * __builtin_amdgcn_rcpf(1.0f + __builtin_amdgcn_exp2f(-2.0f * 1.4426950408889634f * y));
}
__device__ __forceinline__ void scan_c(Frame& F, int l) {
    F.refresh();
    const int ch = F.tid, lane = F.lane;
    LAS float* st = (LAS float*)F.lds;
    const float* la = wsp<float>(F, WS_LA); const float* ub = wsp<float>(F, WS_U); const float* Pl = wsp<float>(F, WS_PL); const float* Hc = wsp<float>(F, WS_HC);
    const bf16* z = wsp<bf16>(F, WS_Z); bf16* y = wsp<bf16>(F, WS_Y);
    const float* out_gain = INF(I_OGAIN) + l * D + 512;
    float og[8];
#pragma unroll
    for (int e = 0; e < 8; ++e) og[e] = out_gain[8 * lane + e];
    for (int un = F.vcu; un < 256; un += F.G) {
        const int c = un & 127, b = un >> 7; const size_t r0 = (size_t)un * 128;
        float hst = 0.f;
#pragma unroll 8
        for (int cc = 0; cc < c; ++cc) { const size_t o = (size_t)(b * 128 + cc) * LRUW + ch; hst = __builtin_amdgcn_exp2f(Pl[o]) * hst + Hc[o]; }
        for (int sub = 0; sub < 4; ++sub) {
#pragma unroll 8
            for (int t = 0; t < 32; ++t) { const size_t row = r0 + sub * 32 + t; const float l2 = la[row * LRUW + ch], uu = ub[row * LRUW + ch];
                hst = __builtin_amdgcn_exp2f(l2) * hst + uu; const float g = bf1(z[row * INP + 1024 + ch]); st[t * 512 + ch] = hst * gelu_tanh(g); }
            __syncthreads();
#pragma unroll
            for (int tt = 0; tt < 4; ++tt) { const int t = F.wave * 4 + tt; const size_t row = r0 + sub * 32 + t;
                const f32x4 a = *(const LAS f32x4*)(st + t * 512 + 8 * lane), bq = *(const LAS f32x4*)(st + t * 512 + 8 * lane + 4);
                float ss = (a.x * a.x + a.y * a.y) + (a.z * a.z + a.w * a.w) + (bq.x * bq.x + bq.y * bq.y) + (bq.z * bq.z + bq.w * bq.w);
                const float rs = 1.0f / sqrtf(wave_sum(ss) * (1.0f / 512.0f) + EPS);
                *(v4u*)(y + row * D + 512 + 8 * lane) = (v4u){pk2(a.x * rs * og[0], a.y * rs * og[1]), pk2(a.z * rs * og[2], a.w * rs * og[3]), pk2(bq.x * rs * og[4], bq.y * rs * og[5]), pk2(bq.z * rs * og[6], bq.w * rs * og[7])}; }
            __syncthreads();
        }
    }
}
__device__ __forceinline__ void attn_norm_pass(Frame& F, int l) {
    F.refresh();
    const int lane = F.lane; float og[8];
    const float* out_gain = INF(I_OGAIN) + l * D; bf16* y = wsp<bf16>(F, WS_Y);
#pragma unroll
    for (int e = 0; e < 8; ++e) og[e] = out_gain[8 * lane + e];
    for (int row = F.gw; row < NTOK; row += F.NGW) {
        bf16* p = y + (size_t)row * D + 8 * lane; const v4u w = *(const v4u*)p;
        const float v0 = bflo(w.x), v1 = bfhi(w.x), v2 = bflo(w.y), v3 = bfhi(w.y), v4 = bflo(w.z), v5 = bfhi(w.z), v6 = bflo(w.w), v7 = bfhi(w.w);
        const float ss = (v0 * v0 + v1 * v1) + (v2 * v2 + v3 * v3) + (v4 * v4 + v5 * v5) + (v6 * v6 + v7 * v7);
        const float rs = 1.0f / sqrtf(wave_sum(ss) * (1.0f / 512.0f) + EPS);
        *(v4u*)p = (v4u){pk2(v0 * rs * og[0], v1 * rs * og[1]), pk2(v2 * rs * og[2], v3 * rs * og[3]), pk2(v4 * rs * og[4], v5 * rs * og[5]), pk2(v6 * rs * og[6], v7 * rs * og[7])};
    }
}
__device__ __forceinline__ void moe_permute(Frame& F, int moe_j) {
    F.refresh();
    LAS int* sb = (LAS int*)F.lds;
    const int* tok_e = wsp<int>(F, WS_TOKE); const int* tok_r = wsp<int>(F, WS_TOKR); int* tok_p = wsp<int>(F, WS_TOKP); int* rte = wsp<int>(F, WS_RTE);
    const bf16* hbuf = wsp<bf16>(F, WS_H); bf16* hs = wsp<bf16>(F, WS_HS);
    if (F.tid == 0) { int acc = 0;
        for (int e = 0; e < NEXP; ++e) { const int cnt = (int)__hip_atomic_load((unsigned*)(F.ctl + CW_GCNT + 64 * (8 * moe_j + e)), RLX_AGENT); sb[e] = acc; sb[16 + e] = cnt; acc += (cnt + 255) & ~255; }
        sb[8] = acc; }
    __syncthreads();
    if (blockIdx.x == 0) { const int nrt = sb[8] >> 8;
        for (int i = F.tid; i < nrt; i += NWAVES * 64) { int e = 0;
#pragma unroll
            for (int k = 1; k < NEXP; ++k) if (i * 256 >= sb[k]) e = k;
            rte[i] = e; }
        if (F.tid == 0) rte[511] = nrt; }
    const int lane = F.lane;
    for (int s = F.gw; s < 2 * NTOK; s += F.NGW) { const int t = s >> 1, e = tok_e[s], pos = sb[e] + tok_r[s];
        const GAS v4u* src = (const GAS v4u*)(hbuf + (size_t)t * D); GAS v4u* dst = (GAS v4u*)(hs + (size_t)pos * D);
        const v4u a = src[lane], bq = src[lane + 64]; dst[lane] = a; dst[lane + 64] = bq;
        if (lane == 0) tok_p[s] = pos; }
    for (int j = F.gw; j < NEXP * 256; j += F.NGW) { const int e = j >> 8, i = j & 255, cnt = sb[16 + e], padn = ((cnt + 255) & ~255) - cnt;
        if (i < padn) { GAS v4u* dst = (GAS v4u*)(hs + (size_t)(sb[e] + cnt + i) * D); dst[lane] = (v4u){0u, 0u, 0u, 0u}; dst[lane + 64] = (v4u){0u, 0u, 0u, 0u}; } }
    __syncthreads();
}
struct MoeOrder {
    pg8::StaticOrder so; const int* rte; int pm_off, tpe;
    __device__ __forceinline__ bool next(int i, pg8::Unit& u) const { if (!so.next(i, u)) return false; u.pm += pm_off; u.pb = rte[u.pm] * tpe + u.pn; return true; }
    __device__ __forceinline__ void a_ready(const pg8::Unit&) const {}
    __device__ __forceinline__ void done(const pg8::Unit&) const {}
};
struct AttnOrder {
    int v, G;
    __device__ __forceinline__ bool next(int i, int& bh, int& qb) const { const int un = v + (i >> 2) * G; if (un >= 256) return false; const int s = un & 15, k = i & 3; bh = un >> 4; qb = (k == 0) ? s : (k == 1) ? 31 - s : (k == 2) ? 32 + s : 63 - s; return true; }
};

struct Args { const void* in[28]; float* out; unsigned char* ws; };
__global__ void __launch_bounds__(NWAVES * 64, 2) trunk_fwd(Args args) {
    extern __shared__ __attribute__((aligned(16))) unsigned char lds[];
    Frame F;
    F.lds = (LAS unsigned char*)lds; F.MISC = (volatile LAS unsigned*)(F.lds + MISC_OFF);
    F.G = gridDim.x; { const int bx = blockIdx.x; F.vcu = (F.G % 8 == 0) ? (bx % 8) * (F.G / 8) + bx / 8 : bx; }
    F.NGW = F.G * NWAVES; F.refresh();
    F.ws = args.ws; F.out = args.out; F.ctl = (gu32*)(args.ws + WS_CTL);
    for (int u = F.tid; u < (LDS_BYTES - LDSCTL_OFF) / 4; u += NWAVES * 64) ((LAS unsigned*)(F.lds + LDSCTL_OFF))[u] = 0u;
    __syncthreads();
    XcdBarrier bar = xcd_barrier_post((unsigned*)(F.ctl + CW_BAR), F.MISC + 8);
#define GRID_BAR() xcd_barrier(bar)
    const int cblk = (int)blockIdx.x;

    p0_prologue(F);
    GRID_BAR();
    p0_finalise(F);
    GRID_BAR();

    for (int l = 0; l < DEPTH; ++l) {
        const int ls1 = 2 * l, ls2 = 2 * l + 1; const bool moe = (l & 1) != 0; const int jj = l >> 1;
        if (l == 0) norm_pass<false, true, false>(F, INF(I_X), nullptr, ls1, 0, 0);
        else if (l == 2) { norm_pass<true, true, false>(F, F.out, F.out, ls1, ls1 - 1, 0); convert_range(F, 22, 46, 1); }
        else norm_pass<false, true, false>(F, F.out, nullptr, ls1, 0, 0);
        GRID_BAR();
        { bf16* Win_t = wsp<bf16>(F, WS_WSMALL + (size_t)l * WSMALL_STRIDE);
          pg8::Gemm g{wsp<bf16>(F, WS_H), Win_t, NTOK, INP, D}; pg8::StaticOrder S; S.init(NTOK, INP, F.G, cblk);
          pg8::EpiBf16<0> E{wsp<bf16>(F, WS_Z), INP, nullptr, 0, 0, 1.f};
          pg8::gemm_phase<pg8::EpiBf16<0>, pg8::StaticOrder, true, true>(F.lds, g, S, E); }
        GRID_BAR();
        mid_pass(F, l);
        GRID_BAR();
        { bf16* Wup_t = wsp<bf16>(F, WS_WSMALL + (size_t)l * WSMALL_STRIDE + 3 * MiB);
          pg8::Gemm g{wsp<bf16>(F, WS_A2), Wup_t, NTOK, UPN, UPK}; pg8::StaticOrder S; S.init(NTOK, UPN, F.G, cblk);
          pg8::EpiBf16<0> E{wsp<bf16>(F, WS_QKV), UPN, nullptr, 0, 0, 1.f};
          pg8::gemm_phase<pg8::EpiBf16<0>, pg8::StaticOrder, true, true>(F.lds, g, S, E); }
        { bf16* Wg_t = wsp<bf16>(F, WS_WSMALL + (size_t)l * WSMALL_STRIDE + 5 * MiB); const bf16* xrb = wsp<bf16>(F, WS_XR);
          pg8::Gemm g{xrb, Wg_t, NTOK, 1024, LRUW}; pg8::StaticOrder S; S.init(NTOK, 1024, F.G, cblk);
          pg8::EpiGates E{xrb, INF(I_BA) + l * LRUW, INF(I_BX) + l * LRUW, wsp<float>(F, WS_LAMC) + l * LRUW, wsp<float>(F, WS_LA), wsp<float>(F, WS_U)};
          pg8::gemm_phase<pg8::EpiGates, pg8::StaticOrder, true, true>(F.lds, g, S, E); }
        GRID_BAR();
        qk_pass(F, l);
        scan_a(F);
        GRID_BAR();
        { const AttnOrder AO{F.vcu, F.G}; int bh, qb; const bf16* Qb = wsp<bf16>(F, WS_Q); const bf16* Kb = wsp<bf16>(F, WS_K); const bf16* Vb = wsp<bf16>(F, WS_QKV) + 768 + 64; bf16* yb = wsp<bf16>(F, WS_Y);
          for (int i = 0; AO.next(i, bh, qb); ++i) att::attn_unit(bh >> 3, bh & 7, qb, Qb, Kb, Vb, yb, F.lds); }
        scan_c(F, l);
        GRID_BAR();
        attn_norm_pass(F, l);
        GRID_BAR();
        { bf16* Wout_t = wsp<bf16>(F, WS_WSMALL + (size_t)l * WSMALL_STRIDE + 6 * MiB);
          pg8::Gemm g{wsp<bf16>(F, WS_Y), Wout_t, NTOK, D, D}; pg8::StaticOrder S; S.init(NTOK, D, F.G, cblk);
          const float* xcur = (l == 0) ? INF(I_X) : (const float*)F.out;
          pg8::EpiResid E{xcur, F.out, wsp<float>(F, WS_MOD) + (size_t)ls1 * 2 * 3072 + 2048};
          pg8::gemm_phase<pg8::EpiResid, pg8::StaticOrder, true, true>(F.lds, g, S, E); }
        GRID_BAR();
        if (!moe) {
            norm_pass<false, true, false>(F, F.out, nullptr, ls2, 0, 0);
            GRID_BAR();
            { bf16* Wgu_t = wsp<bf16>(F, WS_WDENSE + (size_t)jj * WDENSE_STRIDE);
              pg8::Gemm g{wsp<bf16>(F, WS_H), Wgu_t, NTOK, 2 * DFF, D}; pg8::StaticOrder S; S.init(NTOK, 2 * DFF, F.G, cblk);
              pg8::EpiSwiglu E{wsp<bf16>(F, WS_HID), DFF};
              pg8::gemm_phase<pg8::EpiSwiglu, pg8::StaticOrder, true, true>(F.lds, g, S, E); }
            GRID_BAR();
            { bf16* Wd_t = wsp<bf16>(F, WS_WDENSE + (size_t)jj * WDENSE_STRIDE + 11 * MiB);
              pg8::Gemm g{wsp<bf16>(F, WS_HID), Wd_t, NTOK, D, DFF}; pg8::StaticOrder S; S.init(NTOK, D, F.G, cblk);
              pg8::EpiResid E{F.out, F.out, wsp<float>(F, WS_MOD) + (size_t)ls2 * 2 * 3072 + 2048};
              pg8::gemm_phase<pg8::EpiResid, pg8::StaticOrder, true, true>(F.lds, g, S, E); }
            GRID_BAR();
        } else {
            norm_pass<false, true, true>(F, F.out, nullptr, ls2, 0, jj);
            GRID_BAR();
            moe_permute(F, jj);
            GRID_BAR();
            const int* rte = wsp<int>(F, WS_RTE); const int nrt = rte[511];
            for (int pass = 0; pass < 2; ++pass) {
                const int t0 = pass * PASS_TILES; int ntp = nrt - t0; ntp = ntp > PASS_TILES ? PASS_TILES : (ntp < 0 ? 0 : ntp);
                bf16* hidv = wsp<bf16>(F, WS_MHID) - (size_t)t0 * 256 * DFE;
                { pg8::Gemm g{wsp<bf16>(F, WS_HS), wsp<bf16>(F, WS_WMOE_GU), ntp * 256, 2 * DFE, D}; MoeOrder S; S.so.init(ntp * 256, 2 * DFE, F.G, cblk); S.rte = rte; S.pm_off = t0; S.tpe = 2 * DFE / 256;
                  pg8::EpiSwiglu E{hidv, DFE};
                  pg8::gemm_phase<pg8::EpiSwiglu, MoeOrder, true, true>(F.lds, g, S, E); }
                GRID_BAR();
                { pg8::Gemm g{hidv, wsp<bf16>(F, WS_WMOE_D), ntp * 256, D, DFE}; MoeOrder S; S.so.init(ntp * 256, D, F.G, cblk); S.rte = rte; S.pm_off = t0; S.tpe = D / 256;
                  pg8::EpiBf16<0> E{wsp<bf16>(F, WS_Y2), D, nullptr, 0, 0, 1.f};
                  pg8::gemm_phase<pg8::EpiBf16<0>, MoeOrder, true, true>(F.lds, g, S, E); }
                GRID_BAR();
            }
        }
    }
    norm_pass<true, false, false>(F, F.out, F.out, 0, 2 * (DEPTH - 1) + 1, 0);
}

extern "C" void kernel_launch(void* const* d_in, const int* in_sizes, int n_in, void* d_out, int out_size, void* d_ws, size_t ws_size, hipStream_t stream) {
    static int grid = 0;
    if (grid == 0) {
        if (n_in != 28 || out_size != NTOK * D || ws_size < WS_END) { fprintf(stderr, "kernel_launch: unexpected shapes (n_in %d, out %d, ws %zu)\n", n_in, out_size, ws_size); grid = -1; return; }
        int dev = 0, cus = 0, per_cu = 0;
        if (hipGetDevice(&dev) != hipSuccess || hipDeviceGetAttribute(&cus, hipDeviceAttributeMultiprocessorCount, dev) != hipSuccess) { grid = -1; return; }
        if (hipFuncSetAttribute((const void*)trunk_fwd, hipFuncAttributeMaxDynamicSharedMemorySize, LDS_BYTES) != hipSuccess) { fprintf(stderr, "kernel_launch: hipFuncSetAttribute failed\n"); grid = -1; return; }
        if (hipOccupancyMaxActiveBlocksPerMultiprocessor(&per_cu, (const void*)trunk_fwd, NWAVES * 64, LDS_BYTES) != hipSuccess || per_cu < 1) { fprintf(stderr, "kernel_launch: occupancy query reports %d\n", per_cu); per_cu = 1; }
        (void)hipGetLastError();
        grid = cus;
    }
    if (grid < 0) return;
    if (hipMemsetAsync((char*)d_ws + WS_CTL, 0, CTL_ZERO_BYTES, stream) != hipSuccess) return;
    Args a{};
    for (int i = 0; i < 28; ++i) a.in[i] = d_in[i];
    a.out = (float*)d_out; a.ws = (unsigned char*)d_ws;
    hipLaunchKernelGGL(trunk_fwd, dim3(grid), dim3(NWAVES * 64), LDS_BYTES, stream, a);
}
```

```cpp
#include <hip/hip_runtime.h>
#include <cstdio>
#include <cstdint>
namespace pg8 {
#define PG8_LAS __attribute__((address_space(3)))
typedef unsigned short bf16_t;
typedef short bf16x8 __attribute__((ext_vector_type(8)));
typedef float f32x4 __attribute__((ext_vector_type(4)));
typedef unsigned u32x4 __attribute__((ext_vector_type(4)));
typedef int i32x4_ __attribute__((ext_vector_type(4)));
constexpr int BM = 256, BK = 64, HALF = 128, HTB = HALF * BK * 2  , STAGE_BYTES = 8 * HTB, NXCD = 8, WGM = 8;

__host__ __device__ __forceinline__ int lds_byte(int r, int c) { const int st = (r >> 4) * 2 + (c >> 5), rr = r & 15, cc = c & 31, ob = rr * 64 + cc * 2; return st * 1024 + (ob ^ (((ob >> 9) & 1) << 5)); }
__host__ __device__ __forceinline__ void stage_rc(int b, int& R, int& C) { const int st = b / 1024, sb = b % 1024, swz = sb ^ (((sb >> 9) & 1) << 5); R = (st >> 1) * 16 + swz / 64; C = (st & 1) * 32 + (swz % 64) / 2; }
__host__ __device__ __forceinline__ int perm32(int rho) { const int n = rho >> 4, i = rho & 15; return 8 * (i >> 2) + 4 * n + (i & 3); }

struct Unit { int pm, pn, pb, pa; };
struct Gemm { const bf16_t* A; const bf16_t* Bt; int M, N, K; };

struct StaticOrder {
    int nM, nN, nwg, G, c;
    __host__ __device__ void init(int M, int N, int G_, int c_) { nM = M / BM; nN = N / BM; nwg = nM * nN; G = G_; c = c_; }
    __host__ __device__ bool next(int i, Unit& u) const {
        const long L = (long)i * G + c; if (L >= nwg) return false;
        int wgid = (int)L; { const int q = nwg / NXCD, r = nwg % NXCD, xcd = wgid % NXCD, off = wgid / NXCD; wgid = (xcd < r ? xcd * (q + 1) : r * (q + 1) + (xcd - r) * q) + off; }
        const int nig = WGM * nN, gid = wgid / nig, fm = gid * WGM, gsz = (nM - fm) < WGM ? (nM - fm) : WGM;
        u.pm = fm + ((wgid % nig) % gsz); u.pn = (wgid % nig) / gsz; u.pb = u.pn; u.pa = u.pm; return true;
    }
    __device__ __forceinline__ void a_ready(const Unit&) const {}
    __device__ __forceinline__ void done(const Unit&) const {}
};

__device__ __forceinline__ unsigned cvt_pk_bf16(float lo, float hi) { unsigned r; asm volatile("v_cvt_pk_bf16_f32 %0, %1, %2" : "=v"(r) : "v"(lo), "v"(hi)); return r; }
typedef float f32x2 __attribute__((ext_vector_type(2)));
__device__ __forceinline__ f32x2 gelu_pk(f32x2 v) {
    const f32x2 av = __builtin_elementwise_abs(v), d = av * 0.2316418882f + 1.0f;
    f32x2 t; t.x = __builtin_amdgcn_rcpf(d.x); t.y = __builtin_amdgcn_rcpf(d.y);
    f32x2 q = t * 0.5307027145f + (-0.7265760135f); q = q * t + 0.7107068705f; q = q * t + (-0.142248368f); q = q * t + 0.127414796f; q = q * t;
    const f32x2 s = (v * v) * (-0.72134752044f);
    f32x2 e; e.x = __builtin_amdgcn_exp2f(s.x); e.y = __builtin_amdgcn_exp2f(s.y);
    const f32x2 m = v * (q * e), r = v - m;
    f32x2 o; o.x = v.x < 0.f ? m.x : r.x; o.y = v.y < 0.f ? m.y : r.y; return o;
}

template <int ACT  > struct EpiBf16 {
    static constexpr bool PERM = true, AFTER_DRAIN = false; static_assert(ACT == 0 || ACT == 1, "EpiBf16: ACT is 0 (none) or 1 (gelu_pk)");
    bf16_t* O; int ldc; const float* bias; int split_cols; size_t split_stride; float scale0;
    __device__ __forceinline__ void operator()(const f32x4 (&acc)[2][2][4][2], const Unit& u, int wr, int wc, int fr, int fq) const {
        const int row0 = u.pm * BM + wr * 64 + fr; int colt = u.pn * BM; bf16_t* base = O;
        float sc = 1.f; if (split_cols) { const int t = colt / split_cols; base += (size_t)t * split_stride; colt -= t * split_cols; if (t == 0) sc = scale0; }
        const int col0 = colt + wc * 32 + 8 * fq, bcol0 = u.pn * BM + wc * 32 + 8 * fq;
        f32x4 bv[2][2];
#pragma unroll
        for (int bj = 0; bj < 2; ++bj)
#pragma unroll
            for (int n = 0; n < 2; ++n) bv[bj][n] = bias ? *(const f32x4*)(bias + bcol0 + bj * HALF + 4 * n) : (f32x4){0.f, 0.f, 0.f, 0.f};
#pragma unroll
        for (int ai = 0; ai < 2; ++ai)
#pragma unroll
            for (int m = 0; m < 4; ++m) { bf16_t* rowp = base + (size_t)(row0 + ai * HALF + m * 16) * ldc + col0;
#pragma unroll
                for (int bj = 0; bj < 2; ++bj) { f32x4 v0 = acc[ai][bj][m][0] + bv[bj][0], v1 = acc[ai][bj][m][1] + bv[bj][1];
                    if (ACT == 1) { f32x2 a = gelu_pk((f32x2){v0[0], v0[1]}), b = gelu_pk((f32x2){v0[2], v0[3]}), c = gelu_pk((f32x2){v1[0], v1[1]}), d = gelu_pk((f32x2){v1[2], v1[3]});
                        v0 = (f32x4){a.x, a.y, b.x, b.y}; v1 = (f32x4){c.x, c.y, d.x, d.y}; }
                    v0 = v0 * sc; v1 = v1 * sc; u32x4 w; w.x = cvt_pk_bf16(v0[0], v0[1]); w.y = cvt_pk_bf16(v0[2], v0[3]); w.z = cvt_pk_bf16(v1[0], v1[1]); w.w = cvt_pk_bf16(v1[2], v1[3]);
                    *(u32x4*)(rowp + bj * HALF) = w; } }
    }
};
struct EpiBf16I8 {
    static constexpr bool PERM = true, AFTER_DRAIN = false;
    bf16_t* O; int ldc; const float* rsc; float wdq;
    __device__ __forceinline__ void operator()(const f32x4 (&acc)[2][2][4][2], const Unit& u, int wr, int wc, int fr, int fq) const {
        const int row0 = u.pm * BM + wr * 64 + fr, col0 = u.pn * BM + wc * 32 + 8 * fq;
        float rs[2][4];
#pragma unroll
        for (int ai = 0; ai < 2; ++ai)
#pragma unroll
            for (int m = 0; m < 4; ++m) rs[ai][m] = rsc[row0 + ai * HALF + m * 16];
#pragma unroll
        for (int ai = 0; ai < 2; ++ai)
#pragma unroll
            for (int m = 0; m < 4; ++m) { bf16_t* rowp = O + (size_t)(row0 + ai * HALF + m * 16) * ldc + col0; const float s = rs[ai][m] * wdq;
#pragma unroll
                for (int bj = 0; bj < 2; ++bj) { float v[8];
#pragma unroll
                    for (int n = 0; n < 2; ++n)
#pragma unroll
                        for (int e = 0; e < 4; ++e) { const f32x4 av = acc[ai][bj][m][n]; const float ae = av[e]; v[4 * n + e] = (float)__float_as_int(ae) * s; }
                    u32x4 w; w.x = cvt_pk_bf16(v[0], v[1]); w.y = cvt_pk_bf16(v[2], v[3]); w.z = cvt_pk_bf16(v[4], v[5]); w.w = cvt_pk_bf16(v[6], v[7]);
                    *(u32x4*)(rowp + bj * HALF) = w; } }
    }
};
__device__ __forceinline__ float bf2f(unsigned short v) { return __uint_as_float((unsigned)v << 16); }
__device__ __forceinline__ float sigmoidf_(float v) { return __builtin_amdgcn_rcpf(1.0f + __builtin_amdgcn_exp2f(-1.4426950408889634f * v)); }
struct EpiResid {
    static constexpr bool PERM = true, AFTER_DRAIN = false;
    const bf16_t* base; bf16_t* out; const float* gate; float sc;
    __device__ __forceinline__ void operator()(const f32x4 (&acc)[2][2][4][2], const Unit& u, int wr, int wc, int fr, int fq) const {
        const int row0 = u.pm * BM + wr * 64 + fr, col0 = u.pn * BM + wc * 32 + 8 * fq;
        const float* gp = gate + (u.pm >= 64 ? 3072 : 0) + col0;
        f32x4 gv[2][2];
#pragma unroll
        for (int bj = 0; bj < 2; ++bj)
#pragma unroll
            for (int n = 0; n < 2; ++n) gv[bj][n] = *(const f32x4*)(gp + bj * HALF + 4 * n);
        asm volatile("" ::: "memory");
#define ER_OFF(g, q) ((size_t)(row0 + ((g) >> 1) * HALF + (2 * ((g) & 1) + (q)) * 16) * 1024 + col0)
#define ER_PACK(v0, v1) (u32x4){cvt_pk_bf16((v0)[0], (v0)[1]), cvt_pk_bf16((v0)[2], (v0)[3]), cvt_pk_bf16((v1)[0], (v1)[1]), cvt_pk_bf16((v1)[2], (v1)[3])}
        {
            u32x4 bw[2][2][2];
#define ER_LOADB(g, buf) do { _Pragma("unroll") for (int q = 0; q < 2; ++q) { const size_t off = ER_OFF(g, q); \
            _Pragma("unroll") for (int bj = 0; bj < 2; ++bj) bw[buf][q][bj] = *(const u32x4*)(base + off + bj * HALF); } } while (0)
#define ER_STOREB(g, buf) do { _Pragma("unroll") for (int q = 0; q < 2; ++q) { const size_t off = ER_OFF(g, q); \
            _Pragma("unroll") for (int bj = 0; bj < 2; ++bj) { const u32x4 w = bw[buf][q][bj]; \
                const f32x4 b0 = (f32x4){__uint_as_float(w.x << 16), __uint_as_float(w.x & 0xffff0000u), __uint_as_float(w.y << 16), __uint_as_float(w.y & 0xffff0000u)}; \
                const f32x4 b1 = (f32x4){__uint_as_float(w.z << 16), __uint_as_float(w.z & 0xffff0000u), __uint_as_float(w.w << 16), __uint_as_float(w.w & 0xffff0000u)}; \
                const f32x4 v0 = b0 + gv[bj][0] * acc[(g) >> 1][bj][2 * ((g) & 1) + q][0], v1 = b1 + gv[bj][1] * acc[(g) >> 1][bj][2 * ((g) & 1) + q][1]; \
                *(u32x4*)(out + off + bj * HALF) = ER_PACK(v0, v1); } } } while (0)
            ER_LOADB(0, 0); ER_LOADB(1, 1); asm volatile("" ::: "memory");
#pragma unroll
            for (int bj = 0; bj < 2; ++bj)
#pragma unroll
                for (int n = 0; n < 2; ++n) gv[bj][n] = gv[bj][n] * sc;
            ER_STOREB(0, 0); asm volatile("" ::: "memory"); ER_LOADB(2, 0); asm volatile("" ::: "memory");
            ER_STOREB(1, 1); asm volatile("" ::: "memory"); ER_LOADB(3, 1); asm volatile("" ::: "memory");
            ER_STOREB(2, 0); asm volatile("" ::: "memory");
            ER_STOREB(3, 1);
#undef ER_LOADB
#undef ER_STOREB
        }
#undef ER_OFF
#undef ER_PACK
    }
};
struct EpiSwiglu {
    static constexpr bool PERM = true, AFTER_DRAIN = false;
    bf16_t* O; int ldc;
    __device__ __forceinline__ void operator()(const f32x4 (&acc)[2][2][4][2], const Unit& u, int wr, int wc, int fr, int fq) const {
        const int row0 = u.pm * BM + wr * 64 + fr, col0 = u.pn * HALF + wc * 32 + 8 * fq;
#pragma unroll
        for (int ai = 0; ai < 2; ++ai)
#pragma unroll
            for (int m = 0; m < 4; ++m) { bf16_t* rowp = O + (size_t)(row0 + ai * HALF + m * 16) * ldc + col0;
                float hv[8];
#pragma unroll
                for (int n = 0; n < 2; ++n)
#pragma unroll
                    for (int e = 0; e < 4; ++e) { const float g = acc[ai][0][m][n][e], up = acc[ai][1][m][n][e]; hv[4 * n + e] = g * sigmoidf_(g) * up; }
                u32x4 w; w.x = cvt_pk_bf16(hv[0], hv[1]); w.y = cvt_pk_bf16(hv[2], hv[3]); w.z = cvt_pk_bf16(hv[4], hv[5]); w.w = cvt_pk_bf16(hv[6], hv[7]);
                *(u32x4*)rowp = w; }
    }
};
struct EpiGates {
    static constexpr bool PERM = true, AFTER_DRAIN = false;
    const bf16_t* xr; const float* ba; const float* bx; const float* lamc; unsigned* lu;
    __device__ __forceinline__ void operator()(const f32x4 (&acc)[2][2][4][2], const Unit& u, int wr, int wc, int fr, int fq) const {
        const int row0 = u.pm * BM + wr * 64 + fr, ch0 = u.pn * HALF + wc * 32 + 8 * fq;
        f32x4 bav[2], bxv[2], lcv[2]; const float NL2E = -1.4426950408889634f;
#pragma unroll
        for (int n = 0; n < 2; ++n) { bav[n] = *(const f32x4*)(ba + ch0 + 4 * n); bxv[n] = *(const f32x4*)(bx + ch0 + 4 * n); lcv[n] = *(const f32x4*)(lamc + ch0 + 4 * n); }
        u32x4 xws[2][4];
#pragma unroll
        for (int ai = 0; ai < 2; ++ai)
#pragma unroll
            for (int m = 0; m < 4; ++m) xws[ai][m] = *(const u32x4*)(xr + ((size_t)(ch0 >> 7) * 32768 + (row0 + ai * HALF + m * 16)) * 128 + (ch0 & 127));
        asm volatile("" ::: "memory");
#pragma unroll
        for (int n = 0; n < 2; ++n) { bav[n] = bav[n] * NL2E; bxv[n] = bxv[n] * NL2E; }
#pragma unroll
        for (int ai = 0; ai < 2; ++ai)
#pragma unroll
            for (int m = 0; m < 4; ++m) { const size_t off = (size_t)(row0 + ai * HALF + m * 16) * 512 + ch0;
                const u32x4 xw = xws[ai][m];
                float xv[8]; xv[0] = __uint_as_float(xw.x << 16); xv[1] = __uint_as_float(xw.x & 0xffff0000u); xv[2] = __uint_as_float(xw.y << 16); xv[3] = __uint_as_float(xw.y & 0xffff0000u);
                xv[4] = __uint_as_float(xw.z << 16); xv[5] = __uint_as_float(xw.z & 0xffff0000u); xv[6] = __uint_as_float(xw.w << 16); xv[7] = __uint_as_float(xw.w & 0xffff0000u);
#pragma unroll
                for (int n = 0; n < 2; ++n) { u32x4 pk;
#pragma unroll
                    for (int e = 0; e < 4; ++e) {
                        const float r = __builtin_amdgcn_rcpf(1.0f + __builtin_amdgcn_exp2f(__builtin_fmaf(acc[ai][0][m][n][e], NL2E, bav[n][e])));
                        const float ig = __builtin_amdgcn_rcpf(1.0f + __builtin_amdgcn_exp2f(__builtin_fmaf(acc[ai][1][m][n][e], NL2E, bxv[n][e])));
                        const float l2 = r * lcv[n][e];
                        const float om_e = 1.0f - __builtin_amdgcn_exp2f(l2 + l2);
                        const float xx = l2 * -1.3862943611198906f;
                        const float om = xx < 1.0e-4f ? xx : om_e;
                        pk[e] = cvt_pk_bf16(l2, __builtin_amdgcn_sqrtf(om) * ig * xv[4 * n + e]); }
                    *(u32x4*)(lu + off + 4 * n) = pk; } }
    }
};
__device__ __forceinline__ float clamp448(float v) { return __builtin_amdgcn_fmed3f(v, -448.0f, 448.0f); }
__device__ __forceinline__ unsigned pack4_i8(float a, float b, float c, float d) {
    const unsigned ua = __float_as_uint(__builtin_amdgcn_fmed3f(a, -127.0f, 127.0f) + 12582912.0f), ub = __float_as_uint(__builtin_amdgcn_fmed3f(b, -127.0f, 127.0f) + 12582912.0f);
    const unsigned uc = __float_as_uint(__builtin_amdgcn_fmed3f(c, -127.0f, 127.0f) + 12582912.0f), ud = __float_as_uint(__builtin_amdgcn_fmed3f(d, -127.0f, 127.0f) + 12582912.0f);
    return (ua & 0xffu) | ((ub & 0xffu) << 8) | ((uc & 0xffu) << 16) | (ud << 24); }
__device__ __forceinline__ unsigned pack4_fp8(float a, float b, float c, float d) {
    int w = __builtin_amdgcn_cvt_pk_fp8_f32(clamp448(a), clamp448(b), 0, false); w = __builtin_amdgcn_cvt_pk_fp8_f32(clamp448(c), clamp448(d), w, true); return (unsigned)w; }
struct EpiSwigluF8 {
    static constexpr bool PERM = true, AFTER_DRAIN = false;
    unsigned char* O; int ldc; float sin_, sout;
    __device__ __forceinline__ void operator()(const f32x4 (&acc)[2][2][4][2], const Unit& u, int wr, int wc, int fr, int fq) const {
        const int row0 = u.pm * BM + wr * 64 + fr, col0 = u.pn * HALF + wc * 32 + 8 * fq; const float c1 = -1.4426950408889634f * sin_, ik = 1.0f / (sin_ * sin_ * sout);
#pragma unroll
        for (int ai = 0; ai < 2; ++ai)
#pragma unroll
            for (int m = 0; m < 4; ++m) { unsigned char* rowp = O + (size_t)(row0 + ai * HALF + m * 16) * ldc + col0;
                float hv[8];
#pragma unroll
                for (int n = 0; n < 2; ++n)
#pragma unroll
                    for (int e = 0; e < 4; ++e) { const float ag = acc[ai][0][m][n][e], au = acc[ai][1][m][n][e];
                        hv[4 * n + e] = (ag * au) * __builtin_amdgcn_rcpf(__builtin_fmaf(__builtin_amdgcn_exp2f(ag * c1), ik, ik)); }
                typedef unsigned u32x2_ __attribute__((ext_vector_type(2)));
                *(u32x2_*)rowp = (u32x2_){pack4_fp8(hv[0], hv[1], hv[2], hv[3]), pack4_fp8(hv[4], hv[5], hv[6], hv[7])}; }
    }
};
struct EpiSwigluI8 {
    static constexpr bool PERM = true, AFTER_DRAIN = false;
    unsigned char* O; int ldc; const float* rsc; float wdq, sout;
    __device__ __forceinline__ void operator()(const f32x4 (&acc)[2][2][4][2], const Unit& u, int wr, int wc, int fr, int fq) const {
        const int row0 = u.pm * BM + wr * 64 + fr, col0 = u.pn * HALF + wc * 32 + 8 * fq;
        float rs[2][4];
#pragma unroll
        for (int ai = 0; ai < 2; ++ai)
#pragma unroll
            for (int m = 0; m < 4; ++m) rs[ai][m] = rsc[row0 + ai * HALF + m * 16];
#pragma unroll
        for (int ai = 0; ai < 2; ++ai)
#pragma unroll
            for (int m = 0; m < 4; ++m) { unsigned char* rowp = O + (size_t)(row0 + ai * HALF + m * 16) * ldc + col0;
                const float s = rs[ai][m] * wdq, c1 = -1.4426950408889634f * s, ik = __builtin_amdgcn_rcpf(s * s * sout);
                float hv[8];
#pragma unroll
                for (int n = 0; n < 2; ++n)
#pragma unroll
                    for (int e = 0; e < 4; ++e) { const f32x4 gq = acc[ai][0][m][n], uq = acc[ai][1][m][n]; const float ge = gq[e], ue = uq[e];
                        const float ag = (float)__float_as_int(ge), au = (float)__float_as_int(ue);
                        hv[4 * n + e] = (ag * au) * __builtin_amdgcn_rcpf(__builtin_fmaf(__builtin_amdgcn_exp2f(ag * c1), ik, ik)); }
                typedef unsigned u32x2_ __attribute__((ext_vector_type(2)));
                *(u32x2_*)rowp = (u32x2_){pack4_fp8(hv[0], hv[1], hv[2], hv[3]), pack4_fp8(hv[4], hv[5], hv[6], hv[7])}; }
    }
};
struct EpiBf16S {
    static constexpr bool PERM = true, AFTER_DRAIN = false;
    bf16_t* O; int ldc; float sc;
    __device__ __forceinline__ void operator()(const f32x4 (&acc)[2][2][4][2], const Unit& u, int wr, int wc, int fr, int fq) const {
        const int row0 = u.pm * BM + wr * 64 + fr, col0 = u.pn * BM + wc * 32 + 8 * fq;
#pragma unroll
        for (int ai = 0; ai < 2; ++ai)
#pragma unroll
            for (int m = 0; m < 4; ++m) { bf16_t* rowp = O + (size_t)(row0 + ai * HALF + m * 16) * ldc + col0;
#pragma unroll
                for (int bj = 0; bj < 2; ++bj) { const f32x4 v0 = acc[ai][bj][m][0] * sc, v1 = acc[ai][bj][m][1] * sc;
                    u32x4 w; w.x = cvt_pk_bf16(v0[0], v0[1]); w.y = cvt_pk_bf16(v0[2], v0[3]); w.z = cvt_pk_bf16(v1[0], v1[1]); w.w = cvt_pk_bf16(v1[2], v1[3]);
                    *(u32x4*)(rowp + bj * HALF) = w; } }
    }
};
struct EpiUp {
    static constexpr bool PERM = true, AFTER_DRAIN = false;
    bf16_t* Q; bf16_t* K; bf16_t* V; const float* qg; const float* kg; const float* cosT; const float* sinT;
    __device__ __forceinline__ static float sum_fq(float s) {
        s += __int_as_float(__builtin_amdgcn_ds_swizzle(__float_as_int(s), (16 << 10) | 0x1f));
        auto rr = __builtin_amdgcn_permlane32_swap(__float_as_uint(s), __float_as_uint(s), false, false); return __uint_as_float(rr[0]) + __uint_as_float(rr[1]); }
    __device__ __forceinline__ void operator()(const f32x4 (&acc)[2][2][4][2], const Unit& u, int wr, int wc, int fr, int fq) const {
        const int t = u.pn, row0 = u.pm * BM + wr * 64 + fr; const float C2 = 0.10206207261596577f * 1.4426950408889634f, EPSN = 1e-6f;
        if (t >= 5) {
            const int col0 = (t - 5) * BM + wc * 32 + 8 * fq;
#pragma unroll
            for (int ai = 0; ai < 2; ++ai)
#pragma unroll
                for (int m = 0; m < 4; ++m) { bf16_t* rowp = V + (size_t)(row0 + ai * HALF + m * 16) * 512 + col0;
#pragma unroll
                    for (int bj = 0; bj < 2; ++bj) { const f32x4 v0 = acc[ai][bj][m][0], v1 = acc[ai][bj][m][1];
                        u32x4 w; w.x = cvt_pk_bf16(v0[0], v0[1]); w.y = cvt_pk_bf16(v0[2], v0[3]); w.z = cvt_pk_bf16(v1[0], v1[1]); w.w = cvt_pk_bf16(v1[2], v1[3]);
                        *(u32x4*)(rowp + bj * HALF) = w; } }
        } else if (t == 2) {
            const f32x4 g1 = *(const f32x4*)(qg + 64 + 4 * fq), g2 = *(const f32x4*)(qg + 80 + 4 * fq);
#pragma unroll
            for (int ai = 0; ai < 2; ++ai) {
                f32x4 csv[4], snv[4];
#pragma unroll
                for (int m = 0; m < 4; ++m) { const int row = row0 + ai * HALF + m * 16; csv[m] = *(const f32x4*)(cosT + (size_t)row * 16 + 4 * fq); snv[m] = *(const f32x4*)(sinT + (size_t)row * 16 + 4 * fq); }
                asm volatile("" ::: "memory");
#pragma unroll
                for (int m = 0; m < 4; ++m) { const int row = row0 + ai * HALF + m * 16;
                    const f32x4 cs = csv[m], sn = snv[m];
#pragma unroll
                    for (int bj = 0; bj < 2; ++bj) { const f32x4 x1 = acc[ai][bj][m][0], x2 = acc[ai][bj][m][1];
                        float ss = (x1[0] * x1[0] + x1[1] * x1[1]) + (x1[2] * x1[2] + x1[3] * x1[3]) + (x2[0] * x2[0] + x2[1] * x2[1]) + (x2[2] * x2[2] + x2[3] * x2[3]);
                        ss = sum_fq(ss); const float rs = __builtin_amdgcn_rsqf(ss * (1.0f / 32.0f) + EPSN);
                        const f32x4 a = x1 * rs * g1, b = x2 * rs * g2; const f32x4 o1 = (a * cs - b * sn) * C2, o2 = (a * sn + b * cs) * C2;
                        bf16_t* qp = Q + (size_t)row * 768 + (4 * bj + wc) * 96 + 64 + 4 * fq;
                        typedef unsigned u32x2_ __attribute__((ext_vector_type(2)));
                        *(u32x2_*)qp = (u32x2_){cvt_pk_bf16(o1[0], o1[1]), cvt_pk_bf16(o1[2], o1[3])}; *(u32x2_*)(qp + 16) = (u32x2_){cvt_pk_bf16(o2[0], o2[1]), cvt_pk_bf16(o2[2], o2[3])}; } } }
        } else {
            const bool isq = t < 2; const int head = 4 * (isq ? t : t - 3) + wc; const float* g = isq ? qg : kg; bf16_t* dst = isq ? Q : K; const float sc = isq ? C2 : 1.0f;
            f32x4 gv[2][2];
#pragma unroll
            for (int bj = 0; bj < 2; ++bj)
#pragma unroll
                for (int n = 0; n < 2; ++n) gv[bj][n] = *(const f32x4*)(g + 32 * bj + 8 * fq + 4 * n);
#pragma unroll
            for (int ai = 0; ai < 2; ++ai)
#pragma unroll
                for (int m = 0; m < 4; ++m) { const int row = row0 + ai * HALF + m * 16; float ss = 0.f;
#pragma unroll
                    for (int bj = 0; bj < 2; ++bj)
#pragma unroll
                        for (int n = 0; n < 2; ++n) { const f32x4 x = acc[ai][bj][m][n]; ss += (x[0] * x[0] + x[1] * x[1]) + (x[2] * x[2] + x[3] * x[3]); }
                    ss = sum_fq(ss); const float rs = sc / __builtin_sqrtf(ss * (1.0f / 64.0f) + EPSN);
                    bf16_t* rowp = dst + (size_t)row * 768 + head * 96 + 8 * fq;
#pragma unroll
                    for (int bj = 0; bj < 2; ++bj) { const f32x4 v0 = acc[ai][bj][m][0] * rs * gv[bj][0], v1 = acc[ai][bj][m][1] * rs * gv[bj][1];
                        u32x4 w; w.x = cvt_pk_bf16(v0[0], v0[1]); w.y = cvt_pk_bf16(v0[2], v0[3]); w.z = cvt_pk_bf16(v1[0], v1[1]); w.w = cvt_pk_bf16(v1[2], v1[3]);
                        *(u32x4*)(rowp + 32 * bj) = w; } }
        }
    }
};
template <class Epi, class Sched, bool ALIGN_EPI = false, bool SP2 = false, bool F8 = false, bool I8 = false>
__device__ __forceinline__ void gemm_phase(PG8_LAS unsigned char* lds, const Gemm g, const Sched& S, const Epi& E) {
    int tid_ = threadIdx.x; asm volatile("" : "+v"(tid_));
    const int tid = tid_, wid = __builtin_amdgcn_readfirstlane(tid >> 6), lane = tid & 63, wr = wid >> 2, wc = wid & 3, fr = lane & 15, fq = lane >> 4;
    const int K = g.K, nt = K / BK;
    unsigned voffA[2], voffB[2];
#pragma unroll
    for (int i = 0; i < 2; ++i) { int R, C; stage_rc(tid * 16 + i * 8192, R, C); const int Rb = Epi::PERM ? ((R & ~31) + perm32(R & 31)) : R;
        voffA[i] = (unsigned)(R * K + C) * 2u; voffB[i] = (unsigned)(Rb * K + C) * 2u; }
    const size_t kstep = (size_t)(BK * 2);
    const size_t hstep = (size_t)HALF * K * 2;
    const size_t tstep = 2 * hstep;
    const unsigned ldsw = (unsigned)wid * 1024u;
    const int aoff = lds_byte(wr * 64 + fr, fq * 8), boff = lds_byte(wc * 32 + fr, fq * 8);
#define PG8_SA(b, h) (((b) * 2 + (h)) * HTB)
#define PG8_SB(b, h) ((4 + (b) * 2 + (h)) * HTB)
#define PG8_STAGE(bufoff, gbase, voff) do { _Pragma("unroll") for (int _i = 0; _i < 2; ++_i) \
        __builtin_amdgcn_global_load_lds((const unsigned*)((const char*)(gbase) + (voff)[_i]), (PG8_LAS unsigned*)(lds + (bufoff) + ldsw + _i * 8192), 16, 0, 0); } while (0)
#define PG8_LDA(dst, b, h) do { _Pragma("unroll") for (int m = 0; m < 4; ++m) _Pragma("unroll") for (int k = 0; k < 2; ++k) dst[m][k] = *(const PG8_LAS bf16x8*)(lds + PG8_SA(b, h) + aoff + m * 2048 + k * 1024); } while (0)
#define PG8_LDB(dst, b, h) do { _Pragma("unroll") for (int n = 0; n < 2; ++n) _Pragma("unroll") for (int k = 0; k < 2; ++k) dst[n][k] = *(const PG8_LAS bf16x8*)(lds + PG8_SB(b, h) + boff + n * 2048 + k * 1024); } while (0)
#define PG8_CAT(x0, x1) __builtin_shufflevector(__builtin_bit_cast(i32x4_, x0), __builtin_bit_cast(i32x4_, x1), 0, 1, 2, 3, 4, 5, 6, 7)
#define PG8_MMA(ai, bj, At, Bt) do { __builtin_amdgcn_s_setprio(1); \
        if constexpr (I8) { _Pragma("unroll") for (int k = 0; k < 2; ++k) _Pragma("unroll") for (int m = 0; m < 4; ++m) _Pragma("unroll") for (int n = 0; n < 2; ++n) \
            asm volatile("v_mfma_i32_16x16x64_i8 %0, %1, %2, %0" : "+v"(acc[ai][bj][m][n]) : "v"(Bt[n][k]), "v"(At[m][k])); } \
        else { _Pragma("unroll") for (int m = 0; m < 4; ++m) _Pragma("unroll") for (int n = 0; n < 2; ++n) { \
        if constexpr (F8) asm volatile("v_mfma_f32_16x16x128_f8f6f4 %0, %1, %2, %0" : "+v"(acc[ai][bj][m][n]) : "v"(PG8_CAT(Bt[n][0], Bt[n][1])), "v"(PG8_CAT(At[m][0], At[m][1])));     \
        else { _Pragma("unroll") for (int k = 0; k < 2; ++k) acc[ai][bj][m][n] = __builtin_amdgcn_mfma_f32_16x16x32_bf16(Bt[n][k], At[m][k], acc[ai][bj][m][n], 0, 0, 0); } } } __builtin_amdgcn_s_setprio(0); } while (0)
#define PG8_MMA0(ai, bj, At, Bt) do { __builtin_amdgcn_s_setprio(1); \
        if constexpr (I8) { _Pragma("unroll") for (int m = 0; m < 4; ++m) _Pragma("unroll") for (int n = 0; n < 2; ++n) asm volatile("v_mfma_i32_16x16x64_i8 %0, %1, %2, 0" : "=&v"(acc[ai][bj][m][n]) : "v"(Bt[n][0]), "v"(At[m][0])); \
            _Pragma("unroll") for (int m = 0; m < 4; ++m) _Pragma("unroll") for (int n = 0; n < 2; ++n) asm volatile("v_mfma_i32_16x16x64_i8 %0, %1, %2, %0" : "+v"(acc[ai][bj][m][n]) : "v"(Bt[n][1]), "v"(At[m][1])); } \
        else { _Pragma("unroll") for (int m = 0; m < 4; ++m) _Pragma("unroll") for (int n = 0; n < 2; ++n) \
            asm volatile("v_mfma_f32_16x16x128_f8f6f4 %0, %1, %2, 0" : "=&v"(acc[ai][bj][m][n]) : "v"(PG8_CAT(Bt[n][0], Bt[n][1])), "v"(PG8_CAT(At[m][0], At[m][1]))); } \
        __builtin_amdgcn_s_setprio(0); } while (0)
#define PG8_MMAZ(ai, bj, At, Bt) do { if (F8 && t == 0) PG8_MMA0(ai, bj, At, Bt); else PG8_MMA(ai, bj, At, Bt); } while (0)
#define PG8_WAIT_V(n) asm volatile("s_waitcnt vmcnt(" #n ")" ::: "memory")
#define PG8_WAIT_L(n) asm volatile("s_waitcnt lgkmcnt(" #n ")" ::: "memory")
#define PG8_BAR __builtin_amdgcn_s_barrier()
#define PG8_SCHED __builtin_amdgcn_sched_barrier(0)
    Unit cur, nxt; int ui = 0;
    if (!S.next(0, cur)) return;
    f32x4 acc[2][2][4][2];
    if constexpr (!F8) {
#pragma unroll
    for (int a = 0; a < 2; ++a)
#pragma unroll
        for (int b = 0; b < 2; ++b)
#pragma unroll
            for (int m = 0; m < 4; ++m)
#pragma unroll
                for (int n = 0; n < 2; ++n) acc[a][b][m][n] = (f32x4){0.f, 0.f, 0.f, 0.f}; }
    bf16x8 At[4][2], B0[2][2], B1[2][2];
    const char* cA = (const char*)g.A + (size_t)cur.pa * tstep; const char* cB = (const char*)g.Bt + (size_t)cur.pb * tstep;
    S.a_ready(cur);
    if constexpr (SP2) {
        PG8_STAGE(PG8_SB(0, 0), cB, voffB); PG8_STAGE(PG8_SB(0, 1), cB + hstep, voffB); PG8_STAGE(PG8_SA(0, 0), cA, voffA); PG8_STAGE(PG8_SA(0, 1), cA + hstep, voffA);
        if (wr == 1) PG8_BAR;
        PG8_WAIT_V(2); PG8_BAR;
        PG8_STAGE(PG8_SB(1, 0), cB + kstep, voffB); PG8_STAGE(PG8_SA(1, 0), cA + kstep, voffA); PG8_STAGE(PG8_SB(1, 1), cB + hstep + kstep, voffB);
        PG8_WAIT_V(6); PG8_BAR;
    } else {
        PG8_STAGE(PG8_SB(0, 0), cB, voffB); PG8_STAGE(PG8_SA(0, 0), cA, voffA); PG8_STAGE(PG8_SB(0, 1), cB + hstep, voffB); PG8_STAGE(PG8_SA(0, 1), cA + hstep, voffA);
        if (wr == 1) PG8_BAR;
        PG8_WAIT_V(4); PG8_BAR;
        PG8_STAGE(PG8_SB(1, 0), cB + kstep, voffB); PG8_STAGE(PG8_SA(1, 0), cA + kstep, voffA); PG8_STAGE(PG8_SB(1, 1), cB + hstep + kstep, voffB);
        PG8_WAIT_V(6); PG8_BAR;
    }
    for (;;) {
        const bool has_next = S.next(ui + 1, nxt);
        const char* nA = has_next ? (const char*)g.A + (size_t)nxt.pa * tstep : cA; const char* nB = has_next ? (const char*)g.Bt + (size_t)nxt.pb * tstep : cB;
        for (int t = 0; t < nt; t += 2) {
            const bool last = (t == nt - 2);
            const char* a1 = cA + (size_t)(t + 1) * kstep;
            const char* a2 = last ? nA : cA + (size_t)(t + 2) * kstep; const char* b2 = last ? nB : cB + (size_t)(t + 2) * kstep;
            const char* a3 = a2 + kstep; const char* b3 = b2 + kstep;
            if (last && has_next) S.a_ready(nxt);
            if constexpr (SP2) {
            PG8_LDB(B0, 0, 0); PG8_LDB(B1, 0, 1); PG8_SCHED; PG8_LDA(At, 0, 0); PG8_STAGE(PG8_SA(1, 1), a1 + hstep, voffA);
            PG8_WAIT_V(8); PG8_WAIT_L(0); PG8_BAR; PG8_MMAZ(0, 0, At, B0); PG8_MMAZ(0, 1, At, B1); PG8_BAR; PG8_SCHED;
            PG8_LDA(At, 0, 1); PG8_STAGE(PG8_SB(0, 0), b2, voffB); PG8_STAGE(PG8_SB(0, 1), b2 + hstep, voffB); PG8_STAGE(PG8_SA(0, 0), a2, voffA);
            PG8_WAIT_V(8); PG8_WAIT_L(0); PG8_BAR; PG8_MMAZ(1, 0, At, B0); PG8_MMAZ(1, 1, At, B1); PG8_BAR; PG8_SCHED;
            PG8_LDB(B0, 1, 0); PG8_LDB(B1, 1, 1); PG8_SCHED; PG8_LDA(At, 1, 0); PG8_STAGE(PG8_SA(0, 1), a2 + hstep, voffA);
            PG8_WAIT_V(8); PG8_WAIT_L(0); PG8_BAR; PG8_MMA(0, 0, At, B0); PG8_MMA(0, 1, At, B1); PG8_BAR; PG8_SCHED;
            PG8_LDA(At, 1, 1); PG8_STAGE(PG8_SB(1, 0), b3, voffB); PG8_STAGE(PG8_SB(1, 1), b3 + hstep, voffB); PG8_STAGE(PG8_SA(1, 0), a3, voffA);
            PG8_WAIT_V(8); PG8_WAIT_L(0); PG8_BAR; PG8_MMA(1, 0, At, B0); PG8_MMA(1, 1, At, B1); PG8_BAR; PG8_SCHED;
            } else {
            PG8_LDB(B0, 0, 0); PG8_SCHED; PG8_LDA(At, 0, 0); PG8_STAGE(PG8_SA(1, 1), a1 + hstep, voffA);
            PG8_WAIT_L(8); PG8_BAR; PG8_WAIT_L(0); PG8_MMAZ(0, 0, At, B0); PG8_BAR; PG8_SCHED;
            PG8_LDB(B1, 0, 1); PG8_STAGE(PG8_SB(0, 0), b2, voffB);
            PG8_BAR; PG8_WAIT_L(0); PG8_MMAZ(0, 1, At, B1); PG8_BAR;
            PG8_LDA(At, 0, 1); PG8_STAGE(PG8_SA(0, 0), a2, voffA);
            PG8_BAR; PG8_WAIT_L(0); PG8_MMAZ(1, 0, At, B0); PG8_BAR; PG8_SCHED;
            PG8_STAGE(PG8_SB(0, 1), b2 + hstep, voffB);
            PG8_WAIT_V(6); PG8_BAR; PG8_MMAZ(1, 1, At, B1); PG8_BAR;
            PG8_LDB(B0, 1, 0); PG8_SCHED; PG8_LDA(At, 1, 0); PG8_STAGE(PG8_SA(0, 1), a2 + hstep, voffA);
            PG8_WAIT_L(8); PG8_BAR; PG8_WAIT_L(0); PG8_MMA(0, 0, At, B0); PG8_BAR; PG8_SCHED;
            PG8_LDB(B1, 1, 1); PG8_STAGE(PG8_SB(1, 0), b3, voffB);
            PG8_BAR; PG8_WAIT_L(0); PG8_MMA(0, 1, At, B1); PG8_BAR;
            PG8_LDA(At, 1, 1); PG8_STAGE(PG8_SA(1, 0), a3, voffA);
            PG8_BAR; PG8_WAIT_L(0); PG8_MMA(1, 0, At, B0); PG8_BAR; PG8_SCHED;
            PG8_STAGE(PG8_SB(1, 1), b3 + hstep, voffB);
            PG8_WAIT_V(6); PG8_BAR; PG8_MMA(1, 1, At, B1); PG8_BAR;
            }
        }
        if constexpr (ALIGN_EPI) { if (wr == 0) PG8_BAR; }
        if constexpr (F8) asm volatile("s_nop 15\n\ts_nop 15" ::: "memory");
        if constexpr (!Epi::AFTER_DRAIN) { E(acc, cur, wr, wc, fr, fq); S.done(cur); }
        if (!has_next) break;
        if constexpr (!F8) {
#pragma unroll
        for (int a = 0; a < 2; ++a)
#pragma unroll
            for (int b = 0; b < 2; ++b)
#pragma unroll
                for (int m = 0; m < 4; ++m)
#pragma unroll
                    for (int n = 0; n < 2; ++n) acc[a][b][m][n] = (f32x4){0.f, 0.f, 0.f, 0.f}; }
        cur = nxt; cA = nA; cB = nB; ++ui;
        if constexpr (ALIGN_EPI) { if (wr == 1) PG8_BAR; }
    }
    PG8_WAIT_V(0);
    if constexpr (!ALIGN_EPI) { if (wr == 0) PG8_BAR; }
    PG8_BAR;
    if constexpr (Epi::AFTER_DRAIN) { E.fused(acc, cur, wr, wc, fr, fq, lds, wid, lane); S.done(cur); }
#undef PG8_SA
#undef PG8_SB
#undef PG8_STAGE
#undef PG8_LDA
#undef PG8_LDB
#undef PG8_MMA
#undef PG8_MMA0
#undef PG8_MMAZ
#undef PG8_CAT
#undef PG8_WAIT_V
#undef PG8_WAIT_L
#undef PG8_BAR
#undef PG8_SCHED
}
}

#define GAS __attribute__((address_space(1)))
#define LAS __attribute__((address_space(3)))
typedef unsigned short bf16;
typedef unsigned v4u __attribute__((ext_vector_type(4)));
typedef unsigned v2u __attribute__((ext_vector_type(2)));
typedef float f32x4 __attribute__((ext_vector_type(4)));
typedef short bf16x8 __attribute__((ext_vector_type(8)));
typedef GAS unsigned gu32;
typedef GAS unsigned long long gu64;
#define RLX_AGENT __ATOMIC_RELAXED, __HIP_MEMORY_SCOPE_AGENT
#define LDS_WAIT() asm volatile("s_waitcnt lgkmcnt(0)" ::: "memory")
#define VM_WAIT() asm volatile("s_waitcnt vmcnt(0)" ::: "memory")
__device__ __forceinline__ unsigned long long rt() { return __builtin_amdgcn_s_memrealtime(); }
__device__ __forceinline__ unsigned f2bf(float f) { unsigned u = __builtin_bit_cast(unsigned, f); return (u + 0x7fffu + ((u >> 16) & 1u)) >> 16; }
__device__ __forceinline__ unsigned pk2(float lo, float hi) { return f2bf(lo) | (f2bf(hi) << 16); }

#define XB_TMO      128
#define XB_XCNT(j)  (256  + 64 * (j))
#define XB_XSUB(j)  (1280 + 64 * (j))
#define XB_XGEN(j)  (2304 + 64 * (j))
#define XB_TOP      3328
#define XB_TOPGEN   3392
#define XCD_BAR_WORDS 3456
#define XB_SPIN_CAP (1u << 18)

__device__ __forceinline__ unsigned xb_ld(unsigned* p)              { return __hip_atomic_load(p, __ATOMIC_RELAXED, __HIP_MEMORY_SCOPE_AGENT); }
__device__ __forceinline__ unsigned xb_add(unsigned* p, unsigned v) { return __hip_atomic_fetch_add(p, v, __ATOMIC_RELAXED, __HIP_MEMORY_SCOPE_AGENT); }
__device__ __forceinline__ unsigned xb_xcc_id() { return (unsigned)__builtin_amdgcn_s_getreg((3 << 11) | 20) & 0xFu; }
#define XB_SPIN(cond, bar) do { unsigned _sp = 0; while (cond) { __builtin_amdgcn_s_sleep(1); \
    if ((++_sp & 255u) == 0u) { if (xb_ld(&(bar)[XB_TMO])) break; if (_sp > XB_SPIN_CAP) { atomicAdd(&(bar)[XB_TMO], 1u); break; } } } } while (0)

struct XcdBarrier {
    unsigned* bar; unsigned x;
    volatile LAS unsigned* st;
};

__device__ __forceinline__ XcdBarrier xcd_barrier_post(unsigned* bar, volatile LAS unsigned* st) {
    XcdBarrier b; b.bar = bar; b.x = xb_xcc_id(); b.st = st;
    if (threadIdx.x == 0) (void)xb_add(&bar[XB_XCNT(b.x)], 1u);
    return b;
}
__device__ __forceinline__ void xcd_barrier_complete(unsigned* bar, unsigned x, unsigned& nloc, unsigned& nx) {
    const unsigned G = gridDim.x * gridDim.y * gridDim.z;
    unsigned sum, cnt, mine, sp = 0u;
    for (;;) {
        sum = 0u; cnt = 0u; mine = 0u;
#pragma unroll
        for (unsigned j = 0; j < 16; ++j) { const unsigned c = xb_ld(&bar[XB_XCNT(j)]); sum += c; cnt += (c > 0u) ? 1u : 0u; mine = (j == x) ? c : mine; }
        if (sum == G) break;
        __builtin_amdgcn_s_sleep(1);
        if ((++sp & 255u) == 0u) { if (xb_ld(&bar[XB_TMO])) break; if (sp > XB_SPIN_CAP) { atomicAdd(&bar[XB_TMO], 1u); break; } }
    }
    nloc = mine > 0u ? mine : 1u; nx = cnt > 0u ? cnt : 1u;
}

__device__ __forceinline__ void xcd_barrier(const XcdBarrier& b) {
    asm volatile("s_waitcnt vmcnt(0)" ::: "memory");
    __syncthreads();
    unsigned tid0_ = threadIdx.x; asm volatile("" : "+v"(tid0_));
    if (tid0_ == 0) {
        unsigned* bar = b.bar; unsigned bx = b.x;
        asm volatile("" : "+s"(bar), "+s"(bx));
        __builtin_amdgcn_s_waitcnt(0);
        unsigned nloc = b.st[0], nx = b.st[1];
        if (nloc == 0u) { xcd_barrier_complete(bar, bx, nloc, nx); b.st[0] = nloc; b.st[1] = nx; }
        const unsigned old = xb_add(&bar[XB_XSUB(bx)], 1u);
        const unsigned gen = old / nloc;
        if (old + 1u == (gen + 1u) * nloc) {
            __builtin_amdgcn_fence(__ATOMIC_RELEASE, "agent");
            asm volatile("s_waitcnt vmcnt(0)" ::: "memory");
            const unsigned og = xb_add(&bar[XB_TOP], 1u);
            const unsigned tg = og / nx;
            if (og + 1u == (tg + 1u) * nx) xb_add(&bar[XB_TOPGEN], 1u);
            else XB_SPIN(xb_ld(&bar[XB_TOPGEN]) == tg, bar);
            __builtin_amdgcn_fence(__ATOMIC_ACQUIRE, "agent");
            xb_add(&bar[XB_XGEN(bx)], 1u);
            asm volatile("s_waitcnt vmcnt(0)" ::: "memory");
        } else {
            XB_SPIN(xb_ld(&bar[XB_XGEN(bx)]) == gen, bar);
            __builtin_amdgcn_fence(__ATOMIC_ACQUIRE, "agent");
            asm volatile("s_waitcnt vmcnt(0)" ::: "memory");
        }
    }
    __syncthreads();
}

namespace att_online {
#define ALAS __attribute__((address_space(3)))
typedef unsigned short bf16;
typedef short bf16x8 __attribute__((ext_vector_type(8)));
typedef short s16x4 __attribute__((ext_vector_type(4)));
typedef float f32x16 __attribute__((ext_vector_type(16)));
typedef unsigned u32x4 __attribute__((ext_vector_type(4)));
constexpr int SEQ = 16384, NHEAD = 8;
constexpr int QP = 768, KP = 768, VP = 512, OP = 1024;
constexpr int QHS = 96, KHS = 96, VHS = 64, OHS = 64;
constexpr int NW = 8, QBLK = 32, QB = QBLK * NW, KVBLK = 64, NQB = SEQ / QB;
constexpr int KSLOT = 12288, VSLOT = 8192;
constexpr int L_K = 0, L_V = 2 * KSLOT, L_WS = L_V + 2 * VSLOT, L_OST = L_WS + NW * 64 * 4, L_BYTES = L_OST + NW * 4096;
constexpr float THR = 8.0f;
__device__ __forceinline__ int crow(int r, int hi) { return (r & 3) + 8 * (r >> 2) + 4 * hi; }
__device__ __forceinline__ unsigned cvtpk(float lo, float hi) { unsigned r; asm volatile("v_cvt_pk_bf16_f32 %0, %1, %2" : "=v"(r) : "v"(lo), "v"(hi)); return r; }
__device__ __forceinline__ float pswap_max(float m) { auto rr = __builtin_amdgcn_permlane32_swap(__float_as_uint(m), __float_as_uint(m), false, false); return __builtin_fmaxf(__uint_as_float(rr[0]), __uint_as_float(rr[1])); }
__device__ __forceinline__ float pswap_sum(float m) { auto rr = __builtin_amdgcn_permlane32_swap(__float_as_uint(m), __float_as_uint(m), false, false); return __uint_as_float(rr[0]) + __uint_as_float(rr[1]); }

__device__ __forceinline__ void attn_unit(int b, int h, int qb, const bf16* Q, const bf16* K, const bf16* V, bf16* O, ALAS unsigned char* shm) {
    int tid_ = threadIdx.x; asm volatile("" : "+v"(tid_));
    const int tid = tid_, lane = tid & 63, r32 = lane & 31, hi = lane >> 5; const int wid = __builtin_amdgcn_readfirstlane(tid >> 6);
    const long rowbase = (long)b * SEQ; const int q0 = qb * QB;
    const bf16* Qw = Q + (rowbase + q0 + wid * QBLK) * QP + h * QHS;
    const bf16* Kh = K + rowbase * KP + h * KHS; const bf16* Vh = V + rowbase * VP + h * VHS;
    ALAS float* wsf = (ALAS float*)(shm + L_WS) + wid * 64;
    const bf16* ksrc = Kh + (long)lane * KP + wid * 8;
    const bf16* vsrc = Vh + (long)(16 * (wid & 3) + (lane >> 2)) * VP + (wid >> 2) * 32 + (lane & 3) * 8;
#define ATT_DMA(t, slot) do { \
        __builtin_amdgcn_global_load_lds((const unsigned*)(ksrc + (long)(t) * KVBLK * KP), (ALAS unsigned*)(shm + L_K + (slot) * KSLOT + wid * 1024), 16, 0, 0); \
        if (wid < 4) __builtin_amdgcn_global_load_lds((const unsigned*)(ksrc + (long)(t) * KVBLK * KP + 64), (ALAS unsigned*)(shm + L_K + (slot) * KSLOT + (8 + wid) * 1024), 16, 0, 0); \
        __builtin_amdgcn_global_load_lds((const unsigned*)(vsrc + (long)(t) * KVBLK * VP), (ALAS unsigned*)(shm + L_V + (slot) * VSLOT + wid * 1024), 16, 0, 0); } while (0)
    const int NT = (q0 + QB) / KVBLK;
    ATT_DMA(0, 0);
    bf16x8 qr[6];
#pragma unroll
    for (int d0 = 0; d0 < 6; ++d0) qr[d0] = *(const bf16x8*)(Qw + (long)r32 * QP + d0 * 16 + hi * 8);
    float mhat = 0.f, l_reg = 0.f; f32x16 o[2], negm;
#pragma unroll
    for (int r = 0; r < 16; ++r) { o[0][r] = 0.f; o[1][r] = 0.f; negm[r] = 0.f; }
    const int qrel = wid * QBLK + r32;
    const unsigned vb0 = (unsigned)(uintptr_t)(shm + L_V) + ((lane >> 4) & 1) * 32 + (lane & 3) * 8 + (4 * hi + ((lane & 15) >> 2)) * 64;
    for (int t = 0; t < NT; ++t) {
        const int cur = t & 1;
        asm volatile("s_waitcnt vmcnt(0)" ::: "memory"); __syncthreads();
        if (t + 1 < NT) ATT_DMA(t + 1, cur ^ 1);
        f32x16 p0, p1;
        { const ALAS unsigned char* kb = shm + L_K + cur * KSLOT + hi * 1024 + r32 * 16;
#pragma unroll
          for (int d0 = 0; d0 < 6; ++d0) {
              const bf16x8 b0 = *(const ALAS bf16x8*)(kb + d0 * 2048), b1 = *(const ALAS bf16x8*)(kb + d0 * 2048 + 512);
              if (d0 == 0) { p0 = __builtin_amdgcn_mfma_f32_32x32x16_bf16(b0, qr[0], negm, 0, 0, 0); p1 = __builtin_amdgcn_mfma_f32_32x32x16_bf16(b1, qr[0], negm, 0, 0, 0); }
              else { p0 = __builtin_amdgcn_mfma_f32_32x32x16_bf16(b0, qr[d0], p0, 0, 0, 0); p1 = __builtin_amdgcn_mfma_f32_32x32x16_bf16(b1, qr[d0], p1, 0, 0, 0); } } }
        const int jb = t - (NT - 4);
        if (jb >= 0) { const int kb0 = 64 * jb + 4 * hi;
#pragma unroll
            for (int r = 0; r < 16; ++r) { const int kv = kb0 + (r & 3) + 8 * (r >> 2); if (kv > qrel) p0[r] = -__builtin_inff(); if (kv + 32 > qrel) p1[r] = -__builtin_inff(); } }
        float rm = __builtin_fmaxf(p0[0], p1[0]);
#pragma unroll
        for (int r = 1; r < 16; ++r) rm = __builtin_fmaxf(rm, __builtin_fmaxf(p0[r], p1[r]));
        rm = pswap_max(rm);
        bool resc = false;
        if (t == 0 || __any(rm > THR)) {
            const float dl = (t == 0) ? rm : __builtin_fmaxf(rm, 0.f); mhat += dl;
#pragma unroll
            for (int r = 0; r < 16; ++r) { p0[r] -= dl; p1[r] -= dl; negm[r] = -mhat; }
            if (t != 0) { const float f = __builtin_amdgcn_exp2f(-dl); l_reg *= f; if (hi == 0) wsf[r32] = f; resc = true; }
        }
        float sacc = 0.f;
#pragma unroll
        for (int r = 0; r < 16; ++r) { p0[r] = __builtin_amdgcn_exp2f(p0[r]); p1[r] = __builtin_amdgcn_exp2f(p1[r]); sacc += p0[r] + p1[r]; }
        l_reg += sacc;
        if (resc) { asm volatile("s_waitcnt lgkmcnt(0)" ::: "memory");
#pragma unroll
            for (int r = 0; r < 16; ++r) { const float f = wsf[crow(r, hi)]; o[0][r] *= f; o[1][r] *= f; }
            asm volatile("s_waitcnt lgkmcnt(0)" ::: "memory"); }
        u32x4 pw[4];
#pragma unroll
        for (int k = 0; k < 2; ++k) { pw[k] = (u32x4){cvtpk(p0[8 * k], p0[8 * k + 1]), cvtpk(p0[8 * k + 2], p0[8 * k + 3]), cvtpk(p0[8 * k + 4], p0[8 * k + 5]), cvtpk(p0[8 * k + 6], p0[8 * k + 7])};
            pw[2 + k] = (u32x4){cvtpk(p1[8 * k], p1[8 * k + 1]), cvtpk(p1[8 * k + 2], p1[8 * k + 3]), cvtpk(p1[8 * k + 4], p1[8 * k + 5]), cvtpk(p1[8 * k + 6], p1[8 * k + 7])}; }
        { const unsigned vb = vb0 + cur * VSLOT;
#pragma unroll
          for (int d0 = 0; d0 < 2; ++d0) { s16x4 lo[4], hh[4];
#pragma unroll
              for (int ks = 0; ks < 4; ++ks) {
                  asm volatile("ds_read_b64_tr_b16 %0, %1 offset:%c2" : "=&v"(lo[ks]) : "v"(vb), "i"(d0 * 4096 + ks * 1024) : "memory");
                  asm volatile("ds_read_b64_tr_b16 %0, %1 offset:%c2" : "=&v"(hh[ks]) : "v"(vb), "i"(d0 * 4096 + ks * 1024 + 512) : "memory"); }
              asm volatile("s_waitcnt lgkmcnt(0)" : "+v"(lo[0]), "+v"(lo[1]), "+v"(lo[2]), "+v"(lo[3]), "+v"(hh[0]), "+v"(hh[1]), "+v"(hh[2]), "+v"(hh[3]) :: "memory");
#pragma unroll
              for (int ks = 0; ks < 4; ++ks) { const bf16x8 vf = (bf16x8){lo[ks][0], lo[ks][1], lo[ks][2], lo[ks][3], hh[ks][0], hh[ks][1], hh[ks][2], hh[ks][3]};
                  o[d0] = __builtin_amdgcn_mfma_f32_32x32x16_bf16(__builtin_bit_cast(bf16x8, pw[ks]), vf, o[d0], 0, 0, 0); } } }
    }
    l_reg = pswap_sum(l_reg);
    if (hi == 0) wsf[32 + r32] = l_reg;
    asm volatile("s_waitcnt lgkmcnt(0)" ::: "memory");
    float rli[16];
#pragma unroll
    for (int r = 0; r < 16; ++r) rli[r] = __builtin_amdgcn_rcpf(wsf[32 + crow(r, hi)]);
    bf16* Ow = O + (rowbase + q0 + wid * QBLK) * OP + h * OHS;
    { ALAS bf16* stg = (ALAS bf16*)(shm + L_OST) + wid * 2048;
#pragma unroll
      for (int r = 0; r < 16; ++r) { const int orow = crow(r, hi);
#pragma unroll
          for (int d0 = 0; d0 < 2; ++d0) { const float v = o[d0][r] * rli[r]; unsigned u = __float_as_uint(v); u = (u + 0x7fffu + ((u >> 16) & 1u)) >> 16; stg[orow * 64 + d0 * 32 + r32] = (bf16)u; } }
      asm volatile("s_waitcnt lgkmcnt(0)" ::: "memory");
#pragma unroll
      for (int i = 0; i < 4; ++i) { const int row = i * 8 + (lane >> 3), ch = lane & 7; const u32x4 v = *(const ALAS u32x4*)(stg + row * 64 + ch * 8); *(u32x4*)(Ow + (long)row * OP + ch * 8) = v; } }
    asm volatile("s_waitcnt lgkmcnt(0)" ::: "memory"); __syncthreads();
#undef ATT_DMA
}
#undef ALAS
}

namespace att {
#define ALAS __attribute__((address_space(3)))
typedef unsigned short bf16;
typedef short bf16x8 __attribute__((ext_vector_type(8)));
typedef short s16x4 __attribute__((ext_vector_type(4)));
typedef float f32x16 __attribute__((ext_vector_type(16)));
typedef unsigned u32x4 __attribute__((ext_vector_type(4)));
constexpr int SEQ = 16384, NHEAD = 8;
constexpr int QP = 768, KP = 768, VP = 512, OP = 1024;
constexpr int QHS = 96, KHS = 96, VHS = 64, OHS = 64;
constexpr int NW = 8, QBLK = 32, QB = QBLK * NW, KVBLK = 64, NQB = SEQ / QB;
constexpr int KSLOT = 12288, VSLOT = 8192;
constexpr int L_K = 0, L_V = 2 * KSLOT, L_WS = L_V + 3 * VSLOT, L_OST = L_WS + NW * 64 * 4, L_BYTES = L_OST + NW * 4096;
constexpr float THR = 8.0f;
__device__ __forceinline__ int crow(int r, int hi) { return (r & 3) + 8 * (r >> 2) + 4 * hi; }
__device__ __forceinline__ unsigned cvtpk(float lo, float hi) { typedef float f32x2_t __attribute__((ext_vector_type(2))); typedef __bf16 bf16x2_t __attribute__((ext_vector_type(2)));
    f32x2_t v = {lo, hi}; bf16x2_t b = __builtin_convertvector(v, bf16x2_t); return __builtin_bit_cast(unsigned, b); }
__device__ __forceinline__ float pswap_max(float m) { auto rr = __builtin_amdgcn_permlane32_swap(__float_as_uint(m), __float_as_uint(m), false, false); return __builtin_fmaxf(__uint_as_float(rr[0]), __uint_as_float(rr[1])); }
__device__ __forceinline__ float pswap_sum(float m) { auto rr = __builtin_amdgcn_permlane32_swap(__float_as_uint(m), __float_as_uint(m), false, false); return __uint_as_float(rr[0]) + __uint_as_float(rr[1]); }
typedef short v4i16_t __attribute__((ext_vector_type(4)));
__device__ __forceinline__ s16x4 vtr(const ALAS unsigned char* p) { return __builtin_bit_cast(s16x4, __builtin_amdgcn_ds_read_tr16_b64_v4i16((ALAS v4i16_t*)p)); }
__device__ __forceinline__ void qkt(f32x16& s0, f32x16& s1, const ALAS unsigned char* kb, const bf16x8 (&qr)[6]) {
    const f32x16 c0 = {};
#pragma unroll
    for (int d0 = 0; d0 < 6; ++d0) {
        const bf16x8 b0 = *(const ALAS bf16x8*)(kb + d0 * 2048), b1 = *(const ALAS bf16x8*)(kb + d0 * 2048 + 512);
        if (d0 == 0) { s0 = __builtin_amdgcn_mfma_f32_32x32x16_bf16(b0, qr[0], c0, 0, 0, 0); s1 = __builtin_amdgcn_mfma_f32_32x32x16_bf16(b1, qr[0], c0, 0, 0, 0); }
        else { s0 = __builtin_amdgcn_mfma_f32_32x32x16_bf16(b0, qr[d0], s0, 0, 0, 0); s1 = __builtin_amdgcn_mfma_f32_32x32x16_bf16(b1, qr[d0], s1, 0, 0, 0); } }
}
__device__ __forceinline__ void pv(f32x16 (&o)[2], const ALAS unsigned char* vp, const u32x4 (&pk)[4]) {
#pragma unroll
    for (int ks = 0; ks < 4; ++ks)
#pragma unroll
        for (int d0 = 0; d0 < 2; ++d0) { const s16x4 lo = vtr(vp + d0 * 4096 + ks * 1024), hh = vtr(vp + d0 * 4096 + ks * 1024 + 512);
            const bf16x8 vf = (bf16x8){lo[0], lo[1], lo[2], lo[3], hh[0], hh[1], hh[2], hh[3]};
            o[d0] = __builtin_amdgcn_mfma_f32_32x32x16_bf16(__builtin_bit_cast(bf16x8, pk[ks]), vf, o[d0], 0, 0, 0); }
}

constexpr float ATT_MREF_MAX = 40.0f;
#define ATT_SBAR() __builtin_amdgcn_sched_barrier(0)
#define ATT_PIN(x) asm volatile("" : "+v"(x))
#define ATT_VLOAD(i) do { if (VAR == 1) break; const s16x4 lo_ = vtr(vfrag + ((i) & 1) * 4096 + ((i) >> 1) * 1024), hi_ = vtr(vfrag + ((i) & 1) * 4096 + ((i) >> 1) * 1024 + 512); vfr[i] = (bf16x8){lo_[0], lo_[1], lo_[2], lo_[3], hi_[0], hi_[1], hi_[2], hi_[3]}; } while (0)
#define ATT_KLOAD(j) do { if (QK && VAR != 1) kfr[j] = *(const ALAS bf16x8*)(kfrag + ((j) >> 1) * 2048 + ((j) & 1) * 512); } while (0)
template <bool QK, int VAR = 0>
__device__ __forceinline__ void attn_step(f32x16& c0, f32x16& c1, f32x16& n0, f32x16& n1, u32x4 (&pk)[4], f32x16 (&o)[2], float& l_reg, const bf16x8 (&qr)[6],
                                          const ALAS unsigned char* kfrag, const ALAS unsigned char* vfrag, int jb, int qrel, int hi) {
    if (jb >= 0) { const int kbase = 64 * jb + 4 * hi;
#pragma unroll
        for (int r = 0; r < 16; ++r) { const int kv = kbase + (r & 3) + 8 * (r >> 2); if (kv > qrel) c0[r] = -__builtin_inff(); if (kv + 32 > qrel) c1[r] = -__builtin_inff(); } }
    bf16x8 vfr[8] = {}, kfr[12] = {}; float sa = 0.f, sb = 0.f; const f32x16 zero16 = {};
    ATT_VLOAD(0); ATT_VLOAD(1); ATT_SBAR();
      if (VAR != 4) o[0] = __builtin_amdgcn_mfma_f32_32x32x16_bf16(__builtin_bit_cast(bf16x8, pk[0]), vfr[0], o[0], 0, 0, 0); if (VAR != 2) { c0[0] = __builtin_amdgcn_exp2f(c0[0]); c0[1] = __builtin_amdgcn_exp2f(c0[1]); } ATT_VLOAD(2); ATT_PIN(c0); ATT_SBAR();
      if (VAR != 4) o[1] = __builtin_amdgcn_mfma_f32_32x32x16_bf16(__builtin_bit_cast(bf16x8, pk[0]), vfr[1], o[1], 0, 0, 0); if (VAR != 2) { c0[2] = __builtin_amdgcn_exp2f(c0[2]); c0[3] = __builtin_amdgcn_exp2f(c0[3]); } if (VAR != 2) { sa += c0[0]; sa += c0[1]; } ATT_VLOAD(3); ATT_PIN(c0); ATT_PIN(sa); ATT_SBAR();
      if (VAR != 4) o[0] = __builtin_amdgcn_mfma_f32_32x32x16_bf16(__builtin_bit_cast(bf16x8, pk[1]), vfr[2], o[0], 0, 0, 0); if (VAR != 2) { c0[4] = __builtin_amdgcn_exp2f(c0[4]); c0[5] = __builtin_amdgcn_exp2f(c0[5]); } if (VAR != 2) { sa += c0[2]; sa += c0[3]; } ATT_VLOAD(4); ATT_PIN(c0); ATT_PIN(sa); ATT_SBAR();
      if (VAR != 4) o[1] = __builtin_amdgcn_mfma_f32_32x32x16_bf16(__builtin_bit_cast(bf16x8, pk[1]), vfr[3], o[1], 0, 0, 0); if (VAR != 2) { c0[6] = __builtin_amdgcn_exp2f(c0[6]); c0[7] = __builtin_amdgcn_exp2f(c0[7]); } if (VAR != 2) { sa += c0[4]; sa += c0[5]; } ATT_VLOAD(5); ATT_PIN(c0); ATT_PIN(sa); ATT_SBAR();
      if (VAR != 4) o[0] = __builtin_amdgcn_mfma_f32_32x32x16_bf16(__builtin_bit_cast(bf16x8, pk[2]), vfr[4], o[0], 0, 0, 0); if (VAR != 2) { c0[8] = __builtin_amdgcn_exp2f(c0[8]); c0[9] = __builtin_amdgcn_exp2f(c0[9]); } if (VAR != 2) { sa += c0[6]; sa += c0[7]; } if (VAR != 2) { pk[0].x = cvtpk(c0[0], c0[1]); pk[0].y = cvtpk(c0[2], c0[3]); } ATT_VLOAD(6); ATT_PIN(c0); ATT_PIN(pk[0]); ATT_PIN(sa); ATT_SBAR();
      if (VAR != 4) o[1] = __builtin_amdgcn_mfma_f32_32x32x16_bf16(__builtin_bit_cast(bf16x8, pk[2]), vfr[5], o[1], 0, 0, 0); if (VAR != 2) { c0[10] = __builtin_amdgcn_exp2f(c0[10]); c0[11] = __builtin_amdgcn_exp2f(c0[11]); } if (VAR != 2) { sa += c0[8]; sa += c0[9]; } if (VAR != 2) { pk[0].z = cvtpk(c0[4], c0[5]); pk[0].w = cvtpk(c0[6], c0[7]); } ATT_VLOAD(7); ATT_PIN(c0); ATT_PIN(pk[0]); ATT_PIN(sa); ATT_SBAR();
      if (VAR != 4) o[0] = __builtin_amdgcn_mfma_f32_32x32x16_bf16(__builtin_bit_cast(bf16x8, pk[3]), vfr[6], o[0], 0, 0, 0); if (VAR != 2) { c0[12] = __builtin_amdgcn_exp2f(c0[12]); c0[13] = __builtin_amdgcn_exp2f(c0[13]); } if (VAR != 2) { sa += c0[10]; sa += c0[11]; } ATT_KLOAD(0); ATT_PIN(c0); ATT_PIN(sa); ATT_SBAR();
      if (VAR != 4) o[1] = __builtin_amdgcn_mfma_f32_32x32x16_bf16(__builtin_bit_cast(bf16x8, pk[3]), vfr[7], o[1], 0, 0, 0); if (VAR != 2) { c0[14] = __builtin_amdgcn_exp2f(c0[14]); c0[15] = __builtin_amdgcn_exp2f(c0[15]); } if (VAR != 2) { sa += c0[12]; sa += c0[13]; } ATT_KLOAD(1); ATT_PIN(c0); ATT_PIN(sa); ATT_SBAR();
      if (QK && VAR != 4) n0 = __builtin_amdgcn_mfma_f32_32x32x16_bf16(kfr[0], qr[0], zero16, 0, 0, 0); if (VAR != 2) { c1[0] = __builtin_amdgcn_exp2f(c1[0]); c1[1] = __builtin_amdgcn_exp2f(c1[1]); } if (VAR != 2) { sa += c0[14]; sa += c0[15]; } if (VAR != 2) { pk[1].x = cvtpk(c0[8], c0[9]); pk[1].y = cvtpk(c0[10], c0[11]); } ATT_KLOAD(2); ATT_PIN(c1); ATT_PIN(pk[1]); ATT_PIN(sa); ATT_SBAR();
      if (QK && VAR != 4) n1 = __builtin_amdgcn_mfma_f32_32x32x16_bf16(kfr[1], qr[0], zero16, 0, 0, 0); if (VAR != 2) { c1[2] = __builtin_amdgcn_exp2f(c1[2]); c1[3] = __builtin_amdgcn_exp2f(c1[3]); } if (VAR != 2) { sb += c1[0]; sb += c1[1]; } if (VAR != 2) { pk[1].z = cvtpk(c0[12], c0[13]); pk[1].w = cvtpk(c0[14], c0[15]); } ATT_KLOAD(3); ATT_PIN(c1); ATT_PIN(pk[1]); ATT_PIN(sb); ATT_SBAR();
      if (QK && VAR != 4) n0 = __builtin_amdgcn_mfma_f32_32x32x16_bf16(kfr[2], qr[1], n0, 0, 0, 0); if (VAR != 2) { c1[4] = __builtin_amdgcn_exp2f(c1[4]); c1[5] = __builtin_amdgcn_exp2f(c1[5]); } if (VAR != 2) { sb += c1[2]; sb += c1[3]; } ATT_KLOAD(4); ATT_PIN(c1); ATT_PIN(sb); ATT_SBAR();
      if (QK && VAR != 4) n1 = __builtin_amdgcn_mfma_f32_32x32x16_bf16(kfr[3], qr[1], n1, 0, 0, 0); if (VAR != 2) { c1[6] = __builtin_amdgcn_exp2f(c1[6]); c1[7] = __builtin_amdgcn_exp2f(c1[7]); } if (VAR != 2) { sb += c1[4]; sb += c1[5]; } ATT_KLOAD(5); ATT_PIN(c1); ATT_PIN(sb); ATT_SBAR();
      if (QK && VAR != 4) n0 = __builtin_amdgcn_mfma_f32_32x32x16_bf16(kfr[4], qr[2], n0, 0, 0, 0); if (VAR != 2) { c1[8] = __builtin_amdgcn_exp2f(c1[8]); c1[9] = __builtin_amdgcn_exp2f(c1[9]); } if (VAR != 2) { sb += c1[6]; sb += c1[7]; } if (VAR != 2) { pk[2].x = cvtpk(c1[0], c1[1]); pk[2].y = cvtpk(c1[2], c1[3]); } ATT_KLOAD(6); ATT_PIN(c1); ATT_PIN(pk[2]); ATT_PIN(sb); ATT_SBAR();
      if (QK && VAR != 4) n1 = __builtin_amdgcn_mfma_f32_32x32x16_bf16(kfr[5], qr[2], n1, 0, 0, 0); if (VAR != 2) { c1[10] = __builtin_amdgcn_exp2f(c1[10]); c1[11] = __builtin_amdgcn_exp2f(c1[11]); } if (VAR != 2) { sb += c1[8]; sb += c1[9]; } if (VAR != 2) { pk[2].z = cvtpk(c1[4], c1[5]); pk[2].w = cvtpk(c1[6], c1[7]); } ATT_KLOAD(7); ATT_PIN(c1); ATT_PIN(pk[2]); ATT_PIN(sb); ATT_SBAR();
      if (QK && VAR != 4) n0 = __builtin_amdgcn_mfma_f32_32x32x16_bf16(kfr[6], qr[3], n0, 0, 0, 0); if (VAR != 2) { c1[12] = __builtin_amdgcn_exp2f(c1[12]); c1[13] = __builtin_amdgcn_exp2f(c1[13]); } if (VAR != 2) { sb += c1[10]; sb += c1[11]; } ATT_KLOAD(8); ATT_PIN(c1); ATT_PIN(sb); ATT_SBAR();
      if (QK && VAR != 4) n1 = __builtin_amdgcn_mfma_f32_32x32x16_bf16(kfr[7], qr[3], n1, 0, 0, 0); if (VAR != 2) { c1[14] = __builtin_amdgcn_exp2f(c1[14]); c1[15] = __builtin_amdgcn_exp2f(c1[15]); } if (VAR != 2) { sb += c1[12]; sb += c1[13]; } ATT_KLOAD(9); ATT_PIN(c1); ATT_PIN(sb); ATT_SBAR();
      if (QK && VAR != 4) n0 = __builtin_amdgcn_mfma_f32_32x32x16_bf16(kfr[8], qr[4], n0, 0, 0, 0); if (VAR != 2) { sb += c1[14]; sb += c1[15]; } if (VAR != 2) { pk[3].x = cvtpk(c1[8], c1[9]); pk[3].y = cvtpk(c1[10], c1[11]); } ATT_KLOAD(10); ATT_PIN(pk[3]); ATT_PIN(sb); ATT_SBAR();
      if (QK && VAR != 4) n1 = __builtin_amdgcn_mfma_f32_32x32x16_bf16(kfr[9], qr[4], n1, 0, 0, 0); if (VAR != 2) { pk[3].z = cvtpk(c1[12], c1[13]); pk[3].w = cvtpk(c1[14], c1[15]); } ATT_KLOAD(11); ATT_PIN(pk[3]); ATT_SBAR();
      if (QK && VAR != 4) n0 = __builtin_amdgcn_mfma_f32_32x32x16_bf16(kfr[10], qr[5], n0, 0, 0, 0); ATT_SBAR();
      if (QK && VAR != 4) n1 = __builtin_amdgcn_mfma_f32_32x32x16_bf16(kfr[11], qr[5], n1, 0, 0, 0); ATT_SBAR();
    l_reg += sa + sb;
}
#undef ATT_VLOAD
#undef ATT_KLOAD

template <int VAR = 0>
__device__ __forceinline__ void attn_unit(int b, int h, int qb, const bf16* Q, const bf16* K, const bf16* V, bf16* O, ALAS unsigned char* shm, int OPR = OP) {
    int tid_ = threadIdx.x; asm volatile("" : "+v"(tid_));
    const int tid = tid_, lane = tid & 63, r32 = lane & 31, hi = lane >> 5; const int wid = __builtin_amdgcn_readfirstlane(tid >> 6);
    const long rowbase = (long)b * SEQ; const int q0 = qb * QB;
    const bf16* Qw = Q + (rowbase + q0 + wid * QBLK) * QP + h * QHS;
    const bf16* Kh = K + rowbase * KP + h * KHS; const bf16* Vh = V + rowbase * VP + h * VHS;
    ALAS float* wsf = (ALAS float*)(shm + L_WS) + wid * 64;
    const bf16* ksrc = Kh + (long)lane * KP + wid * 8;
    const bf16* vsrc = Vh + (long)(16 * (wid & 3) + (lane >> 2)) * VP + (wid >> 2) * 32 + (lane & 3) * 8;
#define ATT_DMA_K(t, slot) do { \
        __builtin_amdgcn_global_load_lds((const unsigned*)(ksrc + (long)(t) * KVBLK * KP), (ALAS unsigned*)(shm + L_K + (slot) * KSLOT + wid * 1024), 16, 0, 0); \
        if (wid < 4) __builtin_amdgcn_global_load_lds((const unsigned*)(ksrc + (long)(t) * KVBLK * KP + 64), (ALAS unsigned*)(shm + L_K + (slot) * KSLOT + (8 + wid) * 1024), 16, 0, 0); } while (0)
#define ATT_DMA_V(t, slotoff) __builtin_amdgcn_global_load_lds((const unsigned*)(vsrc + (long)(t) * KVBLK * VP), (ALAS unsigned*)(shm + L_V + (slotoff) + wid * 1024), 16, 0, 0)
    const int NT = (q0 + QB) / KVBLK;
    ATT_DMA_K(0, 0); ATT_DMA_V(0, 0); ATT_DMA_K(1, 1);
    bf16x8 qr[6];
#pragma unroll
    for (int d0 = 0; d0 < 6; ++d0) qr[d0] = *(const bf16x8*)(Qw + (long)r32 * QP + d0 * 16 + hi * 8);
    float l_reg = 0.f; f32x16 o[2];
#pragma unroll
    for (int r = 0; r < 16; ++r) { o[0][r] = 0.f; o[1][r] = 0.f; }
    const int qrel = wid * QBLK + r32;
    const ALAS unsigned char* kb0 = shm + L_K + hi * 1024 + r32 * 16;
    const ALAS unsigned char* vp0 = shm + L_V + ((lane >> 4) & 1) * 32 + (lane & 3) * 8 + (4 * hi + ((lane & 15) >> 2)) * 64;
    asm volatile("s_waitcnt vmcnt(0)" ::: "memory"); __syncthreads();
    f32x16 sA0, sA1, sB0, sB1;
    qkt(sA0, sA1, kb0, qr);
    u32x4 pk[4] = {};
    int vs_prev = 0, vs_cur = 0, vs_next = VSLOT;
#define ATT_TOP(t) do { if (VAR == 3) break; asm volatile("s_waitcnt vmcnt(0)" ::: "memory"); __syncthreads();        \
        if ((t) + 2 < NT) ATT_DMA_K((t) + 2, (t) & 1); if ((t) + 1 < NT) ATT_DMA_V((t) + 1, vs_next); } while (0)
#define ATT_ROT() do { vs_prev = vs_cur; vs_cur = vs_next; vs_next = (vs_next == 2 * VSLOT) ? 0 : vs_next + VSLOT; } while (0)
    int t = 0;
    for (; t < NT - 2; t += 2) {
        ATT_TOP(t);
        attn_step<true, VAR>(sA0, sA1, sB0, sB1, pk, o, l_reg, qr, kb0 + KSLOT, vp0 + vs_prev, t - (NT - 4), qrel, hi);
        ATT_ROT();
        ATT_TOP(t + 1);
        attn_step<true, VAR>(sB0, sB1, sA0, sA1, pk, o, l_reg, qr, kb0, vp0 + vs_prev, t + 1 - (NT - 4), qrel, hi);
        ATT_ROT();
    }
    ATT_TOP(t);
    attn_step<true, VAR>(sA0, sA1, sB0, sB1, pk, o, l_reg, qr, kb0 + KSLOT, vp0 + vs_prev, 2, qrel, hi);
    ATT_ROT();
    ATT_TOP(t + 1);
    attn_step<false, VAR>(sB0, sB1, sA0, sA1, pk, o, l_reg, qr, kb0, vp0 + vs_prev, 3, qrel, hi);
    ATT_ROT();
    pv(o, vp0 + vs_prev, pk);
    l_reg = pswap_sum(l_reg);
    if (hi == 0) wsf[32 + r32] = l_reg;
    float rli[16];
#pragma unroll
    for (int r = 0; r < 16; ++r) rli[r] = __builtin_amdgcn_rcpf(wsf[32 + crow(r, hi)]);
    bf16* Ow = O + (rowbase + q0 + wid * QBLK) * OPR + h * OHS;
    { ALAS bf16* stg = (ALAS bf16*)(shm + L_OST) + wid * 2048;
#pragma unroll
      for (int r = 0; r < 16; ++r) { const int orow = crow(r, hi);
#pragma unroll
          for (int d0 = 0; d0 < 2; ++d0) { const float v = o[d0][r] * rli[r]; unsigned u = __float_as_uint(v); u = (u + 0x7fffu + ((u >> 16) & 1u)) >> 16; stg[orow * 64 + d0 * 32 + r32] = (bf16)u; } }
#pragma unroll
      for (int i = 0; i < 4; ++i) { const int row = i * 8 + (lane >> 3), ch = lane & 7; const u32x4 v = *(const ALAS u32x4*)(stg + row * 64 + ch * 8); *(u32x4*)(Ow + (long)row * OPR + ch * 8) = v; } }
    __syncthreads();
#undef ATT_DMA_K
#undef ATT_DMA_V
#undef ATT_TOP
#undef ATT_ROT
}
#undef ALAS
}

namespace att2 {
#define ALAS __attribute__((address_space(3)))
using att::bf16; using att::bf16x8; using att::s16x4; using att::f32x16; using att::u32x4; using att::crow; using att::cvtpk; using att::pswap_sum; using att::vtr;
constexpr int SEQ = 16384, QP = 768, KP = 768, VP = 512, OP = 1024, QHS = 96, KHS = 96, VHS = 64, OHS = 64;
constexpr int NW = 8, QB = 512, KVBLK = 64, NQB = SEQ / QB;
constexpr int KSLOT = 12288, VSLOT = 8192;
constexpr int L_K = 0, L_V = 2 * KSLOT, L_WS = L_V + 2 * VSLOT, L_OST = L_WS + NW * 64 * 4, L_BYTES = L_OST + NW * 4096;
__device__ __forceinline__ void softmax_pack(f32x16& p0, f32x16& p1, u32x4 (&pk)[4], float& l_reg) {
    float sa = 0.f, sb = 0.f;
#pragma unroll
    for (int r = 0; r < 16; ++r) { p0[r] = __builtin_amdgcn_exp2f(p0[r]); p1[r] = __builtin_amdgcn_exp2f(p1[r]); sa += p0[r]; sb += p1[r]; }
    l_reg += sa + sb;
#pragma unroll
    for (int k = 0; k < 2; ++k) { pk[k] = (u32x4){cvtpk(p0[8 * k], p0[8 * k + 1]), cvtpk(p0[8 * k + 2], p0[8 * k + 3]), cvtpk(p0[8 * k + 4], p0[8 * k + 5]), cvtpk(p0[8 * k + 6], p0[8 * k + 7])};
        pk[2 + k] = (u32x4){cvtpk(p1[8 * k], p1[8 * k + 1]), cvtpk(p1[8 * k + 2], p1[8 * k + 3]), cvtpk(p1[8 * k + 4], p1[8 * k + 5]), cvtpk(p1[8 * k + 6], p1[8 * k + 7])}; }
}
__device__ __forceinline__ void attn_unit(int b, int h, int qb, const bf16* Q, const bf16* K, const bf16* V, bf16* O, ALAS unsigned char* shm) {
    int tid_ = threadIdx.x; asm volatile("" : "+v"(tid_));
    const int tid = tid_, lane = tid & 63, r32 = lane & 31, hi = lane >> 5; const int wid = __builtin_amdgcn_readfirstlane(tid >> 6);
    const long rowbase = (long)b * SEQ; const int q0 = qb * QB;
    const bf16* Qw = Q + (rowbase + q0 + wid * 64) * QP + h * QHS;
    const bf16* Kh = K + rowbase * KP + h * KHS; const bf16* Vh = V + rowbase * VP + h * VHS;
    ALAS float* wsf = (ALAS float*)(shm + L_WS) + wid * 64;
    const bf16* ksrc = Kh + (long)lane * KP + wid * 8;
    const bf16* vsrc = Vh + (long)(16 * (wid & 3) + (lane >> 2)) * VP + (wid >> 2) * 32 + (lane & 3) * 8;
#define ATT_DMA(t, slot) do { \
        __builtin_amdgcn_global_load_lds((const unsigned*)(ksrc + (long)(t) * KVBLK * KP), (ALAS unsigned*)(shm + L_K + (slot) * KSLOT + wid * 1024), 16, 0, 0); \
        if (wid < 4) __builtin_amdgcn_global_load_lds((const unsigned*)(ksrc + (long)(t) * KVBLK * KP + 64), (ALAS unsigned*)(shm + L_K + (slot) * KSLOT + (8 + wid) * 1024), 16, 0, 0); \
        __builtin_amdgcn_global_load_lds((const unsigned*)(vsrc + (long)(t) * KVBLK * VP), (ALAS unsigned*)(shm + L_V + (slot) * VSLOT + wid * 1024), 16, 0, 0); } while (0)
    const int NT = (q0 + QB) / KVBLK;
    ATT_DMA(0, 0);
    bf16x8 qa[6], qb_[6];
#pragma unroll
    for (int d0 = 0; d0 < 6; ++d0) { qa[d0] = *(const bf16x8*)(Qw + (long)r32 * QP + d0 * 16 + hi * 8); qb_[d0] = *(const bf16x8*)(Qw + (long)(32 + r32) * QP + d0 * 16 + hi * 8); }
    float la = 0.f, lb = 0.f; f32x16 oa[2], ob[2];
#pragma unroll
    for (int r = 0; r < 16; ++r) { oa[0][r] = 0.f; oa[1][r] = 0.f; ob[0][r] = 0.f; ob[1][r] = 0.f; }
    const ALAS unsigned char* kb0 = shm + L_K + hi * 1024 + r32 * 16;
    const ALAS unsigned char* vp0 = shm + L_V + ((lane >> 4) & 1) * 32 + (lane & 3) * 8 + (4 * hi + ((lane & 15) >> 2)) * 64;
    for (int t = 0; t < NT; ++t) {
        const int cur = t & 1;
        asm volatile("s_waitcnt vmcnt(0)" ::: "memory"); __syncthreads();
        if (t + 1 < NT) ATT_DMA(t + 1, cur ^ 1);
        const int jb = t - (NT - 8);
        if (jb > wid) continue;
        f32x16 pa0, pa1, pb0, pb1; const f32x16 z16 = {};
        { const ALAS unsigned char* kb = kb0 + cur * KSLOT;
#pragma unroll
          for (int d0 = 0; d0 < 6; ++d0) {
              const bf16x8 k0 = *(const ALAS bf16x8*)(kb + d0 * 2048), k1 = *(const ALAS bf16x8*)(kb + d0 * 2048 + 512);
              pa0 = __builtin_amdgcn_mfma_f32_32x32x16_bf16(k0, qa[d0], d0 == 0 ? z16 : pa0, 0, 0, 0); pa1 = __builtin_amdgcn_mfma_f32_32x32x16_bf16(k1, qa[d0], d0 == 0 ? z16 : pa1, 0, 0, 0);
              pb0 = __builtin_amdgcn_mfma_f32_32x32x16_bf16(k0, qb_[d0], d0 == 0 ? z16 : pb0, 0, 0, 0); pb1 = __builtin_amdgcn_mfma_f32_32x32x16_bf16(k1, qb_[d0], d0 == 0 ? z16 : pb1, 0, 0, 0); } }
        if (jb == wid) {
#pragma unroll
            for (int r = 0; r < 16; ++r) { const int kv = 4 * hi + (r & 3) + 8 * (r >> 2);
                if (kv > r32) pa0[r] = -__builtin_inff();
                pa1[r] = -__builtin_inff();
                if (kv > r32) pb1[r] = -__builtin_inff(); }
        }
        u32x4 pka[4], pkb[4];
        softmax_pack(pa0, pa1, pka, la); softmax_pack(pb0, pb1, pkb, lb);
        { const ALAS unsigned char* vp = vp0 + cur * VSLOT;
#pragma unroll
          for (int ks = 0; ks < 4; ++ks)
#pragma unroll
              for (int d0 = 0; d0 < 2; ++d0) { const s16x4 lo = vtr(vp + d0 * 4096 + ks * 1024), hh = vtr(vp + d0 * 4096 + ks * 1024 + 512);
                  const bf16x8 vf = (bf16x8){lo[0], lo[1], lo[2], lo[3], hh[0], hh[1], hh[2], hh[3]};
                  oa[d0] = __builtin_amdgcn_mfma_f32_32x32x16_bf16(__builtin_bit_cast(bf16x8, pka[ks]), vf, oa[d0], 0, 0, 0);
                  ob[d0] = __builtin_amdgcn_mfma_f32_32x32x16_bf16(__builtin_bit_cast(bf16x8, pkb[ks]), vf, ob[d0], 0, 0, 0); } }
    }
#pragma unroll
    for (int blk = 0; blk < 2; ++blk) {
        float l_reg = pswap_sum(blk == 0 ? la : lb);
        if (hi == 0) wsf[32 + r32] = l_reg;
        float rli[16];
#pragma unroll
        for (int r = 0; r < 16; ++r) rli[r] = __builtin_amdgcn_rcpf(wsf[32 + crow(r, hi)]);
        bf16* Ow = O + (rowbase + q0 + wid * 64 + blk * 32) * OP + h * OHS;
        ALAS bf16* stg = (ALAS bf16*)(shm + L_OST) + wid * 2048;
#pragma unroll
        for (int r = 0; r < 16; ++r) { const int orow = crow(r, hi);
#pragma unroll
            for (int d0 = 0; d0 < 2; ++d0) { const float v = (blk == 0 ? oa[d0][r] : ob[d0][r]) * rli[r]; unsigned u = __float_as_uint(v); u = (u + 0x7fffu + ((u >> 16) & 1u)) >> 16; stg[orow * 64 + d0 * 32 + r32] = (bf16)u; } }
#pragma unroll
        for (int i = 0; i < 4; ++i) { const int row = i * 8 + (lane >> 3), ch = lane & 7; const u32x4 v = *(const ALAS u32x4*)(stg + row * 64 + ch * 8); *(u32x4*)(Ow + (long)row * OP + ch * 8) = v; }
    }
    __syncthreads();
#undef ATT_DMA
}
#undef ALAS
}

namespace att3 {
#define ALAS __attribute__((address_space(3)))
using att::bf16; using att::bf16x8; using att::s16x4; using att::f32x16; using att::u32x4; using att::crow; using att::cvtpk; using att::pswap_sum; using att::vtr;
using att2::softmax_pack;
constexpr int SEQ = 16384, QP = 768, KP = 768, VP = 512, OP = 1024, QHS = 96, KHS = 96, VHS = 64, OHS = 64;
constexpr int NW = 8, QB = 512, KVBLK = 64;
constexpr int KSLOT = 12288, VSLOT = 8192;
constexpr int L_K = 0, L_V = 2 * KSLOT, L_WS = L_V + 2 * VSLOT, L_OST = L_WS + NW * 64 * 4, L_BYTES = L_OST + NW * 4096;
__device__ __forceinline__ void attn_unit(int b, int h, int qb, const bf16* Q, const bf16* K, const bf16* V, bf16* O, ALAS unsigned char* shm) {
    int tid_ = threadIdx.x; asm volatile("" : "+v"(tid_));
    const int tid = tid_, lane = tid & 63, r32 = lane & 31, hi = lane >> 5; const int wid = __builtin_amdgcn_readfirstlane(tid >> 6);
    const long rowbase = (long)b * SEQ; const int q0 = qb * QB;
    const bf16* Qw = Q + (rowbase + q0 + wid * 64) * QP + h * QHS;
    const bf16* Kh = K + rowbase * KP + h * KHS; const bf16* Vh = V + rowbase * VP + h * VHS;
    ALAS float* wsf = (ALAS float*)(shm + L_WS) + wid * 64;
    const unsigned lds0 = (unsigned)(uintptr_t)shm;
    const bf16* ksrc = Kh + (long)lane * KP + wid * 8;
    const int kdelta = (8 + (wid & 3) - wid) * 8;
    const bf16* vsrc = Vh + (long)(16 * (wid & 3) + (lane >> 2)) * VP + (wid >> 2) * 32 + (lane & 3) * 8;
#define GLDS16(gsrc, ldsdst) do { unsigned keep_; asm volatile("s_mov_b32 %0, m0\n\ts_mov_b32 m0, %2\n\ts_nop 0\n\tglobal_load_lds_dwordx4 %1, off\n\ts_mov_b32 m0, %0" : "=&s"(keep_) : "v"(gsrc), "s"(ldsdst) : "memory"); } while (0)
#define DMA_K(t, slot) do { GLDS16(ksrc + (long)(t) * KVBLK * KP, (unsigned)__builtin_amdgcn_readfirstlane(lds0 + L_K + (slot) * KSLOT + wid * 1024)); \
        GLDS16(ksrc + ((long)(t) * KVBLK * KP + kdelta), (unsigned)__builtin_amdgcn_readfirstlane(lds0 + L_K + (slot) * KSLOT + (8 + (wid & 3)) * 1024)); } while (0)
#define DMA_V(t, slot) GLDS16(vsrc + (long)(t) * KVBLK * VP, (unsigned)__builtin_amdgcn_readfirstlane(lds0 + L_V + (slot) * VSLOT + wid * 1024))
#define BAR_W(n) do { asm volatile("s_waitcnt vmcnt(" #n ") lgkmcnt(0)" ::: "memory"); __builtin_amdgcn_s_barrier(); asm volatile("" ::: "memory"); } while (0)
#define BAR1(t) do { if ((t) < NT) BAR_W(1); else BAR_W(0); if ((t) + 1 < NT) DMA_K((t) + 1, ((t) + 1) & 1); } while (0)
#define BAR2(t) do { if ((t) + 1 < NT) BAR_W(2); else BAR_W(0); if ((t) + 1 < NT) DMA_V((t) + 1, ((t) + 1) & 1); } while (0)
    const int NT = (q0 + QB) / KVBLK;
    DMA_K(0, 0); DMA_V(0, 0);
    bf16x8 qa[6], qb_[6];
#pragma unroll
    for (int d0 = 0; d0 < 6; ++d0) { qa[d0] = *(const bf16x8*)(Qw + (long)r32 * QP + d0 * 16 + hi * 8); qb_[d0] = *(const bf16x8*)(Qw + (long)(32 + r32) * QP + d0 * 16 + hi * 8); }
    asm volatile("s_waitcnt vmcnt(0)" ::: "memory");
    float la = 0.f, lb = 0.f; f32x16 oa[2], ob[2];
#pragma unroll
    for (int r = 0; r < 16; ++r) { oa[0][r] = 0.f; oa[1][r] = 0.f; ob[0][r] = 0.f; ob[1][r] = 0.f; }
    const ALAS unsigned char* kb0 = shm + L_K + hi * 1024 + r32 * 16;
    const ALAS unsigned char* vp0 = shm + L_V + ((lane >> 4) & 1) * 32 + (lane & 3) * 8 + (4 * hi + ((lane & 15) >> 2)) * 64;
    f32x16 pa0, pa1, pb0, pb1;
#define ALPHA(t) do { if ((t) - (NT - 8) <= wid) { const ALAS unsigned char* kb = kb0 + ((t) & 1) * KSLOT; const f32x16 z16 = {}; \
        bf16x8 k0n = *(const ALAS bf16x8*)(kb), k1n = *(const ALAS bf16x8*)(kb + 512); \
        _Pragma("unroll") for (int d0 = 0; d0 < 6; ++d0) { const bf16x8 k0 = k0n, k1 = k1n; \
            if (d0 < 5) { k0n = *(const ALAS bf16x8*)(kb + (d0 + 1) * 2048); k1n = *(const ALAS bf16x8*)(kb + (d0 + 1) * 2048 + 512); }     \
            pa0 = __builtin_amdgcn_mfma_f32_32x32x16_bf16(k0, qa[d0], d0 == 0 ? z16 : pa0, 0, 0, 0); pa1 = __builtin_amdgcn_mfma_f32_32x32x16_bf16(k1, qa[d0], d0 == 0 ? z16 : pa1, 0, 0, 0); \
            pb0 = __builtin_amdgcn_mfma_f32_32x32x16_bf16(k0, qb_[d0], d0 == 0 ? z16 : pb0, 0, 0, 0); pb1 = __builtin_amdgcn_mfma_f32_32x32x16_bf16(k1, qb_[d0], d0 == 0 ? z16 : pb1, 0, 0, 0); \
            __builtin_amdgcn_sched_barrier(0); } } } while (0)
#define BETA(t) do { const int jb_ = (t) - (NT - 8); if (jb_ <= wid) { \
        if (jb_ == wid) { _Pragma("unroll") for (int r = 0; r < 16; ++r) { const int kv = 4 * hi + (r & 3) + 8 * (r >> 2); \
            if (kv > r32) pa0[r] = -__builtin_inff(); pa1[r] = -__builtin_inff(); if (kv > r32) pb1[r] = -__builtin_inff(); } } \
        u32x4 pka[4], pkb[4]; softmax_pack(pa0, pa1, pka, la); softmax_pack(pb0, pb1, pkb, lb); \
        const ALAS unsigned char* vp = vp0 + ((t) & 1) * VSLOT; \
        _Pragma("unroll") for (int i_ = 0; i_ < 8; ++i_) { const int ks = i_ >> 1, d0 = i_ & 1; \
            const s16x4 lo = vtr(vp + d0 * 4096 + ks * 1024), hh = vtr(vp + d0 * 4096 + ks * 1024 + 512); \
            const bf16x8 vf = (bf16x8){lo[0], lo[1], lo[2], lo[3], hh[0], hh[1], hh[2], hh[3]}; \
            oa[d0] = __builtin_amdgcn_mfma_f32_32x32x16_bf16(__builtin_bit_cast(bf16x8, pka[ks]), vf, oa[d0], 0, 0, 0); \
            ob[d0] = __builtin_amdgcn_mfma_f32_32x32x16_bf16(__builtin_bit_cast(bf16x8, pkb[ks]), vf, ob[d0], 0, 0, 0); \
            __builtin_amdgcn_sched_barrier(0); } } } while (0)
    if (wid < 4) {
        for (int t = 0; t < NT; ++t) { BAR1(t); ALPHA(t); BAR2(t); BETA(t); }
        BAR1(NT); BAR2(NT);
    } else {
        BAR1(0); BAR2(0); ALPHA(0);
        for (int t = 1; t < NT; ++t) { BAR1(t); BETA(t - 1); BAR2(t); ALPHA(t); }
        BAR1(NT); BETA(NT - 1); BAR2(NT);
    }
#pragma unroll
    for (int blk = 0; blk < 2; ++blk) {
        float l_reg = pswap_sum(blk == 0 ? la : lb);
        if (hi == 0) wsf[32 + r32] = l_reg;
        float rli[16];
#pragma unroll
        for (int r = 0; r < 16; ++r) rli[r] = __builtin_amdgcn_rcpf(wsf[32 + crow(r, hi)]);
        bf16* Ow = O + (rowbase + q0 + wid * 64 + blk * 32) * OP + h * OHS;
        ALAS bf16* stg = (ALAS bf16*)(shm + L_OST) + wid * 2048;
#pragma unroll
        for (int r = 0; r < 16; ++r) { const int orow = crow(r, hi);
#pragma unroll
            for (int d0 = 0; d0 < 2; ++d0) { const float v = (blk == 0 ? oa[d0][r] : ob[d0][r]) * rli[r]; unsigned u = __float_as_uint(v); u = (u + 0x7fffu + ((u >> 16) & 1u)) >> 16; stg[orow * 64 + d0 * 32 + r32] = (bf16)u; } }
#pragma unroll
        for (int i = 0; i < 4; ++i) { const int row = i * 8 + (lane >> 3), ch = lane & 7; const u32x4 v = *(const ALAS u32x4*)(stg + row * 64 + ch * 8); *(u32x4*)(Ow + (long)row * OP + ch * 8) = v; }
    }
    asm volatile("s_waitcnt vmcnt(0) lgkmcnt(0)" ::: "memory"); __syncthreads();
#undef GLDS16
#undef DMA_K
#undef DMA_V
#undef BAR_W
#undef BAR1
#undef BAR2
#undef ALPHA
#undef BETA
}
#undef ALAS
}

constexpr int NB = 2, SEQ = 16384, D = 1024, NTOK = NB * SEQ, DEPTH = 4;
constexpr int INCOLS = 1440, INP = 1536;
constexpr int UPK = 384, UPN = 1792;
constexpr int LRUW = 512;
constexpr int DFF = 2816, NEXP = 8, DFE = 3584;
constexpr int MOE_TILES = (2 * NTOK) / 256 + NEXP;
constexpr float EPS = 1e-6f;
constexpr int NWAVES = 8;

constexpr size_t MiB = 1u << 20;
constexpr size_t WS_CTL = 0, CTL_ZERO_BYTES = 1 * MiB;
constexpr size_t WS_MREF = 6 * MiB + 64 * 1024;
constexpr size_t WS_RSC = 10 * MiB;
constexpr size_t WS_MODP = 1 * MiB;
constexpr size_t WS_MOD = 1 * MiB + 768 * 1024;
constexpr size_t WS_COS = 2 * MiB, WS_SIN = 4 * MiB;
constexpr size_t WS_LAMC = 6 * MiB;
constexpr size_t WS_TOKE = 7 * MiB, WS_TOKR = WS_TOKE + 256 * 1024, WS_TOKW = WS_TOKR + 256 * 1024, WS_TOKP = WS_TOKW + 256 * 1024;
constexpr size_t WS_RTE = 8 * MiB;
constexpr size_t WS_PL = 9 * MiB, WS_HC = 9 * MiB + 512 * 1024;
constexpr size_t WS_WSMALL = 16 * MiB, WSMALL_STRIDE = 8 * MiB;
constexpr size_t WS_WDENSE = 48 * MiB, WDENSE_STRIDE = 17 * MiB;
constexpr size_t WS_WMOE_GU = 82 * MiB, WS_WMOE_D = 194 * MiB;
constexpr size_t WS_H = 250 * MiB;
constexpr size_t WS_Z = 314 * MiB, WS_A2 = 410 * MiB, WS_XR = 866 * MiB, WS_QKV = 466 * MiB, WS_Q = 578 * MiB, WS_K = 626 * MiB, WS_LA = 674 * MiB, WS_XB = 738 * MiB, WS_Y = 802 * MiB;
constexpr size_t WS_HID = 314 * MiB;
constexpr size_t WS_HS = 314 * MiB, WS_Y2 = 314 * MiB, WS_MHID = 446 * MiB;
constexpr size_t WS_END = 908 * MiB;
static_assert(WS_MHID + (size_t)MOE_TILES * 256 * DFE <= WS_XB && WS_LA + (size_t)NTOK * 512 * 4 <= WS_XB && WS_XB + (size_t)NTOK * D * 2 <= WS_Y, "residual stream map");
static_assert(WS_MHID + (size_t)MOE_TILES * 256 * DFE * 2 <= WS_END && WS_HS + (size_t)MOE_TILES * 256 * D * 2 <= WS_MHID && WS_Y2 >= WS_H + (size_t)NTOK * D * 2, "MoE map");
static_assert(WS_HID + (size_t)NTOK * DFF * 2 <= WS_END && WS_Y + (size_t)NTOK * D * 2 <= WS_END, "map");
constexpr int CW_TMO = 0, CW_CODE = 1, CW_BAR = 4096, CW_GCNT = 8192, CW_WMAX = 12288, CW_AGRP = 16384, CW_SCNT = 24576;

constexpr int RING_BYTES = 131072, LDSCTL_OFF = RING_BYTES, MISC_OFF = LDSCTL_OFF + 320, LDS_BYTES = 147456;

struct Frame {
    LAS unsigned char* lds; volatile LAS unsigned* MISC; gu32* ctl;
    int tid, lane, wave, vcu, G, gw, NGW;
    float* out; unsigned char* ws;
    __device__ __forceinline__ void refresh() { int t = threadIdx.x; asm volatile("" : "+v"(t)); tid = t; lane = t & 63; wave = __builtin_amdgcn_readfirstlane(t >> 6); int v = vcu; asm volatile("" : "+s"(v)); vcu = v; gw = v * 8 + wave; }
};
template <int K> __device__ __forceinline__ const void* in_ptr() {
    unsigned long long p; const __attribute__((address_space(4))) void* ka = (const __attribute__((address_space(4))) void*)__builtin_amdgcn_kernarg_segment_ptr();
    asm volatile("s_load_dwordx2 %0, %1, %2\n\ts_waitcnt lgkmcnt(0)" : "=s"(p) : "s"(ka), "i"(8 * K) : "memory");
    return (const void*)p;
}
#define INF(K) ((const float*)in_ptr<K>())
template <class T> __device__ __forceinline__ T* wsp(const Frame& F, size_t off) { asm volatile("" : "+s"(off)); return (T*)(F.ws + off); }
enum { I_X = 0, I_C, I_POS, I_WADA, I_BADA, I_NGAIN, I_WIN, I_LGAIN, I_WQUP, I_WKVUP, I_QGAIN, I_KGAIN, I_CONVW, I_CONVB, I_WA, I_BA, I_WX, I_BX, I_LAM, I_OGAIN, I_WOUT, I_FWG, I_FWU, I_FWD, I_RW, I_MWG, I_MWU, I_MWD };

template <int K> __device__ __forceinline__ float swz_xor(float v) { return __int_as_float(__builtin_amdgcn_ds_swizzle(__float_as_int(v), (K << 10) | 0x1f)); }
__device__ __forceinline__ float wave_sum(float v) {
    v += swz_xor<1>(v); v += swz_xor<2>(v); v += swz_xor<4>(v); v += swz_xor<8>(v); v += swz_xor<16>(v);
    return att::pswap_sum(v);
}
__device__ __forceinline__ float wave_max(float v) {
    v = __builtin_fmaxf(v, swz_xor<1>(v)); v = __builtin_fmaxf(v, swz_xor<2>(v)); v = __builtin_fmaxf(v, swz_xor<4>(v)); v = __builtin_fmaxf(v, swz_xor<8>(v)); v = __builtin_fmaxf(v, swz_xor<16>(v));
    return att::pswap_max(v);
}
__device__ __forceinline__ float bflo(unsigned w) { return __uint_as_float(w << 16); }
__device__ __forceinline__ float bfhi(unsigned w) { return __uint_as_float(w & 0xffff0000u); }
__device__ __forceinline__ float bf1(bf16 v) { return __uint_as_float((unsigned)v << 16); }

__device__ __forceinline__ void transpose_item(const float* W, int ldw, int k0, int n0, bf16* WT, int ldt, int drow0, int dk0, LAS float* scr, int lane, bool ropemap = false) {
    float rv[32];
#pragma unroll
    for (int i = 0; i < 32; ++i) rv[i] = W[(size_t)(k0 + 2 * i + (lane >> 5)) * ldw + n0 + (lane & 31)];
#pragma unroll
    for (int i = 0; i < 32; ++i) scr[(2 * i + (lane >> 5)) * 33 + (lane & 31)] = rv[i];
    LDS_WAIT(); asm volatile("" ::: "memory");
    const int c = lane & 7;
#pragma unroll
    for (int j = 0; j < 4; ++j) { const int n = (lane >> 3) + 8 * j; const LAS float* s = scr + (8 * c) * 33 + n;
        v4u o; o.x = pk2(s[0 * 33], s[1 * 33]); o.y = pk2(s[2 * 33], s[3 * 33]); o.z = pk2(s[4 * 33], s[5 * 33]); o.w = pk2(s[6 * 33], s[7 * 33]);
        const int nd = ropemap ? 8 * ((n & 15) >> 2) + 4 * (n >> 4) + (n & 3) : n;
        *(GAS v4u*)(WT + (size_t)(drow0 + nd) * ldt + dk0 + k0 + 8 * c) = o; }
    LDS_WAIT(); asm volatile("" ::: "memory");
}
__device__ __forceinline__ void transpose_item_f8(const float* W, int ldw, int k0, int n0, unsigned char* WT, int ldt, int drow0, float sc, LAS float* scr, int lane) {
    float rv[32];
#pragma unroll
    for (int i = 0; i < 32; ++i) rv[i] = W[(size_t)(k0 + 2 * i + (lane >> 5)) * ldw + n0 + (lane & 31)];
#pragma unroll
    for (int i = 0; i < 32; ++i) scr[(2 * i + (lane >> 5)) * 33 + (lane & 31)] = rv[i];
    LDS_WAIT(); asm volatile("" ::: "memory");
    const int c = lane & 3;
#pragma unroll
    for (int j = 0; j < 2; ++j) { const int n = (lane >> 2) + 16 * j; const LAS float* s = scr + (16 * c) * 33 + n;
        v4u o; o.x = pg8::pack4_fp8(s[0 * 33] * sc, s[1 * 33] * sc, s[2 * 33] * sc, s[3 * 33] * sc); o.y = pg8::pack4_fp8(s[4 * 33] * sc, s[5 * 33] * sc, s[6 * 33] * sc, s[7 * 33] * sc);
        o.z = pg8::pack4_fp8(s[8 * 33] * sc, s[9 * 33] * sc, s[10 * 33] * sc, s[11 * 33] * sc); o.w = pg8::pack4_fp8(s[12 * 33] * sc, s[13 * 33] * sc, s[14 * 33] * sc, s[15 * 33] * sc);
        *(GAS v4u*)(WT + (size_t)(drow0 + n) * ldt + k0 + 16 * c) = o; }
    LDS_WAIT(); asm volatile("" ::: "memory");
}
__device__ __forceinline__ void transpose_item_i8(const float* W, int ldw, int k0, int n0, unsigned char* WT, int ldt, int drow0, float sc, LAS float* scr, int lane) {
    float rv[32];
#pragma unroll
    for (int i = 0; i < 32; ++i) rv[i] = W[(size_t)(k0 + 2 * i + (lane >> 5)) * ldw + n0 + (lane & 31)];
#pragma unroll
    for (int i = 0; i < 32; ++i) scr[(2 * i + (lane >> 5)) * 33 + (lane & 31)] = rv[i];
    LDS_WAIT(); asm volatile("" ::: "memory");
    const int c = lane & 3;
#pragma unroll
    for (int j = 0; j < 2; ++j) { const int n = (lane >> 2) + 16 * j; const LAS float* s = scr + (16 * c) * 33 + n;
        v4u o; o.x = pg8::pack4_i8(s[0 * 33] * sc, s[1 * 33] * sc, s[2 * 33] * sc, s[3 * 33] * sc); o.y = pg8::pack4_i8(s[4 * 33] * sc, s[5 * 33] * sc, s[6 * 33] * sc, s[7 * 33] * sc);
        o.z = pg8::pack4_i8(s[8 * 33] * sc, s[9 * 33] * sc, s[10 * 33] * sc, s[11 * 33] * sc); o.w = pg8::pack4_i8(s[12 * 33] * sc, s[13 * 33] * sc, s[14 * 33] * sc, s[15 * 33] * sc);
        *(GAS v4u*)(WT + (size_t)(drow0 + n) * ldt + k0 + 16 * c) = o; }
    LDS_WAIT(); asm volatile("" ::: "memory");
}
constexpr bool DENSE0_BF16 = false;
constexpr float SC_H8 = 8.0f, SC_WGU8 = 64.0f, SC_HID8 = 4.0f, SC_WD8 = 128.0f;
struct CDesc { const float* W; bf16* WT; int K, N, ldt, roff, dk0, map; float f8sc; };
__device__ __forceinline__ void conv_run(Frame& F, const CDesc& d, int gw0, int ngw) {
    LAS float* scr = (LAS float*)(F.lds + F.wave * 16384);
    const int nblk = d.N / 32, items = (d.K / 64) * nblk;
    for (int it = gw0; it < items; it += ngw) { const int kb = it / nblk, nb = it % nblk, n0 = 32 * nb;
        int drow0 = d.map == 0 ? n0 + d.roff : (d.map == 1 ? (n0 >= 416 ? n0 + 96 : n0) : 256 * (n0 / 128) + (n0 % 128) + d.roff); bool rope = false;
        if (d.map == 3) { const int h = n0 / 96, r = n0 - 96 * h;
            if (r < 64) drow0 = 256 * (h >> 2) + 128 * (r >> 5) + 32 * (h & 3); else { drow0 = 512 + 128 * (h >> 2) + 32 * (h & 3); rope = true; } }
        if (d.map == 4) { const int h = n0 / 128, r = n0 - 128 * h;
            drow0 = r < 64 ? 768 + 256 * (h >> 2) + 128 * (r >> 5) + 32 * (h & 3) : 1280 + 64 * h + (r - 64); }
        if (d.f8sc != 0.f) transpose_item_f8(d.W, d.N, 64 * kb, n0, (unsigned char*)d.WT, d.ldt, drow0, d.f8sc, scr, F.lane);
        else transpose_item(d.W, d.N, 64 * kb, n0, d.WT, d.ldt, drow0, d.dk0, scr, F.lane, rope); }
}
__device__ __forceinline__ CDesc conv_desc(Frame& F, int idx, int moe_j) {
    CDesc d;
    if (idx < 16) { const int l = idx >> 2, m = idx & 3; bf16* base = wsp<bf16>(F, WS_WSMALL + (size_t)l * WSMALL_STRIDE);
        if (m == 0)      d = CDesc{INF(I_WIN) + (size_t)l * D * INCOLS, base, D, INCOLS, D, 0, 0, 1, 0.f};
        else if (m == 1) d = CDesc{INF(I_WQUP) + (size_t)l * 256 * 768, base + 3 * MiB / 2, 256, 768, 256, 0, 0, 3, 0.f};
        else if (m == 2) d = CDesc{INF(I_WKVUP) + (size_t)l * 128 * 1024, base + 3 * MiB / 2, 128, 1024, 256, 768, 0, 4, 0.f};
        else             d = CDesc{INF(I_WOUT) + (size_t)l * D * D, base + 6 * MiB / 2, D, D, D, 0, 0, 0, 0.f};
    } else if (idx < 22) { const int j = (idx - 16) / 3, m = (idx - 16) % 3; bf16* base = wsp<bf16>(F, WS_WDENSE + (size_t)j * WDENSE_STRIDE);
        if (m == 0)      d = CDesc{INF(I_FWG) + (size_t)j * D * DFF, base, D, DFF, D, 0, 0, 2, SC_WGU8};
        else if (m == 1) d = CDesc{INF(I_FWU) + (size_t)j * D * DFF, base, D, DFF, D, 128, 0, 2, SC_WGU8};
        else             d = CDesc{INF(I_FWD) + (size_t)j * DFF * D, base + (size_t)11 * MiB / 2, DFF, D, DFF, 0, 0, 0, SC_WD8};
    } else { const int e = (idx - 22) / 3, m = (idx - 22) % 3; const size_t we = (size_t)(moe_j * NEXP + e) * D * DFE;
        if (m == 0)      d = CDesc{INF(I_MWG) + we, (bf16*)(wsp<unsigned char>(F, WS_WMOE_GU) + (size_t)e * 2 * DFE * D), D, DFE, D, 0, 0, 2, SC_WGU8};
        else if (m == 1) d = CDesc{INF(I_MWU) + we, (bf16*)(wsp<unsigned char>(F, WS_WMOE_GU) + (size_t)e * 2 * DFE * D), D, DFE, D, 128, 0, 2, SC_WGU8};
        else             d = CDesc{INF(I_MWD) + we, (bf16*)(wsp<unsigned char>(F, WS_WMOE_D) + (size_t)e * D * DFE), DFE, D, DFE, 0, 0, 0, SC_WD8};
    }
    return d;
}
__device__ __forceinline__ void convert_range(Frame& F, int lo, int hi, int moe_j) {
    F.refresh();
    for (int idx = lo; idx < hi; ++idx) { if ((idx < 16 && (idx & 3) == 0) || idx == 16 || idx == 17 || idx == 19 || idx == 20) continue;
        const CDesc d = conv_desc(F, idx, moe_j); conv_run(F, d, F.gw, F.NGW); }
}
constexpr int MOE_EARLY_E = 6;
__device__ __forceinline__ void convert_moe_early(Frame& F, int rank, int nshare) {
    F.refresh();
    for (int e = 0; e < MOE_EARLY_E; ++e)
        for (int m = 0; m < 2; ++m) { const CDesc d = conv_desc(F, 22 + 3 * e + m, 1); conv_run(F, d, rank * NWAVES + F.wave, nshare * NWAVES); }
}
__device__ __forceinline__ void convert_moe_first(Frame& F) {
    F.refresh();
    for (int idx = 22; idx < 46; ++idx) { const CDesc d = conv_desc(F, idx, 0); conv_run(F, d, F.gw, F.NGW); }
    __syncthreads();
}
__device__ __forceinline__ void convert_moe_late(Frame& F) {
    F.refresh();
    for (int idx = 22; idx < 46; ++idx) { const int e = (idx - 22) / 3, m = (idx - 22) % 3; if (e < MOE_EARLY_E && m < 2) continue;
        const CDesc d = conv_desc(F, idx, 1); conv_run(F, d, F.gw, F.NGW); }
}
__device__ __forceinline__ void zero_block(Frame& F, bf16* WT, int ldt, int r0, int rows, int c0, int cols) {
    const int cpr = cols / 8, n = rows * cpr;
    v4u zz = (v4u){0u, 0u, 0u, 0u}; asm volatile("" : "+v"(zz));
    for (int i = F.gw * 64 + F.lane; i < n; i += F.NGW * 64) { const int r = i / cpr, cc = i % cpr; *(GAS v4u*)(WT + (size_t)(r0 + r) * ldt + c0 + 8 * cc) = zz; }
}
__device__ __forceinline__ float lane_absmax4(const GAS f32x4* W, int n4, int first, int step) {
    float m = 0.f;
    for (int i0 = first; i0 < n4; i0 += 8 * step) { f32x4 v[8];
#pragma unroll
        for (int u = 0; u < 8; ++u) { const int i = i0 + u * step; v[u] = i < n4 ? W[i] : (f32x4){0.f, 0.f, 0.f, 0.f}; }
#pragma unroll
        for (int u = 0; u < 8; ++u) m = __builtin_fmaxf(__builtin_fmaxf(m, __builtin_fmaxf(__builtin_fabsf(v[u].x), __builtin_fabsf(v[u].y))), __builtin_fmaxf(__builtin_fabsf(v[u].z), __builtin_fabsf(v[u].w))); }
    return m;
}
__device__ __forceinline__ void p0_prologue(Frame& F) {
    F.refresh();
    {
      const float* w_ada = INF(I_WADA); const float* cc = INF(I_C); float* modp = wsp<float>(F, WS_MODP);
      for (int task = F.gw; task < 8 * 4 * 48; task += F.NGW) {
        const int jb = task % 48, kq = (task / 48) % 4, ls = task / 192, j = jb * 64 + F.lane;
        const float* W = w_ada + (size_t)ls * D * 3072 + j; float a0 = 0.f, a1 = 0.f;
        for (int k0 = kq * 256; k0 < kq * 256 + 256; k0 += 32) { float wv[32];
#pragma unroll
            for (int i = 0; i < 32; ++i) wv[i] = W[(size_t)(k0 + i) * 3072];
#pragma unroll
            for (int i = 0; i < 32; ++i) { const float c0 = cc[k0 + i], c1 = cc[D + k0 + i]; a0 += c0 * pg8::sigmoidf_(c0) * wv[i]; a1 += c1 * pg8::sigmoidf_(c1) * wv[i]; } }
        modp[((size_t)(kq * 8 + ls) * 2 + 0) * 3072 + j] = a0; modp[((size_t)(kq * 8 + ls) * 2 + 1) * 3072 + j] = a1;
      } }
    {
      const float* w_in = INF(I_WIN);
      for (int l = 0; l < DEPTH; ++l) { float m = lane_absmax4((const GAS f32x4*)(w_in + (size_t)l * D * INCOLS), D * INCOLS / 4, F.gw * 64 + F.lane, F.NGW * 64);
          m = wave_max(m);
          if (F.lane == 0) __hip_atomic_fetch_max((unsigned*)(F.ctl + CW_WMAX + 64 * l), __float_as_uint(m), __ATOMIC_RELAXED, __HIP_MEMORY_SCOPE_AGENT); } }
    for (int j = 0; j < 2; ++j) { float m = 0.f;
      for (int h = 0; h < 2; ++h) m = __builtin_fmaxf(m, lane_absmax4((const GAS f32x4*)((h ? INF(I_FWU) : INF(I_FWG)) + (size_t)j * D * DFF), D * DFF / 4, F.gw * 64 + F.lane, F.NGW * 64));
      m = wave_max(m);
      if (F.lane == 0) __hip_atomic_fetch_max((unsigned*)(F.ctl + CW_WMAX + 64 * (4 + j)), __float_as_uint(m), __ATOMIC_RELAXED, __HIP_MEMORY_SCOPE_AGENT); }
    {
      const int* positions = (const int*)in_ptr<I_POS>(); float* cosT = wsp<float>(F, WS_COS); float* sinT = wsp<float>(F, WS_SIN);
      for (int i0 = F.gw * 64 + F.lane; i0 < NTOK * 16; i0 += 4 * F.NGW * 64) { int pv[4];
#pragma unroll
        for (int u = 0; u < 4; ++u) { const int i = i0 + u * F.NGW * 64; pv[u] = i < NTOK * 16 ? positions[i >> 4] : 0; }
#pragma unroll
        for (int u = 0; u < 4; ++u) { const int i = i0 + u * F.NGW * 64; if (i >= NTOK * 16) break; const int j = i & 15;
        const float invf = __builtin_amdgcn_exp2f(-(float)j * (13.287712379549449f / 16.0f));
        const float ang = (float)pv[u] * invf;
        const float rev = ang * 0.15915494309189535f; const float fr = rev - __builtin_floorf(rev);
        cosT[i] = __builtin_amdgcn_cosf(fr); sinT[i] = __builtin_amdgcn_sinf(fr); } } }
    {
      const float* lam = INF(I_LAM); float* lamc = wsp<float>(F, WS_LAMC);
      for (int i = F.gw * 64 + F.lane; i < DEPTH * LRUW; i += F.NGW * 64) { const float t = __builtin_amdgcn_exp2f(-1.4426950408889634f * lam[i]); lamc[i] = t < 0.02f ? -8.0f * 1.4426950408889634f * t * (1.0f - t * (0.5f - t * (0.33333334f - 0.25f * t))) : -8.0f * __builtin_amdgcn_logf(1.0f + t); } }
    convert_range(F, 0, F.G == 256 ? 22 : 46, 0);
    for (int l = 0; l < DEPTH; ++l) {
        bf16* Win_t = wsp<bf16>(F, WS_WSMALL + (size_t)l * WSMALL_STRIDE); bf16* Wup_t = Win_t + 3 * MiB / 2; bf16* Wg_t = Win_t + 5 * MiB / 2;
        zero_block(F, Win_t, D / 2, 416, 96, 0, D / 2);
        zero_block(F, Wup_t, 256, 768, 1024, 128, 128);
        const float* w_a = INF(I_WA); const float* w_x = INF(I_WX);
        for (int i8 = F.gw * 64 + F.lane; i8 < 1024 * 16; i8 += F.NGW * 64) {
            const int row = i8 >> 4, kq0 = (i8 & 15) * 8, pn = row >> 8, half = (row >> 7) & 1, ch = 128 * pn + (row & 127), g = ch >> 6, kA0 = 128 * pn + kq0;
            float v[8];
#pragma unroll
            for (int e = 0; e < 8; ++e) v[e] = 0.f;
            if ((kA0 >> 6) == g) { const float* sp = (half ? w_x : w_a) + (((size_t)l * 8 + g) * 64 + (kA0 & 63)) * 64 + (ch & 63);
#pragma unroll
                for (int e = 0; e < 8; ++e) v[e] = sp[(size_t)e * 64]; }
            *(GAS v4u*)(Wg_t + (size_t)row * 128 + kq0) = (v4u){pk2(v[0], v[1]), pk2(v[2], v[3]), pk2(v[4], v[5]), pk2(v[6], v[7])}; }
    }
}
__device__ __forceinline__ void p0_finalise(Frame& F) {
    F.refresh();
    const float* b_ada = INF(I_BADA); const float* modp = wsp<float>(F, WS_MODP); float* mod = wsp<float>(F, WS_MOD);
    for (int i = F.gw * 64 + F.lane; i < 8 * 2 * 3072; i += F.NGW * 64) { const int j = i % 3072, ls = i / 6144;
        float v = b_ada[ls * 3072 + j];
#pragma unroll
        for (int kq = 0; kq < 4; ++kq) v += modp[(size_t)kq * 8 * 2 * 3072 + i];
        mod[i] = v; }
    float wmx[6];
#pragma unroll
    for (int q = 0; q < 6; ++q) wmx[q] = __uint_as_float(__hip_atomic_load((unsigned*)(F.ctl + CW_WMAX + 64 * q), __ATOMIC_RELAXED, __HIP_MEMORY_SCOPE_AGENT));
    if (F.gw == 0 && F.lane < 6) { float v = wmx[0];
#pragma unroll
        for (int q = 1; q < 6; ++q) if (F.lane == q) v = wmx[q];
        wsp<float>(F, WS_MREF)[8 + F.lane] = v * (1.0f / 127.0f); }
    if (F.gw == 0 && F.lane < DEPTH) { const int l = F.lane; const float* qg = INF(I_QGAIN) + l * 96; const float* kg = INF(I_KGAIN) + l * 96; float a = 0.f, bq = 0.f, c = 0.f, d = 0.f;
        for (int i = 0; i < 64; ++i) { a = fmaxf(a, qg[i] * qg[i]); c = fmaxf(c, kg[i] * kg[i]); }
        for (int i = 64; i < 96; ++i) { bq = fmaxf(bq, qg[i] * qg[i]); d = fmaxf(d, kg[i] * kg[i]); }
        wsp<float>(F, WS_MREF)[l] = 1.01f * 0.10206207261596577f * 1.4426950408889634f * sqrtf(64.f * a + 32.f * bq) * sqrtf(64.f * c + 32.f * d); }
    { LAS float* scr = (LAS float*)(F.lds + F.wave * 16384); const int nblk = INCOLS / 32, items = (D / 64) * nblk;
      for (int it = F.gw; it < DEPTH * items; it += F.NGW) { const int l = it / items, r = it - l * items, kb = r / nblk, nb = r - kb * nblk, n0 = 32 * nb;
          float wm = wmx[0];
#pragma unroll
          for (int q = 1; q < 4; ++q) if (l == q) wm = wmx[q];
          transpose_item_i8(INF(I_WIN) + (size_t)l * D * INCOLS, INCOLS, 64 * kb, n0, wsp<unsigned char>(F, WS_WSMALL + (size_t)l * WSMALL_STRIDE), D, n0 >= 416 ? n0 + 96 : n0, 127.0f / __builtin_fmaxf(wm, 1e-30f), scr, F.lane); } }
    { LAS float* scr = (LAS float*)(F.lds + F.wave * 16384); const int nblk = DFF / 32, items = (D / 64) * nblk;
      for (int it = F.gw; it < 4 * items; it += F.NGW) { const int q = it / items, j = q >> 1, h = q & 1, r = it - q * items, kb = r / nblk, nb = r - kb * nblk, n0 = 32 * nb;
          const float wm = j ? wmx[5] : wmx[4];
          transpose_item_i8((h ? INF(I_FWU) : INF(I_FWG)) + (size_t)j * D * DFF, DFF, 64 * kb, n0, wsp<unsigned char>(F, WS_WDENSE + (size_t)j * WDENSE_STRIDE), D, 256 * (n0 / 128) + (n0 % 128) + (h ? 128 : 0), 127.0f / __builtin_fmaxf(wm, 1e-30f), scr, F.lane); } }
}

template <bool COMBINE, bool NORM, bool ROUTER, bool F8H = false, bool I8H = false, bool XB16 = true, bool XO16 = true>
__device__ __forceinline__ void norm_pass(Frame& F, const void* xin_, void* xout_, int ls, int ls_prev, int moe_j) {
    const float* xin = (const float*)xin_; const bf16* xinb = (const bf16*)xin_; float* xout = (float*)xout_; bf16* xoutb = (bf16*)xout_;
    F.refresh();
    LAS float* gs = (LAS float*)(F.lds); LAS float* sh = gs + 2048;
    LAS int* lcnt = (LAS int*)(F.lds + 16384); LAS int* gbase = lcnt + 16; LAS int* ltab = lcnt + 32;
    const int lane = F.lane;
    const float* mod = wsp<float>(F, WS_MOD); bf16* hbuf = wsp<bf16>(F, WS_H); float* rsc_ = wsp<float>(F, WS_RSC);
    int* tok_e = wsp<int>(F, WS_TOKE); int* tok_r = wsp<int>(F, WS_TOKR); float* tok_w = wsp<float>(F, WS_TOKW); const int* tok_p = wsp<int>(F, WS_TOKP); const bf16* y2 = wsp<bf16>(F, WS_Y2);
    if (NORM) { const float* modl = mod + (size_t)ls * 2 * 3072; const float* ng = INF(I_NGAIN) + (size_t)ls * D;
        float t_ng[4], t_sc[4], t_sh[4];
#pragma unroll
        for (int u = 0; u < 4; ++u) { const int i = F.tid + u * NWAVES * 64, b = i >> 10, j = i & 1023; t_ng[u] = ng[j]; t_sc[u] = modl[b * 3072 + 1024 + j]; t_sh[u] = modl[b * 3072 + j]; }
#pragma unroll
        for (int u = 0; u < 4; ++u) { const int i = F.tid + u * NWAVES * 64; gs[i] = t_ng[u] * (1.0f + t_sc[u]); sh[i] = t_sh[u]; } }
    const float* rw = ROUTER ? INF(I_RW) + (size_t)moe_j * D * 8 : nullptr;
    f32x4 rwa[16], rwb[16];
    if (ROUTER) {
#pragma unroll
        for (int jq = 0; jq < 16; ++jq) { const f32x4* wp = (const f32x4*)(rw + (size_t)(4 * lane + 256 * (jq >> 2) + (jq & 3)) * 8); rwa[jq] = wp[0]; rwb[jq] = wp[1]; } }
    __syncthreads();
    for (int blk = F.vcu; blk < NTOK / 128; blk += F.G) {
        if (ROUTER) { if (F.tid < 8) lcnt[F.tid] = 0; __syncthreads(); }
        f32x4 nx[4]; v2u nxb[4];
        if (XB16) { const GAS v2u* xr = (const GAS v2u*)(xinb + (size_t)(blk * 128 + F.wave * 16) * D) + lane;
#pragma unroll
          for (int j = 0; j < 4; ++j) nxb[j] = xr[64 * j]; }
        else { const GAS f32x4* xr = (const GAS f32x4*)(xin + (size_t)(blk * 128 + F.wave * 16) * D) + lane;
#pragma unroll
          for (int j = 0; j < 4; ++j) nx[j] = xr[64 * j]; }
        for (int i = 0; i < 16; ++i) {
            const int row = blk * 128 + F.wave * 16 + i, b = row >> 14;
            f32x4 v[4];
#pragma unroll
            for (int j = 0; j < 4; ++j) { if (XB16) v[j] = (f32x4){bflo(nxb[j].x), bfhi(nxb[j].x), bflo(nxb[j].y), bfhi(nxb[j].y)}; else v[j] = nx[j]; }
            if (i < 15) {
                if (XB16) { const GAS v2u* xr = (const GAS v2u*)(xinb + (size_t)(row + 1) * D) + lane;
#pragma unroll
                    for (int j = 0; j < 4; ++j) nxb[j] = xr[64 * j]; }
                else { const GAS f32x4* xr = (const GAS f32x4*)(xin + (size_t)(row + 1) * D) + lane;
#pragma unroll
                    for (int j = 0; j < 4; ++j) nx[j] = xr[64 * j]; } }
            if (!XB16 && !COMBINE) { GAS v2u* xob = (GAS v2u*)(xoutb + (size_t)row * D) + lane;
#pragma unroll
                for (int j = 0; j < 4; ++j) xob[64 * j] = (v2u){pk2(v[j].x, v[j].y), pk2(v[j].z, v[j].w)}; }
            if (COMBINE) {
                const int p0 = tok_p[row * 2], p1 = tok_p[row * 2 + 1]; const float w0 = tok_w[row * 2], w1 = tok_w[row * 2 + 1];
                const float* gp = mod + (size_t)ls_prev * 2 * 3072 + b * 3072 + 2048;
                GAS f32x4* xo = (GAS f32x4*)(xout + (size_t)row * D) + lane; GAS v2u* xob = (GAS v2u*)(xoutb + (size_t)row * D) + lane;
                uint2 yav[4], ybv[4]; f32x4 gvv[4];
#pragma unroll
                for (int j = 0; j < 4; ++j) { yav[j] = *(const uint2*)(y2 + (size_t)p0 * D + 4 * lane + 256 * j); ybv[j] = *(const uint2*)(y2 + (size_t)p1 * D + 4 * lane + 256 * j); gvv[j] = *(const f32x4*)(gp + 4 * lane + 256 * j); }
                asm volatile("" ::: "memory");
#pragma unroll
                for (int j = 0; j < 4; ++j) { const uint2 ya = yav[j], yb = ybv[j]; const f32x4 g = gvv[j];
                    v[j].x += g.x * (w0 * bflo(ya.x) + w1 * bflo(yb.x)); v[j].y += g.y * (w0 * bfhi(ya.x) + w1 * bfhi(yb.x));
                    v[j].z += g.z * (w0 * bflo(ya.y) + w1 * bflo(yb.y)); v[j].w += g.w * (w0 * bfhi(ya.y) + w1 * bfhi(yb.y));
                    if (XO16) { const v2u o2 = (v2u){pk2(v[j].x, v[j].y), pk2(v[j].z, v[j].w)}; xob[64 * j] = o2; v[j] = (f32x4){bflo(o2.x), bfhi(o2.x), bflo(o2.y), bfhi(o2.y)}; }
                    else xo[64 * j] = v[j]; }
            }
            if (NORM) {
                float ss = 0.f;
#pragma unroll
                for (int j = 0; j < 4; ++j) ss += (v[j].x * v[j].x + v[j].y * v[j].y) + (v[j].z * v[j].z + v[j].w * v[j].w);
                const float rstd = 1.0f / sqrtf(wave_sum(ss) * (1.0f / D) + EPS);
                GAS unsigned long long* o8 = (GAS unsigned long long*)(hbuf + (size_t)row * D) + lane;
                GAS unsigned* o4 = (GAS unsigned*)((unsigned char*)hbuf + (size_t)row * D) + lane;
#pragma unroll
                for (int j = 0; j < 4; ++j) { const f32x4 g = *(const LAS f32x4*)(gs + b * 1024 + 4 * lane + 256 * j), s = *(const LAS f32x4*)(sh + b * 1024 + 4 * lane + 256 * j);
                    v[j] = v[j] * rstd * g + s;
                    if (I8H) continue;
                    if (F8H) o4[64 * j] = pg8::pack4_fp8(v[j].x * SC_H8, v[j].y * SC_H8, v[j].z * SC_H8, v[j].w * SC_H8);
                    else o8[64 * j] = (unsigned long long)pk2(v[j].x, v[j].y) | ((unsigned long long)pk2(v[j].z, v[j].w) << 32); }
                if (I8H) { float am = 0.f;
#pragma unroll
                    for (int j = 0; j < 4; ++j) am = __builtin_fmaxf(__builtin_fmaxf(am, __builtin_fmaxf(__builtin_fabsf(v[j].x), __builtin_fabsf(v[j].y))), __builtin_fmaxf(__builtin_fabsf(v[j].z), __builtin_fabsf(v[j].w)));
                    am = __builtin_fmaxf(wave_max(am), 1e-30f); const float qs = 127.0f / am;
#pragma unroll
                    for (int j = 0; j < 4; ++j) o4[64 * j] = pg8::pack4_i8(v[j].x * qs, v[j].y * qs, v[j].z * qs, v[j].w * qs);
                    if (lane == 0) rsc_[row] = am * (1.0f / 127.0f); }
                if (ROUTER) {
                    float lg[8];
#pragma unroll
                    for (int e = 0; e < 8; ++e) lg[e] = 0.f;
#pragma unroll
                    for (int j = 0; j < 4; ++j)
#pragma unroll
                        for (int q = 0; q < 4; ++q) { const float hv = v[j][q]; const f32x4 wa = rwa[4 * j + q], wb = rwb[4 * j + q];
                            lg[0] += hv * wa.x; lg[1] += hv * wa.y; lg[2] += hv * wa.z; lg[3] += hv * wa.w; lg[4] += hv * wb.x; lg[5] += hv * wb.y; lg[6] += hv * wb.z; lg[7] += hv * wb.w; }
#pragma unroll
                    for (int e = 0; e < 8; ++e) lg[e] = wave_sum(lg[e]);
                    int e0 = 0; float v0 = lg[0];
#pragma unroll
                    for (int e = 1; e < 8; ++e) if (lg[e] > v0) { v0 = lg[e]; e0 = e; }
                    int e1 = 0; float v1 = -__builtin_inff();
#pragma unroll
                    for (int e = 0; e < 8; ++e) if (e != e0 && lg[e] > v1) { v1 = lg[e]; e1 = e; }
                    const float w0 = 1.0f / (1.0f + __builtin_amdgcn_exp2f(1.4426950408889634f * (v1 - v0))), w1 = 1.0f - w0;
                    if (lane == 0) { const int r0 = __hip_atomic_fetch_add(lcnt + e0, 1, __ATOMIC_RELAXED, __HIP_MEMORY_SCOPE_WORKGROUP), r1 = __hip_atomic_fetch_add(lcnt + e1, 1, __ATOMIC_RELAXED, __HIP_MEMORY_SCOPE_WORKGROUP);
                        LAS int* lt = ltab + (F.wave * 16 + i) * 8; lt[0] = e0; lt[1] = e1; lt[2] = r0; lt[3] = r1; lt[4] = (int)__float_as_uint(w0); lt[5] = (int)__float_as_uint(w1); }
                }
            }
        }
        if (ROUTER) {
            __syncthreads();
            if (F.tid < 8) gbase[F.tid] = (int)__hip_atomic_fetch_add((unsigned*)(F.ctl + CW_GCNT + 64 * (8 * moe_j + F.tid)), (unsigned)lcnt[F.tid], RLX_AGENT);
            __syncthreads();
            if (F.tid < 128) { const int row = blk * 128 + F.tid; const LAS int* lt = ltab + F.tid * 8; const int e0 = lt[0], e1 = lt[1];
                tok_e[row * 2] = e0; tok_e[row * 2 + 1] = e1; tok_r[row * 2] = gbase[e0] + lt[2]; tok_r[row * 2 + 1] = gbase[e1] + lt[3];
                tok_w[row * 2] = __uint_as_float((unsigned)lt[4]); tok_w[row * 2 + 1] = __uint_as_float((unsigned)lt[5]); }
            __syncthreads();
        }
    }
    __syncthreads();
}

__device__ __forceinline__ void mid_pass(Frame& F, int l) {
    F.refresh();
    const int lane = F.lane;
    const bf16* z = wsp<bf16>(F, WS_Z); bf16* A2 = wsp<bf16>(F, WS_A2); bf16* Kb = wsp<bf16>(F, WS_K); bf16* xrb = wsp<bf16>(F, WS_XR);
    const float* cosT = wsp<float>(F, WS_COS); const float* sinT = wsp<float>(F, WS_SIN);
    const float* lg = INF(I_LGAIN) + l * 384; const f32x4 lgq = *(const f32x4*)(lg + 4 * lane); const f32x4 lgkv = *(const f32x4*)(lg + 256 + 4 * (lane & 31));
    const float* kg = INF(I_KGAIN) + l * 96; const float kg1 = kg[64 + (lane & 15)], kg2 = kg[80 + (lane & 15)];
    const float* conv_w = INF(I_CONVW); const float* conv_b = INF(I_CONVB);
    float cw[4][8], cb[8];
#pragma unroll
    for (int e = 0; e < 8; ++e) { cb[e] = conv_b[l * 512 + 8 * lane + e];
#pragma unroll
        for (int j = 0; j < 4; ++j) cw[j][e] = conv_w[(size_t)(l * 4 + j) * 512 + 8 * lane + e]; }
    struct MidIn { uint2 q2, k2; bf16 x1, x2; v4u xw[4]; float cs, sn; };
    auto mid_load = [&](int row) -> MidIn { MidIn r; const bf16* zr = z + (size_t)row * INP; const int t = row & (SEQ - 1);
        r.q2 = *(const uint2*)(zr + 4 * lane); r.k2 = *(const uint2*)(zr + 256 + 4 * (lane & 31)); r.x1 = zr[384 + (lane & 15)]; r.x2 = zr[400 + (lane & 15)];
#pragma unroll
        for (int j = 0; j < 4; ++j) { if (t - 3 + j >= 0) r.xw[j] = *(const v4u*)(zr + (long)(j - 3) * INP + 512 + 8 * lane); else r.xw[j] = (v4u){0u, 0u, 0u, 0u}; }
        r.cs = cosT[row * 16 + (lane & 15)]; r.sn = sinT[row * 16 + (lane & 15)]; return r; };
    MidIn nxt = mid_load(F.gw < NTOK ? F.gw : 0);
    for (int row = F.gw; row < NTOK; row += F.NGW) {
        const MidIn in = nxt;
        if (row + F.NGW < NTOK) nxt = mid_load(row + F.NGW);
        const float q0 = bflo(in.q2.x), q1 = bfhi(in.q2.x), q2f = bflo(in.q2.y), q3 = bfhi(in.q2.y);
        float ssq = (q0 * q0 + q1 * q1) + (q2f * q2f + q3 * q3);
        const float k0 = bflo(in.k2.x), k1 = bfhi(in.k2.x), k2f = bflo(in.k2.y), k3 = bfhi(in.k2.y);
        float sskv = lane < 32 ? (k0 * k0 + k1 * k1) + (k2f * k2f + k3 * k3) : 0.f;
        const float x1 = bf1(in.x1), x2 = bf1(in.x2);
        float ssr = lane < 16 ? x1 * x1 + x2 * x2 : 0.f;
        ssq = wave_sum(ssq); sskv = wave_sum(sskv); ssr = wave_sum(ssr);
        const float rq = 1.0f / sqrtf(ssq * (1.0f / 256.0f) + EPS), rkv = 1.0f / sqrtf(sskv * (1.0f / 128.0f) + EPS), rr = 1.0f / sqrtf(ssr * (1.0f / 32.0f) + EPS);
        *(uint2*)(A2 + (size_t)row * 256 + 4 * lane) = make_uint2(pk2(q0 * rq * lgq.x, q1 * rq * lgq.y), pk2(q2f * rq * lgq.z, q3 * rq * lgq.w));
        *(uint2*)(A2 + (size_t)(NTOK + row) * 256 + 4 * lane) = lane < 32 ? make_uint2(pk2(k0 * rkv * lgkv.x, k1 * rkv * lgkv.y), pk2(k2f * rkv * lgkv.z, k3 * rkv * lgkv.w)) : make_uint2(0u, 0u);
        if (lane < 16) { const float a = x1 * rr * kg1, bb = x2 * rr * kg2;
            const bf16 o1 = (bf16)f2bf(a * in.cs - bb * in.sn), o2 = (bf16)f2bf(a * in.sn + bb * in.cs); bf16* kr = Kb + (size_t)row * 768 + 64 + lane;
#pragma unroll
            for (int hh = 0; hh < 8; ++hh) { kr[hh * 96] = o1; kr[hh * 96 + 16] = o2; } }
        float acc[8];
#pragma unroll
        for (int e = 0; e < 8; ++e) acc[e] = cb[e];
#pragma unroll
        for (int j = 0; j < 4; ++j) { const v4u xw = in.xw[j];
                acc[0] += cw[j][0] * bflo(xw.x); acc[1] += cw[j][1] * bfhi(xw.x); acc[2] += cw[j][2] * bflo(xw.y); acc[3] += cw[j][3] * bfhi(xw.y);
                acc[4] += cw[j][4] * bflo(xw.z); acc[5] += cw[j][5] * bfhi(xw.z); acc[6] += cw[j][6] * bflo(xw.w); acc[7] += cw[j][7] * bfhi(xw.w); }
        *(v4u*)(xrb + ((size_t)(lane >> 4) * NTOK + row) * 128 + 8 * (lane & 15)) = (v4u){pk2(acc[0], acc[1]), pk2(acc[2], acc[3]), pk2(acc[4], acc[5]), pk2(acc[6], acc[7])};
    }
}

__device__ __forceinline__ void qk_pass(Frame& F, int l) {
    F.refresh();
    const int lane = F.lane, g8 = lane & 7, h8 = lane >> 3, g4 = lane & 3, h4 = (lane >> 2) & 7;
    const float C2 = 0.10206207261596577f * 1.4426950408889634f;
    const bf16* qkv = wsp<bf16>(F, WS_QKV); bf16* Qb = wsp<bf16>(F, WS_Q); bf16* Kb = wsp<bf16>(F, WS_K);
    const float* cosT = wsp<float>(F, WS_COS); const float* sinT = wsp<float>(F, WS_SIN);
    const float* q_gain = INF(I_QGAIN) + l * 96; const float* k_gain = INF(I_KGAIN) + l * 96;
    float qgn[8], kgn[8], qgr[8];
#pragma unroll
    for (int e = 0; e < 8; ++e) { qgn[e] = q_gain[g8 * 8 + e]; kgn[e] = k_gain[g8 * 8 + e]; qgr[e] = q_gain[64 + g4 * 8 + e]; }
    struct QkIn { v4u qn, kn, qp; f32x4 ca, cb, sa, sb; };
    auto qk_load = [&](int row) -> QkIn { QkIn r; const bf16* qr = qkv + (size_t)row * UPN;
        r.qn = *(const v4u*)(qr + h8 * 96 + g8 * 8); r.kn = *(const v4u*)(qr + 768 + h8 * 128 + g8 * 8); r.qp = *(const v4u*)(qr + h4 * 96 + 64 + g4 * 8);
        r.ca = *(const f32x4*)(cosT + row * 16 + (g4 & 1) * 8); r.cb = *(const f32x4*)(cosT + row * 16 + (g4 & 1) * 8 + 4);
        r.sa = *(const f32x4*)(sinT + row * 16 + (g4 & 1) * 8); r.sb = *(const f32x4*)(sinT + row * 16 + (g4 & 1) * 8 + 4); return r; };
    QkIn nxt = qk_load(F.gw < NTOK ? F.gw : 0);
    for (int row = F.gw; row < NTOK; row += F.NGW) {
        const QkIn in = nxt;
        if (row + F.NGW < NTOK) nxt = qk_load(row + F.NGW);
        float v[8], o[8];
#define UP8(dst, w_) do { dst[0] = bflo(w_.x); dst[1] = bfhi(w_.x); dst[2] = bflo(w_.y); dst[3] = bfhi(w_.y); dst[4] = bflo(w_.z); dst[5] = bfhi(w_.z); dst[6] = bflo(w_.w); dst[7] = bfhi(w_.w); } while (0)
#define ST8(p, s) do { *(v4u*)(p) = (v4u){pk2(s[0], s[1]), pk2(s[2], s[3]), pk2(s[4], s[5]), pk2(s[6], s[7])}; } while (0)
        UP8(v, in.qn);
        { float ss = 0.f;
#pragma unroll
          for (int e = 0; e < 8; ++e) ss += v[e] * v[e];
          ss += swz_xor<1>(ss); ss += swz_xor<2>(ss); ss += swz_xor<4>(ss);
          const float rs = C2 / sqrtf(ss * (1.0f / 64.0f) + EPS);
#pragma unroll
          for (int e = 0; e < 8; ++e) o[e] = v[e] * rs * qgn[e];
          ST8(Qb + (size_t)row * 768 + h8 * 96 + g8 * 8, o); }
        UP8(v, in.kn);
        { float ss = 0.f;
#pragma unroll
          for (int e = 0; e < 8; ++e) ss += v[e] * v[e];
          ss += swz_xor<1>(ss); ss += swz_xor<2>(ss); ss += swz_xor<4>(ss);
          const float rs = 1.0f / sqrtf(ss * (1.0f / 64.0f) + EPS);
#pragma unroll
          for (int e = 0; e < 8; ++e) o[e] = v[e] * rs * kgn[e];
          ST8(Kb + (size_t)row * 768 + h8 * 96 + g8 * 8, o); }
        UP8(v, in.qp);
        { float ss = 0.f;
#pragma unroll
          for (int e = 0; e < 8; ++e) ss += v[e] * v[e];
          ss += swz_xor<1>(ss); ss += swz_xor<2>(ss);
          const float rs = 1.0f / sqrtf(ss * (1.0f / 32.0f) + EPS);
#pragma unroll
          for (int e = 0; e < 8; ++e) { const float vn = v[e] * rs * qgr[e]; const float pe = swz_xor<2>(vn);
              const float cs = e < 4 ? in.ca[e & 3] : in.cb[e & 3], sn = e < 4 ? in.sa[e & 3] : in.sb[e & 3];
              o[e] = (g4 < 2 ? vn * cs - pe * sn : pe * sn + vn * cs) * C2; }
          if (lane < 32) ST8(Qb + (size_t)row * 768 + h4 * 96 + 64 + g4 * 8, o); }
#undef UP8
#undef ST8
    }
}

__device__ __forceinline__ void scan_a(Frame& F) {
    F.refresh();
    const int ch = F.tid;
    const unsigned* lu = wsp<unsigned>(F, WS_LA); float* Pl = wsp<float>(F, WS_PL); float* Hc = wsp<float>(F, WS_HC);
    for (int un = F.vcu; un < 256; un += F.G) {
        const size_t r0 = (size_t)un * 128; float S = 0.f, H = 0.f;
        for (int t0 = 0; t0 < 128; t0 += 32) { unsigned w[32];
#pragma unroll
            for (int t = 0; t < 32; ++t) w[t] = lu[(r0 + t0 + t) * LRUW + ch];
#pragma unroll
            for (int t = 0; t < 32; ++t) { const float l2 = bflo(w[t]); H = __builtin_amdgcn_exp2f(l2) * H + bfhi(w[t]); S += l2; } }
        Pl[(size_t)un * LRUW + ch] = S; Hc[(size_t)un * LRUW + ch] = H;
    }
}
__device__ __forceinline__ void scan_arrive(Frame& F, int l) {
    asm volatile("s_waitcnt vmcnt(0)" ::: "memory");
    __syncthreads();
    int t0 = threadIdx.x; asm volatile("" : "+v"(t0));
    if (t0 == 0) { __builtin_amdgcn_fence(__ATOMIC_RELEASE, "agent"); asm volatile("s_waitcnt vmcnt(0)" ::: "memory"); (void)xb_add((unsigned*)(F.ctl + CW_SCNT + 16 * l), 1u); }
}
__device__ __forceinline__ void scan_wait(Frame& F, int l) {
    int t0 = threadIdx.x; asm volatile("" : "+v"(t0));
    if (t0 == 0) { unsigned* bar = (unsigned*)(F.ctl + CW_BAR); unsigned* cnt = (unsigned*)(F.ctl + CW_SCNT + 16 * l);
        XB_SPIN(xb_ld(cnt) < 256u, bar);
        __builtin_amdgcn_fence(__ATOMIC_ACQUIRE, "agent"); asm volatile("s_waitcnt vmcnt(0)" ::: "memory"); }
    __syncthreads();
}
__device__ __forceinline__ float gelu_tanh(float x) {
    const float y = 0.7978845608028654f * (x + 0.044715f * x * x * x);
    return x * __builtin_amdgcn_rcpf(1.0f + __builtin_amdgcn_exp2f(-2.0f * 1.4426950408889634f * y));
}
__device__ __forceinline__ void scan_c(Frame& F, int l) {
    F.refresh();
    const int ch = F.tid, lane = F.lane;
    LAS float* st = (LAS float*)F.lds;
    const unsigned* lu = wsp<unsigned>(F, WS_LA); const float* Pl = wsp<float>(F, WS_PL); const float* Hc = wsp<float>(F, WS_HC);
    const bf16* z = wsp<bf16>(F, WS_Z); bf16* y = wsp<bf16>(F, WS_Y);
    const float* out_gain = INF(I_OGAIN) + l * D + 512;
    float og[8];
#pragma unroll
    for (int e = 0; e < 8; ++e) og[e] = out_gain[8 * lane + e];
    for (int un = F.vcu; un < 256; un += F.G) {
        const int c = un & 127, b = un >> 7; const size_t r0 = (size_t)un * 128;
        unsigned w[32]; bf16 gq[32];
#pragma unroll
        for (int t = 0; t < 32; ++t) { w[t] = lu[(r0 + t) * LRUW + ch]; gq[t] = z[(r0 + t) * INP + 1024 + ch]; }
        float hst = 0.f;
        {
            float plA[16], hcA[16], plB[16], hcB[16];
#define SCC_LOAD(PLv, HCv, c0_) do { _Pragma("unroll") for (int u = 0; u < 16; ++u) { const int cc = (c0_) + u; const size_t o = (size_t)(b * 128 + (cc < c ? cc : 0)) * LRUW + ch; PLv[u] = cc < c ? Pl[o] : 0.f; HCv[u] = cc < c ? Hc[o] : 0.f; } } while (0)
#define SCC_STEP(PLv, HCv) do { _Pragma("unroll") for (int u = 0; u < 16; ++u) hst = __builtin_amdgcn_exp2f(PLv[u]) * hst + HCv[u]; } while (0)
            if (c > 0) SCC_LOAD(plA, hcA, 0);
            for (int c0 = 0; c0 < c; c0 += 32) {
                if (c0 + 16 < c) SCC_LOAD(plB, hcB, c0 + 16);
                SCC_STEP(plA, hcA);
                if (c0 + 16 >= c) break;
                if (c0 + 32 < c) SCC_LOAD(plA, hcA, c0 + 32);
                SCC_STEP(plB, hcB);
            }
#undef SCC_LOAD
#undef SCC_STEP
        }
        for (int sub = 0; sub < 4; ++sub) {
#pragma unroll
            for (int t = 0; t < 32; ++t) { hst = __builtin_amdgcn_exp2f(bflo(w[t])) * hst + bfhi(w[t]); st[t * 512 + ch] = hst * gelu_tanh(bf1(gq[t])); }
            if (sub < 3) {
#pragma unroll
                for (int t = 0; t < 32; ++t) { w[t] = lu[(r0 + (sub + 1) * 32 + t) * LRUW + ch]; gq[t] = z[(r0 + (sub + 1) * 32 + t) * INP + 1024 + ch]; } }
            __syncthreads();
#pragma unroll
            for (int tt = 0; tt < 4; ++tt) { const int t = F.wave * 4 + tt; const size_t row = r0 + sub * 32 + t;
                const f32x4 a = *(const LAS f32x4*)(st + t * 512 + 8 * lane), bq = *(const LAS f32x4*)(st + t * 512 + 8 * lane + 4);
                float ss = (a.x * a.x + a.y * a.y) + (a.z * a.z + a.w * a.w) + (bq.x * bq.x + bq.y * bq.y) + (bq.z * bq.z + bq.w * bq.w);
                const float rs = 1.0f / sqrtf(wave_sum(ss) * (1.0f / 512.0f) + EPS);
                *(v4u*)(y + row * D + 512 + 8 * lane) = (v4u){pk2(a.x * rs * og[0], a.y * rs * og[1]), pk2(a.z * rs * og[2], a.w * rs * og[3]), pk2(bq.x * rs * og[4], bq.y * rs * og[5]), pk2(bq.z * rs * og[6], bq.w * rs * og[7])}; }
            __syncthreads();
        }
    }
}
__device__ __forceinline__ void attn_norm_pass(Frame& F, int l) {
    F.refresh();
    const int lane = F.lane; float og[8];
    const float* out_gain = INF(I_OGAIN) + l * D; bf16* y = wsp<bf16>(F, WS_Y);
#pragma unroll
    for (int e = 0; e < 8; ++e) og[e] = out_gain[8 * lane + e];
    for (int row0 = F.gw; row0 < NTOK; row0 += 4 * F.NGW) {
        v4u wv[4];
#pragma unroll
        for (int r = 0; r < 4; ++r) { const int row = row0 + r * F.NGW; if (row < NTOK) wv[r] = *(const v4u*)(y + (size_t)row * D + 8 * lane); else wv[r] = (v4u){0u, 0u, 0u, 0u}; }
#pragma unroll
        for (int r = 0; r < 4; ++r) { const int row = row0 + r * F.NGW; const v4u w = wv[r];
            const float v0 = bflo(w.x), v1 = bfhi(w.x), v2 = bflo(w.y), v3 = bfhi(w.y), v4 = bflo(w.z), v5 = bfhi(w.z), v6 = bflo(w.w), v7 = bfhi(w.w);
            const float ss = (v0 * v0 + v1 * v1) + (v2 * v2 + v3 * v3) + (v4 * v4 + v5 * v5) + (v6 * v6 + v7 * v7);
            const float rs = 1.0f / sqrtf(wave_sum(ss) * (1.0f / 512.0f) + EPS);
            if (row < NTOK) *(v4u*)(y + (size_t)row * D + 8 * lane) = (v4u){pk2(v0 * rs * og[0], v1 * rs * og[1]), pk2(v2 * rs * og[2], v3 * rs * og[3]), pk2(v4 * rs * og[4], v5 * rs * og[5]), pk2(v6 * rs * og[6], v7 * rs * og[7])}; }
    }
}
__device__ __forceinline__ void attn_group_norm(Frame& F, int l, int b, int h, int qb) {
    asm volatile("s_waitcnt vmcnt(0)" ::: "memory");
    __syncthreads();
    int t0 = threadIdx.x; asm volatile("" : "+v"(t0));
    if (t0 == 0) {
        unsigned* bar = (unsigned*)(F.ctl + CW_BAR); unsigned* cnt = (unsigned*)(F.ctl + CW_AGRP + 16 * ((l * 2 + b) * 32 + qb));
        __builtin_amdgcn_fence(__ATOMIC_RELEASE, "agent");
        asm volatile("s_waitcnt vmcnt(0)" ::: "memory");
        (void)xb_add(cnt, 1u);
        XB_SPIN(xb_ld(cnt) < 8u, bar);
        __builtin_amdgcn_fence(__ATOMIC_ACQUIRE, "agent");
        asm volatile("s_waitcnt vmcnt(0)" ::: "memory");
    }
    __syncthreads();
    F.refresh();
    const int lane = F.lane; float og[8];
    const float* out_gain = INF(I_OGAIN) + l * D; bf16* y = wsp<bf16>(F, WS_Y);
#pragma unroll
    for (int e = 0; e < 8; ++e) og[e] = out_gain[8 * lane + e];
    const size_t row0 = (size_t)b * SEQ + (size_t)qb * 512 + h * 64 + F.wave * 8;
    v4u wv[8];
#pragma unroll
    for (int r = 0; r < 8; ++r) wv[r] = *(const v4u*)(y + (row0 + r) * D + 8 * lane);
#pragma unroll
    for (int r = 0; r < 8; ++r) { const v4u w = wv[r];
        const float v0 = bflo(w.x), v1 = bfhi(w.x), v2 = bflo(w.y), v3 = bfhi(w.y), v4 = bflo(w.z), v5 = bfhi(w.z), v6 = bflo(w.w), v7 = bfhi(w.w);
        const float ss = (v0 * v0 + v1 * v1) + (v2 * v2 + v3 * v3) + (v4 * v4 + v5 * v5) + (v6 * v6 + v7 * v7);
        const float rs = 1.0f / sqrtf(wave_sum(ss) * (1.0f / 512.0f) + EPS);
        *(v4u*)(y + (row0 + r) * D + 8 * lane) = (v4u){pk2(v0 * rs * og[0], v1 * rs * og[1]), pk2(v2 * rs * og[2], v3 * rs * og[3]), pk2(v4 * rs * og[4], v5 * rs * og[5]), pk2(v6 * rs * og[6], v7 * rs * og[7])}; }
}
__device__ __forceinline__ void moe_permute(Frame& F, int moe_j) {
    F.refresh();
    LAS int* sb = (LAS int*)F.lds;
    const int* tok_e = wsp<int>(F, WS_TOKE); const int* tok_r = wsp<int>(F, WS_TOKR); int* tok_p = wsp<int>(F, WS_TOKP); int* rte = wsp<int>(F, WS_RTE);
    const bf16* hbuf = wsp<bf16>(F, WS_H); bf16* hs = wsp<bf16>(F, WS_HS);
    if (F.tid < NEXP) sb[16 + F.tid] = (int)__hip_atomic_load((unsigned*)(F.ctl + CW_GCNT + 64 * (8 * moe_j + F.tid)), RLX_AGENT);
    __syncthreads();
    if (F.tid == 0) { int acc = 0;
        for (int e = 0; e < NEXP; ++e) { const int cnt = sb[16 + e]; sb[e] = acc; acc += (cnt + 255) & ~255; }
        sb[8] = acc; }
    __syncthreads();
    if (blockIdx.x == 0) { const int nrt = sb[8] >> 8;
        for (int i = F.tid; i < nrt; i += NWAVES * 64) { int e = 0;
#pragma unroll
            for (int k = 1; k < NEXP; ++k) if (i * 256 >= sb[k]) e = k;
            rte[i] = e; }
        if (F.tid == 0) rte[511] = nrt; }
    const int lane = F.lane;
    for (int s = F.gw; s < 2 * NTOK; s += F.NGW) { const int t = s >> 1, e = tok_e[s], pos = sb[e] + tok_r[s];
        const GAS v4u* src = (const GAS v4u*)((const unsigned char*)hbuf + (size_t)t * D); GAS v4u* dst = (GAS v4u*)((unsigned char*)hs + (size_t)pos * D);
        dst[lane] = src[lane];
        if (lane == 0) tok_p[s] = pos; }
    for (int j = F.gw; j < NEXP * 256; j += F.NGW) { const int e = j >> 8, i = j & 255, cnt = sb[16 + e], padn = ((cnt + 255) & ~255) - cnt;
        if (i < padn) { v4u zz = (v4u){0u, 0u, 0u, 0u}; asm volatile("" : "+v"(zz));
            GAS v4u* dst = (GAS v4u*)((unsigned char*)hs + (size_t)(sb[e] + cnt + i) * D); dst[lane] = zz; } }
    __syncthreads();
}
struct UpOrder : pg8::StaticOrder {
    __device__ __forceinline__ bool next(int i, pg8::Unit& u) const { if (!pg8::StaticOrder::next(i, u)) return false; u.pa = u.pm + (u.pn >= 3 ? NTOK / 256 : 0); return true; } };
struct GateOrder : pg8::StaticOrder {
    __device__ __forceinline__ bool next(int i, pg8::Unit& u) const { if (!pg8::StaticOrder::next(i, u)) return false; u.pa = u.pm + u.pn * (NTOK / 256); return true; } };
struct MoeOrder {
    pg8::StaticOrder so; const int* rte; int pm_off, tpe, rev;
    __device__ __forceinline__ bool next(int i, pg8::Unit& u) const { if (!so.next(i, u)) return false; if (rev) u.pm = so.nM - 1 - u.pm; u.pm += pm_off; u.pa = u.pm; u.pb = rte[u.pm] * tpe + u.pn; return true; }
    __device__ __forceinline__ void a_ready(const pg8::Unit&) const {}
    __device__ __forceinline__ void done(const pg8::Unit&) const {}
};
struct AttnOrder {
    int v, G;
    __device__ __forceinline__ bool next(int i, int& bh, int& qb) const { const int un = v + (i >> 2) * G; if (un >= 256) return false; const int s = un & 15, k = i & 3; bh = un >> 4; qb = (k == 0) ? s : (k == 1) ? 31 - s : (k == 2) ? 32 + s : 63 - s; return true; }
};

struct Args { const void* in[28]; float* out; unsigned char* ws; };
__global__ void __launch_bounds__(NWAVES * 64, 2) trunk_fwd(Args args) {
    extern __shared__ __attribute__((aligned(16))) unsigned char lds[];
    Frame F;
    F.lds = (LAS unsigned char*)lds; F.MISC = (volatile LAS unsigned*)(F.lds + MISC_OFF);
    F.G = gridDim.x; { const int bx = blockIdx.x; F.vcu = (F.G % 8 == 0) ? (bx % 8) * (F.G / 8) + bx / 8 : bx; }
    F.NGW = F.G * NWAVES; F.refresh();
    F.ws = args.ws; F.out = args.out; F.ctl = (gu32*)(args.ws + WS_CTL);
    for (int u = F.tid; u < (LDS_BYTES - LDSCTL_OFF) / 4; u += NWAVES * 64) ((LAS unsigned*)(F.lds + LDSCTL_OFF))[u] = 0u;
    __syncthreads();
    XcdBarrier bar = xcd_barrier_post((unsigned*)(F.ctl + CW_BAR), F.MISC + 8);
#ifndef PROBE_MASK
#define PROBE_MASK 0u
#endif
    unsigned long long pr_last = PROBE_MASK ? rt() : 0ull, pr_acc = 0ull;
#define GRID_BAR(c) do { xcd_barrier(bar); if (PROBE_MASK) { const unsigned long long now_ = rt(); if ((PROBE_MASK >> (c)) & 1u) pr_acc += now_ - pr_last; pr_last = now_; } } while (0)
    const int cblk = (int)blockIdx.x;
    bf16* const xb = wsp<bf16>(F, WS_XB);

    p0_prologue(F);
    GRID_BAR(0);
    p0_finalise(F);
    GRID_BAR(0);

    for (int l = 0; l < DEPTH; ++l) {
        const int ls1 = 2 * l, ls2 = 2 * l + 1; const bool moe = (l & 1) != 0; const int jj = l >> 1;
        if (l == 0) norm_pass<false, true, false, false, true, false>(F, INF(I_X), xb, ls1, 0, 0);
        else if (l == 2) { norm_pass<true, true, false, false, true>(F, xb, xb, ls1, ls1 - 1, 0); convert_moe_late(F); }
        else norm_pass<false, true, false, false, true>(F, xb, nullptr, ls1, 0, 0);
        GRID_BAR(1);
        { bf16* Win_t = wsp<bf16>(F, WS_WSMALL + (size_t)l * WSMALL_STRIDE);
          pg8::Gemm g{wsp<bf16>(F, WS_H), Win_t, NTOK, INP, D / 2}; pg8::StaticOrder S; S.init(NTOK, INP, F.G, cblk);
          pg8::EpiBf16I8 E{wsp<bf16>(F, WS_Z), INP, wsp<float>(F, WS_RSC), wsp<float>(F, WS_MREF)[8 + l]};
          pg8::gemm_phase<pg8::EpiBf16I8, pg8::StaticOrder, true, true, true, true>(F.lds, g, S, E); }
        GRID_BAR(2);
        mid_pass(F, l);
        GRID_BAR(3);
        { bf16* Wup_t = wsp<bf16>(F, WS_WSMALL + (size_t)l * WSMALL_STRIDE + 3 * MiB);
          int k256 = 256; asm volatile("" : "+s"(k256));
          pg8::Gemm g{wsp<bf16>(F, WS_A2), Wup_t, NTOK, UPN, k256}; UpOrder S; S.init(NTOK, UPN, F.G, cblk);
          pg8::EpiUp E{wsp<bf16>(F, WS_Q), wsp<bf16>(F, WS_K), wsp<bf16>(F, WS_QKV), INF(I_QGAIN) + l * 96, INF(I_KGAIN) + l * 96, wsp<float>(F, WS_COS), wsp<float>(F, WS_SIN)};
          pg8::gemm_phase<pg8::EpiUp, UpOrder, true, true>(F.lds, g, S, E); }
        { bf16* Wg_t = wsp<bf16>(F, WS_WSMALL + (size_t)l * WSMALL_STRIDE + 5 * MiB); const bf16* xrb = wsp<bf16>(F, WS_XR);
          int k128 = 128; asm volatile("" : "+s"(k128));
          pg8::Gemm g{xrb, Wg_t, NTOK, 1024, k128}; GateOrder S; S.init(NTOK, 1024, F.G, cblk);
          pg8::EpiGates E{xrb, INF(I_BA) + l * LRUW, INF(I_BX) + l * LRUW, wsp<float>(F, WS_LAMC) + l * LRUW, wsp<unsigned>(F, WS_LA)};
          pg8::gemm_phase<pg8::EpiGates, GateOrder, true, true>(F.lds, g, S, E); }
        GRID_BAR(4);
        const bool inphase = F.G == 256 && wsp<float>(F, WS_MREF)[l] <= att::ATT_MREF_MAX;
        if (!inphase) { scan_a(F); GRID_BAR(5); }
        { const AttnOrder AO{F.vcu, F.G}; int bh, qb; const bf16* Qb = wsp<bf16>(F, WS_Q); const bf16* Kb = wsp<bf16>(F, WS_K); const bf16* Vb = wsp<bf16>(F, WS_QKV); bf16* yb = wsp<bf16>(F, WS_Y);
          const float mref = wsp<float>(F, WS_MREF)[l];
          if (mref <= att::ATT_MREF_MAX) {
              for (int base = F.vcu; base < 256; base += F.G)
                  for (int i = 0; i < 2; ++i) { int un = base; asm volatile("" : "+s"(un));
                      att2::attn_unit(un >> 7, (un >> 4) & 7, i ? 31 - (un & 15) : (un & 15), Qb, Kb, Vb, yb, F.lds);
                      if (F.G == 256) { int u2 = base; asm volatile("" : "+s"(u2)); attn_group_norm(F, l, u2 >> 7, (u2 >> 4) & 7, i ? 31 - (u2 & 15) : (u2 & 15));
                          if (i == 0) { scan_a(F); scan_arrive(F, l); if (l == 0) convert_moe_first(F); } } }
#ifdef ATT_XVAR
            { bf16* xo = wsp<bf16>(F, (size_t)866 * MiB); for (int i = 0; AO.next(i, bh, qb); ++i) att::attn_unit<ATT_XVAR>(bh >> 3, bh & 7, qb, Qb, Kb, Vb, xo, F.lds, 512); }
#endif
          }
          else {
              for (int base = F.vcu; base < 256; base += F.G)
                  for (int i = 0; i < 4; ++i) { int un = base; asm volatile("" : "+s"(un)); const int s_ = un & 15;
                      att_online::attn_unit(un >> 7, (un >> 4) & 7, i == 0 ? s_ : (i == 1 ? 31 - s_ : (i == 2 ? 32 + s_ : 63 - s_)), Qb, Kb, Vb, yb, F.lds);
                      if (i == 0 && l == 0 && F.G == 256) convert_moe_first(F); } } }
        if (inphase) scan_wait(F, l);
        scan_c(F, l);
        GRID_BAR(6);
        if (!inphase) { attn_norm_pass(F, l); GRID_BAR(7); }
        { bf16* Wout_t = wsp<bf16>(F, WS_WSMALL + (size_t)l * WSMALL_STRIDE + 6 * MiB);
          pg8::Gemm g{wsp<bf16>(F, WS_Y), Wout_t, NTOK, D, D}; pg8::StaticOrder S; S.init(NTOK, D, F.G, cblk);
          pg8::EpiResid E{xb, xb, wsp<float>(F, WS_MOD) + (size_t)ls1 * 2 * 3072 + 2048, 1.0f};
          pg8::gemm_phase<pg8::EpiResid, pg8::StaticOrder, true, true>(F.lds, g, S, E); }
        GRID_BAR(8);
        if (!moe) {
            if (true) {
                norm_pass<false, true, false, false, true>(F, xb, nullptr, ls2, 0, 0);
                GRID_BAR(1);
                { unsigned char* Wgu8 = wsp<unsigned char>(F, WS_WDENSE + (size_t)jj * WDENSE_STRIDE);
                  pg8::Gemm g{wsp<bf16>(F, WS_H), (const bf16*)Wgu8, NTOK, 2 * DFF, D / 2}; pg8::StaticOrder S; S.init(NTOK, 2 * DFF, F.G, cblk);
                  pg8::EpiSwigluI8 E{wsp<unsigned char>(F, WS_HID), DFF, wsp<float>(F, WS_RSC), wsp<float>(F, WS_MREF)[8 + 4 + jj], SC_HID8};
                  pg8::gemm_phase<pg8::EpiSwigluI8, pg8::StaticOrder, true, true, true, true>(F.lds, g, S, E); }
                GRID_BAR(9);
                { unsigned char* Wd8 = wsp<unsigned char>(F, WS_WDENSE + (size_t)jj * WDENSE_STRIDE + 11 * MiB);
                  pg8::Gemm g{wsp<bf16>(F, WS_HID), (const bf16*)Wd8, NTOK, D, DFF / 2}; pg8::StaticOrder S; S.init(NTOK, D, F.G, cblk);
                  pg8::EpiResid E{xb, xb, wsp<float>(F, WS_MOD) + (size_t)ls2 * 2 * 3072 + 2048, 1.0f / (SC_HID8 * SC_WD8)};
                  pg8::gemm_phase<pg8::EpiResid, pg8::StaticOrder, true, true, true>(F.lds, g, S, E); }
                GRID_BAR(10);
            } else {
                norm_pass<false, true, false, true>(F, xb, nullptr, ls2, 0, 0);
                GRID_BAR(1);
                { unsigned char* Wgu8 = wsp<unsigned char>(F, WS_WDENSE + (size_t)jj * WDENSE_STRIDE);
                  pg8::Gemm g{wsp<bf16>(F, WS_H), (const bf16*)Wgu8, NTOK, 2 * DFF, D / 2}; pg8::StaticOrder S; S.init(NTOK, 2 * DFF, F.G, cblk);
                  pg8::EpiSwigluF8 E{wsp<unsigned char>(F, WS_HID), DFF, 1.0f / (SC_H8 * SC_WGU8), SC_HID8};
                  pg8::gemm_phase<pg8::EpiSwigluF8, pg8::StaticOrder, true, true, true>(F.lds, g, S, E); }
                GRID_BAR(9);
                { unsigned char* Wd8 = wsp<unsigned char>(F, WS_WDENSE + (size_t)jj * WDENSE_STRIDE + 11 * MiB);
                  pg8::Gemm g{wsp<bf16>(F, WS_HID), (const bf16*)Wd8, NTOK, D, DFF / 2}; pg8::StaticOrder S; S.init(NTOK, D, F.G, cblk);
                  pg8::EpiResid E{xb, xb, wsp<float>(F, WS_MOD) + (size_t)ls2 * 2 * 3072 + 2048, 1.0f / (SC_HID8 * SC_WD8)};
                  pg8::gemm_phase<pg8::EpiResid, pg8::StaticOrder, true, true, true>(F.lds, g, S, E); }
                GRID_BAR(10);
            }
        } else {
            norm_pass<false, true, true, true>(F, xb, nullptr, ls2, 0, jj);
            GRID_BAR(11);
            moe_permute(F, jj);
            GRID_BAR(12);
            const int* rte = wsp<int>(F, WS_RTE); const int nrt = rte[511];
            { pg8::Gemm g{wsp<bf16>(F, WS_HS), wsp<bf16>(F, WS_WMOE_GU), nrt * 256, 2 * DFE, D / 2}; MoeOrder S; S.so.init(nrt * 256, 2 * DFE, F.G, cblk); S.rte = rte; S.pm_off = 0; S.tpe = 2 * DFE / 256; S.rev = 0;
              pg8::EpiSwigluF8 E{wsp<unsigned char>(F, WS_MHID), DFE, 1.0f / (SC_H8 * SC_WGU8), SC_HID8};
              pg8::gemm_phase<pg8::EpiSwigluF8, MoeOrder, true, true, true>(F.lds, g, S, E); }
            GRID_BAR(13);
            { pg8::Gemm g{wsp<bf16>(F, WS_MHID), wsp<bf16>(F, WS_WMOE_D), nrt * 256, D, DFE / 2}; MoeOrder S; S.so.init(nrt * 256, D, F.G, cblk); S.rte = rte; S.pm_off = 0; S.tpe = D / 256; S.rev = 1;
              pg8::EpiBf16S E{wsp<bf16>(F, WS_Y2), D, 1.0f / (SC_HID8 * SC_WD8)};
              pg8::gemm_phase<pg8::EpiBf16S, MoeOrder, true, true, true>(F.lds, g, S, E); }
                        if (jj == 0) { const int nwg = nrt * (D / 256), rem = nwg % F.G, nshare = rem ? F.G - rem : F.G, rank = rem ? cblk - rem : cblk;
                if (rank >= 0) convert_moe_early(F, rank, nshare); }
GRID_BAR(14);
        }
    }
    norm_pass<true, false, false, false, false, true, false>(F, xb, F.out, 0, 2 * (DEPTH - 1) + 1, 0);
    if (PROBE_MASK) { const unsigned long long now_ = rt(); if ((PROBE_MASK >> 15) & 1u) pr_acc += now_ - pr_last; if (blockIdx.x == 0) { while (rt() - now_ < pr_acc) __builtin_amdgcn_s_sleep(8); } }
}

extern "C" void kernel_launch(void* const* d_in, const int* in_sizes, int n_in, void* d_out, int out_size, void* d_ws, size_t ws_size, hipStream_t stream) {
    static int grid = 0;
    if (grid == 0) {
        if (n_in != 28 || out_size != NTOK * D || ws_size < WS_END) { fprintf(stderr, "kernel_launch: unexpected shapes (n_in %d, out %d, ws %zu)\n", n_in, out_size, ws_size); grid = -1; return; }
        int dev = 0, cus = 0, per_cu = 0;
        if (hipGetDevice(&dev) != hipSuccess || hipDeviceGetAttribute(&cus, hipDeviceAttributeMultiprocessorCount, dev) != hipSuccess) { grid = -1; return; }
        if (hipFuncSetAttribute((const void*)trunk_fwd, hipFuncAttributeMaxDynamicSharedMemorySize, LDS_BYTES) != hipSuccess) { fprintf(stderr, "kernel_launch: hipFuncSetAttribute failed\n"); grid = -1; return; }
        if (hipOccupancyMaxActiveBlocksPerMultiprocessor(&per_cu, (const void*)trunk_fwd, NWAVES * 64, LDS_BYTES) != hipSuccess || per_cu < 1) { fprintf(stderr, "kernel_launch: occupancy query reports %d\n", per_cu); per_cu = 1; }
        (void)hipGetLastError();
        grid = cus;
    }
    if (grid < 0) return;
    if (hipMemsetAsync((char*)d_ws + WS_CTL, 0, CTL_ZERO_BYTES, stream) != hipSuccess) return;
    Args a{};
    for (int i = 0; i < 28; ++i) a.in[i] = d_in[i];
    a.out = (float*)d_out; a.ws = (unsigned char*)d_ws;
    hipLaunchKernelGGL(trunk_fwd, dim3(grid), dim3(NWAVES * 64), LDS_BYTES, stream, a);
}
```

```cpp
#include <hip/hip_runtime.h>
#include <cstdio>
#include <cstdint>
namespace pg8 {
#define PG8_LAS __attribute__((address_space(3)))
typedef unsigned short bf16_t;
typedef short bf16x8 __attribute__((ext_vector_type(8)));
typedef float f32x4 __attribute__((ext_vector_type(4)));
typedef unsigned u32x4 __attribute__((ext_vector_type(4)));
typedef int i32x4_ __attribute__((ext_vector_type(4)));
constexpr int BM = 256, BK = 64, HALF = 128, HTB = HALF * BK * 2  , STAGE_BYTES = 8 * HTB, NXCD = 8, WGM = 8;

__host__ __device__ __forceinline__ int lds_byte(int r, int c) { const int st = (r >> 4) * 2 + (c >> 5), rr = r & 15, cc = c & 31, ob = rr * 64 + cc * 2; return st * 1024 + (ob ^ (((ob >> 9) & 1) << 5)); }
__host__ __device__ __forceinline__ void stage_rc(int b, int& R, int& C) { const int st = b / 1024, sb = b % 1024, swz = sb ^ (((sb >> 9) & 1) << 5); R = (st >> 1) * 16 + swz / 64; C = (st & 1) * 32 + (swz % 64) / 2; }
__host__ __device__ __forceinline__ int perm32(int rho) { const int n = rho >> 4, i = rho & 15; return 8 * (i >> 2) + 4 * n + (i & 3); }

struct Unit { int pm, pn, pb, pa; };
struct Gemm { const bf16_t* A; const bf16_t* Bt; int M, N, K; };

struct StaticOrder {
    int nM, nN, nwg, G, c;
    __host__ __device__ void init(int M, int N, int G_, int c_) { nM = M / BM; nN = N / BM; nwg = nM * nN; G = G_; c = c_; }
    __host__ __device__ bool next(int i, Unit& u) const {
        const long L = (long)i * G + c; if (L >= nwg) return false;
        int wgid = (int)L; { const int q = nwg / NXCD, r = nwg % NXCD, xcd = wgid % NXCD, off = wgid / NXCD; wgid = (xcd < r ? xcd * (q + 1) : r * (q + 1) + (xcd - r) * q) + off; }
        const int nig = WGM * nN, gid = wgid / nig, fm = gid * WGM, gsz = (nM - fm) < WGM ? (nM - fm) : WGM;
        u.pm = fm + ((wgid % nig) % gsz); u.pn = (wgid % nig) / gsz; u.pb = u.pn; u.pa = u.pm; return true;
    }
    __device__ __forceinline__ void a_ready(const Unit&) const {}
    __device__ __forceinline__ void done(const Unit&) const {}
    __device__ __forceinline__ int ktiles(const Unit&, int nt) const { return nt; }
};

__device__ __forceinline__ unsigned cvt_pk_bf16(float lo, float hi) { unsigned r; asm volatile("v_cvt_pk_bf16_f32 %0, %1, %2" : "=v"(r) : "v"(lo), "v"(hi)); return r; }
typedef float f32x2 __attribute__((ext_vector_type(2)));
__device__ __forceinline__ f32x2 gelu_pk(f32x2 v) {
    const f32x2 av = __builtin_elementwise_abs(v), d = av * 0.2316418882f + 1.0f;
    f32x2 t; t.x = __builtin_amdgcn_rcpf(d.x); t.y = __builtin_amdgcn_rcpf(d.y);
    f32x2 q = t * 0.5307027145f + (-0.7265760135f); q = q * t + 0.7107068705f; q = q * t + (-0.142248368f); q = q * t + 0.127414796f; q = q * t;
    const f32x2 s = (v * v) * (-0.72134752044f);
    f32x2 e; e.x = __builtin_amdgcn_exp2f(s.x); e.y = __builtin_amdgcn_exp2f(s.y);
    const f32x2 m = v * (q * e), r = v - m;
    f32x2 o; o.x = v.x < 0.f ? m.x : r.x; o.y = v.y < 0.f ? m.y : r.y; return o;
}

template <int ACT  > struct EpiBf16 {
    static constexpr bool PERM = true, AFTER_DRAIN = false; static_assert(ACT == 0 || ACT == 1, "EpiBf16: ACT is 0 (none) or 1 (gelu_pk)");
    bf16_t* O; int ldc; const float* bias; int split_cols; size_t split_stride; float scale0;
    __device__ __forceinline__ void operator()(const f32x4 (&acc)[2][2][4][2], const Unit& u, int wr, int wc, int fr, int fq) const {
        const int row0 = u.pm * BM + wr * 64 + fr; int colt = u.pn * BM; bf16_t* base = O;
        float sc = 1.f; if (split_cols) { const int t = colt / split_cols; base += (size_t)t * split_stride; colt -= t * split_cols; if (t == 0) sc = scale0; }
        const int col0 = colt + wc * 32 + 8 * fq, bcol0 = u.pn * BM + wc * 32 + 8 * fq;
        f32x4 bv[2][2];
#pragma unroll
        for (int bj = 0; bj < 2; ++bj)
#pragma unroll
            for (int n = 0; n < 2; ++n) bv[bj][n] = bias ? *(const f32x4*)(bias + bcol0 + bj * HALF + 4 * n) : (f32x4){0.f, 0.f, 0.f, 0.f};
#pragma unroll
        for (int ai = 0; ai < 2; ++ai)
#pragma unroll
            for (int m = 0; m < 4; ++m) { bf16_t* rowp = base + (size_t)(row0 + ai * HALF + m * 16) * ldc + col0;
#pragma unroll
                for (int bj = 0; bj < 2; ++bj) { f32x4 v0 = acc[ai][bj][m][0] + bv[bj][0], v1 = acc[ai][bj][m][1] + bv[bj][1];
                    if (ACT == 1) { f32x2 a = gelu_pk((f32x2){v0[0], v0[1]}), b = gelu_pk((f32x2){v0[2], v0[3]}), c = gelu_pk((f32x2){v1[0], v1[1]}), d = gelu_pk((f32x2){v1[2], v1[3]});
                        v0 = (f32x4){a.x, a.y, b.x, b.y}; v1 = (f32x4){c.x, c.y, d.x, d.y}; }
                    v0 = v0 * sc; v1 = v1 * sc; u32x4 w; w.x = cvt_pk_bf16(v0[0], v0[1]); w.y = cvt_pk_bf16(v0[2], v0[3]); w.z = cvt_pk_bf16(v1[0], v1[1]); w.w = cvt_pk_bf16(v1[2], v1[3]);
                    *(u32x4*)(rowp + bj * HALF) = w; } }
    }
};
struct EpiBf16I8 {
    static constexpr bool PERM = true, AFTER_DRAIN = false;
    bf16_t* O; int ldc; const float* rsc; float wdq;
    __device__ __forceinline__ void operator()(const f32x4 (&acc)[2][2][4][2], const Unit& u, int wr, int wc, int fr, int fq) const {
        const int row0 = u.pm * BM + wr * 64 + fr, col0 = u.pn * BM + wc * 32 + 8 * fq;
        float rs[2][4];
#pragma unroll
        for (int ai = 0; ai < 2; ++ai)
#pragma unroll
            for (int m = 0; m < 4; ++m) rs[ai][m] = rsc[row0 + ai * HALF + m * 16];
#pragma unroll
        for (int ai = 0; ai < 2; ++ai)
#pragma unroll
            for (int m = 0; m < 4; ++m) { bf16_t* rowp = O + (size_t)(row0 + ai * HALF + m * 16) * ldc + col0; const float s = rs[ai][m] * wdq;
#pragma unroll
                for (int bj = 0; bj < 2; ++bj) { float v[8];
#pragma unroll
                    for (int n = 0; n < 2; ++n)
#pragma unroll
                        for (int e = 0; e < 4; ++e) { const f32x4 av = acc[ai][bj][m][n]; const float ae = av[e]; v[4 * n + e] = (float)__float_as_int(ae) * s; }
                    u32x4 w; w.x = cvt_pk_bf16(v[0], v[1]); w.y = cvt_pk_bf16(v[2], v[3]); w.z = cvt_pk_bf16(v[4], v[5]); w.w = cvt_pk_bf16(v[6], v[7]);
                    *(u32x4*)(rowp + bj * HALF) = w; } }
    }
};
__device__ __forceinline__ float bf2f(unsigned short v) { return __uint_as_float((unsigned)v << 16); }
__device__ __forceinline__ float sigmoidf_(float v) { return __builtin_amdgcn_rcpf(1.0f + __builtin_amdgcn_exp2f(-1.4426950408889634f * v)); }
struct EpiResid {
    static constexpr bool PERM = true, AFTER_DRAIN = false;
    const bf16_t* base; bf16_t* out; const float* gate; float sc;
    __device__ __forceinline__ void operator()(const f32x4 (&acc)[2][2][4][2], const Unit& u, int wr, int wc, int fr, int fq) const {
        const int row0 = u.pm * BM + wr * 64 + fr, col0 = u.pn * BM + wc * 32 + 8 * fq;
        const float* gp = gate + (u.pm >= 64 ? 3072 : 0) + col0;
        f32x4 gv[2][2];
#pragma unroll
        for (int bj = 0; bj < 2; ++bj)
#pragma unroll
            for (int n = 0; n < 2; ++n) gv[bj][n] = *(const f32x4*)(gp + bj * HALF + 4 * n);
        asm volatile("" ::: "memory");
#define ER_OFF(g, q) ((size_t)(row0 + ((g) >> 1) * HALF + (2 * ((g) & 1) + (q)) * 16) * 1024 + col0)
#define ER_PACK(v0, v1) (u32x4){cvt_pk_bf16((v0)[0], (v0)[1]), cvt_pk_bf16((v0)[2], (v0)[3]), cvt_pk_bf16((v1)[0], (v1)[1]), cvt_pk_bf16((v1)[2], (v1)[3])}
        {
            u32x4 bw[2][2][2];
#define ER_LOADB(g, buf) do { _Pragma("unroll") for (int q = 0; q < 2; ++q) { const size_t off = ER_OFF(g, q); \
            _Pragma("unroll") for (int bj = 0; bj < 2; ++bj) bw[buf][q][bj] = *(const u32x4*)(base + off + bj * HALF); } } while (0)
#define ER_STOREB(g, buf) do { _Pragma("unroll") for (int q = 0; q < 2; ++q) { const size_t off = ER_OFF(g, q); \
            _Pragma("unroll") for (int bj = 0; bj < 2; ++bj) { const u32x4 w = bw[buf][q][bj]; \
                const f32x4 b0 = (f32x4){__uint_as_float(w.x << 16), __uint_as_float(w.x & 0xffff0000u), __uint_as_float(w.y << 16), __uint_as_float(w.y & 0xffff0000u)}; \
                const f32x4 b1 = (f32x4){__uint_as_float(w.z << 16), __uint_as_float(w.z & 0xffff0000u), __uint_as_float(w.w << 16), __uint_as_float(w.w & 0xffff0000u)}; \
                const f32x4 v0 = b0 + gv[bj][0] * acc[(g) >> 1][bj][2 * ((g) & 1) + q][0], v1 = b1 + gv[bj][1] * acc[(g) >> 1][bj][2 * ((g) & 1) + q][1]; \
                *(u32x4*)(out + off + bj * HALF) = ER_PACK(v0, v1); } } } while (0)
            ER_LOADB(0, 0); ER_LOADB(1, 1); asm volatile("" ::: "memory");
#pragma unroll
            for (int bj = 0; bj < 2; ++bj)
#pragma unroll
                for (int n = 0; n < 2; ++n) gv[bj][n] = gv[bj][n] * sc;
            ER_STOREB(0, 0); asm volatile("" ::: "memory"); ER_LOADB(2, 0); asm volatile("" ::: "memory");
            ER_STOREB(1, 1); asm volatile("" ::: "memory"); ER_LOADB(3, 1); asm volatile("" ::: "memory");
            ER_STOREB(2, 0); asm volatile("" ::: "memory");
            ER_STOREB(3, 1);
#undef ER_LOADB
#undef ER_STOREB
        }
#undef ER_OFF
#undef ER_PACK
    }
};
struct EpiSwiglu {
    static constexpr bool PERM = true, AFTER_DRAIN = false;
    bf16_t* O; int ldc;
    __device__ __forceinline__ void operator()(const f32x4 (&acc)[2][2][4][2], const Unit& u, int wr, int wc, int fr, int fq) const {
        const int row0 = u.pm * BM + wr * 64 + fr, col0 = u.pn * HALF + wc * 32 + 8 * fq;
#pragma unroll
        for (int ai = 0; ai < 2; ++ai)
#pragma unroll
            for (int m = 0; m < 4; ++m) { bf16_t* rowp = O + (size_t)(row0 + ai * HALF + m * 16) * ldc + col0;
                float hv[8];
#pragma unroll
                for (int n = 0; n < 2; ++n)
#pragma unroll
                    for (int e = 0; e < 4; ++e) { const float g = acc[ai][0][m][n][e], up = acc[ai][1][m][n][e]; hv[4 * n + e] = g * sigmoidf_(g) * up; }
                u32x4 w; w.x = cvt_pk_bf16(hv[0], hv[1]); w.y = cvt_pk_bf16(hv[2], hv[3]); w.z = cvt_pk_bf16(hv[4], hv[5]); w.w = cvt_pk_bf16(hv[6], hv[7]);
                *(u32x4*)rowp = w; }
    }
};
struct EpiGates {
    static constexpr bool PERM = true, AFTER_DRAIN = false;
    const bf16_t* xr; const float* ba; const float* bx; const float* lamc; unsigned* lu;
    __device__ __forceinline__ void operator()(const f32x4 (&acc)[2][2][4][2], const Unit& u, int wr, int wc, int fr, int fq) const {
        const int row0 = u.pm * BM + wr * 64 + fr, ch0 = u.pn * HALF + wc * 32 + 8 * fq;
        f32x4 bav[2], bxv[2], lcv[2]; const float NL2E = -1.4426950408889634f;
#pragma unroll
        for (int n = 0; n < 2; ++n) { bav[n] = *(const f32x4*)(ba + ch0 + 4 * n); bxv[n] = *(const f32x4*)(bx + ch0 + 4 * n); lcv[n] = *(const f32x4*)(lamc + ch0 + 4 * n); }
        u32x4 xws[2][4];
#pragma unroll
        for (int ai = 0; ai < 2; ++ai)
#pragma unroll
            for (int m = 0; m < 4; ++m) xws[ai][m] = *(const u32x4*)(xr + ((size_t)(ch0 >> 7) * 32768 + (row0 + ai * HALF + m * 16)) * 128 + (ch0 & 127));
        asm volatile("" ::: "memory");
#pragma unroll
        for (int n = 0; n < 2; ++n) { bav[n] = bav[n] * NL2E; bxv[n] = bxv[n] * NL2E; }
#pragma unroll
        for (int ai = 0; ai < 2; ++ai)
#pragma unroll
            for (int m = 0; m < 4; ++m) { const size_t off = (size_t)(row0 + ai * HALF + m * 16) * 512 + ch0;
                const u32x4 xw = xws[ai][m];
                float xv[8]; xv[0] = __uint_as_float(xw.x << 16); xv[1] = __uint_as_float(xw.x & 0xffff0000u); xv[2] = __uint_as_float(xw.y << 16); xv[3] = __uint_as_float(xw.y & 0xffff0000u);
                xv[4] = __uint_as_float(xw.z << 16); xv[5] = __uint_as_float(xw.z & 0xffff0000u); xv[6] = __uint_as_float(xw.w << 16); xv[7] = __uint_as_float(xw.w & 0xffff0000u);
#pragma unroll
                for (int n = 0; n < 2; ++n) { u32x4 pk;
#pragma unroll
                    for (int e = 0; e < 4; ++e) {
                        const float r = __builtin_amdgcn_rcpf(1.0f + __builtin_amdgcn_exp2f(__builtin_fmaf(acc[ai][0][m][n][e], NL2E, bav[n][e])));
                        const float ig = __builtin_amdgcn_rcpf(1.0f + __builtin_amdgcn_exp2f(__builtin_fmaf(acc[ai][1][m][n][e], NL2E, bxv[n][e])));
                        const float l2 = r * lcv[n][e];
                        const float om_e = 1.0f - __builtin_amdgcn_exp2f(l2 + l2);
                        const float xx = l2 * -1.3862943611198906f;
                        const float om = xx < 1.0e-4f ? xx : om_e;
                        pk[e] = cvt_pk_bf16(l2, __builtin_amdgcn_sqrtf(om) * ig * xv[4 * n + e]); }
                    *(u32x4*)(lu + off + 4 * n) = pk; } }
    }
};
__device__ __forceinline__ float clamp448(float v) { return __builtin_amdgcn_fmed3f(v, -448.0f, 448.0f); }
__device__ __forceinline__ unsigned pack4_i8(float a, float b, float c, float d) {
    const unsigned ua = __float_as_uint(__builtin_amdgcn_fmed3f(a, -127.0f, 127.0f) + 12582912.0f), ub = __float_as_uint(__builtin_amdgcn_fmed3f(b, -127.0f, 127.0f) + 12582912.0f);
    const unsigned uc = __float_as_uint(__builtin_amdgcn_fmed3f(c, -127.0f, 127.0f) + 12582912.0f), ud = __float_as_uint(__builtin_amdgcn_fmed3f(d, -127.0f, 127.0f) + 12582912.0f);
    return (ua & 0xffu) | ((ub & 0xffu) << 8) | ((uc & 0xffu) << 16) | (ud << 24); }
__device__ __forceinline__ unsigned pack4_fp8(float a, float b, float c, float d) {
    int w = __builtin_amdgcn_cvt_pk_fp8_f32(clamp448(a), clamp448(b), 0, false); w = __builtin_amdgcn_cvt_pk_fp8_f32(clamp448(c), clamp448(d), w, true); return (unsigned)w; }
struct EpiSwigluF8 {
    static constexpr bool PERM = true, AFTER_DRAIN = false;
    unsigned char* O; int ldc; float sin_, sout;
    __device__ __forceinline__ void operator()(const f32x4 (&acc)[2][2][4][2], const Unit& u, int wr, int wc, int fr, int fq) const {
        const int row0 = u.pm * BM + wr * 64 + fr, col0 = u.pn * HALF + wc * 32 + 8 * fq; const float c1 = -1.4426950408889634f * sin_, ik = 1.0f / (sin_ * sin_ * sout);
#pragma unroll
        for (int ai = 0; ai < 2; ++ai)
#pragma unroll
            for (int m = 0; m < 4; ++m) { unsigned char* rowp = O + (size_t)(row0 + ai * HALF + m * 16) * ldc + col0;
                float hv[8];
#pragma unroll
                for (int n = 0; n < 2; ++n)
#pragma unroll
                    for (int e = 0; e < 4; ++e) { const float ag = acc[ai][0][m][n][e], au = acc[ai][1][m][n][e];
                        hv[4 * n + e] = (ag * au) * __builtin_amdgcn_rcpf(__builtin_fmaf(__builtin_amdgcn_exp2f(ag * c1), ik, ik)); }
                typedef unsigned u32x2_ __attribute__((ext_vector_type(2)));
                *(u32x2_*)rowp = (u32x2_){pack4_fp8(hv[0], hv[1], hv[2], hv[3]), pack4_fp8(hv[4], hv[5], hv[6], hv[7])}; }
    }
};
struct EpiSwigluI8 {
    static constexpr bool PERM = true, AFTER_DRAIN = false;
    unsigned char* O; int ldc; const float* rsc; float wdq, sout;
    __device__ __forceinline__ void operator()(const f32x4 (&acc)[2][2][4][2], const Unit& u, int wr, int wc, int fr, int fq) const {
        const int row0 = u.pm * BM + wr * 64 + fr, col0 = u.pn * HALF + wc * 32 + 8 * fq;
        float rs[2][4];
#pragma unroll
        for (int ai = 0; ai < 2; ++ai)
#pragma unroll
            for (int m = 0; m < 4; ++m) rs[ai][m] = rsc[row0 + ai * HALF + m * 16];
#pragma unroll
        for (int ai = 0; ai < 2; ++ai)
#pragma unroll
            for (int m = 0; m < 4; ++m) { unsigned char* rowp = O + (size_t)(row0 + ai * HALF + m * 16) * ldc + col0;
                const float s = rs[ai][m] * wdq, c1 = -1.4426950408889634f * s, ik = __builtin_amdgcn_rcpf(s * s * sout);
                float hv[8];
#pragma unroll
                for (int n = 0; n < 2; ++n)
#pragma unroll
                    for (int e = 0; e < 4; ++e) { const f32x4 gq = acc[ai][0][m][n], uq = acc[ai][1][m][n]; const float ge = gq[e], ue = uq[e];
                        const float ag = (float)__float_as_int(ge), au = (float)__float_as_int(ue);
                        hv[4 * n + e] = (ag * au) * __builtin_amdgcn_rcpf(__builtin_fmaf(__builtin_amdgcn_exp2f(ag * c1), ik, ik)); }
                typedef unsigned u32x2_ __attribute__((ext_vector_type(2)));
                *(u32x2_*)rowp = (u32x2_){pack4_fp8(hv[0], hv[1], hv[2], hv[3]), pack4_fp8(hv[4], hv[5], hv[6], hv[7])}; }
    }
};
struct EpiBf16S {
    static constexpr bool PERM = true, AFTER_DRAIN = false;
    bf16_t* O; int ldc; float sc;
    __device__ __forceinline__ void operator()(const f32x4 (&acc)[2][2][4][2], const Unit& u, int wr, int wc, int fr, int fq) const {
        const int row0 = u.pm * BM + wr * 64 + fr, col0 = u.pn * BM + wc * 32 + 8 * fq;
#pragma unroll
        for (int ai = 0; ai < 2; ++ai)
#pragma unroll
            for (int m = 0; m < 4; ++m) { bf16_t* rowp = O + (size_t)(row0 + ai * HALF + m * 16) * ldc + col0;
#pragma unroll
                for (int bj = 0; bj < 2; ++bj) { const f32x4 v0 = acc[ai][bj][m][0] * sc, v1 = acc[ai][bj][m][1] * sc;
                    u32x4 w; w.x = cvt_pk_bf16(v0[0], v0[1]); w.y = cvt_pk_bf16(v0[2], v0[3]); w.z = cvt_pk_bf16(v1[0], v1[1]); w.w = cvt_pk_bf16(v1[2], v1[3]);
                    *(u32x4*)(rowp + bj * HALF) = w; } }
    }
};
struct EpiUp {
    static constexpr bool PERM = true, AFTER_DRAIN = false;
    bf16_t* Q; bf16_t* K; bf16_t* V; const float* qg; const float* kg; const float* cosT; const float* sinT;
    __device__ __forceinline__ static float sum_fq(float s) {
        s += __int_as_float(__builtin_amdgcn_ds_swizzle(__float_as_int(s), (16 << 10) | 0x1f));
        auto rr = __builtin_amdgcn_permlane32_swap(__float_as_uint(s), __float_as_uint(s), false, false); return __uint_as_float(rr[0]) + __uint_as_float(rr[1]); }
    __device__ __forceinline__ void operator()(const f32x4 (&acc)[2][2][4][2], const Unit& u, int wr, int wc, int fr, int fq) const {
        const int t = u.pn, row0 = u.pm * BM + wr * 64 + fr; const float C2 = 0.10206207261596577f * 1.4426950408889634f, EPSN = 1e-6f;
        if (t >= 5) {
            const int col0 = (t - 5) * BM + wc * 32 + 8 * fq;
#pragma unroll
            for (int ai = 0; ai < 2; ++ai)
#pragma unroll
                for (int m = 0; m < 4; ++m) { bf16_t* rowp = V + (size_t)(row0 + ai * HALF + m * 16) * 512 + col0;
#pragma unroll
                    for (int bj = 0; bj < 2; ++bj) { const f32x4 v0 = acc[ai][bj][m][0], v1 = acc[ai][bj][m][1];
                        u32x4 w; w.x = cvt_pk_bf16(v0[0], v0[1]); w.y = cvt_pk_bf16(v0[2], v0[3]); w.z = cvt_pk_bf16(v1[0], v1[1]); w.w = cvt_pk_bf16(v1[2], v1[3]);
                        *(u32x4*)(rowp + bj * HALF) = w; } }
        } else if (t == 2) {
            const f32x4 g1 = *(const f32x4*)(qg + 64 + 4 * fq), g2 = *(const f32x4*)(qg + 80 + 4 * fq);
#pragma unroll
            for (int ai = 0; ai < 2; ++ai) {
                f32x4 csv[4], snv[4];
#pragma unroll
                for (int m = 0; m < 4; ++m) { const int row = row0 + ai * HALF + m * 16; csv[m] = *(const f32x4*)(cosT + (size_t)row * 16 + 4 * fq); snv[m] = *(const f32x4*)(sinT + (size_t)row * 16 + 4 * fq); }
                asm volatile("" ::: "memory");
#pragma unroll
                for (int m = 0; m < 4; ++m) { const int row = row0 + ai * HALF + m * 16;
                    const f32x4 cs = csv[m], sn = snv[m];
#pragma unroll
                    for (int bj = 0; bj < 2; ++bj) { const f32x4 x1 = acc[ai][bj][m][0], x2 = acc[ai][bj][m][1];
                        float ss = (x1[0] * x1[0] + x1[1] * x1[1]) + (x1[2] * x1[2] + x1[3] * x1[3]) + (x2[0] * x2[0] + x2[1] * x2[1]) + (x2[2] * x2[2] + x2[3] * x2[3]);
                        ss = sum_fq(ss); const float rs = __builtin_amdgcn_rsqf(ss * (1.0f / 32.0f) + EPSN);
                        const f32x4 a = x1 * rs * g1, b = x2 * rs * g2; const f32x4 o1 = (a * cs - b * sn) * C2, o2 = (a * sn + b * cs) * C2;
                        bf16_t* qp = Q + (size_t)row * 768 + (4 * bj + wc) * 96 + 64 + 4 * fq;
                        typedef unsigned u32x2_ __attribute__((ext_vector_type(2)));
                        *(u32x2_*)qp = (u32x2_){cvt_pk_bf16(o1[0], o1[1]), cvt_pk_bf16(o1[2], o1[3])}; *(u32x2_*)(qp + 16) = (u32x2_){cvt_pk_bf16(o2[0], o2[1]), cvt_pk_bf16(o2[2], o2[3])}; } } }
        } else {
            const bool isq = t < 2; const int head = 4 * (isq ? t : t - 3) + wc; const float* g = isq ? qg : kg; bf16_t* dst = isq ? Q : K; const float sc = isq ? C2 : 1.0f;
            f32x4 gv[2][2];
#pragma unroll
            for (int bj = 0; bj < 2; ++bj)
#pragma unroll
                for (int n = 0; n < 2; ++n) gv[bj][n] = *(const f32x4*)(g + 32 * bj + 8 * fq + 4 * n);
#pragma unroll
            for (int ai = 0; ai < 2; ++ai)
#pragma unroll
                for (int m = 0; m < 4; ++m) { const int row = row0 + ai * HALF + m * 16; float ss = 0.f;
#pragma unroll
                    for (int bj = 0; bj < 2; ++bj)
#pragma unroll
                        for (int n = 0; n < 2; ++n) { const f32x4 x = acc[ai][bj][m][n]; ss += (x[0] * x[0] + x[1] * x[1]) + (x[2] * x[2] + x[3] * x[3]); }
                    ss = sum_fq(ss); const float rs = sc / __builtin_sqrtf(ss * (1.0f / 64.0f) + EPSN);
                    bf16_t* rowp = dst + (size_t)row * 768 + head * 96 + 8 * fq;
#pragma unroll
                    for (int bj = 0; bj < 2; ++bj) { const f32x4 v0 = acc[ai][bj][m][0] * rs * gv[bj][0], v1 = acc[ai][bj][m][1] * rs * gv[bj][1];
                        u32x4 w; w.x = cvt_pk_bf16(v0[0], v0[1]); w.y = cvt_pk_bf16(v0[2], v0[3]); w.z = cvt_pk_bf16(v1[0], v1[1]); w.w = cvt_pk_bf16(v1[2], v1[3]);
                        *(u32x4*)(rowp + 32 * bj) = w; } }
        }
    }
};
template <class Epi, class Sched, bool ALIGN_EPI = false, bool SP2 = false, bool F8 = false, bool I8 = false>
__device__ __forceinline__ void gemm_phase(PG8_LAS unsigned char* lds, const Gemm g, const Sched& S, const Epi& E) {
    int tid_ = threadIdx.x; asm volatile("" : "+v"(tid_));
    const int tid = tid_, wid = __builtin_amdgcn_readfirstlane(tid >> 6), lane = tid & 63, wr = wid >> 2, wc = wid & 3, fr = lane & 15, fq = lane >> 4;
    const int K = g.K, nt = K / BK;
    unsigned voffA[2], voffB[2];
#pragma unroll
    for (int i = 0; i < 2; ++i) { int R, C; stage_rc(tid * 16 + i * 8192, R, C); const int Rb = Epi::PERM ? ((R & ~31) + perm32(R & 31)) : R;
        voffA[i] = (unsigned)(R * K + C) * 2u; voffB[i] = (unsigned)(Rb * K + C) * 2u; }
    const size_t kstep = (size_t)(BK * 2);
    const size_t hstep = (size_t)HALF * K * 2;
    const size_t tstep = 2 * hstep;
    const unsigned ldsw = (unsigned)wid * 1024u;
    const int aoff = lds_byte(wr * 64 + fr, fq * 8), boff = lds_byte(wc * 32 + fr, fq * 8);
#define PG8_SA(b, h) (((b) * 2 + (h)) * HTB)
#define PG8_SB(b, h) ((4 + (b) * 2 + (h)) * HTB)
#define PG8_STAGE(bufoff, gbase, voff) do { _Pragma("unroll") for (int _i = 0; _i < 2; ++_i) \
        __builtin_amdgcn_global_load_lds((const unsigned*)((const char*)(gbase) + (voff)[_i]), (PG8_LAS unsigned*)(lds + (bufoff) + ldsw + _i * 8192), 16, 0, 0); } while (0)
#define PG8_LDA(dst, b, h) do { _Pragma("unroll") for (int m = 0; m < 4; ++m) _Pragma("unroll") for (int k = 0; k < 2; ++k) dst[m][k] = *(const PG8_LAS bf16x8*)(lds + PG8_SA(b, h) + aoff + m * 2048 + k * 1024); } while (0)
#define PG8_LDB(dst, b, h) do { _Pragma("unroll") for (int n = 0; n < 2; ++n) _Pragma("unroll") for (int k = 0; k < 2; ++k) dst[n][k] = *(const PG8_LAS bf16x8*)(lds + PG8_SB(b, h) + boff + n * 2048 + k * 1024); } while (0)
#define PG8_CAT(x0, x1) __builtin_shufflevector(__builtin_bit_cast(i32x4_, x0), __builtin_bit_cast(i32x4_, x1), 0, 1, 2, 3, 4, 5, 6, 7)
#define PG8_MMA(ai, bj, At, Bt) do { __builtin_amdgcn_s_setprio(1); \
        if constexpr (I8) { _Pragma("unroll") for (int k = 0; k < 2; ++k) _Pragma("unroll") for (int m = 0; m < 4; ++m) _Pragma("unroll") for (int n = 0; n < 2; ++n) \
            asm volatile("v_mfma_i32_16x16x64_i8 %0, %1, %2, %0" : "+v"(acc[ai][bj][m][n]) : "v"(Bt[n][k]), "v"(At[m][k])); } \
        else { _Pragma("unroll") for (int m = 0; m < 4; ++m) _Pragma("unroll") for (int n = 0; n < 2; ++n) { \
        if constexpr (F8) asm volatile("v_mfma_f32_16x16x128_f8f6f4 %0, %1, %2, %0" : "+v"(acc[ai][bj][m][n]) : "v"(PG8_CAT(Bt[n][0], Bt[n][1])), "v"(PG8_CAT(At[m][0], At[m][1])));     \
        else { _Pragma("unroll") for (int k = 0; k < 2; ++k) acc[ai][bj][m][n] = __builtin_amdgcn_mfma_f32_16x16x32_bf16(Bt[n][k], At[m][k], acc[ai][bj][m][n], 0, 0, 0); } } } __builtin_amdgcn_s_setprio(0); } while (0)
#define PG8_MMA0(ai, bj, At, Bt) do { __builtin_amdgcn_s_setprio(1); \
        if constexpr (I8) { _Pragma("unroll") for (int m = 0; m < 4; ++m) _Pragma("unroll") for (int n = 0; n < 2; ++n) asm volatile("v_mfma_i32_16x16x64_i8 %0, %1, %2, 0" : "=&v"(acc[ai][bj][m][n]) : "v"(Bt[n][0]), "v"(At[m][0])); \
            _Pragma("unroll") for (int m = 0; m < 4; ++m) _Pragma("unroll") for (int n = 0; n < 2; ++n) asm volatile("v_mfma_i32_16x16x64_i8 %0, %1, %2, %0" : "+v"(acc[ai][bj][m][n]) : "v"(Bt[n][1]), "v"(At[m][1])); } \
        else { _Pragma("unroll") for (int m = 0; m < 4; ++m) _Pragma("unroll") for (int n = 0; n < 2; ++n) \
            asm volatile("v_mfma_f32_16x16x128_f8f6f4 %0, %1, %2, 0" : "=&v"(acc[ai][bj][m][n]) : "v"(PG8_CAT(Bt[n][0], Bt[n][1])), "v"(PG8_CAT(At[m][0], At[m][1]))); } \
        __builtin_amdgcn_s_setprio(0); } while (0)
#define PG8_MMAZ(ai, bj, At, Bt) do { if (F8 && t == 0) PG8_MMA0(ai, bj, At, Bt); else PG8_MMA(ai, bj, At, Bt); } while (0)
#define PG8_WAIT_V(n) asm volatile("s_waitcnt vmcnt(" #n ")" ::: "memory")
#define PG8_WAIT_L(n) asm volatile("s_waitcnt lgkmcnt(" #n ")" ::: "memory")
#define PG8_BAR __builtin_amdgcn_s_barrier()
#define PG8_SCHED __builtin_amdgcn_sched_barrier(0)
    Unit cur, nxt; int ui = 0;
    if (!S.next(0, cur)) return;
    f32x4 acc[2][2][4][2];
    if constexpr (!F8) {
#pragma unroll
    for (int a = 0; a < 2; ++a)
#pragma unroll
        for (int b = 0; b < 2; ++b)
#pragma unroll
            for (int m = 0; m < 4; ++m)
#pragma unroll
                for (int n = 0; n < 2; ++n) acc[a][b][m][n] = (f32x4){0.f, 0.f, 0.f, 0.f}; }
    bf16x8 At[4][2], B0[2][2], B1[2][2];
    const char* cA = (const char*)g.A + (size_t)cur.pa * tstep; const char* cB = (const char*)g.Bt + (size_t)cur.pb * tstep;
    S.a_ready(cur);
    if constexpr (SP2) {
        PG8_STAGE(PG8_SB(0, 0), cB, voffB); PG8_STAGE(PG8_SB(0, 1), cB + hstep, voffB); PG8_STAGE(PG8_SA(0, 0), cA, voffA); PG8_STAGE(PG8_SA(0, 1), cA + hstep, voffA);
        if (wr == 1) PG8_BAR;
        PG8_WAIT_V(2); PG8_BAR;
        PG8_STAGE(PG8_SB(1, 0), cB + kstep, voffB); PG8_STAGE(PG8_SA(1, 0), cA + kstep, voffA); PG8_STAGE(PG8_SB(1, 1), cB + hstep + kstep, voffB);
        PG8_WAIT_V(6); PG8_BAR;
    } else {
        PG8_STAGE(PG8_SB(0, 0), cB, voffB); PG8_STAGE(PG8_SA(0, 0), cA, voffA); PG8_STAGE(PG8_SB(0, 1), cB + hstep, voffB); PG8_STAGE(PG8_SA(0, 1), cA + hstep, voffA);
        if (wr == 1) PG8_BAR;
        PG8_WAIT_V(4); PG8_BAR;
        PG8_STAGE(PG8_SB(1, 0), cB + kstep, voffB); PG8_STAGE(PG8_SA(1, 0), cA + kstep, voffA); PG8_STAGE(PG8_SB(1, 1), cB + hstep + kstep, voffB);
        PG8_WAIT_V(6); PG8_BAR;
    }
    for (;;) {
        const bool has_next = S.next(ui + 1, nxt);
        const char* nA = has_next ? (const char*)g.A + (size_t)nxt.pa * tstep : cA; const char* nB = has_next ? (const char*)g.Bt + (size_t)nxt.pb * tstep : cB;
        const int ntu = S.ktiles(cur, nt);
        for (int t = 0; t < ntu; t += 2) {
            const bool last = (t == ntu - 2);
            const char* a1 = cA + (size_t)(t + 1) * kstep;
            const char* a2 = last ? nA : cA + (size_t)(t + 2) * kstep; const char* b2 = last ? nB : cB + (size_t)(t + 2) * kstep;
            const char* a3 = a2 + kstep; const char* b3 = b2 + kstep;
            if (last && has_next) S.a_ready(nxt);
            if constexpr (SP2) {
            PG8_LDB(B0, 0, 0); PG8_LDB(B1, 0, 1); PG8_SCHED; PG8_LDA(At, 0, 0); PG8_STAGE(PG8_SA(1, 1), a1 + hstep, voffA);
            PG8_WAIT_V(8); PG8_WAIT_L(0); PG8_BAR; PG8_MMAZ(0, 0, At, B0); PG8_MMAZ(0, 1, At, B1); PG8_BAR; PG8_SCHED;
            PG8_LDA(At, 0, 1); PG8_STAGE(PG8_SB(0, 0), b2, voffB); PG8_STAGE(PG8_SB(0, 1), b2 + hstep, voffB); PG8_STAGE(PG8_SA(0, 0), a2, voffA);
            PG8_WAIT_V(8); PG8_WAIT_L(0); PG8_BAR; PG8_MMAZ(1, 0, At, B0); PG8_MMAZ(1, 1, At, B1); PG8_BAR; PG8_SCHED;
            PG8_LDB(B0, 1, 0); PG8_LDB(B1, 1, 1); PG8_SCHED; PG8_LDA(At, 1, 0); PG8_STAGE(PG8_SA(0, 1), a2 + hstep, voffA);
            PG8_WAIT_V(8); PG8_WAIT_L(0); PG8_BAR; PG8_MMA(0, 0, At, B0); PG8_MMA(0, 1, At, B1); PG8_BAR; PG8_SCHED;
            PG8_LDA(At, 1, 1); PG8_STAGE(PG8_SB(1, 0), b3, voffB); PG8_STAGE(PG8_SB(1, 1), b3 + hstep, voffB); PG8_STAGE(PG8_SA(1, 0), a3, voffA);
            PG8_WAIT_V(8); PG8_WAIT_L(0); PG8_BAR; PG8_MMA(1, 0, At, B0); PG8_MMA(1, 1, At, B1); PG8_BAR; PG8_SCHED;
            } else {
            PG8_LDB(B0, 0, 0); PG8_SCHED; PG8_LDA(At, 0, 0); PG8_STAGE(PG8_SA(1, 1), a1 + hstep, voffA);
            PG8_WAIT_L(8); PG8_BAR; PG8_WAIT_L(0); PG8_MMAZ(0, 0, At, B0); PG8_BAR; PG8_SCHED;
            PG8_LDB(B1, 0, 1); PG8_STAGE(PG8_SB(0, 0), b2, voffB);
            PG8_BAR; PG8_WAIT_L(0); PG8_MMAZ(0, 1, At, B1); PG8_BAR;
            PG8_LDA(At, 0, 1); PG8_STAGE(PG8_SA(0, 0), a2, voffA);
            PG8_BAR; PG8_WAIT_L(0); PG8_MMAZ(1, 0, At, B0); PG8_BAR; PG8_SCHED;
            PG8_STAGE(PG8_SB(0, 1), b2 + hstep, voffB);
            PG8_WAIT_V(6); PG8_BAR; PG8_MMAZ(1, 1, At, B1); PG8_BAR;
            PG8_LDB(B0, 1, 0); PG8_SCHED; PG8_LDA(At, 1, 0); PG8_STAGE(PG8_SA(0, 1), a2 + hstep, voffA);
            PG8_WAIT_L(8); PG8_BAR; PG8_WAIT_L(0); PG8_MMA(0, 0, At, B0); PG8_BAR; PG8_SCHED;
            PG8_LDB(B1, 1, 1); PG8_STAGE(PG8_SB(1, 0), b3, voffB);
            PG8_BAR; PG8_WAIT_L(0); PG8_MMA(0, 1, At, B1); PG8_BAR;
            PG8_LDA(At, 1, 1); PG8_STAGE(PG8_SA(1, 0), a3, voffA);
            PG8_BAR; PG8_WAIT_L(0); PG8_MMA(1, 0, At, B0); PG8_BAR; PG8_SCHED;
            PG8_STAGE(PG8_SB(1, 1), b3 + hstep, voffB);
            PG8_WAIT_V(6); PG8_BAR; PG8_MMA(1, 1, At, B1); PG8_BAR;
            }
        }
        if constexpr (ALIGN_EPI) { if (wr == 0) PG8_BAR; }
        if constexpr (F8) asm volatile("s_nop 15\n\ts_nop 15" ::: "memory");
        if constexpr (!Epi::AFTER_DRAIN) { E(acc, cur, wr, wc, fr, fq); S.done(cur); }
        if (!has_next) break;
        if constexpr (!F8) {
#pragma unroll
        for (int a = 0; a < 2; ++a)
#pragma unroll
            for (int b = 0; b < 2; ++b)
#pragma unroll
                for (int m = 0; m < 4; ++m)
#pragma unroll
                    for (int n = 0; n < 2; ++n) acc[a][b][m][n] = (f32x4){0.f, 0.f, 0.f, 0.f}; }
        cur = nxt; cA = nA; cB = nB; ++ui;
        if constexpr (ALIGN_EPI) { if (wr == 1) PG8_BAR; }
    }
    PG8_WAIT_V(0);
    if constexpr (!ALIGN_EPI) { if (wr == 0) PG8_BAR; }
    PG8_BAR;
    if constexpr (Epi::AFTER_DRAIN) { E.fused(acc, cur, wr, wc, fr, fq, lds, wid, lane); S.done(cur); }
#undef PG8_SA
#undef PG8_SB
#undef PG8_STAGE
#undef PG8_LDA
#undef PG8_LDB
#undef PG8_MMA
#undef PG8_MMA0
#undef PG8_MMAZ
#undef PG8_CAT
#undef PG8_WAIT_V
#undef PG8_WAIT_L
#undef PG8_BAR
#undef PG8_SCHED
}
}

#define GAS __attribute__((address_space(1)))
#define LAS __attribute__((address_space(3)))
typedef unsigned short bf16;
typedef unsigned v4u __attribute__((ext_vector_type(4)));
typedef unsigned v2u __attribute__((ext_vector_type(2)));
typedef float f32x4 __attribute__((ext_vector_type(4)));
typedef short bf16x8 __attribute__((ext_vector_type(8)));
typedef GAS unsigned gu32;
typedef GAS unsigned long long gu64;
#define RLX_AGENT __ATOMIC_RELAXED, __HIP_MEMORY_SCOPE_AGENT
#define LDS_WAIT() asm volatile("s_waitcnt lgkmcnt(0)" ::: "memory")
#define VM_WAIT() asm volatile("s_waitcnt vmcnt(0)" ::: "memory")
__device__ __forceinline__ unsigned long long rt() { return __builtin_amdgcn_s_memrealtime(); }
__device__ __forceinline__ unsigned f2bf(float f) { unsigned u = __builtin_bit_cast(unsigned, f); return (u + 0x7fffu + ((u >> 16) & 1u)) >> 16; }
__device__ __forceinline__ unsigned pk2(float lo, float hi) { return f2bf(lo) | (f2bf(hi) << 16); }

#define XB_TMO      128
#define XB_XCNT(j)  (256  + 64 * (j))
#define XB_XSUB(j)  (1280 + 64 * (j))
#define XB_XGEN(j)  (2304 + 64 * (j))
#define XB_TOP      3328
#define XB_TOPGEN   3392
#define XCD_BAR_WORDS 3456
#define XB_SPIN_CAP (1u << 18)

__device__ __forceinline__ unsigned xb_ld(unsigned* p)              { return __hip_atomic_load(p, __ATOMIC_RELAXED, __HIP_MEMORY_SCOPE_AGENT); }
__device__ __forceinline__ unsigned xb_add(unsigned* p, unsigned v) { return __hip_atomic_fetch_add(p, v, __ATOMIC_RELAXED, __HIP_MEMORY_SCOPE_AGENT); }
__device__ __forceinline__ unsigned xb_xcc_id() { return (unsigned)__builtin_amdgcn_s_getreg((3 << 11) | 20) & 0xFu; }
#define XB_SPIN(cond, bar) do { unsigned _sp = 0; while (cond) { __builtin_amdgcn_s_sleep(1); \
    if ((++_sp & 255u) == 0u) { if (xb_ld(&(bar)[XB_TMO])) break; if (_sp > XB_SPIN_CAP) { atomicAdd(&(bar)[XB_TMO], 1u); break; } } } } while (0)

struct XcdBarrier {
    unsigned* bar; unsigned x;
    volatile LAS unsigned* st;
};

__device__ __forceinline__ XcdBarrier xcd_barrier_post(unsigned* bar, volatile LAS unsigned* st) {
    XcdBarrier b; b.bar = bar; b.x = xb_xcc_id(); b.st = st;
    if (threadIdx.x == 0) (void)xb_add(&bar[XB_XCNT(b.x)], 1u);
    return b;
}
__device__ __forceinline__ void xcd_barrier_complete(unsigned* bar, unsigned x, unsigned& nloc, unsigned& nx) {
    const unsigned G = gridDim.x * gridDim.y * gridDim.z;
    unsigned sum, cnt, mine, sp = 0u;
    for (;;) {
        sum = 0u; cnt = 0u; mine = 0u;
#pragma unroll
        for (unsigned j = 0; j < 16; ++j) { const unsigned c = xb_ld(&bar[XB_XCNT(j)]); sum += c; cnt += (c > 0u) ? 1u : 0u; mine = (j == x) ? c : mine; }
        if (sum == G) break;
        __builtin_amdgcn_s_sleep(1);
        if ((++sp & 255u) == 0u) { if (xb_ld(&bar[XB_TMO])) break; if (sp > XB_SPIN_CAP) { atomicAdd(&bar[XB_TMO], 1u); break; } }
    }
    nloc = mine > 0u ? mine : 1u; nx = cnt > 0u ? cnt : 1u;
}

__device__ __forceinline__ void xcd_barrier(const XcdBarrier& b) {
    asm volatile("s_waitcnt vmcnt(0)" ::: "memory");
    __syncthreads();
    unsigned tid0_ = threadIdx.x; asm volatile("" : "+v"(tid0_));
    if (tid0_ == 0) {
        unsigned* bar = b.bar; unsigned bx = b.x;
        asm volatile("" : "+s"(bar), "+s"(bx));
        __builtin_amdgcn_s_waitcnt(0);
        unsigned nloc = b.st[0], nx = b.st[1];
        if (nloc == 0u) { xcd_barrier_complete(bar, bx, nloc, nx); b.st[0] = nloc; b.st[1] = nx; }
        const unsigned old = xb_add(&bar[XB_XSUB(bx)], 1u);
        const unsigned gen = old / nloc;
        if (old + 1u == (gen + 1u) * nloc) {
            __builtin_amdgcn_fence(__ATOMIC_RELEASE, "agent");
            asm volatile("s_waitcnt vmcnt(0)" ::: "memory");
            const unsigned og = xb_add(&bar[XB_TOP], 1u);
            const unsigned tg = og / nx;
            if (og + 1u == (tg + 1u) * nx) xb_add(&bar[XB_TOPGEN], 1u);
            else XB_SPIN(xb_ld(&bar[XB_TOPGEN]) == tg, bar);
            __builtin_amdgcn_fence(__ATOMIC_ACQUIRE, "agent");
            xb_add(&bar[XB_XGEN(bx)], 1u);
            asm volatile("s_waitcnt vmcnt(0)" ::: "memory");
        } else {
            XB_SPIN(xb_ld(&bar[XB_XGEN(bx)]) == gen, bar);
            __builtin_amdgcn_fence(__ATOMIC_ACQUIRE, "agent");
            asm volatile("s_waitcnt vmcnt(0)" ::: "memory");
        }
    }
    __syncthreads();
}

namespace att_online {
#define ALAS __attribute__((address_space(3)))
typedef unsigned short bf16;
typedef short bf16x8 __attribute__((ext_vector_type(8)));
typedef short s16x4 __attribute__((ext_vector_type(4)));
typedef float f32x16 __attribute__((ext_vector_type(16)));
typedef unsigned u32x4 __attribute__((ext_vector_type(4)));
constexpr int SEQ = 16384, NHEAD = 8;
constexpr int QP = 768, KP = 768, VP = 512, OP = 1024;
constexpr int QHS = 96, KHS = 96, VHS = 64, OHS = 64;
constexpr int NW = 8, QBLK = 32, QB = QBLK * NW, KVBLK = 64, NQB = SEQ / QB;
constexpr int KSLOT = 12288, VSLOT = 8192;
constexpr int L_K = 0, L_V = 2 * KSLOT, L_WS = L_V + 2 * VSLOT, L_OST = L_WS + NW * 64 * 4, L_BYTES = L_OST + NW * 4096;
constexpr float THR = 8.0f;
__device__ __forceinline__ int crow(int r, int hi) { return (r & 3) + 8 * (r >> 2) + 4 * hi; }
__device__ __forceinline__ unsigned cvtpk(float lo, float hi) { unsigned r; asm volatile("v_cvt_pk_bf16_f32 %0, %1, %2" : "=v"(r) : "v"(lo), "v"(hi)); return r; }
__device__ __forceinline__ float pswap_max(float m) { auto rr = __builtin_amdgcn_permlane32_swap(__float_as_uint(m), __float_as_uint(m), false, false); return __builtin_fmaxf(__uint_as_float(rr[0]), __uint_as_float(rr[1])); }
__device__ __forceinline__ float pswap_sum(float m) { auto rr = __builtin_amdgcn_permlane32_swap(__float_as_uint(m), __float_as_uint(m), false, false); return __uint_as_float(rr[0]) + __uint_as_float(rr[1]); }

__device__ __forceinline__ void attn_unit(int b, int h, int qb, const bf16* Q, const bf16* K, const bf16* V, bf16* O, ALAS unsigned char* shm) {
    int tid_ = threadIdx.x; asm volatile("" : "+v"(tid_));
    const int tid = tid_, lane = tid & 63, r32 = lane & 31, hi = lane >> 5; const int wid = __builtin_amdgcn_readfirstlane(tid >> 6);
    const long rowbase = (long)b * SEQ; const int q0 = qb * QB;
    const bf16* Qw = Q + (rowbase + q0 + wid * QBLK) * QP + h * QHS;
    const bf16* Kh = K + rowbase * KP + h * KHS; const bf16* Vh = V + rowbase * VP + h * VHS;
    ALAS float* wsf = (ALAS float*)(shm + L_WS) + wid * 64;
    const bf16* ksrc = Kh + (long)lane * KP + wid * 8;
    const bf16* vsrc = Vh + (long)(16 * (wid & 3) + (lane >> 2)) * VP + (wid >> 2) * 32 + (lane & 3) * 8;
#define ATT_DMA(t, slot) do { \
        __builtin_amdgcn_global_load_lds((const unsigned*)(ksrc + (long)(t) * KVBLK * KP), (ALAS unsigned*)(shm + L_K + (slot) * KSLOT + wid * 1024), 16, 0, 0); \
        if (wid < 4) __builtin_amdgcn_global_load_lds((const unsigned*)(ksrc + (long)(t) * KVBLK * KP + 64), (ALAS unsigned*)(shm + L_K + (slot) * KSLOT + (8 + wid) * 1024), 16, 0, 0); \
        __builtin_amdgcn_global_load_lds((const unsigned*)(vsrc + (long)(t) * KVBLK * VP), (ALAS unsigned*)(shm + L_V + (slot) * VSLOT + wid * 1024), 16, 0, 0); } while (0)
    const int NT = (q0 + QB) / KVBLK;
    ATT_DMA(0, 0);
    bf16x8 qr[6];
#pragma unroll
    for (int d0 = 0; d0 < 6; ++d0) qr[d0] = *(const bf16x8*)(Qw + (long)r32 * QP + d0 * 16 + hi * 8);
    float mhat = 0.f, l_reg = 0.f; f32x16 o[2], negm;
#pragma unroll
    for (int r = 0; r < 16; ++r) { o[0][r] = 0.f; o[1][r] = 0.f; negm[r] = 0.f; }
    const int qrel = wid * QBLK + r32;
    const unsigned vb0 = (unsigned)(uintptr_t)(shm + L_V) + ((lane >> 4) & 1) * 32 + (lane & 3) * 8 + (4 * hi + ((lane & 15) >> 2)) * 64;
    for (int t = 0; t < NT; ++t) {
        const int cur = t & 1;
        asm volatile("s_waitcnt vmcnt(0)" ::: "memory"); __syncthreads();
        if (t + 1 < NT) ATT_DMA(t + 1, cur ^ 1);
        f32x16 p0, p1;
        { const ALAS unsigned char* kb = shm + L_K + cur * KSLOT + hi * 1024 + r32 * 16;
#pragma unroll
          for (int d0 = 0; d0 < 6; ++d0) {
              const bf16x8 b0 = *(const ALAS bf16x8*)(kb + d0 * 2048), b1 = *(const ALAS bf16x8*)(kb + d0 * 2048 + 512);
              if (d0 == 0) { p0 = __builtin_amdgcn_mfma_f32_32x32x16_bf16(b0, qr[0], negm, 0, 0, 0); p1 = __builtin_amdgcn_mfma_f32_32x32x16_bf16(b1, qr[0], negm, 0, 0, 0); }
              else { p0 = __builtin_amdgcn_mfma_f32_32x32x16_bf16(b0, qr[d0], p0, 0, 0, 0); p1 = __builtin_amdgcn_mfma_f32_32x32x16_bf16(b1, qr[d0], p1, 0, 0, 0); } } }
        const int jb = t - (NT - 4);
        if (jb >= 0) { const int kb0 = 64 * jb + 4 * hi;
#pragma unroll
            for (int r = 0; r < 16; ++r) { const int kv = kb0 + (r & 3) + 8 * (r >> 2); if (kv > qrel) p0[r] = -__builtin_inff(); if (kv + 32 > qrel) p1[r] = -__builtin_inff(); } }
        float rm = __builtin_fmaxf(p0[0], p1[0]);
#pragma unroll
        for (int r = 1; r < 16; ++r) rm = __builtin_fmaxf(rm, __builtin_fmaxf(p0[r], p1[r]));
        rm = pswap_max(rm);
        bool resc = false;
        if (t == 0 || __any(rm > THR)) {
            const float dl = (t == 0) ? rm : __builtin_fmaxf(rm, 0.f); mhat += dl;
#pragma unroll
            for (int r = 0; r < 16; ++r) { p0[r] -= dl; p1[r] -= dl; negm[r] = -mhat; }
            if (t != 0) { const float f = __builtin_amdgcn_exp2f(-dl); l_reg *= f; if (hi == 0) wsf[r32] = f; resc = true; }
        }
        float sacc = 0.f;
#pragma unroll
        for (int r = 0; r < 16; ++r) { p0[r] = __builtin_amdgcn_exp2f(p0[r]); p1[r] = __builtin_amdgcn_exp2f(p1[r]); sacc += p0[r] + p1[r]; }
        l_reg += sacc;
        if (resc) { asm volatile("s_waitcnt lgkmcnt(0)" ::: "memory");
#pragma unroll
            for (int r = 0; r < 16; ++r) { const float f = wsf[crow(r, hi)]; o[0][r] *= f; o[1][r] *= f; }
            asm volatile("s_waitcnt lgkmcnt(0)" ::: "memory"); }
        u32x4 pw[4];
#pragma unroll
        for (int k = 0; k < 2; ++k) { pw[k] = (u32x4){cvtpk(p0[8 * k], p0[8 * k + 1]), cvtpk(p0[8 * k + 2], p0[8 * k + 3]), cvtpk(p0[8 * k + 4], p0[8 * k + 5]), cvtpk(p0[8 * k + 6], p0[8 * k + 7])};
            pw[2 + k] = (u32x4){cvtpk(p1[8 * k], p1[8 * k + 1]), cvtpk(p1[8 * k + 2], p1[8 * k + 3]), cvtpk(p1[8 * k + 4], p1[8 * k + 5]), cvtpk(p1[8 * k + 6], p1[8 * k + 7])}; }
        { const unsigned vb = vb0 + cur * VSLOT;
#pragma unroll
          for (int d0 = 0; d0 < 2; ++d0) { s16x4 lo[4], hh[4];
#pragma unroll
              for (int ks = 0; ks < 4; ++ks) {
                  asm volatile("ds_read_b64_tr_b16 %0, %1 offset:%c2" : "=&v"(lo[ks]) : "v"(vb), "i"(d0 * 4096 + ks * 1024) : "memory");
                  asm volatile("ds_read_b64_tr_b16 %0, %1 offset:%c2" : "=&v"(hh[ks]) : "v"(vb), "i"(d0 * 4096 + ks * 1024 + 512) : "memory"); }
              asm volatile("s_waitcnt lgkmcnt(0)" : "+v"(lo[0]), "+v"(lo[1]), "+v"(lo[2]), "+v"(lo[3]), "+v"(hh[0]), "+v"(hh[1]), "+v"(hh[2]), "+v"(hh[3]) :: "memory");
#pragma unroll
              for (int ks = 0; ks < 4; ++ks) { const bf16x8 vf = (bf16x8){lo[ks][0], lo[ks][1], lo[ks][2], lo[ks][3], hh[ks][0], hh[ks][1], hh[ks][2], hh[ks][3]};
                  o[d0] = __builtin_amdgcn_mfma_f32_32x32x16_bf16(__builtin_bit_cast(bf16x8, pw[ks]), vf, o[d0], 0, 0, 0); } } }
    }
    l_reg = pswap_sum(l_reg);
    if (hi == 0) wsf[32 + r32] = l_reg;
    asm volatile("s_waitcnt lgkmcnt(0)" ::: "memory");
    float rli[16];
#pragma unroll
    for (int r = 0; r < 16; ++r) rli[r] = __builtin_amdgcn_rcpf(wsf[32 + crow(r, hi)]);
    bf16* Ow = O + (rowbase + q0 + wid * QBLK) * OP + h * OHS;
    { ALAS bf16* stg = (ALAS bf16*)(shm + L_OST) + wid * 2048;
#pragma unroll
      for (int r = 0; r < 16; ++r) { const int orow = crow(r, hi);
#pragma unroll
          for (int d0 = 0; d0 < 2; ++d0) { const float v = o[d0][r] * rli[r]; unsigned u = __float_as_uint(v); u = (u + 0x7fffu + ((u >> 16) & 1u)) >> 16; stg[orow * 64 + d0 * 32 + r32] = (bf16)u; } }
      asm volatile("s_waitcnt lgkmcnt(0)" ::: "memory");
#pragma unroll
      for (int i = 0; i < 4; ++i) { const int row = i * 8 + (lane >> 3), ch = lane & 7; const u32x4 v = *(const ALAS u32x4*)(stg + row * 64 + ch * 8); *(u32x4*)(Ow + (long)row * OP + ch * 8) = v; } }
    asm volatile("s_waitcnt lgkmcnt(0)" ::: "memory"); __syncthreads();
#undef ATT_DMA
}
#undef ALAS
}

namespace att {
#define ALAS __attribute__((address_space(3)))
typedef unsigned short bf16;
typedef short bf16x8 __attribute__((ext_vector_type(8)));
typedef short s16x4 __attribute__((ext_vector_type(4)));
typedef float f32x16 __attribute__((ext_vector_type(16)));
typedef unsigned u32x4 __attribute__((ext_vector_type(4)));
constexpr int SEQ = 16384, NHEAD = 8;
constexpr int QP = 768, KP = 768, VP = 512, OP = 1024;
constexpr int QHS = 96, KHS = 96, VHS = 64, OHS = 64;
constexpr int NW = 8, QBLK = 32, QB = QBLK * NW, KVBLK = 64, NQB = SEQ / QB;
constexpr int KSLOT = 12288, VSLOT = 8192;
constexpr int L_K = 0, L_V = 2 * KSLOT, L_WS = L_V + 3 * VSLOT, L_OST = L_WS + NW * 64 * 4, L_BYTES = L_OST + NW * 4096;
constexpr float THR = 8.0f;
__device__ __forceinline__ int crow(int r, int hi) { return (r & 3) + 8 * (r >> 2) + 4 * hi; }
__device__ __forceinline__ unsigned cvtpk(float lo, float hi) { typedef float f32x2_t __attribute__((ext_vector_type(2))); typedef __bf16 bf16x2_t __attribute__((ext_vector_type(2)));
    f32x2_t v = {lo, hi}; bf16x2_t b = __builtin_convertvector(v, bf16x2_t); return __builtin_bit_cast(unsigned, b); }
__device__ __forceinline__ float pswap_max(float m) { auto rr = __builtin_amdgcn_permlane32_swap(__float_as_uint(m), __float_as_uint(m), false, false); return __builtin_fmaxf(__uint_as_float(rr[0]), __uint_as_float(rr[1])); }
__device__ __forceinline__ float pswap_sum(float m) { auto rr = __builtin_amdgcn_permlane32_swap(__float_as_uint(m), __float_as_uint(m), false, false); return __uint_as_float(rr[0]) + __uint_as_float(rr[1]); }
typedef short v4i16_t __attribute__((ext_vector_type(4)));
__device__ __forceinline__ s16x4 vtr(const ALAS unsigned char* p) { return __builtin_bit_cast(s16x4, __builtin_amdgcn_ds_read_tr16_b64_v4i16((ALAS v4i16_t*)p)); }
__device__ __forceinline__ void qkt(f32x16& s0, f32x16& s1, const ALAS unsigned char* kb, const bf16x8 (&qr)[6]) {
    const f32x16 c0 = {};
#pragma unroll
    for (int d0 = 0; d0 < 6; ++d0) {
        const bf16x8 b0 = *(const ALAS bf16x8*)(kb + d0 * 2048), b1 = *(const ALAS bf16x8*)(kb + d0 * 2048 + 512);
        if (d0 == 0) { s0 = __builtin_amdgcn_mfma_f32_32x32x16_bf16(b0, qr[0], c0, 0, 0, 0); s1 = __builtin_amdgcn_mfma_f32_32x32x16_bf16(b1, qr[0], c0, 0, 0, 0); }
        else { s0 = __builtin_amdgcn_mfma_f32_32x32x16_bf16(b0, qr[d0], s0, 0, 0, 0); s1 = __builtin_amdgcn_mfma_f32_32x32x16_bf16(b1, qr[d0], s1, 0, 0, 0); } }
}
__device__ __forceinline__ void pv(f32x16 (&o)[2], const ALAS unsigned char* vp, const u32x4 (&pk)[4]) {
#pragma unroll
    for (int ks = 0; ks < 4; ++ks)
#pragma unroll
        for (int d0 = 0; d0 < 2; ++d0) { const s16x4 lo = vtr(vp + d0 * 4096 + ks * 1024), hh = vtr(vp + d0 * 4096 + ks * 1024 + 512);
            const bf16x8 vf = (bf16x8){lo[0], lo[1], lo[2], lo[3], hh[0], hh[1], hh[2], hh[3]};
            o[d0] = __builtin_amdgcn_mfma_f32_32x32x16_bf16(__builtin_bit_cast(bf16x8, pk[ks]), vf, o[d0], 0, 0, 0); }
}

constexpr float ATT_MREF_MAX = 40.0f;
#define ATT_SBAR() __builtin_amdgcn_sched_barrier(0)
#define ATT_PIN(x) asm volatile("" : "+v"(x))
#define ATT_VLOAD(i) do { if (VAR == 1) break; const s16x4 lo_ = vtr(vfrag + ((i) & 1) * 4096 + ((i) >> 1) * 1024), hi_ = vtr(vfrag + ((i) & 1) * 4096 + ((i) >> 1) * 1024 + 512); vfr[i] = (bf16x8){lo_[0], lo_[1], lo_[2], lo_[3], hi_[0], hi_[1], hi_[2], hi_[3]}; } while (0)
#define ATT_KLOAD(j) do { if (QK && VAR != 1) kfr[j] = *(const ALAS bf16x8*)(kfrag + ((j) >> 1) * 2048 + ((j) & 1) * 512); } while (0)
template <bool QK, int VAR = 0>
__device__ __forceinline__ void attn_step(f32x16& c0, f32x16& c1, f32x16& n0, f32x16& n1, u32x4 (&pk)[4], f32x16 (&o)[2], float& l_reg, const bf16x8 (&qr)[6],
                                          const ALAS unsigned char* kfrag, const ALAS unsigned char* vfrag, int jb, int qrel, int hi) {
    if (jb >= 0) { const int kbase = 64 * jb + 4 * hi;
#pragma unroll
        for (int r = 0; r < 16; ++r) { const int kv = kbase + (r & 3) + 8 * (r >> 2); if (kv > qrel) c0[r] = -__builtin_inff(); if (kv + 32 > qrel) c1[r] = -__builtin_inff(); } }
    bf16x8 vfr[8] = {}, kfr[12] = {}; float sa = 0.f, sb = 0.f; const f32x16 zero16 = {};
    ATT_VLOAD(0); ATT_VLOAD(1); ATT_SBAR();
      if (VAR != 4) o[0] = __builtin_amdgcn_mfma_f32_32x32x16_bf16(__builtin_bit_cast(bf16x8, pk[0]), vfr[0], o[0], 0, 0, 0); if (VAR != 2) { c0[0] = __builtin_amdgcn_exp2f(c0[0]); c0[1] = __builtin_amdgcn_exp2f(c0[1]); } ATT_VLOAD(2); ATT_PIN(c0); ATT_SBAR();
      if (VAR != 4) o[1] = __builtin_amdgcn_mfma_f32_32x32x16_bf16(__builtin_bit_cast(bf16x8, pk[0]), vfr[1], o[1], 0, 0, 0); if (VAR != 2) { c0[2] = __builtin_amdgcn_exp2f(c0[2]); c0[3] = __builtin_amdgcn_exp2f(c0[3]); } if (VAR != 2) { sa += c0[0]; sa += c0[1]; } ATT_VLOAD(3); ATT_PIN(c0); ATT_PIN(sa); ATT_SBAR();
      if (VAR != 4) o[0] = __builtin_amdgcn_mfma_f32_32x32x16_bf16(__builtin_bit_cast(bf16x8, pk[1]), vfr[2], o[0], 0, 0, 0); if (VAR != 2) { c0[4] = __builtin_amdgcn_exp2f(c0[4]); c0[5] = __builtin_amdgcn_exp2f(c0[5]); } if (VAR != 2) { sa += c0[2]; sa += c0[3]; } ATT_VLOAD(4); ATT_PIN(c0); ATT_PIN(sa); ATT_SBAR();
      if (VAR != 4) o[1] = __builtin_amdgcn_mfma_f32_32x32x16_bf16(__builtin_bit_cast(bf16x8, pk[1]), vfr[3], o[1], 0, 0, 0); if (VAR != 2) { c0[6] = __builtin_amdgcn_exp2f(c0[6]); c0[7] = __builtin_amdgcn_exp2f(c0[7]); } if (VAR != 2) { sa += c0[4]; sa += c0[5]; } ATT_VLOAD(5); ATT_PIN(c0); ATT_PIN(sa); ATT_SBAR();
      if (VAR != 4) o[0] = __builtin_amdgcn_mfma_f32_32x32x16_bf16(__builtin_bit_cast(bf16x8, pk[2]), vfr[4], o[0], 0, 0, 0); if (VAR != 2) { c0[8] = __builtin_amdgcn_exp2f(c0[8]); c0[9] = __builtin_amdgcn_exp2f(c0[9]); } if (VAR != 2) { sa += c0[6]; sa += c0[7]; } if (VAR != 2) { pk[0].x = cvtpk(c0[0], c0[1]); pk[0].y = cvtpk(c0[2], c0[3]); } ATT_VLOAD(6); ATT_PIN(c0); ATT_PIN(pk[0]); ATT_PIN(sa); ATT_SBAR();
      if (VAR != 4) o[1] = __builtin_amdgcn_mfma_f32_32x32x16_bf16(__builtin_bit_cast(bf16x8, pk[2]), vfr[5], o[1], 0, 0, 0); if (VAR != 2) { c0[10] = __builtin_amdgcn_exp2f(c0[10]); c0[11] = __builtin_amdgcn_exp2f(c0[11]); } if (VAR != 2) { sa += c0[8]; sa += c0[9]; } if (VAR != 2) { pk[0].z = cvtpk(c0[4], c0[5]); pk[0].w = cvtpk(c0[6], c0[7]); } ATT_VLOAD(7); ATT_PIN(c0); ATT_PIN(pk[0]); ATT_PIN(sa); ATT_SBAR();
      if (VAR != 4) o[0] = __builtin_amdgcn_mfma_f32_32x32x16_bf16(__builtin_bit_cast(bf16x8, pk[3]), vfr[6], o[0], 0, 0, 0); if (VAR != 2) { c0[12] = __builtin_amdgcn_exp2f(c0[12]); c0[13] = __builtin_amdgcn_exp2f(c0[13]); } if (VAR != 2) { sa += c0[10]; sa += c0[11]; } ATT_KLOAD(0); ATT_PIN(c0); ATT_PIN(sa); ATT_SBAR();
      if (VAR != 4) o[1] = __builtin_amdgcn_mfma_f32_32x32x16_bf16(__builtin_bit_cast(bf16x8, pk[3]), vfr[7], o[1], 0, 0, 0); if (VAR != 2) { c0[14] = __builtin_amdgcn_exp2f(c0[14]); c0[15] = __builtin_amdgcn_exp2f(c0[15]); } if (VAR != 2) { sa += c0[12]; sa += c0[13]; } ATT_KLOAD(1); ATT_PIN(c0); ATT_PIN(sa); ATT_SBAR();
      if (QK && VAR != 4) n0 = __builtin_amdgcn_mfma_f32_32x32x16_bf16(kfr[0], qr[0], zero16, 0, 0, 0); if (VAR != 2) { c1[0] = __builtin_amdgcn_exp2f(c1[0]); c1[1] = __builtin_amdgcn_exp2f(c1[1]); } if (VAR != 2) { sa += c0[14]; sa += c0[15]; } if (VAR != 2) { pk[1].x = cvtpk(c0[8], c0[9]); pk[1].y = cvtpk(c0[10], c0[11]); } ATT_KLOAD(2); ATT_PIN(c1); ATT_PIN(pk[1]); ATT_PIN(sa); ATT_SBAR();
      if (QK && VAR != 4) n1 = __builtin_amdgcn_mfma_f32_32x32x16_bf16(kfr[1], qr[0], zero16, 0, 0, 0); if (VAR != 2) { c1[2] = __builtin_amdgcn_exp2f(c1[2]); c1[3] = __builtin_amdgcn_exp2f(c1[3]); } if (VAR != 2) { sb += c1[0]; sb += c1[1]; } if (VAR != 2) { pk[1].z = cvtpk(c0[12], c0[13]); pk[1].w = cvtpk(c0[14], c0[15]); } ATT_KLOAD(3); ATT_PIN(c1); ATT_PIN(pk[1]); ATT_PIN(sb); ATT_SBAR();
      if (QK && VAR != 4) n0 = __builtin_amdgcn_mfma_f32_32x32x16_bf16(kfr[2], qr[1], n0, 0, 0, 0); if (VAR != 2) { c1[4] = __builtin_amdgcn_exp2f(c1[4]); c1[5] = __builtin_amdgcn_exp2f(c1[5]); } if (VAR != 2) { sb += c1[2]; sb += c1[3]; } ATT_KLOAD(4); ATT_PIN(c1); ATT_PIN(sb); ATT_SBAR();
      if (QK && VAR != 4) n1 = __builtin_amdgcn_mfma_f32_32x32x16_bf16(kfr[3], qr[1], n1, 0, 0, 0); if (VAR != 2) { c1[6] = __builtin_amdgcn_exp2f(c1[6]); c1[7] = __builtin_amdgcn_exp2f(c1[7]); } if (VAR != 2) { sb += c1[4]; sb += c1[5]; } ATT_KLOAD(5); ATT_PIN(c1); ATT_PIN(sb); ATT_SBAR();
      if (QK && VAR != 4) n0 = __builtin_amdgcn_mfma_f32_32x32x16_bf16(kfr[4], qr[2], n0, 0, 0, 0); if (VAR != 2) { c1[8] = __builtin_amdgcn_exp2f(c1[8]); c1[9] = __builtin_amdgcn_exp2f(c1[9]); } if (VAR != 2) { sb += c1[6]; sb += c1[7]; } if (VAR != 2) { pk[2].x = cvtpk(c1[0], c1[1]); pk[2].y = cvtpk(c1[2], c1[3]); } ATT_KLOAD(6); ATT_PIN(c1); ATT_PIN(pk[2]); ATT_PIN(sb); ATT_SBAR();
      if (QK && VAR != 4) n1 = __builtin_amdgcn_mfma_f32_32x32x16_bf16(kfr[5], qr[2], n1, 0, 0, 0); if (VAR != 2) { c1[10] = __builtin_amdgcn_exp2f(c1[10]); c1[11] = __builtin_amdgcn_exp2f(c1[11]); } if (VAR != 2) { sb += c1[8]; sb += c1[9]; } if (VAR != 2) { pk[2].z = cvtpk(c1[4], c1[5]); pk[2].w = cvtpk(c1[6], c1[7]); } ATT_KLOAD(7); ATT_PIN(c1); ATT_PIN(pk[2]); ATT_PIN(sb); ATT_SBAR();
      if (QK && VAR != 4) n0 = __builtin_amdgcn_mfma_f32_32x32x16_bf16(kfr[6], qr[3], n0, 0, 0, 0); if (VAR != 2) { c1[12] = __builtin_amdgcn_exp2f(c1[12]); c1[13] = __builtin_amdgcn_exp2f(c1[13]); } if (VAR != 2) { sb += c1[10]; sb += c1[11]; } ATT_KLOAD(8); ATT_PIN(c1); ATT_PIN(sb); ATT_SBAR();
      if (QK && VAR != 4) n1 = __builtin_amdgcn_mfma_f32_32x32x16_bf16(kfr[7], qr[3], n1, 0, 0, 0); if (VAR != 2) { c1[14] = __builtin_amdgcn_exp2f(c1[14]); c1[15] = __builtin_amdgcn_exp2f(c1[15]); } if (VAR != 2) { sb += c1[12]; sb += c1[13]; } ATT_KLOAD(9); ATT_PIN(c1); ATT_PIN(sb); ATT_SBAR();
      if (QK && VAR != 4) n0 = __builtin_amdgcn_mfma_f32_32x32x16_bf16(kfr[8], qr[4], n0, 0, 0, 0); if (VAR != 2) { sb += c1[14]; sb += c1[15]; } if (VAR != 2) { pk[3].x = cvtpk(c1[8], c1[9]); pk[3].y = cvtpk(c1[10], c1[11]); } ATT_KLOAD(10); ATT_PIN(pk[3]); ATT_PIN(sb); ATT_SBAR();
      if (QK && VAR != 4) n1 = __builtin_amdgcn_mfma_f32_32x32x16_bf16(kfr[9], qr[4], n1, 0, 0, 0); if (VAR != 2) { pk[3].z = cvtpk(c1[12], c1[13]); pk[3].w = cvtpk(c1[14], c1[15]); } ATT_KLOAD(11); ATT_PIN(pk[3]); ATT_SBAR();
      if (QK && VAR != 4) n0 = __builtin_amdgcn_mfma_f32_32x32x16_bf16(kfr[10], qr[5], n0, 0, 0, 0); ATT_SBAR();
      if (QK && VAR != 4) n1 = __builtin_amdgcn_mfma_f32_32x32x16_bf16(kfr[11], qr[5], n1, 0, 0, 0); ATT_SBAR();
    l_reg += sa + sb;
}
#undef ATT_VLOAD
#undef ATT_KLOAD

template <int VAR = 0>
__device__ __forceinline__ void attn_unit(int b, int h, int qb, const bf16* Q, const bf16* K, const bf16* V, bf16* O, ALAS unsigned char* shm, int OPR = OP) {
    int tid_ = threadIdx.x; asm volatile("" : "+v"(tid_));
    const int tid = tid_, lane = tid & 63, r32 = lane & 31, hi = lane >> 5; const int wid = __builtin_amdgcn_readfirstlane(tid >> 6);
    const long rowbase = (long)b * SEQ; const int q0 = qb * QB;
    const bf16* Qw = Q + (rowbase + q0 + wid * QBLK) * QP + h * QHS;
    const bf16* Kh = K + rowbase * KP + h * KHS; const bf16* Vh = V + rowbase * VP + h * VHS;
    ALAS float* wsf = (ALAS float*)(shm + L_WS) + wid * 64;
    const bf16* ksrc = Kh + (long)lane * KP + wid * 8;
    const bf16* vsrc = Vh + (long)(16 * (wid & 3) + (lane >> 2)) * VP + (wid >> 2) * 32 + (lane & 3) * 8;
#define ATT_DMA_K(t, slot) do { \
        __builtin_amdgcn_global_load_lds((const unsigned*)(ksrc + (long)(t) * KVBLK * KP), (ALAS unsigned*)(shm + L_K + (slot) * KSLOT + wid * 1024), 16, 0, 0); \
        if (wid < 4) __builtin_amdgcn_global_load_lds((const unsigned*)(ksrc + (long)(t) * KVBLK * KP + 64), (ALAS unsigned*)(shm + L_K + (slot) * KSLOT + (8 + wid) * 1024), 16, 0, 0); } while (0)
#define ATT_DMA_V(t, slotoff) __builtin_amdgcn_global_load_lds((const unsigned*)(vsrc + (long)(t) * KVBLK * VP), (ALAS unsigned*)(shm + L_V + (slotoff) + wid * 1024), 16, 0, 0)
    const int NT = (q0 + QB) / KVBLK;
    ATT_DMA_K(0, 0); ATT_DMA_V(0, 0); ATT_DMA_K(1, 1);
    bf16x8 qr[6];
#pragma unroll
    for (int d0 = 0; d0 < 6; ++d0) qr[d0] = *(const bf16x8*)(Qw + (long)r32 * QP + d0 * 16 + hi * 8);
    float l_reg = 0.f; f32x16 o[2];
#pragma unroll
    for (int r = 0; r < 16; ++r) { o[0][r] = 0.f; o[1][r] = 0.f; }
    const int qrel = wid * QBLK + r32;
    const ALAS unsigned char* kb0 = shm + L_K + hi * 1024 + r32 * 16;
    const ALAS unsigned char* vp0 = shm + L_V + ((lane >> 4) & 1) * 32 + (lane & 3) * 8 + (4 * hi + ((lane & 15) >> 2)) * 64;
    asm volatile("s_waitcnt vmcnt(0)" ::: "memory"); __syncthreads();
    f32x16 sA0, sA1, sB0, sB1;
    qkt(sA0, sA1, kb0, qr);
    u32x4 pk[4] = {};
    int vs_prev = 0, vs_cur = 0, vs_next = VSLOT;
#define ATT_TOP(t) do { if (VAR == 3) break; asm volatile("s_waitcnt vmcnt(0)" ::: "memory"); __syncthreads();        \
        if ((t) + 2 < NT) ATT_DMA_K((t) + 2, (t) & 1); if ((t) + 1 < NT) ATT_DMA_V((t) + 1, vs_next); } while (0)
#define ATT_ROT() do { vs_prev = vs_cur; vs_cur = vs_next; vs_next = (vs_next == 2 * VSLOT) ? 0 : vs_next + VSLOT; } while (0)
    int t = 0;
    for (; t < NT - 2; t += 2) {
        ATT_TOP(t);
        attn_step<true, VAR>(sA0, sA1, sB0, sB1, pk, o, l_reg, qr, kb0 + KSLOT, vp0 + vs_prev, t - (NT - 4), qrel, hi);
        ATT_ROT();
        ATT_TOP(t + 1);
        attn_step<true, VAR>(sB0, sB1, sA0, sA1, pk, o, l_reg, qr, kb0, vp0 + vs_prev, t + 1 - (NT - 4), qrel, hi);
        ATT_ROT();
    }
    ATT_TOP(t);
    attn_step<true, VAR>(sA0, sA1, sB0, sB1, pk, o, l_reg, qr, kb0 + KSLOT, vp0 + vs_prev, 2, qrel, hi);
    ATT_ROT();
    ATT_TOP(t + 1);
    attn_step<false, VAR>(sB0, sB1, sA0, sA1, pk, o, l_reg, qr, kb0, vp0 + vs_prev, 3, qrel, hi);
    ATT_ROT();
    pv(o, vp0 + vs_prev, pk);
    l_reg = pswap_sum(l_reg);
    if (hi == 0) wsf[32 + r32] = l_reg;
    float rli[16];
#pragma unroll
    for (int r = 0; r < 16; ++r) rli[r] = __builtin_amdgcn_rcpf(wsf[32 + crow(r, hi)]);
    bf16* Ow = O + (rowbase + q0 + wid * QBLK) * OPR + h * OHS;
    { ALAS bf16* stg = (ALAS bf16*)(shm + L_OST) + wid * 2048;
#pragma unroll
      for (int r = 0; r < 16; ++r) { const int orow = crow(r, hi);
#pragma unroll
          for (int d0 = 0; d0 < 2; ++d0) { const float v = o[d0][r] * rli[r]; unsigned u = __float_as_uint(v); u = (u + 0x7fffu + ((u >> 16) & 1u)) >> 16; stg[orow * 64 + d0 * 32 + r32] = (bf16)u; } }
#pragma unroll
      for (int i = 0; i < 4; ++i) { const int row = i * 8 + (lane >> 3), ch = lane & 7; const u32x4 v = *(const ALAS u32x4*)(stg + row * 64 + ch * 8); *(u32x4*)(Ow + (long)row * OPR + ch * 8) = v; } }
    __syncthreads();
#undef ATT_DMA_K
#undef ATT_DMA_V
#undef ATT_TOP
#undef ATT_ROT
}
#undef ALAS
}

namespace att2 {
#define ALAS __attribute__((address_space(3)))
using att::bf16; using att::bf16x8; using att::s16x4; using att::f32x16; using att::u32x4; using att::crow; using att::cvtpk; using att::pswap_sum; using att::vtr;
constexpr int SEQ = 16384, QP = 768, KP = 768, VP = 512, OP = 1024, QHS = 96, KHS = 96, VHS = 64, OHS = 64;
constexpr int NW = 8, QB = 512, KVBLK = 64, NQB = SEQ / QB;
constexpr int KSLOT = 12288, VSLOT = 8192;
constexpr int L_K = 0, L_V = 2 * KSLOT, L_WS = L_V + 2 * VSLOT, L_OST = L_WS + NW * 64 * 4, L_BYTES = L_OST + NW * 4096;
__device__ __forceinline__ void softmax_pack(f32x16& p0, f32x16& p1, u32x4 (&pk)[4], float& l_reg) {
    float sa = 0.f, sb = 0.f;
#pragma unroll
    for (int r = 0; r < 16; ++r) { p0[r] = __builtin_amdgcn_exp2f(p0[r]); p1[r] = __builtin_amdgcn_exp2f(p1[r]); sa += p0[r]; sb += p1[r]; }
    l_reg += sa + sb;
#pragma unroll
    for (int k = 0; k < 2; ++k) { pk[k] = (u32x4){cvtpk(p0[8 * k], p0[8 * k + 1]), cvtpk(p0[8 * k + 2], p0[8 * k + 3]), cvtpk(p0[8 * k + 4], p0[8 * k + 5]), cvtpk(p0[8 * k + 6], p0[8 * k + 7])};
        pk[2 + k] = (u32x4){cvtpk(p1[8 * k], p1[8 * k + 1]), cvtpk(p1[8 * k + 2], p1[8 * k + 3]), cvtpk(p1[8 * k + 4], p1[8 * k + 5]), cvtpk(p1[8 * k + 6], p1[8 * k + 7])}; }
}
__device__ __forceinline__ void attn_unit(int b, int h, int qb, const bf16* Q, const bf16* K, const bf16* V, bf16* O, ALAS unsigned char* shm) {
    int tid_ = threadIdx.x; asm volatile("" : "+v"(tid_));
    const int tid = tid_, lane = tid & 63, r32 = lane & 31, hi = lane >> 5; const int wid = __builtin_amdgcn_readfirstlane(tid >> 6);
    const long rowbase = (long)b * SEQ; const int q0 = qb * QB;
    const bf16* Qw = Q + (rowbase + q0 + wid * 64) * QP + h * QHS;
    const bf16* Kh = K + rowbase * KP + h * KHS; const bf16* Vh = V + rowbase * VP + h * VHS;
    ALAS float* wsf = (ALAS float*)(shm + L_WS) + wid * 64;
    const bf16* ksrc = Kh + (long)lane * KP + wid * 8;
    const bf16* vsrc = Vh + (long)(16 * (wid & 3) + (lane >> 2)) * VP + (wid >> 2) * 32 + (lane & 3) * 8;
#define ATT_DMA(t, slot) do { \
        __builtin_amdgcn_global_load_lds((const unsigned*)(ksrc + (long)(t) * KVBLK * KP), (ALAS unsigned*)(shm + L_K + (slot) * KSLOT + wid * 1024), 16, 0, 0); \
        if (wid < 4) __builtin_amdgcn_global_load_lds((const unsigned*)(ksrc + (long)(t) * KVBLK * KP + 64), (ALAS unsigned*)(shm + L_K + (slot) * KSLOT + (8 + wid) * 1024), 16, 0, 0); \
        __builtin_amdgcn_global_load_lds((const unsigned*)(vsrc + (long)(t) * KVBLK * VP), (ALAS unsigned*)(shm + L_V + (slot) * VSLOT + wid * 1024), 16, 0, 0); } while (0)
    const int NT = (q0 + QB) / KVBLK;
    ATT_DMA(0, 0);
    bf16x8 qa[6], qb_[6];
#pragma unroll
    for (int d0 = 0; d0 < 6; ++d0) { qa[d0] = *(const bf16x8*)(Qw + (long)r32 * QP + d0 * 16 + hi * 8); qb_[d0] = *(const bf16x8*)(Qw + (long)(32 + r32) * QP + d0 * 16 + hi * 8); }
    float la = 0.f, lb = 0.f; f32x16 oa[2], ob[2];
#pragma unroll
    for (int r = 0; r < 16; ++r) { oa[0][r] = 0.f; oa[1][r] = 0.f; ob[0][r] = 0.f; ob[1][r] = 0.f; }
    const ALAS unsigned char* kb0 = shm + L_K + hi * 1024 + r32 * 16;
    const ALAS unsigned char* vp0 = shm + L_V + ((lane >> 4) & 1) * 32 + (lane & 3) * 8 + (4 * hi + ((lane & 15) >> 2)) * 64;
    for (int t = 0; t < NT; ++t) {
        const int cur = t & 1;
        asm volatile("s_waitcnt vmcnt(0)" ::: "memory"); __syncthreads();
        if (t + 1 < NT) ATT_DMA(t + 1, cur ^ 1);
        const int jb = t - (NT - 8);
        if (jb > wid) continue;
        f32x16 pa0, pa1, pb0, pb1; const f32x16 z16 = {};
        { const ALAS unsigned char* kb = kb0 + cur * KSLOT;
#pragma unroll
          for (int d0 = 0; d0 < 6; ++d0) {
              const bf16x8 k0 = *(const ALAS bf16x8*)(kb + d0 * 2048), k1 = *(const ALAS bf16x8*)(kb + d0 * 2048 + 512);
              pa0 = __builtin_amdgcn_mfma_f32_32x32x16_bf16(k0, qa[d0], d0 == 0 ? z16 : pa0, 0, 0, 0); pa1 = __builtin_amdgcn_mfma_f32_32x32x16_bf16(k1, qa[d0], d0 == 0 ? z16 : pa1, 0, 0, 0);
              pb0 = __builtin_amdgcn_mfma_f32_32x32x16_bf16(k0, qb_[d0], d0 == 0 ? z16 : pb0, 0, 0, 0); pb1 = __builtin_amdgcn_mfma_f32_32x32x16_bf16(k1, qb_[d0], d0 == 0 ? z16 : pb1, 0, 0, 0); } }
        if (jb == wid) {
#pragma unroll
            for (int r = 0; r < 16; ++r) { const int kv = 4 * hi + (r & 3) + 8 * (r >> 2);
                if (kv > r32) pa0[r] = -__builtin_inff();
                pa1[r] = -__builtin_inff();
                if (kv > r32) pb1[r] = -__builtin_inff(); }
        }
        u32x4 pka[4], pkb[4];
        softmax_pack(pa0, pa1, pka, la); softmax_pack(pb0, pb1, pkb, lb);
        { const ALAS unsigned char* vp = vp0 + cur * VSLOT;
#pragma unroll
          for (int ks = 0; ks < 4; ++ks)
#pragma unroll
              for (int d0 = 0; d0 < 2; ++d0) { const s16x4 lo = vtr(vp + d0 * 4096 + ks * 1024), hh = vtr(vp + d0 * 4096 + ks * 1024 + 512);
                  const bf16x8 vf = (bf16x8){lo[0], lo[1], lo[2], lo[3], hh[0], hh[1], hh[2], hh[3]};
                  oa[d0] = __builtin_amdgcn_mfma_f32_32x32x16_bf16(__builtin_bit_cast(bf16x8, pka[ks]), vf, oa[d0], 0, 0, 0);
                  ob[d0] = __builtin_amdgcn_mfma_f32_32x32x16_bf16(__builtin_bit_cast(bf16x8, pkb[ks]), vf, ob[d0], 0, 0, 0); } }
    }
#pragma unroll
    for (int blk = 0; blk < 2; ++blk) {
        float l_reg = pswap_sum(blk == 0 ? la : lb);
        if (hi == 0) wsf[32 + r32] = l_reg;
        float rli[16];
#pragma unroll
        for (int r = 0; r < 16; ++r) rli[r] = __builtin_amdgcn_rcpf(wsf[32 + crow(r, hi)]);
        bf16* Ow = O + (rowbase + q0 + wid * 64 + blk * 32) * OP + h * OHS;
        ALAS bf16* stg = (ALAS bf16*)(shm + L_OST) + wid * 2048;
#pragma unroll
        for (int r = 0; r < 16; ++r) { const int orow = crow(r, hi);
#pragma unroll
            for (int d0 = 0; d0 < 2; ++d0) { const float v = (blk == 0 ? oa[d0][r] : ob[d0][r]) * rli[r]; unsigned u = __float_as_uint(v); u = (u + 0x7fffu + ((u >> 16) & 1u)) >> 16; stg[orow * 64 + d0 * 32 + r32] = (bf16)u; } }
#pragma unroll
        for (int i = 0; i < 4; ++i) { const int row = i * 8 + (lane >> 3), ch = lane & 7; const u32x4 v = *(const ALAS u32x4*)(stg + row * 64 + ch * 8); *(u32x4*)(Ow + (long)row * OP + ch * 8) = v; }
    }
    __syncthreads();
#undef ATT_DMA
}
#undef ALAS
}

namespace att3 {
#define ALAS __attribute__((address_space(3)))
using att::bf16; using att::bf16x8; using att::s16x4; using att::f32x16; using att::u32x4; using att::crow; using att::cvtpk; using att::pswap_sum; using att::vtr;
using att2::softmax_pack;
constexpr int SEQ = 16384, QP = 768, KP = 768, VP = 512, OP = 1024, QHS = 96, KHS = 96, VHS = 64, OHS = 64;
constexpr int NW = 8, QB = 512, KVBLK = 64;
constexpr int KSLOT = 12288, VSLOT = 8192;
constexpr int L_K = 0, L_V = 2 * KSLOT, L_WS = L_V + 2 * VSLOT, L_OST = L_WS + NW * 64 * 4, L_BYTES = L_OST + NW * 4096;
__device__ __forceinline__ void attn_unit(int b, int h, int qb, const bf16* Q, const bf16* K, const bf16* V, bf16* O, ALAS unsigned char* shm) {
    int tid_ = threadIdx.x; asm volatile("" : "+v"(tid_));
    const int tid = tid_, lane = tid & 63, r32 = lane & 31, hi = lane >> 5; const int wid = __builtin_amdgcn_readfirstlane(tid >> 6);
    const long rowbase = (long)b * SEQ; const int q0 = qb * QB;
    const bf16* Qw = Q + (rowbase + q0 + wid * 64) * QP + h * QHS;
    const bf16* Kh = K + rowbase * KP + h * KHS; const bf16* Vh = V + rowbase * VP + h * VHS;
    ALAS float* wsf = (ALAS float*)(shm + L_WS) + wid * 64;
    const unsigned lds0 = (unsigned)(uintptr_t)shm;
    const bf16* ksrc = Kh + (long)lane * KP + wid * 8;
    const int kdelta = (8 + (wid & 3) - wid) * 8;
    const bf16* vsrc = Vh + (long)(16 * (wid & 3) + (lane >> 2)) * VP + (wid >> 2) * 32 + (lane & 3) * 8;
#define GLDS16(gsrc, ldsdst) do { unsigned keep_; asm volatile("s_mov_b32 %0, m0\n\ts_mov_b32 m0, %2\n\ts_nop 0\n\tglobal_load_lds_dwordx4 %1, off\n\ts_mov_b32 m0, %0" : "=&s"(keep_) : "v"(gsrc), "s"(ldsdst) : "memory"); } while (0)
#define DMA_K(t, slot) do { GLDS16(ksrc + (long)(t) * KVBLK * KP, (unsigned)__builtin_amdgcn_readfirstlane(lds0 + L_K + (slot) * KSLOT + wid * 1024)); \
        GLDS16(ksrc + ((long)(t) * KVBLK * KP + kdelta), (unsigned)__builtin_amdgcn_readfirstlane(lds0 + L_K + (slot) * KSLOT + (8 + (wid & 3)) * 1024)); } while (0)
#define DMA_V(t, slot) GLDS16(vsrc + (long)(t) * KVBLK * VP, (unsigned)__builtin_amdgcn_readfirstlane(lds0 + L_V + (slot) * VSLOT + wid * 1024))
#define BAR_W(n) do { asm volatile("s_waitcnt vmcnt(" #n ") lgkmcnt(0)" ::: "memory"); __builtin_amdgcn_s_barrier(); asm volatile("" ::: "memory"); } while (0)
#define BAR1(t) do { if ((t) < NT) BAR_W(1); else BAR_W(0); if ((t) + 1 < NT) DMA_K((t) + 1, ((t) + 1) & 1); } while (0)
#define BAR2(t) do { if ((t) + 1 < NT) BAR_W(2); else BAR_W(0); if ((t) + 1 < NT) DMA_V((t) + 1, ((t) + 1) & 1); } while (0)
    const int NT = (q0 + QB) / KVBLK;
    DMA_K(0, 0); DMA_V(0, 0);
    bf16x8 qa[6], qb_[6];
#pragma unroll
    for (int d0 = 0; d0 < 6; ++d0) { qa[d0] = *(const bf16x8*)(Qw + (long)r32 * QP + d0 * 16 + hi * 8); qb_[d0] = *(const bf16x8*)(Qw + (long)(32 + r32) * QP + d0 * 16 + hi * 8); }
    asm volatile("s_waitcnt vmcnt(0)" ::: "memory");
    float la = 0.f, lb = 0.f; f32x16 oa[2], ob[2];
#pragma unroll
    for (int r = 0; r < 16; ++r) { oa[0][r] = 0.f; oa[1][r] = 0.f; ob[0][r] = 0.f; ob[1][r] = 0.f; }
    const ALAS unsigned char* kb0 = shm + L_K + hi * 1024 + r32 * 16;
    const ALAS unsigned char* vp0 = shm + L_V + ((lane >> 4) & 1) * 32 + (lane & 3) * 8 + (4 * hi + ((lane & 15) >> 2)) * 64;
    f32x16 pa0, pa1, pb0, pb1;
#define ALPHA(t) do { if ((t) - (NT - 8) <= wid) { const ALAS unsigned char* kb = kb0 + ((t) & 1) * KSLOT; const f32x16 z16 = {}; \
        bf16x8 k0n = *(const ALAS bf16x8*)(kb), k1n = *(const ALAS bf16x8*)(kb + 512); \
        _Pragma("unroll") for (int d0 = 0; d0 < 6; ++d0) { const bf16x8 k0 = k0n, k1 = k1n; \
            if (d0 < 5) { k0n = *(const ALAS bf16x8*)(kb + (d0 + 1) * 2048); k1n = *(const ALAS bf16x8*)(kb + (d0 + 1) * 2048 + 512); }     \
            pa0 = __builtin_amdgcn_mfma_f32_32x32x16_bf16(k0, qa[d0], d0 == 0 ? z16 : pa0, 0, 0, 0); pa1 = __builtin_amdgcn_mfma_f32_32x32x16_bf16(k1, qa[d0], d0 == 0 ? z16 : pa1, 0, 0, 0); \
            pb0 = __builtin_amdgcn_mfma_f32_32x32x16_bf16(k0, qb_[d0], d0 == 0 ? z16 : pb0, 0, 0, 0); pb1 = __builtin_amdgcn_mfma_f32_32x32x16_bf16(k1, qb_[d0], d0 == 0 ? z16 : pb1, 0, 0, 0); \
            __builtin_amdgcn_sched_barrier(0); } } } while (0)
#define BETA(t) do { const int jb_ = (t) - (NT - 8); if (jb_ <= wid) { \
        if (jb_ == wid) { _Pragma("unroll") for (int r = 0; r < 16; ++r) { const int kv = 4 * hi + (r & 3) + 8 * (r >> 2); \
            if (kv > r32) pa0[r] = -__builtin_inff(); pa1[r] = -__builtin_inff(); if (kv > r32) pb1[r] = -__builtin_inff(); } } \
        u32x4 pka[4], pkb[4]; softmax_pack(pa0, pa1, pka, la); softmax_pack(pb0, pb1, pkb, lb); \
        const ALAS unsigned char* vp = vp0 + ((t) & 1) * VSLOT; \
        _Pragma("unroll") for (int i_ = 0; i_ < 8; ++i_) { const int ks = i_ >> 1, d0 = i_ & 1; \
            const s16x4 lo = vtr(vp + d0 * 4096 + ks * 1024), hh = vtr(vp + d0 * 4096 + ks * 1024 + 512); \
            const bf16x8 vf = (bf16x8){lo[0], lo[1], lo[2], lo[3], hh[0], hh[1], hh[2], hh[3]}; \
            oa[d0] = __builtin_amdgcn_mfma_f32_32x32x16_bf16(__builtin_bit_cast(bf16x8, pka[ks]), vf, oa[d0], 0, 0, 0); \
            ob[d0] = __builtin_amdgcn_mfma_f32_32x32x16_bf16(__builtin_bit_cast(bf16x8, pkb[ks]), vf, ob[d0], 0, 0, 0); \
            __builtin_amdgcn_sched_barrier(0); } } } while (0)
    if (wid < 4) {
        for (int t = 0; t < NT; ++t) { BAR1(t); ALPHA(t); BAR2(t); BETA(t); }
        BAR1(NT); BAR2(NT);
    } else {
        BAR1(0); BAR2(0); ALPHA(0);
        for (int t = 1; t < NT; ++t) { BAR1(t); BETA(t - 1); BAR2(t); ALPHA(t); }
        BAR1(NT); BETA(NT - 1); BAR2(NT);
    }
#pragma unroll
    for (int blk = 0; blk < 2; ++blk) {
        float l_reg = pswap_sum(blk == 0 ? la : lb);
        if (hi == 0) wsf[32 + r32] = l_reg;
        float rli[16];
#pragma unroll
        for (int r = 0; r < 16; ++r) rli[r] = __builtin_amdgcn_rcpf(wsf[32 + crow(r, hi)]);
        bf16* Ow = O + (rowbase + q0 + wid * 64 + blk * 32) * OP + h * OHS;
        ALAS bf16* stg = (ALAS bf16*)(shm + L_OST) + wid * 2048;
#pragma unroll
        for (int r = 0; r < 16; ++r) { const int orow = crow(r, hi);
#pragma unroll
            for (int d0 = 0; d0 < 2; ++d0) { const float v = (blk == 0 ? oa[d0][r] : ob[d0][r]) * rli[r]; unsigned u = __float_as_uint(v); u = (u + 0x7fffu + ((u >> 16) & 1u)) >> 16; stg[orow * 64 + d0 * 32 + r32] = (bf16)u; } }
#pragma unroll
        for (int i = 0; i < 4; ++i) { const int row = i * 8 + (lane >> 3), ch = lane & 7; const u32x4 v = *(const ALAS u32x4*)(stg + row * 64 + ch * 8); *(u32x4*)(Ow + (long)row * OP + ch * 8) = v; }
    }
    asm volatile("s_waitcnt vmcnt(0) lgkmcnt(0)" ::: "memory"); __syncthreads();
#undef GLDS16
#undef DMA_K
#undef DMA_V
#undef BAR_W
#undef BAR1
#undef BAR2
#undef ALPHA
#undef BETA
}
#undef ALAS
}

constexpr int NB = 2, SEQ = 16384, D = 1024, NTOK = NB * SEQ, DEPTH = 4;
constexpr int INCOLS = 1440, INP = 1536;
constexpr int UPK = 384, UPN = 1792;
constexpr int LRUW = 512;
constexpr int DFF = 2816, NEXP = 8, DFE = 3584;
constexpr int MOE_TILES = (2 * NTOK) / 256 + NEXP;
constexpr float EPS = 1e-6f;
constexpr int NWAVES = 8;

constexpr size_t MiB = 1u << 20;
constexpr size_t WS_CTL = 0, CTL_ZERO_BYTES = 1 * MiB;
constexpr size_t WS_MREF = 6 * MiB + 64 * 1024;
constexpr size_t WS_RSC = 10 * MiB;
constexpr size_t WS_MODP = 1 * MiB;
constexpr size_t WS_MOD = 1 * MiB + 768 * 1024;
constexpr size_t WS_COS = 2 * MiB, WS_SIN = 4 * MiB;
constexpr size_t WS_LAMC = 6 * MiB;
constexpr size_t WS_TOKE = 7 * MiB, WS_TOKR = WS_TOKE + 256 * 1024, WS_TOKW = WS_TOKR + 256 * 1024, WS_TOKP = WS_TOKW + 256 * 1024;
constexpr size_t WS_RTE = 8 * MiB;
constexpr size_t WS_PL = 9 * MiB, WS_HC = 9 * MiB + 512 * 1024;
constexpr size_t WS_WSMALL = 16 * MiB, WSMALL_STRIDE = 8 * MiB;
constexpr size_t WS_WDENSE = 48 * MiB, WDENSE_STRIDE = 17 * MiB;
constexpr size_t WS_WMOE_GU = 82 * MiB, WS_WMOE_D = 194 * MiB;
constexpr size_t WS_H = 250 * MiB;
constexpr size_t WS_Z = 314 * MiB, WS_A2 = 410 * MiB, WS_XR = 866 * MiB, WS_QKV = 466 * MiB, WS_Q = 578 * MiB, WS_K = 626 * MiB, WS_LA = 674 * MiB, WS_XB = 738 * MiB, WS_Y = 802 * MiB;
constexpr size_t WS_HID = 314 * MiB;
constexpr size_t WS_HS = 314 * MiB, WS_Y2 = 314 * MiB, WS_MHID = 446 * MiB;
constexpr size_t WS_END = 908 * MiB;
static_assert(WS_MHID + (size_t)MOE_TILES * 256 * DFE <= WS_XB && WS_LA + (size_t)NTOK * 512 * 4 <= WS_XB && WS_XB + (size_t)NTOK * D * 2 <= WS_Y, "residual stream map");
static_assert(WS_MHID + (size_t)MOE_TILES * 256 * DFE * 2 <= WS_END && WS_HS + (size_t)MOE_TILES * 256 * D * 2 <= WS_MHID && WS_Y2 >= WS_H + (size_t)NTOK * D * 2, "MoE map");
static_assert(WS_HID + (size_t)NTOK * DFF * 2 <= WS_END && WS_Y + (size_t)NTOK * D * 2 <= WS_END, "map");
constexpr int CW_TMO = 0, CW_CODE = 1, CW_BAR = 4096, CW_GCNT = 8192, CW_WMAX = 12288, CW_AGRP = 16384, CW_SCNT = 24576;

constexpr int RING_BYTES = 131072, LDSCTL_OFF = RING_BYTES, MISC_OFF = LDSCTL_OFF + 320, LDS_BYTES = 147456;

struct Frame {
    LAS unsigned char* lds; volatile LAS unsigned* MISC; gu32* ctl;
    int tid, lane, wave, vcu, G, gw, NGW;
    float* out; unsigned char* ws;
    __device__ __forceinline__ void refresh() { int t = threadIdx.x; asm volatile("" : "+v"(t)); tid = t; lane = t & 63; wave = __builtin_amdgcn_readfirstlane(t >> 6); int v = vcu; asm volatile("" : "+s"(v)); vcu = v; gw = v * 8 + wave; }
};
template <int K> __device__ __forceinline__ const void* in_ptr() {
    unsigned long long p; const __attribute__((address_space(4))) void* ka = (const __attribute__((address_space(4))) void*)__builtin_amdgcn_kernarg_segment_ptr();
    asm volatile("s_load_dwordx2 %0, %1, %2\n\ts_waitcnt lgkmcnt(0)" : "=s"(p) : "s"(ka), "i"(8 * K) : "memory");
    return (const void*)p;
}
#define INF(K) ((const float*)in_ptr<K>())
template <class T> __device__ __forceinline__ T* wsp(const Frame& F, size_t off) { asm volatile("" : "+s"(off)); return (T*)(F.ws + off); }
enum { I_X = 0, I_C, I_POS, I_WADA, I_BADA, I_NGAIN, I_WIN, I_LGAIN, I_WQUP, I_WKVUP, I_QGAIN, I_KGAIN, I_CONVW, I_CONVB, I_WA, I_BA, I_WX, I_BX, I_LAM, I_OGAIN, I_WOUT, I_FWG, I_FWU, I_FWD, I_RW, I_MWG, I_MWU, I_MWD };

template <int K> __device__ __forceinline__ float swz_xor(float v) { return __int_as_float(__builtin_amdgcn_ds_swizzle(__float_as_int(v), (K << 10) | 0x1f)); }
__device__ __forceinline__ float wave_sum(float v) {
    v += swz_xor<1>(v); v += swz_xor<2>(v); v += swz_xor<4>(v); v += swz_xor<8>(v); v += swz_xor<16>(v);
    return att::pswap_sum(v);
}
__device__ __forceinline__ float wave_max(float v) {
    v = __builtin_fmaxf(v, swz_xor<1>(v)); v = __builtin_fmaxf(v, swz_xor<2>(v)); v = __builtin_fmaxf(v, swz_xor<4>(v)); v = __builtin_fmaxf(v, swz_xor<8>(v)); v = __builtin_fmaxf(v, swz_xor<16>(v));
    return att::pswap_max(v);
}
__device__ __forceinline__ float bflo(unsigned w) { return __uint_as_float(w << 16); }
__device__ __forceinline__ float bfhi(unsigned w) { return __uint_as_float(w & 0xffff0000u); }
__device__ __forceinline__ float bf1(bf16 v) { return __uint_as_float((unsigned)v << 16); }

__device__ __forceinline__ void transpose_item(const float* W, int ldw, int k0, int n0, bf16* WT, int ldt, int drow0, int dk0, LAS float* scr, int lane, bool ropemap = false) {
    float rv[32];
#pragma unroll
    for (int i = 0; i < 32; ++i) rv[i] = W[(size_t)(k0 + 2 * i + (lane >> 5)) * ldw + n0 + (lane & 31)];
#pragma unroll
    for (int i = 0; i < 32; ++i) scr[(2 * i + (lane >> 5)) * 33 + (lane & 31)] = rv[i];
    LDS_WAIT(); asm volatile("" ::: "memory");
    const int c = lane & 7;
#pragma unroll
    for (int j = 0; j < 4; ++j) { const int n = (lane >> 3) + 8 * j; const LAS float* s = scr + (8 * c) * 33 + n;
        v4u o; o.x = pk2(s[0 * 33], s[1 * 33]); o.y = pk2(s[2 * 33], s[3 * 33]); o.z = pk2(s[4 * 33], s[5 * 33]); o.w = pk2(s[6 * 33], s[7 * 33]);
        const int nd = ropemap ? 8 * ((n & 15) >> 2) + 4 * (n >> 4) + (n & 3) : n;
        *(GAS v4u*)(WT + (size_t)(drow0 + nd) * ldt + dk0 + k0 + 8 * c) = o; }
    LDS_WAIT(); asm volatile("" ::: "memory");
}
__device__ __forceinline__ void transpose_item_f8(const float* W, int ldw, int k0, int n0, unsigned char* WT, int ldt, int drow0, float sc, LAS float* scr, int lane) {
    float rv[32];
#pragma unroll
    for (int i = 0; i < 32; ++i) rv[i] = W[(size_t)(k0 + 2 * i + (lane >> 5)) * ldw + n0 + (lane & 31)];
#pragma unroll
    for (int i = 0; i < 32; ++i) scr[(2 * i + (lane >> 5)) * 33 + (lane & 31)] = rv[i];
    LDS_WAIT(); asm volatile("" ::: "memory");
    const int c = lane & 3;
#pragma unroll
    for (int j = 0; j < 2; ++j) { const int n = (lane >> 2) + 16 * j; const LAS float* s = scr + (16 * c) * 33 + n;
        v4u o; o.x = pg8::pack4_fp8(s[0 * 33] * sc, s[1 * 33] * sc, s[2 * 33] * sc, s[3 * 33] * sc); o.y = pg8::pack4_fp8(s[4 * 33] * sc, s[5 * 33] * sc, s[6 * 33] * sc, s[7 * 33] * sc);
        o.z = pg8::pack4_fp8(s[8 * 33] * sc, s[9 * 33] * sc, s[10 * 33] * sc, s[11 * 33] * sc); o.w = pg8::pack4_fp8(s[12 * 33] * sc, s[13 * 33] * sc, s[14 * 33] * sc, s[15 * 33] * sc);
        *(GAS v4u*)(WT + (size_t)(drow0 + n) * ldt + k0 + 16 * c) = o; }
    LDS_WAIT(); asm volatile("" ::: "memory");
}
__device__ __forceinline__ void transpose_item_i8(const float* W, int ldw, int k0, int n0, unsigned char* WT, int ldt, int drow0, float sc, LAS float* scr, int lane) {
    float rv[32];
#pragma unroll
    for (int i = 0; i < 32; ++i) rv[i] = W[(size_t)(k0 + 2 * i + (lane >> 5)) * ldw + n0 + (lane & 31)];
#pragma unroll
    for (int i = 0; i < 32; ++i) scr[(2 * i + (lane >> 5)) * 33 + (lane & 31)] = rv[i];
    LDS_WAIT(); asm volatile("" ::: "memory");
    const int c = lane & 3;
#pragma unroll
    for (int j = 0; j < 2; ++j) { const int n = (lane >> 2) + 16 * j; const LAS float* s = scr + (16 * c) * 33 + n;
        v4u o; o.x = pg8::pack4_i8(s[0 * 33] * sc, s[1 * 33] * sc, s[2 * 33] * sc, s[3 * 33] * sc); o.y = pg8::pack4_i8(s[4 * 33] * sc, s[5 * 33] * sc, s[6 * 33] * sc, s[7 * 33] * sc);
        o.z = pg8::pack4_i8(s[8 * 33] * sc, s[9 * 33] * sc, s[10 * 33] * sc, s[11 * 33] * sc); o.w = pg8::pack4_i8(s[12 * 33] * sc, s[13 * 33] * sc, s[14 * 33] * sc, s[15 * 33] * sc);
        *(GAS v4u*)(WT + (size_t)(drow0 + n) * ldt + k0 + 16 * c) = o; }
    LDS_WAIT(); asm volatile("" ::: "memory");
}
constexpr bool DENSE0_BF16 = false;
constexpr float SC_H8 = 8.0f, SC_WGU8 = 64.0f, SC_HID8 = 4.0f, SC_WD8 = 128.0f;
struct CDesc { const float* W; bf16* WT; int K, N, ldt, roff, dk0, map; float f8sc; };
__device__ __forceinline__ void conv_run(Frame& F, const CDesc& d, int gw0, int ngw) {
    LAS float* scr = (LAS float*)(F.lds + F.wave * 16384);
    const int nblk = d.N / 32, items = (d.K / 64) * nblk;
    for (int it = gw0; it < items; it += ngw) { const int kb = it / nblk, nb = it % nblk, n0 = 32 * nb;
        int drow0 = d.map == 0 ? n0 + d.roff : (d.map == 1 ? (n0 >= 416 ? n0 + 96 : n0) : 256 * (n0 / 128) + (n0 % 128) + d.roff); bool rope = false;
        if (d.map == 3) { const int h = n0 / 96, r = n0 - 96 * h;
            if (r < 64) drow0 = 256 * (h >> 2) + 128 * (r >> 5) + 32 * (h & 3); else { drow0 = 512 + 128 * (h >> 2) + 32 * (h & 3); rope = true; } }
        if (d.map == 4) { const int h = n0 / 128, r = n0 - 128 * h;
            drow0 = r < 64 ? 768 + 256 * (h >> 2) + 128 * (r >> 5) + 32 * (h & 3) : 1280 + 64 * h + (r - 64); }
        if (d.f8sc != 0.f) transpose_item_f8(d.W, d.N, 64 * kb, n0, (unsigned char*)d.WT, d.ldt, drow0, d.f8sc, scr, F.lane);
        else transpose_item(d.W, d.N, 64 * kb, n0, d.WT, d.ldt, drow0, d.dk0, scr, F.lane, rope); }
}
__device__ __forceinline__ CDesc conv_desc(Frame& F, int idx, int moe_j) {
    CDesc d;
    if (idx < 16) { const int l = idx >> 2, m = idx & 3; bf16* base = wsp<bf16>(F, WS_WSMALL + (size_t)l * WSMALL_STRIDE);
        if (m == 0)      d = CDesc{INF(I_WIN) + (size_t)l * D * INCOLS, base, D, INCOLS, D, 0, 0, 1, 0.f};
        else if (m == 1) d = CDesc{INF(I_WQUP) + (size_t)l * 256 * 768, base + 3 * MiB / 2, 256, 768, 256, 0, 0, 3, 0.f};
        else if (m == 2) d = CDesc{INF(I_WKVUP) + (size_t)l * 128 * 1024, base + 3 * MiB / 2, 128, 1024, 256, 768, 0, 4, 0.f};
        else             d = CDesc{INF(I_WOUT) + (size_t)l * D * D, base + 6 * MiB / 2, D, D, D, 0, 0, 0, 0.f};
    } else if (idx < 22) { const int j = (idx - 16) / 3, m = (idx - 16) % 3; bf16* base = wsp<bf16>(F, WS_WDENSE + (size_t)j * WDENSE_STRIDE);
        if (m == 0)      d = CDesc{INF(I_FWG) + (size_t)j * D * DFF, base, D, DFF, D, 0, 0, 2, SC_WGU8};
        else if (m == 1) d = CDesc{INF(I_FWU) + (size_t)j * D * DFF, base, D, DFF, D, 128, 0, 2, SC_WGU8};
        else             d = CDesc{INF(I_FWD) + (size_t)j * DFF * D, base + (size_t)11 * MiB / 2, DFF, D, DFF, 0, 0, 0, SC_WD8};
    } else { const int e = (idx - 22) / 3, m = (idx - 22) % 3; const size_t we = (size_t)(moe_j * NEXP + e) * D * DFE;
        if (m == 0)      d = CDesc{INF(I_MWG) + we, (bf16*)(wsp<unsigned char>(F, WS_WMOE_GU) + (size_t)e * 2 * DFE * D), D, DFE, D, 0, 0, 2, SC_WGU8};
        else if (m == 1) d = CDesc{INF(I_MWU) + we, (bf16*)(wsp<unsigned char>(F, WS_WMOE_GU) + (size_t)e * 2 * DFE * D), D, DFE, D, 128, 0, 2, SC_WGU8};
        else             d = CDesc{INF(I_MWD) + we, (bf16*)(wsp<unsigned char>(F, WS_WMOE_D) + (size_t)e * D * DFE), DFE, D, DFE, 0, 0, 0, SC_WD8};
    }
    return d;
}
__device__ __forceinline__ void convert_range(Frame& F, int lo, int hi, int moe_j) {
    F.refresh();
    for (int idx = lo; idx < hi; ++idx) { if ((idx < 16 && (idx & 3) == 0) || idx == 16 || idx == 17 || idx == 19 || idx == 20) continue;
        const CDesc d = conv_desc(F, idx, moe_j); conv_run(F, d, F.gw, F.NGW); }
}
constexpr int MOE_EARLY_E = 6;
__device__ __forceinline__ void convert_moe_early(Frame& F, int rank, int nshare) {
    F.refresh();
    for (int e = 0; e < MOE_EARLY_E; ++e)
        for (int m = 0; m < 2; ++m) { const CDesc d = conv_desc(F, 22 + 3 * e + m, 1); conv_run(F, d, rank * NWAVES + F.wave, nshare * NWAVES); }
}
__device__ __forceinline__ void convert_moe_first(Frame& F) {
    F.refresh();
    for (int idx = 22; idx < 46; ++idx) { const CDesc d = conv_desc(F, idx, 0); conv_run(F, d, F.gw, F.NGW); }
    __syncthreads();
}
__device__ __forceinline__ void convert_moe_late(Frame& F) {
    F.refresh();
    for (int idx = 22; idx < 46; ++idx) { const int e = (idx - 22) / 3, m = (idx - 22) % 3; if (e < MOE_EARLY_E && m < 2) continue;
        const CDesc d = conv_desc(F, idx, 1); conv_run(F, d, F.gw, F.NGW); }
}
__device__ __forceinline__ void zero_block(Frame& F, bf16* WT, int ldt, int r0, int rows, int c0, int cols) {
    const int cpr = cols / 8, n = rows * cpr;
    v4u zz = (v4u){0u, 0u, 0u, 0u}; asm volatile("" : "+v"(zz));
    for (int i = F.gw * 64 + F.lane; i < n; i += F.NGW * 64) { const int r = i / cpr, cc = i % cpr; *(GAS v4u*)(WT + (size_t)(r0 + r) * ldt + c0 + 8 * cc) = zz; }
}
__device__ __forceinline__ float lane_absmax4(const GAS f32x4* W, int n4, int first, int step) {
    float m = 0.f;
    for (int i0 = first; i0 < n4; i0 += 8 * step) { f32x4 v[8];
#pragma unroll
        for (int u = 0; u < 8; ++u) { const int i = i0 + u * step; v[u] = i < n4 ? W[i] : (f32x4){0.f, 0.f, 0.f, 0.f}; }
#pragma unroll
        for (int u = 0; u < 8; ++u) m = __builtin_fmaxf(__builtin_fmaxf(m, __builtin_fmaxf(__builtin_fabsf(v[u].x), __builtin_fabsf(v[u].y))), __builtin_fmaxf(__builtin_fabsf(v[u].z), __builtin_fabsf(v[u].w))); }
    return m;
}
__device__ __forceinline__ void p0_prologue(Frame& F) {
    F.refresh();
    {
      const float* w_ada = INF(I_WADA); const float* cc = INF(I_C); float* modp = wsp<float>(F, WS_MODP);
      for (int task = F.gw; task < 8 * 4 * 48; task += F.NGW) {
        const int jb = task % 48, kq = (task / 48) % 4, ls = task / 192, j = jb * 64 + F.lane;
        const float* W = w_ada + (size_t)ls * D * 3072 + j; float a0 = 0.f, a1 = 0.f;
        for (int k0 = kq * 256; k0 < kq * 256 + 256; k0 += 32) { float wv[32];
#pragma unroll
            for (int i = 0; i < 32; ++i) wv[i] = W[(size_t)(k0 + i) * 3072];
#pragma unroll
            for (int i = 0; i < 32; ++i) { const float c0 = cc[k0 + i], c1 = cc[D + k0 + i]; a0 += c0 * pg8::sigmoidf_(c0) * wv[i]; a1 += c1 * pg8::sigmoidf_(c1) * wv[i]; } }
        modp[((size_t)(kq * 8 + ls) * 2 + 0) * 3072 + j] = a0; modp[((size_t)(kq * 8 + ls) * 2 + 1) * 3072 + j] = a1;
      } }
    {
      const float* w_in = INF(I_WIN);
      for (int l = 0; l < DEPTH; ++l) { float m = lane_absmax4((const GAS f32x4*)(w_in + (size_t)l * D * INCOLS), D * INCOLS / 4, F.gw * 64 + F.lane, F.NGW * 64);
          m = wave_max(m);
          if (F.lane == 0) __hip_atomic_fetch_max((unsigned*)(F.ctl + CW_WMAX + 64 * l), __float_as_uint(m), __ATOMIC_RELAXED, __HIP_MEMORY_SCOPE_AGENT); } }
    for (int j = 0; j < 2; ++j) { float m = 0.f;
      for (int h = 0; h < 2; ++h) m = __builtin_fmaxf(m, lane_absmax4((const GAS f32x4*)((h ? INF(I_FWU) : INF(I_FWG)) + (size_t)j * D * DFF), D * DFF / 4, F.gw * 64 + F.lane, F.NGW * 64));
      m = wave_max(m);
      if (F.lane == 0) __hip_atomic_fetch_max((unsigned*)(F.ctl + CW_WMAX + 64 * (4 + j)), __float_as_uint(m), __ATOMIC_RELAXED, __HIP_MEMORY_SCOPE_AGENT); }
    {
      const int* positions = (const int*)in_ptr<I_POS>(); float* cosT = wsp<float>(F, WS_COS); float* sinT = wsp<float>(F, WS_SIN);
      for (int i0 = F.gw * 64 + F.lane; i0 < NTOK * 16; i0 += 4 * F.NGW * 64) { int pv[4];
#pragma unroll
        for (int u = 0; u < 4; ++u) { const int i = i0 + u * F.NGW * 64; pv[u] = i < NTOK * 16 ? positions[i >> 4] : 0; }
#pragma unroll
        for (int u = 0; u < 4; ++u) { const int i = i0 + u * F.NGW * 64; if (i >= NTOK * 16) break; const int j = i & 15;
        const float invf = __builtin_amdgcn_exp2f(-(float)j * (13.287712379549449f / 16.0f));
        const float ang = (float)pv[u] * invf;
        const float rev = ang * 0.15915494309189535f; const float fr = rev - __builtin_floorf(rev);
        cosT[i] = __builtin_amdgcn_cosf(fr); sinT[i] = __builtin_amdgcn_sinf(fr); } } }
    {
      const float* lam = INF(I_LAM); float* lamc = wsp<float>(F, WS_LAMC);
      for (int i = F.gw * 64 + F.lane; i < DEPTH * LRUW; i += F.NGW * 64) { const float t = __builtin_amdgcn_exp2f(-1.4426950408889634f * lam[i]); lamc[i] = t < 0.02f ? -8.0f * 1.4426950408889634f * t * (1.0f - t * (0.5f - t * (0.33333334f - 0.25f * t))) : -8.0f * __builtin_amdgcn_logf(1.0f + t); } }
    convert_range(F, 0, F.G == 256 ? 22 : 46, 0);
    for (int l = 0; l < DEPTH; ++l) {
        bf16* Win_t = wsp<bf16>(F, WS_WSMALL + (size_t)l * WSMALL_STRIDE); bf16* Wup_t = Win_t + 3 * MiB / 2; bf16* Wg_t = Win_t + 5 * MiB / 2;
        zero_block(F, Win_t, D / 2, 416, 96, 0, D / 2);
        zero_block(F, Wup_t, 256, 768, 1024, 128, 128);
        const float* w_a = INF(I_WA); const float* w_x = INF(I_WX);
        for (int i8 = F.gw * 64 + F.lane; i8 < 1024 * 16; i8 += F.NGW * 64) {
            const int row = i8 >> 4, kq0 = (i8 & 15) * 8, pn = row >> 8, half = (row >> 7) & 1, ch = 128 * pn + (row & 127), g = ch >> 6, kA0 = 128 * pn + kq0;
            float v[8];
#pragma unroll
            for (int e = 0; e < 8; ++e) v[e] = 0.f;
            if ((kA0 >> 6) == g) { const float* sp = (half ? w_x : w_a) + (((size_t)l * 8 + g) * 64 + (kA0 & 63)) * 64 + (ch & 63);
#pragma unroll
                for (int e = 0; e < 8; ++e) v[e] = sp[(size_t)e * 64]; }
            *(GAS v4u*)(Wg_t + (size_t)row * 128 + kq0) = (v4u){pk2(v[0], v[1]), pk2(v[2], v[3]), pk2(v[4], v[5]), pk2(v[6], v[7])}; }
    }
}
__device__ __forceinline__ void p0_finalise(Frame& F) {
    F.refresh();
    const float* b_ada = INF(I_BADA); const float* modp = wsp<float>(F, WS_MODP); float* mod = wsp<float>(F, WS_MOD);
    for (int i = F.gw * 64 + F.lane; i < 8 * 2 * 3072; i += F.NGW * 64) { const int j = i % 3072, ls = i / 6144;
        float v = b_ada[ls * 3072 + j];
#pragma unroll
        for (int kq = 0; kq < 4; ++kq) v += modp[(size_t)kq * 8 * 2 * 3072 + i];
        mod[i] = v; }
    float wmx[6];
#pragma unroll
    for (int q = 0; q < 6; ++q) wmx[q] = __uint_as_float(__hip_atomic_load((unsigned*)(F.ctl + CW_WMAX + 64 * q), __ATOMIC_RELAXED, __HIP_MEMORY_SCOPE_AGENT));
    if (F.gw == 0 && F.lane < 6) { float v = wmx[0];
#pragma unroll
        for (int q = 1; q < 6; ++q) if (F.lane == q) v = wmx[q];
        wsp<float>(F, WS_MREF)[8 + F.lane] = v * (1.0f / 127.0f); }
    if (F.gw == 0 && F.lane < DEPTH) { const int l = F.lane; const float* qg = INF(I_QGAIN) + l * 96; const float* kg = INF(I_KGAIN) + l * 96; float a = 0.f, bq = 0.f, c = 0.f, d = 0.f;
        for (int i = 0; i < 64; ++i) { a = fmaxf(a, qg[i] * qg[i]); c = fmaxf(c, kg[i] * kg[i]); }
        for (int i = 64; i < 96; ++i) { bq = fmaxf(bq, qg[i] * qg[i]); d = fmaxf(d, kg[i] * kg[i]); }
        wsp<float>(F, WS_MREF)[l] = 1.01f * 0.10206207261596577f * 1.4426950408889634f * sqrtf(64.f * a + 32.f * bq) * sqrtf(64.f * c + 32.f * d); }
    { LAS float* scr = (LAS float*)(F.lds + F.wave * 16384); const int nblk = INCOLS / 32, items = (D / 64) * nblk;
      for (int it = F.gw; it < DEPTH * items; it += F.NGW) { const int l = it / items, r = it - l * items, kb = r / nblk, nb = r - kb * nblk, n0 = 32 * nb;
          float wm = wmx[0];
#pragma unroll
          for (int q = 1; q < 4; ++q) if (l == q) wm = wmx[q];
          transpose_item_i8(INF(I_WIN) + (size_t)l * D * INCOLS, INCOLS, 64 * kb, n0, wsp<unsigned char>(F, WS_WSMALL + (size_t)l * WSMALL_STRIDE), D, n0 >= 416 ? n0 + 96 : n0, 127.0f / __builtin_fmaxf(wm, 1e-30f), scr, F.lane); } }
    { LAS float* scr = (LAS float*)(F.lds + F.wave * 16384); const int nblk = DFF / 32, items = (D / 64) * nblk;
      for (int it = F.gw; it < 4 * items; it += F.NGW) { const int q = it / items, j = q >> 1, h = q & 1, r = it - q * items, kb = r / nblk, nb = r - kb * nblk, n0 = 32 * nb;
          const float wm = j ? wmx[5] : wmx[4];
          transpose_item_i8((h ? INF(I_FWU) : INF(I_FWG)) + (size_t)j * D * DFF, DFF, 64 * kb, n0, wsp<unsigned char>(F, WS_WDENSE + (size_t)j * WDENSE_STRIDE), D, 256 * (n0 / 128) + (n0 % 128) + (h ? 128 : 0), 127.0f / __builtin_fmaxf(wm, 1e-30f), scr, F.lane); } }
}

template <bool COMBINE, bool NORM, bool ROUTER, bool F8H = false, bool I8H = false, bool XB16 = true, bool XO16 = true>
__device__ __forceinline__ void norm_pass(Frame& F, const void* xin_, void* xout_, int ls, int ls_prev, int moe_j) {
    const float* xin = (const float*)xin_; const bf16* xinb = (const bf16*)xin_; float* xout = (float*)xout_; bf16* xoutb = (bf16*)xout_;
    F.refresh();
    LAS float* gs = (LAS float*)(F.lds); LAS float* sh = gs + 2048;
    LAS int* lcnt = (LAS int*)(F.lds + 16384); LAS int* gbase = lcnt + 16; LAS int* ltab = lcnt + 32;
    const int lane = F.lane;
    const float* mod = wsp<float>(F, WS_MOD); bf16* hbuf = wsp<bf16>(F, WS_H); float* rsc_ = wsp<float>(F, WS_RSC);
    int* tok_e = wsp<int>(F, WS_TOKE); int* tok_r = wsp<int>(F, WS_TOKR); float* tok_w = wsp<float>(F, WS_TOKW); const int* tok_p = wsp<int>(F, WS_TOKP); const bf16* y2 = wsp<bf16>(F, WS_Y2);
    if (NORM) { const float* modl = mod + (size_t)ls * 2 * 3072; const float* ng = INF(I_NGAIN) + (size_t)ls * D;
        float t_ng[4], t_sc[4], t_sh[4];
#pragma unroll
        for (int u = 0; u < 4; ++u) { const int i = F.tid + u * NWAVES * 64, b = i >> 10, j = i & 1023; t_ng[u] = ng[j]; t_sc[u] = modl[b * 3072 + 1024 + j]; t_sh[u] = modl[b * 3072 + j]; }
#pragma unroll
        for (int u = 0; u < 4; ++u) { const int i = F.tid + u * NWAVES * 64; gs[i] = t_ng[u] * (1.0f + t_sc[u]); sh[i] = t_sh[u]; } }
    const float* rw = ROUTER ? INF(I_RW) + (size_t)moe_j * D * 8 : nullptr;
    f32x4 rwa[16], rwb[16];
    if (ROUTER) {
#pragma unroll
        for (int jq = 0; jq < 16; ++jq) { const f32x4* wp = (const f32x4*)(rw + (size_t)(4 * lane + 256 * (jq >> 2) + (jq & 3)) * 8); rwa[jq] = wp[0]; rwb[jq] = wp[1]; } }
    __syncthreads();
    for (int blk = F.vcu; blk < NTOK / 128; blk += F.G) {
        if (ROUTER) { if (F.tid < 8) lcnt[F.tid] = 0; __syncthreads(); }
        f32x4 nx[4]; v2u nxb[4];
        if (XB16) { const GAS v2u* xr = (const GAS v2u*)(xinb + (size_t)(blk * 128 + F.wave * 16) * D) + lane;
#pragma unroll
          for (int j = 0; j < 4; ++j) nxb[j] = xr[64 * j]; }
        else { const GAS f32x4* xr = (const GAS f32x4*)(xin + (size_t)(blk * 128 + F.wave * 16) * D) + lane;
#pragma unroll
          for (int j = 0; j < 4; ++j) nx[j] = xr[64 * j]; }
        for (int i = 0; i < 16; ++i) {
            const int row = blk * 128 + F.wave * 16 + i, b = row >> 14;
            f32x4 v[4];
#pragma unroll
            for (int j = 0; j < 4; ++j) { if (XB16) v[j] = (f32x4){bflo(nxb[j].x), bfhi(nxb[j].x), bflo(nxb[j].y), bfhi(nxb[j].y)}; else v[j] = nx[j]; }
            if (i < 15) {
                if (XB16) { const GAS v2u* xr = (const GAS v2u*)(xinb + (size_t)(row + 1) * D) + lane;
#pragma unroll
                    for (int j = 0; j < 4; ++j) nxb[j] = xr[64 * j]; }
                else { const GAS f32x4* xr = (const GAS f32x4*)(xin + (size_t)(row + 1) * D) + lane;
#pragma unroll
                    for (int j = 0; j < 4; ++j) nx[j] = xr[64 * j]; } }
            if (!XB16 && !COMBINE) { GAS v2u* xob = (GAS v2u*)(xoutb + (size_t)row * D) + lane;
#pragma unroll
                for (int j = 0; j < 4; ++j) xob[64 * j] = (v2u){pk2(v[j].x, v[j].y), pk2(v[j].z, v[j].w)}; }
            if (COMBINE) {
                const int p0 = tok_p[row * 2], p1 = tok_p[row * 2 + 1]; const float w0 = tok_w[row * 2], w1 = tok_w[row * 2 + 1];
                const float* gp = mod + (size_t)ls_prev * 2 * 3072 + b * 3072 + 2048;
                GAS f32x4* xo = (GAS f32x4*)(xout + (size_t)row * D) + lane; GAS v2u* xob = (GAS v2u*)(xoutb + (size_t)row * D) + lane;
                uint2 yav[4], ybv[4]; f32x4 gvv[4];
#pragma unroll
                for (int j = 0; j < 4; ++j) { yav[j] = *(const uint2*)(y2 + (size_t)p0 * D + 4 * lane + 256 * j); ybv[j] = *(const uint2*)(y2 + (size_t)p1 * D + 4 * lane + 256 * j); gvv[j] = *(const f32x4*)(gp + 4 * lane + 256 * j); }
                asm volatile("" ::: "memory");
#pragma unroll
                for (int j = 0; j < 4; ++j) { const uint2 ya = yav[j], yb = ybv[j]; const f32x4 g = gvv[j];
                    v[j].x += g.x * (w0 * bflo(ya.x) + w1 * bflo(yb.x)); v[j].y += g.y * (w0 * bfhi(ya.x) + w1 * bfhi(yb.x));
                    v[j].z += g.z * (w0 * bflo(ya.y) + w1 * bflo(yb.y)); v[j].w += g.w * (w0 * bfhi(ya.y) + w1 * bfhi(yb.y));
                    if (XO16) { const v2u o2 = (v2u){pk2(v[j].x, v[j].y), pk2(v[j].z, v[j].w)}; xob[64 * j] = o2; v[j] = (f32x4){bflo(o2.x), bfhi(o2.x), bflo(o2.y), bfhi(o2.y)}; }
                    else xo[64 * j] = v[j]; }
            }
            if (NORM) {
                float ss = 0.f;
#pragma unroll
                for (int j = 0; j < 4; ++j) ss += (v[j].x * v[j].x + v[j].y * v[j].y) + (v[j].z * v[j].z + v[j].w * v[j].w);
                const float rstd = 1.0f / sqrtf(wave_sum(ss) * (1.0f / D) + EPS);
                GAS unsigned long long* o8 = (GAS unsigned long long*)(hbuf + (size_t)row * D) + lane;
                GAS unsigned* o4 = (GAS unsigned*)((unsigned char*)hbuf + (size_t)row * D) + lane;
#pragma unroll
                for (int j = 0; j < 4; ++j) { const f32x4 g = *(const LAS f32x4*)(gs + b * 1024 + 4 * lane + 256 * j), s = *(const LAS f32x4*)(sh + b * 1024 + 4 * lane + 256 * j);
                    v[j] = v[j] * rstd * g + s;
                    if (I8H) continue;
                    if (F8H) o4[64 * j] = pg8::pack4_fp8(v[j].x * SC_H8, v[j].y * SC_H8, v[j].z * SC_H8, v[j].w * SC_H8);
                    else o8[64 * j] = (unsigned long long)pk2(v[j].x, v[j].y) | ((unsigned long long)pk2(v[j].z, v[j].w) << 32); }
                if (I8H) { float am = 0.f;
#pragma unroll
                    for (int j = 0; j < 4; ++j) am = __builtin_fmaxf(__builtin_fmaxf(am, __builtin_fmaxf(__builtin_fabsf(v[j].x), __builtin_fabsf(v[j].y))), __builtin_fmaxf(__builtin_fabsf(v[j].z), __builtin_fabsf(v[j].w)));
                    am = __builtin_fmaxf(wave_max(am), 1e-30f); const float qs = 127.0f / am;
#pragma unroll
                    for (int j = 0; j < 4; ++j) o4[64 * j] = pg8::pack4_i8(v[j].x * qs, v[j].y * qs, v[j].z * qs, v[j].w * qs);
                    if (lane == 0) rsc_[row] = am * (1.0f / 127.0f); }
                if (ROUTER) {
                    float lg[8];
#pragma unroll
                    for (int e = 0; e < 8; ++e) lg[e] = 0.f;
#pragma unroll
                    for (int j = 0; j < 4; ++j)
#pragma unroll
                        for (int q = 0; q < 4; ++q) { const float hv = v[j][q]; const f32x4 wa = rwa[4 * j + q], wb = rwb[4 * j + q];
                            lg[0] += hv * wa.x; lg[1] += hv * wa.y; lg[2] += hv * wa.z; lg[3] += hv * wa.w; lg[4] += hv * wb.x; lg[5] += hv * wb.y; lg[6] += hv * wb.z; lg[7] += hv * wb.w; }
#pragma unroll
                    for (int e = 0; e < 8; ++e) lg[e] = wave_sum(lg[e]);
                    int e0 = 0; float v0 = lg[0];
#pragma unroll
                    for (int e = 1; e < 8; ++e) if (lg[e] > v0) { v0 = lg[e]; e0 = e; }
                    int e1 = 0; float v1 = -__builtin_inff();
#pragma unroll
                    for (int e = 0; e < 8; ++e) if (e != e0 && lg[e] > v1) { v1 = lg[e]; e1 = e; }
                    const float w0 = 1.0f / (1.0f + __builtin_amdgcn_exp2f(1.4426950408889634f * (v1 - v0))), w1 = 1.0f - w0;
                    if (lane == 0) { const int r0 = __hip_atomic_fetch_add(lcnt + e0, 1, __ATOMIC_RELAXED, __HIP_MEMORY_SCOPE_WORKGROUP), r1 = __hip_atomic_fetch_add(lcnt + e1, 1, __ATOMIC_RELAXED, __HIP_MEMORY_SCOPE_WORKGROUP);
                        LAS int* lt = ltab + (F.wave * 16 + i) * 8; lt[0] = e0; lt[1] = e1; lt[2] = r0; lt[3] = r1; lt[4] = (int)__float_as_uint(w0); lt[5] = (int)__float_as_uint(w1); }
                }
            }
        }
        if (ROUTER) {
            __syncthreads();
            if (F.tid < 8) gbase[F.tid] = (int)__hip_atomic_fetch_add((unsigned*)(F.ctl + CW_GCNT + 64 * (8 * moe_j + F.tid)), (unsigned)lcnt[F.tid], RLX_AGENT);
            __syncthreads();
            if (F.tid < 128) { const int row = blk * 128 + F.tid; const LAS int* lt = ltab + F.tid * 8; const int e0 = lt[0], e1 = lt[1];
                tok_e[row * 2] = e0; tok_e[row * 2 + 1] = e1; tok_r[row * 2] = gbase[e0] + lt[2]; tok_r[row * 2 + 1] = gbase[e1] + lt[3];
                tok_w[row * 2] = __uint_as_float((unsigned)lt[4]); tok_w[row * 2 + 1] = __uint_as_float((unsigned)lt[5]); }
            __syncthreads();
        }
    }
    __syncthreads();
}

__device__ __forceinline__ void mid_pass(Frame& F, int l) {
    F.refresh();
    const int lane = F.lane;
    const bf16* z = wsp<bf16>(F, WS_Z); bf16* A2 = wsp<bf16>(F, WS_A2); bf16* Kb = wsp<bf16>(F, WS_K); bf16* xrb = wsp<bf16>(F, WS_XR);
    const float* cosT = wsp<float>(F, WS_COS); const float* sinT = wsp<float>(F, WS_SIN);
    const float* lg = INF(I_LGAIN) + l * 384; const f32x4 lgq = *(const f32x4*)(lg + 4 * lane); const f32x4 lgkv = *(const f32x4*)(lg + 256 + 4 * (lane & 31));
    const float* kg = INF(I_KGAIN) + l * 96; const float kg1 = kg[64 + (lane & 15)], kg2 = kg[80 + (lane & 15)];
    const float* conv_w = INF(I_CONVW); const float* conv_b = INF(I_CONVB);
    float cw[4][8], cb[8];
#pragma unroll
    for (int e = 0; e < 8; ++e) { cb[e] = conv_b[l * 512 + 8 * lane + e];
#pragma unroll
        for (int j = 0; j < 4; ++j) cw[j][e] = conv_w[(size_t)(l * 4 + j) * 512 + 8 * lane + e]; }
    struct MidIn { uint2 q2, k2; bf16 x1, x2; v4u xw[4]; float cs, sn; };
    auto mid_load = [&](int row) -> MidIn { MidIn r; const bf16* zr = z + (size_t)row * INP; const int t = row & (SEQ - 1);
        r.q2 = *(const uint2*)(zr + 4 * lane); r.k2 = *(const uint2*)(zr + 256 + 4 * (lane & 31)); r.x1 = zr[384 + (lane & 15)]; r.x2 = zr[400 + (lane & 15)];
#pragma unroll
        for (int j = 0; j < 4; ++j) { if (t - 3 + j >= 0) r.xw[j] = *(const v4u*)(zr + (long)(j - 3) * INP + 512 + 8 * lane); else r.xw[j] = (v4u){0u, 0u, 0u, 0u}; }
        r.cs = cosT[row * 16 + (lane & 15)]; r.sn = sinT[row * 16 + (lane & 15)]; return r; };
    MidIn nxt = mid_load(F.gw < NTOK ? F.gw : 0);
    for (int row = F.gw; row < NTOK; row += F.NGW) {
        const MidIn in = nxt;
        if (row + F.NGW < NTOK) nxt = mid_load(row + F.NGW);
        const float q0 = bflo(in.q2.x), q1 = bfhi(in.q2.x), q2f = bflo(in.q2.y), q3 = bfhi(in.q2.y);
        float ssq = (q0 * q0 + q1 * q1) + (q2f * q2f + q3 * q3);
        const float k0 = bflo(in.k2.x), k1 = bfhi(in.k2.x), k2f = bflo(in.k2.y), k3 = bfhi(in.k2.y);
        float sskv = lane < 32 ? (k0 * k0 + k1 * k1) + (k2f * k2f + k3 * k3) : 0.f;
        const float x1 = bf1(in.x1), x2 = bf1(in.x2);
        float ssr = lane < 16 ? x1 * x1 + x2 * x2 : 0.f;
        ssq = wave_sum(ssq); sskv = wave_sum(sskv); ssr = wave_sum(ssr);
        const float rq = 1.0f / sqrtf(ssq * (1.0f / 256.0f) + EPS), rkv = 1.0f / sqrtf(sskv * (1.0f / 128.0f) + EPS), rr = 1.0f / sqrtf(ssr * (1.0f / 32.0f) + EPS);
        *(uint2*)(A2 + (size_t)row * 256 + 4 * lane) = make_uint2(pk2(q0 * rq * lgq.x, q1 * rq * lgq.y), pk2(q2f * rq * lgq.z, q3 * rq * lgq.w));
        if (lane < 32) *(uint2*)(A2 + (size_t)(NTOK + row) * 256 + 4 * lane) = make_uint2(pk2(k0 * rkv * lgkv.x, k1 * rkv * lgkv.y), pk2(k2f * rkv * lgkv.z, k3 * rkv * lgkv.w));
        if (lane < 16) { const float a = x1 * rr * kg1, bb = x2 * rr * kg2;
            const bf16 o1 = (bf16)f2bf(a * in.cs - bb * in.sn), o2 = (bf16)f2bf(a * in.sn + bb * in.cs); bf16* kr = Kb + (size_t)row * 768 + 64 + lane;
#pragma unroll
            for (int hh = 0; hh < 8; ++hh) { kr[hh * 96] = o1; kr[hh * 96 + 16] = o2; } }
        float acc[8];
#pragma unroll
        for (int e = 0; e < 8; ++e) acc[e] = cb[e];
#pragma unroll
        for (int j = 0; j < 4; ++j) { const v4u xw = in.xw[j];
                acc[0] += cw[j][0] * bflo(xw.x); acc[1] += cw[j][1] * bfhi(xw.x); acc[2] += cw[j][2] * bflo(xw.y); acc[3] += cw[j][3] * bfhi(xw.y);
                acc[4] += cw[j][4] * bflo(xw.z); acc[5] += cw[j][5] * bfhi(xw.z); acc[6] += cw[j][6] * bflo(xw.w); acc[7] += cw[j][7] * bfhi(xw.w); }
        *(v4u*)(xrb + ((size_t)(lane >> 4) * NTOK + row) * 128 + 8 * (lane & 15)) = (v4u){pk2(acc[0], acc[1]), pk2(acc[2], acc[3]), pk2(acc[4], acc[5]), pk2(acc[6], acc[7])};
    }
}

__device__ __forceinline__ void qk_pass(Frame& F, int l) {
    F.refresh();
    const int lane = F.lane, g8 = lane & 7, h8 = lane >> 3, g4 = lane & 3, h4 = (lane >> 2) & 7;
    const float C2 = 0.10206207261596577f * 1.4426950408889634f;
    const bf16* qkv = wsp<bf16>(F, WS_QKV); bf16* Qb = wsp<bf16>(F, WS_Q); bf16* Kb = wsp<bf16>(F, WS_K);
    const float* cosT = wsp<float>(F, WS_COS); const float* sinT = wsp<float>(F, WS_SIN);
    const float* q_gain = INF(I_QGAIN) + l * 96; const float* k_gain = INF(I_KGAIN) + l * 96;
    float qgn[8], kgn[8], qgr[8];
#pragma unroll
    for (int e = 0; e < 8; ++e) { qgn[e] = q_gain[g8 * 8 + e]; kgn[e] = k_gain[g8 * 8 + e]; qgr[e] = q_gain[64 + g4 * 8 + e]; }
    struct QkIn { v4u qn, kn, qp; f32x4 ca, cb, sa, sb; };
    auto qk_load = [&](int row) -> QkIn { QkIn r; const bf16* qr = qkv + (size_t)row * UPN;
        r.qn = *(const v4u*)(qr + h8 * 96 + g8 * 8); r.kn = *(const v4u*)(qr + 768 + h8 * 128 + g8 * 8); r.qp = *(const v4u*)(qr + h4 * 96 + 64 + g4 * 8);
        r.ca = *(const f32x4*)(cosT + row * 16 + (g4 & 1) * 8); r.cb = *(const f32x4*)(cosT + row * 16 + (g4 & 1) * 8 + 4);
        r.sa = *(const f32x4*)(sinT + row * 16 + (g4 & 1) * 8); r.sb = *(const f32x4*)(sinT + row * 16 + (g4 & 1) * 8 + 4); return r; };
    QkIn nxt = qk_load(F.gw < NTOK ? F.gw : 0);
    for (int row = F.gw; row < NTOK; row += F.NGW) {
        const QkIn in = nxt;
        if (row + F.NGW < NTOK) nxt = qk_load(row + F.NGW);
        float v[8], o[8];
#define UP8(dst, w_) do { dst[0] = bflo(w_.x); dst[1] = bfhi(w_.x); dst[2] = bflo(w_.y); dst[3] = bfhi(w_.y); dst[4] = bflo(w_.z); dst[5] = bfhi(w_.z); dst[6] = bflo(w_.w); dst[7] = bfhi(w_.w); } while (0)
#define ST8(p, s) do { *(v4u*)(p) = (v4u){pk2(s[0], s[1]), pk2(s[2], s[3]), pk2(s[4], s[5]), pk2(s[6], s[7])}; } while (0)
        UP8(v, in.qn);
        { float ss = 0.f;
#pragma unroll
          for (int e = 0; e < 8; ++e) ss += v[e] * v[e];
          ss += swz_xor<1>(ss); ss += swz_xor<2>(ss); ss += swz_xor<4>(ss);
          const float rs = C2 / sqrtf(ss * (1.0f / 64.0f) + EPS);
#pragma unroll
          for (int e = 0; e < 8; ++e) o[e] = v[e] * rs * qgn[e];
          ST8(Qb + (size_t)row * 768 + h8 * 96 + g8 * 8, o); }
        UP8(v, in.kn);
        { float ss = 0.f;
#pragma unroll
          for (int e = 0; e < 8; ++e) ss += v[e] * v[e];
          ss += swz_xor<1>(ss); ss += swz_xor<2>(ss); ss += swz_xor<4>(ss);
          const float rs = 1.0f / sqrtf(ss * (1.0f / 64.0f) + EPS);
#pragma unroll
          for (int e = 0; e < 8; ++e) o[e] = v[e] * rs * kgn[e];
          ST8(Kb + (size_t)row * 768 + h8 * 96 + g8 * 8, o); }
        UP8(v, in.qp);
        { float ss = 0.f;
#pragma unroll
          for (int e = 0; e < 8; ++e) ss += v[e] * v[e];
          ss += swz_xor<1>(ss); ss += swz_xor<2>(ss);
          const float rs = 1.0f / sqrtf(ss * (1.0f / 32.0f) + EPS);
#pragma unroll
          for (int e = 0; e < 8; ++e) { const float vn = v[e] * rs * qgr[e]; const float pe = swz_xor<2>(vn);
              const float cs = e < 4 ? in.ca[e & 3] : in.cb[e & 3], sn = e < 4 ? in.sa[e & 3] : in.sb[e & 3];
              o[e] = (g4 < 2 ? vn * cs - pe * sn : pe * sn + vn * cs) * C2; }
          if (lane < 32) ST8(Qb + (size_t)row * 768 + h4 * 96 + 64 + g4 * 8, o); }
#undef UP8
#undef ST8
    }
}

__device__ __forceinline__ void scan_a(Frame& F) {
    F.refresh();
    const int ch = F.tid;
    const unsigned* lu = wsp<unsigned>(F, WS_LA); float* Pl = wsp<float>(F, WS_PL); float* Hc = wsp<float>(F, WS_HC);
    for (int un = F.vcu; un < 256; un += F.G) {
        const size_t r0 = (size_t)un * 128; float S = 0.f, H = 0.f;
        for (int t0 = 0; t0 < 128; t0 += 32) { unsigned w[32];
#pragma unroll
            for (int t = 0; t < 32; ++t) w[t] = lu[(r0 + t0 + t) * LRUW + ch];
#pragma unroll
            for (int t = 0; t < 32; ++t) { const float l2 = bflo(w[t]); H = __builtin_amdgcn_exp2f(l2) * H + bfhi(w[t]); S += l2; } }
        Pl[(size_t)un * LRUW + ch] = S; Hc[(size_t)un * LRUW + ch] = H;
    }
}
__device__ __forceinline__ void scan_arrive(Frame& F, int l) {
    asm volatile("s_waitcnt vmcnt(0)" ::: "memory");
    __syncthreads();
    int t0 = threadIdx.x; asm volatile("" : "+v"(t0));
    if (t0 == 0) { __builtin_amdgcn_fence(__ATOMIC_RELEASE, "agent"); asm volatile("s_waitcnt vmcnt(0)" ::: "memory"); (void)xb_add((unsigned*)(F.ctl + CW_SCNT + 16 * l), 1u); }
}
__device__ __forceinline__ void scan_wait(Frame& F, int l) {
    int t0 = threadIdx.x; asm volatile("" : "+v"(t0));
    if (t0 == 0) { unsigned* bar = (unsigned*)(F.ctl + CW_BAR); unsigned* cnt = (unsigned*)(F.ctl + CW_SCNT + 16 * l);
        XB_SPIN(xb_ld(cnt) < 256u, bar);
        __builtin_amdgcn_fence(__ATOMIC_ACQUIRE, "agent"); asm volatile("s_waitcnt vmcnt(0)" ::: "memory"); }
    __syncthreads();
}
__device__ __forceinline__ float gelu_tanh(float x) {
    const float y = 0.7978845608028654f * (x + 0.044715f * x * x * x);
    return x * __builtin_amdgcn_rcpf(1.0f + __builtin_amdgcn_exp2f(-2.0f * 1.4426950408889634f * y));
}
__device__ __forceinline__ void scan_c(Frame& F, int l) {
    F.refresh();
    const int ch = F.tid, lane = F.lane;
    LAS float* st = (LAS float*)F.lds;
    const unsigned* lu = wsp<unsigned>(F, WS_LA); const float* Pl = wsp<float>(F, WS_PL); const float* Hc = wsp<float>(F, WS_HC);
    const bf16* z = wsp<bf16>(F, WS_Z); bf16* y = wsp<bf16>(F, WS_Y);
    const float* out_gain = INF(I_OGAIN) + l * D + 512;
    float og[8];
#pragma unroll
    for (int e = 0; e < 8; ++e) og[e] = out_gain[8 * lane + e];
    for (int un = F.vcu; un < 256; un += F.G) {
        const int c = un & 127, b = un >> 7; const size_t r0 = (size_t)un * 128;
        unsigned w[32]; bf16 gq[32];
#pragma unroll
        for (int t = 0; t < 32; ++t) { w[t] = lu[(r0 + t) * LRUW + ch]; gq[t] = z[(r0 + t) * INP + 1024 + ch]; }
        float hst = 0.f;
        {
            float plA[16], hcA[16], plB[16], hcB[16];
#define SCC_LOAD(PLv, HCv, c0_) do { _Pragma("unroll") for (int u = 0; u < 16; ++u) { const int cc = (c0_) + u; const size_t o = (size_t)(b * 128 + (cc < c ? cc : 0)) * LRUW + ch; PLv[u] = cc < c ? Pl[o] : 0.f; HCv[u] = cc < c ? Hc[o] : 0.f; } } while (0)
#define SCC_STEP(PLv, HCv) do { _Pragma("unroll") for (int u = 0; u < 16; ++u) hst = __builtin_amdgcn_exp2f(PLv[u]) * hst + HCv[u]; } while (0)
            if (c > 0) SCC_LOAD(plA, hcA, 0);
            for (int c0 = 0; c0 < c; c0 += 32) {
                if (c0 + 16 < c) SCC_LOAD(plB, hcB, c0 + 16);
                SCC_STEP(plA, hcA);
                if (c0 + 16 >= c) break;
                if (c0 + 32 < c) SCC_LOAD(plA, hcA, c0 + 32);
                SCC_STEP(plB, hcB);
            }
#undef SCC_LOAD
#undef SCC_STEP
        }
        for (int sub = 0; sub < 4; ++sub) {
#pragma unroll
            for (int t = 0; t < 32; ++t) { hst = __builtin_amdgcn_exp2f(bflo(w[t])) * hst + bfhi(w[t]); st[t * 512 + ch] = hst * gelu_tanh(bf1(gq[t])); }
            if (sub < 3) {
#pragma unroll
                for (int t = 0; t < 32; ++t) { w[t] = lu[(r0 + (sub + 1) * 32 + t) * LRUW + ch]; gq[t] = z[(r0 + (sub + 1) * 32 + t) * INP + 1024 + ch]; } }
            __syncthreads();
#pragma unroll
            for (int tt = 0; tt < 4; ++tt) { const int t = F.wave * 4 + tt; const size_t row = r0 + sub * 32 + t;
                const f32x4 a = *(const LAS f32x4*)(st + t * 512 + 8 * lane), bq = *(const LAS f32x4*)(st + t * 512 + 8 * lane + 4);
                float ss = (a.x * a.x + a.y * a.y) + (a.z * a.z + a.w * a.w) + (bq.x * bq.x + bq.y * bq.y) + (bq.z * bq.z + bq.w * bq.w);
                const float rs = 1.0f / sqrtf(wave_sum(ss) * (1.0f / 512.0f) + EPS);
                *(v4u*)(y + row * D + 512 + 8 * lane) = (v4u){pk2(a.x * rs * og[0], a.y * rs * og[1]), pk2(a.z * rs * og[2], a.w * rs * og[3]), pk2(bq.x * rs * og[4], bq.y * rs * og[5]), pk2(bq.z * rs * og[6], bq.w * rs * og[7])}; }
            __syncthreads();
        }
    }
}
__device__ __forceinline__ void attn_norm_pass(Frame& F, int l) {
    F.refresh();
    const int lane = F.lane; float og[8];
    const float* out_gain = INF(I_OGAIN) + l * D; bf16* y = wsp<bf16>(F, WS_Y);
#pragma unroll
    for (int e = 0; e < 8; ++e) og[e] = out_gain[8 * lane + e];
    for (int row0 = F.gw; row0 < NTOK; row0 += 4 * F.NGW) {
        v4u wv[4];
#pragma unroll
        for (int r = 0; r < 4; ++r) { const int row = row0 + r * F.NGW; if (row < NTOK) wv[r] = *(const v4u*)(y + (size_t)row * D + 8 * lane); else wv[r] = (v4u){0u, 0u, 0u, 0u}; }
#pragma unroll
        for (int r = 0; r < 4; ++r) { const int row = row0 + r * F.NGW; const v4u w = wv[r];
            const float v0 = bflo(w.x), v1 = bfhi(w.x), v2 = bflo(w.y), v3 = bfhi(w.y), v4 = bflo(w.z), v5 = bfhi(w.z), v6 = bflo(w.w), v7 = bfhi(w.w);
            const float ss = (v0 * v0 + v1 * v1) + (v2 * v2 + v3 * v3) + (v4 * v4 + v5 * v5) + (v6 * v6 + v7 * v7);
            const float rs = 1.0f / sqrtf(wave_sum(ss) * (1.0f / 512.0f) + EPS);
            if (row < NTOK) *(v4u*)(y + (size_t)row * D + 8 * lane) = (v4u){pk2(v0 * rs * og[0], v1 * rs * og[1]), pk2(v2 * rs * og[2], v3 * rs * og[3]), pk2(v4 * rs * og[4], v5 * rs * og[5]), pk2(v6 * rs * og[6], v7 * rs * og[7])}; }
    }
}
__device__ __forceinline__ void attn_group_norm(Frame& F, int l, int b, int h, int qb) {
    asm volatile("s_waitcnt vmcnt(0)" ::: "memory");
    __syncthreads();
    int t0 = threadIdx.x; asm volatile("" : "+v"(t0));
    if (t0 == 0) {
        unsigned* bar = (unsigned*)(F.ctl + CW_BAR); unsigned* cnt = (unsigned*)(F.ctl + CW_AGRP + 16 * ((l * 2 + b) * 32 + qb));
        __builtin_amdgcn_fence(__ATOMIC_RELEASE, "agent");
        asm volatile("s_waitcnt vmcnt(0)" ::: "memory");
        (void)xb_add(cnt, 1u);
        XB_SPIN(xb_ld(cnt) < 8u, bar);
        __builtin_amdgcn_fence(__ATOMIC_ACQUIRE, "agent");
        asm volatile("s_waitcnt vmcnt(0)" ::: "memory");
    }
    __syncthreads();
    F.refresh();
    const int lane = F.lane; float og[8];
    const float* out_gain = INF(I_OGAIN) + l * D; bf16* y = wsp<bf16>(F, WS_Y);
#pragma unroll
    for (int e = 0; e < 8; ++e) og[e] = out_gain[8 * lane + e];
    const size_t row0 = (size_t)b * SEQ + (size_t)qb * 512 + h * 64 + F.wave * 8;
    v4u wv[8];
#pragma unroll
    for (int r = 0; r < 8; ++r) wv[r] = *(const v4u*)(y + (row0 + r) * D + 8 * lane);
#pragma unroll
    for (int r = 0; r < 8; ++r) { const v4u w = wv[r];
        const float v0 = bflo(w.x), v1 = bfhi(w.x), v2 = bflo(w.y), v3 = bfhi(w.y), v4 = bflo(w.z), v5 = bfhi(w.z), v6 = bflo(w.w), v7 = bfhi(w.w);
        const float ss = (v0 * v0 + v1 * v1) + (v2 * v2 + v3 * v3) + (v4 * v4 + v5 * v5) + (v6 * v6 + v7 * v7);
        const float rs = 1.0f / sqrtf(wave_sum(ss) * (1.0f / 512.0f) + EPS);
        *(v4u*)(y + (row0 + r) * D + 8 * lane) = (v4u){pk2(v0 * rs * og[0], v1 * rs * og[1]), pk2(v2 * rs * og[2], v3 * rs * og[3]), pk2(v4 * rs * og[4], v5 * rs * og[5]), pk2(v6 * rs * og[6], v7 * rs * og[7])}; }
}
__device__ __forceinline__ void moe_permute(Frame& F, int moe_j) {
    F.refresh();
    LAS int* sb = (LAS int*)F.lds;
    const int* tok_e = wsp<int>(F, WS_TOKE); const int* tok_r = wsp<int>(F, WS_TOKR); int* tok_p = wsp<int>(F, WS_TOKP); int* rte = wsp<int>(F, WS_RTE);
    const bf16* hbuf = wsp<bf16>(F, WS_H); bf16* hs = wsp<bf16>(F, WS_HS);
    if (F.tid < NEXP) sb[16 + F.tid] = (int)__hip_atomic_load((unsigned*)(F.ctl + CW_GCNT + 64 * (8 * moe_j + F.tid)), RLX_AGENT);
    __syncthreads();
    if (F.tid == 0) { int acc = 0;
        for (int e = 0; e < NEXP; ++e) { const int cnt = sb[16 + e]; sb[e] = acc; acc += (cnt + 255) & ~255; }
        sb[8] = acc; }
    __syncthreads();
    if (blockIdx.x == 0) { const int nrt = sb[8] >> 8;
        for (int i = F.tid; i < nrt; i += NWAVES * 64) { int e = 0;
#pragma unroll
            for (int k = 1; k < NEXP; ++k) if (i * 256 >= sb[k]) e = k;
            rte[i] = e; }
        if (F.tid == 0) rte[511] = nrt; }
    const int lane = F.lane;
    for (int s = F.gw; s < 2 * NTOK; s += F.NGW) { const int t = s >> 1, e = tok_e[s], pos = sb[e] + tok_r[s];
        const GAS v4u* src = (const GAS v4u*)((const unsigned char*)hbuf + (size_t)t * D); GAS v4u* dst = (GAS v4u*)((unsigned char*)hs + (size_t)pos * D);
        dst[lane] = src[lane];
        if (lane == 0) tok_p[s] = pos; }
    for (int j = F.gw; j < NEXP * 256; j += F.NGW) { const int e = j >> 8, i = j & 255, cnt = sb[16 + e], padn = ((cnt + 255) & ~255) - cnt;
        if (i < padn) { v4u zz = (v4u){0u, 0u, 0u, 0u}; asm volatile("" : "+v"(zz));
            GAS v4u* dst = (GAS v4u*)((unsigned char*)hs + (size_t)(sb[e] + cnt + i) * D); dst[lane] = zz; } }
    __syncthreads();
}
struct UpOrder : pg8::StaticOrder {
    __device__ __forceinline__ bool next(int i, pg8::Unit& u) const { if (!pg8::StaticOrder::next(i, u)) return false; u.pa = u.pm + (u.pn >= 3 ? NTOK / 256 : 0); return true; }
    __device__ __forceinline__ int ktiles(const pg8::Unit& u, int nt) const { return u.pn >= 3 ? nt / 2 : nt; } };
struct GateOrder : pg8::StaticOrder {
    __device__ __forceinline__ bool next(int i, pg8::Unit& u) const { if (!pg8::StaticOrder::next(i, u)) return false; u.pa = u.pm + u.pn * (NTOK / 256); return true; } };
struct MoeOrder {
    pg8::StaticOrder so; const int* rte; int pm_off, tpe, rev;
    __device__ __forceinline__ bool next(int i, pg8::Unit& u) const { if (!so.next(i, u)) return false; if (rev) u.pm = so.nM - 1 - u.pm; u.pm += pm_off; u.pa = u.pm; u.pb = rte[u.pm] * tpe + u.pn; return true; }
    __device__ __forceinline__ void a_ready(const pg8::Unit&) const {}
    __device__ __forceinline__ void done(const pg8::Unit&) const {}
    __device__ __forceinline__ int ktiles(const pg8::Unit&, int nt) const { return nt; }
};
struct AttnOrder {
    int v, G;
    __device__ __forceinline__ bool next(int i, int& bh, int& qb) const { const int un = v + (i >> 2) * G; if (un >= 256) return false; const int s = un & 15, k = i & 3; bh = un >> 4; qb = (k == 0) ? s : (k == 1) ? 31 - s : (k == 2) ? 32 + s : 63 - s; return true; }
};

struct Args { const void* in[28]; float* out; unsigned char* ws; };
__global__ void __launch_bounds__(NWAVES * 64, 2) trunk_fwd(Args args) {
    extern __shared__ __attribute__((aligned(16))) unsigned char lds[];
    Frame F;
    F.lds = (LAS unsigned char*)lds; F.MISC = (volatile LAS unsigned*)(F.lds + MISC_OFF);
    F.G = gridDim.x; { const int bx = blockIdx.x; F.vcu = (F.G % 8 == 0) ? (bx % 8) * (F.G / 8) + bx / 8 : bx; }
    F.NGW = F.G * NWAVES; F.refresh();
    F.ws = args.ws; F.out = args.out; F.ctl = (gu32*)(args.ws + WS_CTL);
    for (int u = F.tid; u < (LDS_BYTES - LDSCTL_OFF) / 4; u += NWAVES * 64) ((LAS unsigned*)(F.lds + LDSCTL_OFF))[u] = 0u;
    __syncthreads();
    XcdBarrier bar = xcd_barrier_post((unsigned*)(F.ctl + CW_BAR), F.MISC + 8);
#ifndef PROBE_MASK
#define PROBE_MASK 0u
#endif
    unsigned long long pr_last = PROBE_MASK ? rt() : 0ull, pr_acc = 0ull;
#define GRID_BAR(c) do { xcd_barrier(bar); if (PROBE_MASK) { const unsigned long long now_ = rt(); if ((PROBE_MASK >> (c)) & 1u) pr_acc += now_ - pr_last; pr_last = now_; } } while (0)
    const int cblk = (int)blockIdx.x;
    bf16* const xb = wsp<bf16>(F, WS_XB);

    p0_prologue(F);
    GRID_BAR(0);
    p0_finalise(F);
    GRID_BAR(0);

    for (int l = 0; l < DEPTH; ++l) {
        const int ls1 = 2 * l, ls2 = 2 * l + 1; const bool moe = (l & 1) != 0; const int jj = l >> 1;
        if (l == 0) norm_pass<false, true, false, false, true, false>(F, INF(I_X), xb, ls1, 0, 0);
        else if (l == 2) { norm_pass<true, true, false, false, true>(F, xb, xb, ls1, ls1 - 1, 0); convert_moe_late(F); }
        else norm_pass<false, true, false, false, true>(F, xb, nullptr, ls1, 0, 0);
        GRID_BAR(1);
        { bf16* Win_t = wsp<bf16>(F, WS_WSMALL + (size_t)l * WSMALL_STRIDE);
          pg8::Gemm g{wsp<bf16>(F, WS_H), Win_t, NTOK, INP, D / 2}; pg8::StaticOrder S; S.init(NTOK, INP, F.G, cblk);
          pg8::EpiBf16I8 E{wsp<bf16>(F, WS_Z), INP, wsp<float>(F, WS_RSC), wsp<float>(F, WS_MREF)[8 + l]};
          pg8::gemm_phase<pg8::EpiBf16I8, pg8::StaticOrder, true, true, true, true>(F.lds, g, S, E); }
        GRID_BAR(2);
        mid_pass(F, l);
        GRID_BAR(3);
        { bf16* Wup_t = wsp<bf16>(F, WS_WSMALL + (size_t)l * WSMALL_STRIDE + 3 * MiB);
          int k256 = 256; asm volatile("" : "+s"(k256));
          pg8::Gemm g{wsp<bf16>(F, WS_A2), Wup_t, NTOK, UPN, k256}; UpOrder S; S.init(NTOK, UPN, F.G, cblk);
          pg8::EpiUp E{wsp<bf16>(F, WS_Q), wsp<bf16>(F, WS_K), wsp<bf16>(F, WS_QKV), INF(I_QGAIN) + l * 96, INF(I_KGAIN) + l * 96, wsp<float>(F, WS_COS), wsp<float>(F, WS_SIN)};
          pg8::gemm_phase<pg8::EpiUp, UpOrder, true, true>(F.lds, g, S, E); }
        { bf16* Wg_t = wsp<bf16>(F, WS_WSMALL + (size_t)l * WSMALL_STRIDE + 5 * MiB); const bf16* xrb = wsp<bf16>(F, WS_XR);
          int k128 = 128; asm volatile("" : "+s"(k128));
          pg8::Gemm g{xrb, Wg_t, NTOK, 1024, k128}; GateOrder S; S.init(NTOK, 1024, F.G, cblk);
          pg8::EpiGates E{xrb, INF(I_BA) + l * LRUW, INF(I_BX) + l * LRUW, wsp<float>(F, WS_LAMC) + l * LRUW, wsp<unsigned>(F, WS_LA)};
          pg8::gemm_phase<pg8::EpiGates, GateOrder, true, true>(F.lds, g, S, E); }
        GRID_BAR(4);
        const bool inphase = F.G == 256 && wsp<float>(F, WS_MREF)[l] <= att::ATT_MREF_MAX;
        if (!inphase) { scan_a(F); GRID_BAR(5); }
        { const AttnOrder AO{F.vcu, F.G}; int bh, qb; const bf16* Qb = wsp<bf16>(F, WS_Q); const bf16* Kb = wsp<bf16>(F, WS_K); const bf16* Vb = wsp<bf16>(F, WS_QKV); bf16* yb = wsp<bf16>(F, WS_Y);
          const float mref = wsp<float>(F, WS_MREF)[l];
          if (mref <= att::ATT_MREF_MAX) {
              for (int base = F.vcu; base < 256; base += F.G)
                  for (int i = 0; i < 2; ++i) { int un = base; asm volatile("" : "+s"(un));
                      att2::attn_unit(un >> 7, (un >> 4) & 7, i ? 31 - (un & 15) : (un & 15), Qb, Kb, Vb, yb, F.lds);
                      if (F.G == 256) { int u2 = base; asm volatile("" : "+s"(u2)); attn_group_norm(F, l, u2 >> 7, (u2 >> 4) & 7, i ? 31 - (u2 & 15) : (u2 & 15));
                          if (i == 0) { scan_a(F); scan_arrive(F, l); if (l == 0) convert_moe_first(F); } } }
#ifdef ATT_XVAR
            { bf16* xo = wsp<bf16>(F, (size_t)866 * MiB); for (int i = 0; AO.next(i, bh, qb); ++i) att::attn_unit<ATT_XVAR>(bh >> 3, bh & 7, qb, Qb, Kb, Vb, xo, F.lds, 512); }
#endif
          }
          else {
              for (int base = F.vcu; base < 256; base += F.G)
                  for (int i = 0; i < 4; ++i) { int un = base; asm volatile("" : "+s"(un)); const int s_ = un & 15;
                      att_online::attn_unit(un >> 7, (un >> 4) & 7, i == 0 ? s_ : (i == 1 ? 31 - s_ : (i == 2 ? 32 + s_ : 63 - s_)), Qb, Kb, Vb, yb, F.lds);
                      if (i == 0 && l == 0 && F.G == 256) convert_moe_first(F); } } }
        if (inphase) scan_wait(F, l);
        scan_c(F, l);
        GRID_BAR(6);
        if (!inphase) { attn_norm_pass(F, l); GRID_BAR(7); }
        { bf16* Wout_t = wsp<bf16>(F, WS_WSMALL + (size_t)l * WSMALL_STRIDE + 6 * MiB);
          pg8::Gemm g{wsp<bf16>(F, WS_Y), Wout_t, NTOK, D, D}; pg8::StaticOrder S; S.init(NTOK, D, F.G, cblk);
          pg8::EpiResid E{xb, xb, wsp<float>(F, WS_MOD) + (size_t)ls1 * 2 * 3072 + 2048, 1.0f};
          pg8::gemm_phase<pg8::EpiResid, pg8::StaticOrder, true, true>(F.lds, g, S, E); }
        GRID_BAR(8);
        if (!moe) {
            if (true) {
                norm_pass<false, true, false, false, true>(F, xb, nullptr, ls2, 0, 0);
                GRID_BAR(1);
                { unsigned char* Wgu8 = wsp<unsigned char>(F, WS_WDENSE + (size_t)jj * WDENSE_STRIDE);
                  pg8::Gemm g{wsp<bf16>(F, WS_H), (const bf16*)Wgu8, NTOK, 2 * DFF, D / 2}; pg8::StaticOrder S; S.init(NTOK, 2 * DFF, F.G, cblk);
                  pg8::EpiSwigluI8 E{wsp<unsigned char>(F, WS_HID), DFF, wsp<float>(F, WS_RSC), wsp<float>(F, WS_MREF)[8 + 4 + jj], SC_HID8};
                  pg8::gemm_phase<pg8::EpiSwigluI8, pg8::StaticOrder, true, true, true, true>(F.lds, g, S, E); }
                GRID_BAR(9);
                { unsigned char* Wd8 = wsp<unsigned char>(F, WS_WDENSE + (size_t)jj * WDENSE_STRIDE + 11 * MiB);
                  pg8::Gemm g{wsp<bf16>(F, WS_HID), (const bf16*)Wd8, NTOK, D, DFF / 2}; pg8::StaticOrder S; S.init(NTOK, D, F.G, cblk);
                  pg8::EpiResid E{xb, xb, wsp<float>(F, WS_MOD) + (size_t)ls2 * 2 * 3072 + 2048, 1.0f / (SC_HID8 * SC_WD8)};
                  pg8::gemm_phase<pg8::EpiResid, pg8::StaticOrder, true, true, true>(F.lds, g, S, E); }
                GRID_BAR(10);
            } else {
                norm_pass<false, true, false, true>(F, xb, nullptr, ls2, 0, 0);
                GRID_BAR(1);
                { unsigned char* Wgu8 = wsp<unsigned char>(F, WS_WDENSE + (size_t)jj * WDENSE_STRIDE);
                  pg8::Gemm g{wsp<bf16>(F, WS_H), (const bf16*)Wgu8, NTOK, 2 * DFF, D / 2}; pg8::StaticOrder S; S.init(NTOK, 2 * DFF, F.G, cblk);
                  pg8::EpiSwigluF8 E{wsp<unsigned char>(F, WS_HID), DFF, 1.0f / (SC_H8 * SC_WGU8), SC_HID8};
                  pg8::gemm_phase<pg8::EpiSwigluF8, pg8::StaticOrder, true, true, true>(F.lds, g, S, E); }
                GRID_BAR(9);
                { unsigned char* Wd8 = wsp<unsigned char>(F, WS_WDENSE + (size_t)jj * WDENSE_STRIDE + 11 * MiB);
                  pg8::Gemm g{wsp<bf16>(F, WS_HID), (const bf16*)Wd8, NTOK, D, DFF / 2}; pg8::StaticOrder S; S.init(NTOK, D, F.G, cblk);
                  pg8::EpiResid E{xb, xb, wsp<float>(F, WS_MOD) + (size_t)ls2 * 2 * 3072 + 2048, 1.0f / (SC_HID8 * SC_WD8)};
                  pg8::gemm_phase<pg8::EpiResid, pg8::StaticOrder, true, true, true>(F.lds, g, S, E); }
                GRID_BAR(10);
            }
        } else {
            norm_pass<false, true, true, true>(F, xb, nullptr, ls2, 0, jj);
            GRID_BAR(11);
            moe_permute(F, jj);
            GRID_BAR(12);
            const int* rte = wsp<int>(F, WS_RTE); const int nrt = rte[511];
            { pg8::Gemm g{wsp<bf16>(F, WS_HS), wsp<bf16>(F, WS_WMOE_GU), nrt * 256, 2 * DFE, D / 2}; MoeOrder S; S.so.init(nrt * 256, 2 * DFE, F.G, cblk); S.rte = rte; S.pm_off = 0; S.tpe = 2 * DFE / 256; S.rev = 0;
              pg8::EpiSwigluF8 E{wsp<unsigned char>(F, WS_MHID), DFE, 1.0f / (SC_H8 * SC_WGU8), SC_HID8};
              pg8::gemm_phase<pg8::EpiSwigluF8, MoeOrder, true, true, true>(F.lds, g, S, E); }
            GRID_BAR(13);
            { pg8::Gemm g{wsp<bf16>(F, WS_MHID), wsp<bf16>(F, WS_WMOE_D), nrt * 256, D, DFE / 2}; MoeOrder S; S.so.init(nrt * 256, D, F.G, cblk); S.rte = rte; S.pm_off = 0; S.tpe = D / 256; S.rev = 1;
              pg8::EpiBf16S E{wsp<bf16>(F, WS_Y2), D, 1.0f / (SC_HID8 * SC_WD8)};
              pg8::gemm_phase<pg8::EpiBf16S, MoeOrder, true, true, true>(F.lds, g, S, E); }
                        if (jj == 0) { const int nwg = nrt * (D / 256), rem = nwg % F.G, nshare = rem ? F.G - rem : F.G, rank = rem ? cblk - rem : cblk;
                if (rank >= 0) convert_moe_early(F, rank, nshare); }
GRID_BAR(14);
        }
    }
    norm_pass<true, false, false, false, false, true, false>(F, xb, F.out, 0, 2 * (DEPTH - 1) + 1, 0);
    if (PROBE_MASK) { const unsigned long long now_ = rt(); if ((PROBE_MASK >> 15) & 1u) pr_acc += now_ - pr_last; if (blockIdx.x == 0) { while (rt() - now_ < pr_acc) __builtin_amdgcn_s_sleep(8); } }
}

extern "C" void kernel_launch(void* const* d_in, const int* in_sizes, int n_in, void* d_out, int out_size, void* d_ws, size_t ws_size, hipStream_t stream) {
    static int grid = 0;
    if (grid == 0) {
        if (n_in != 28 || out_size != NTOK * D || ws_size < WS_END) { fprintf(stderr, "kernel_launch: unexpected shapes (n_in %d, out %d, ws %zu)\n", n_in, out_size, ws_size); grid = -1; return; }
        int dev = 0, cus = 0, per_cu = 0;
        if (hipGetDevice(&dev) != hipSuccess || hipDeviceGetAttribute(&cus, hipDeviceAttributeMultiprocessorCount, dev) != hipSuccess) { grid = -1; return; }
        if (hipFuncSetAttribute((const void*)trunk_fwd, hipFuncAttributeMaxDynamicSharedMemorySize, LDS_BYTES) != hipSuccess) { fprintf(stderr, "kernel_launch: hipFuncSetAttribute failed\n"); grid = -1; return; }
        if (hipOccupancyMaxActiveBlocksPerMultiprocessor(&per_cu, (const void*)trunk_fwd, NWAVES * 64, LDS_BYTES) != hipSuccess || per_cu < 1) { fprintf(stderr, "kernel_launch: occupancy query reports %d\n", per_cu); per_cu = 1; }
        (void)hipGetLastError();
        grid = cus;
    }
    if (grid < 0) return;
    if (hipMemsetAsync((char*)d_ws + WS_CTL, 0, CTL_ZERO_BYTES, stream) != hipSuccess) return;
    Args a{};
    for (int i = 0; i < 28; ++i) a.in[i] = d_in[i];
    a.out = (float*)d_out; a.ws = (unsigned char*)d_ws;
    hipLaunchKernelGGL(trunk_fwd, dim3(grid), dim3(NWAVES * 64), LDS_BYTES, stream, a);
}
```

```cpp
#include <hip/hip_runtime.h>
#include <cstdio>
#include <cstdint>
namespace pg8 {
#define PG8_LAS __attribute__((address_space(3)))
typedef unsigned short bf16_t;
typedef short bf16x8 __attribute__((ext_vector_type(8)));
typedef float f32x4 __attribute__((ext_vector_type(4)));
typedef unsigned u32x4 __attribute__((ext_vector_type(4)));
typedef int i32x4_ __attribute__((ext_vector_type(4)));
constexpr int BM = 256, BK = 64, HALF = 128, HTB = HALF * BK * 2  , STAGE_BYTES = 8 * HTB, NXCD = 8, WGM = 8;

__host__ __device__ __forceinline__ int lds_byte(int r, int c) { const int st = (r >> 4) * 2 + (c >> 5), rr = r & 15, cc = c & 31, ob = rr * 64 + cc * 2; return st * 1024 + (ob ^ (((ob >> 9) & 1) << 5)); }
__host__ __device__ __forceinline__ void stage_rc(int b, int& R, int& C) { const int st = b / 1024, sb = b % 1024, swz = sb ^ (((sb >> 9) & 1) << 5); R = (st >> 1) * 16 + swz / 64; C = (st & 1) * 32 + (swz % 64) / 2; }
__host__ __device__ __forceinline__ int perm32(int rho) { const int n = rho >> 4, i = rho & 15; return 8 * (i >> 2) + 4 * n + (i & 3); }

struct Unit { int pm, pn, pb, pa; };
struct Gemm { const bf16_t* A; const bf16_t* Bt; int M, N, K; };

struct StaticOrder {
    int nM, nN, nwg, G, c;
    __host__ __device__ void init(int M, int N, int G_, int c_) { nM = M / BM; nN = N / BM; nwg = nM * nN; G = G_; c = c_; }
    __host__ __device__ bool next(int i, Unit& u) const {
        const long L = (long)i * G + c; if (L >= nwg) return false;
        int wgid = (int)L; { const int q = nwg / NXCD, r = nwg % NXCD, xcd = wgid % NXCD, off = wgid / NXCD; wgid = (xcd < r ? xcd * (q + 1) : r * (q + 1) + (xcd - r) * q) + off; }
        const int nig = WGM * nN, gid = wgid / nig, fm = gid * WGM, gsz = (nM - fm) < WGM ? (nM - fm) : WGM;
        u.pm = fm + ((wgid % nig) % gsz); u.pn = (wgid % nig) / gsz; u.pb = u.pn; u.pa = u.pm; return true;
    }
    __device__ __forceinline__ void a_ready(const Unit&) const {}
    __device__ __forceinline__ void done(const Unit&) const {}
    __device__ __forceinline__ int ktiles(const Unit&, int nt) const { return nt; }
};

__device__ __forceinline__ unsigned cvt_pk_bf16(float lo, float hi) { unsigned r; asm volatile("v_cvt_pk_bf16_f32 %0, %1, %2" : "=v"(r) : "v"(lo), "v"(hi)); return r; }
typedef float f32x2 __attribute__((ext_vector_type(2)));
__device__ __forceinline__ f32x2 gelu_pk(f32x2 v) {
    const f32x2 av = __builtin_elementwise_abs(v), d = av * 0.2316418882f + 1.0f;
    f32x2 t; t.x = __builtin_amdgcn_rcpf(d.x); t.y = __builtin_amdgcn_rcpf(d.y);
    f32x2 q = t * 0.5307027145f + (-0.7265760135f); q = q * t + 0.7107068705f; q = q * t + (-0.142248368f); q = q * t + 0.127414796f; q = q * t;
    const f32x2 s = (v * v) * (-0.72134752044f);
    f32x2 e; e.x = __builtin_amdgcn_exp2f(s.x); e.y = __builtin_amdgcn_exp2f(s.y);
    const f32x2 m = v * (q * e), r = v - m;
    f32x2 o; o.x = v.x < 0.f ? m.x : r.x; o.y = v.y < 0.f ? m.y : r.y; return o;
}

template <int ACT  > struct EpiBf16 {
    static constexpr bool PERM = true, AFTER_DRAIN = false; static_assert(ACT == 0 || ACT == 1, "EpiBf16: ACT is 0 (none) or 1 (gelu_pk)");
    bf16_t* O; int ldc; const float* bias; int split_cols; size_t split_stride; float scale0;
    __device__ __forceinline__ void operator()(const f32x4 (&acc)[2][2][4][2], const Unit& u, int wr, int wc, int fr, int fq) const {
        const int row0 = u.pm * BM + wr * 64 + fr; int colt = u.pn * BM; bf16_t* base = O;
        float sc = 1.f; if (split_cols) { const int t = colt / split_cols; base += (size_t)t * split_stride; colt -= t * split_cols; if (t == 0) sc = scale0; }
        const int col0 = colt + wc * 32 + 8 * fq, bcol0 = u.pn * BM + wc * 32 + 8 * fq;
        f32x4 bv[2][2];
#pragma unroll
        for (int bj = 0; bj < 2; ++bj)
#pragma unroll
            for (int n = 0; n < 2; ++n) bv[bj][n] = bias ? *(const f32x4*)(bias + bcol0 + bj * HALF + 4 * n) : (f32x4){0.f, 0.f, 0.f, 0.f};
#pragma unroll
        for (int ai = 0; ai < 2; ++ai)
#pragma unroll
            for (int m = 0; m < 4; ++m) { bf16_t* rowp = base + (size_t)(row0 + ai * HALF + m * 16) * ldc + col0;
#pragma unroll
                for (int bj = 0; bj < 2; ++bj) { f32x4 v0 = acc[ai][bj][m][0] + bv[bj][0], v1 = acc[ai][bj][m][1] + bv[bj][1];
                    if (ACT == 1) { f32x2 a = gelu_pk((f32x2){v0[0], v0[1]}), b = gelu_pk((f32x2){v0[2], v0[3]}), c = gelu_pk((f32x2){v1[0], v1[1]}), d = gelu_pk((f32x2){v1[2], v1[3]});
                        v0 = (f32x4){a.x, a.y, b.x, b.y}; v1 = (f32x4){c.x, c.y, d.x, d.y}; }
                    v0 = v0 * sc; v1 = v1 * sc; u32x4 w; w.x = cvt_pk_bf16(v0[0], v0[1]); w.y = cvt_pk_bf16(v0[2], v0[3]); w.z = cvt_pk_bf16(v1[0], v1[1]); w.w = cvt_pk_bf16(v1[2], v1[3]);
                    *(u32x4*)(rowp + bj * HALF) = w; } }
    }
};
struct EpiBf16I8 {
    static constexpr bool PERM = true, AFTER_DRAIN = false;
    bf16_t* O; int ldc; const float* rsc; float wdq;
    __device__ __forceinline__ void operator()(const f32x4 (&acc)[2][2][4][2], const Unit& u, int wr, int wc, int fr, int fq) const {
        const int row0 = u.pm * BM + wr * 64 + fr, col0 = u.pn * BM + wc * 32 + 8 * fq;
        float rs[2][4];
#pragma unroll
        for (int ai = 0; ai < 2; ++ai)
#pragma unroll
            for (int m = 0; m < 4; ++m) rs[ai][m] = rsc[row0 + ai * HALF + m * 16];
#pragma unroll
        for (int ai = 0; ai < 2; ++ai)
#pragma unroll
            for (int m = 0; m < 4; ++m) { bf16_t* rowp = O + (size_t)(row0 + ai * HALF + m * 16) * ldc + col0; const float s = rs[ai][m] * wdq;
#pragma unroll
                for (int bj = 0; bj < 2; ++bj) { float v[8];
#pragma unroll
                    for (int n = 0; n < 2; ++n)
#pragma unroll
                        for (int e = 0; e < 4; ++e) { const f32x4 av = acc[ai][bj][m][n]; const float ae = av[e]; v[4 * n + e] = (float)__float_as_int(ae) * s; }
                    u32x4 w; w.x = cvt_pk_bf16(v[0], v[1]); w.y = cvt_pk_bf16(v[2], v[3]); w.z = cvt_pk_bf16(v[4], v[5]); w.w = cvt_pk_bf16(v[6], v[7]);
                    *(u32x4*)(rowp + bj * HALF) = w; } }
    }
};
__device__ __forceinline__ float bf2f(unsigned short v) { return __uint_as_float((unsigned)v << 16); }
__device__ __forceinline__ float sigmoidf_(float v) { return __builtin_amdgcn_rcpf(1.0f + __builtin_amdgcn_exp2f(-1.4426950408889634f * v)); }
struct EpiResid {
    static constexpr bool PERM = true, AFTER_DRAIN = false;
    const bf16_t* base; bf16_t* out; const float* gate; float sc;
    __device__ __forceinline__ void operator()(const f32x4 (&acc)[2][2][4][2], const Unit& u, int wr, int wc, int fr, int fq) const {
        const int row0 = u.pm * BM + wr * 64 + fr, col0 = u.pn * BM + wc * 32 + 8 * fq;
        const float* gp = gate + (u.pm >= 64 ? 3072 : 0) + col0;
        f32x4 gv[2][2];
#pragma unroll
        for (int bj = 0; bj < 2; ++bj)
#pragma unroll
            for (int n = 0; n < 2; ++n) gv[bj][n] = *(const f32x4*)(gp + bj * HALF + 4 * n);
        asm volatile("" ::: "memory");
#define ER_OFF(g, q) ((size_t)(row0 + ((g) >> 1) * HALF + (2 * ((g) & 1) + (q)) * 16) * 1024 + col0)
#define ER_PACK(v0, v1) (u32x4){cvt_pk_bf16((v0)[0], (v0)[1]), cvt_pk_bf16((v0)[2], (v0)[3]), cvt_pk_bf16((v1)[0], (v1)[1]), cvt_pk_bf16((v1)[2], (v1)[3])}
        {
            u32x4 bw[2][2][2];
#define ER_LOADB(g, buf) do { _Pragma("unroll") for (int q = 0; q < 2; ++q) { const size_t off = ER_OFF(g, q); \
            _Pragma("unroll") for (int bj = 0; bj < 2; ++bj) bw[buf][q][bj] = *(const u32x4*)(base + off + bj * HALF); } } while (0)
#define ER_STOREB(g, buf) do { _Pragma("unroll") for (int q = 0; q < 2; ++q) { const size_t off = ER_OFF(g, q); \
            _Pragma("unroll") for (int bj = 0; bj < 2; ++bj) { const u32x4 w = bw[buf][q][bj]; \
                const f32x4 b0 = (f32x4){__uint_as_float(w.x << 16), __uint_as_float(w.x & 0xffff0000u), __uint_as_float(w.y << 16), __uint_as_float(w.y & 0xffff0000u)}; \
                const f32x4 b1 = (f32x4){__uint_as_float(w.z << 16), __uint_as_float(w.z & 0xffff0000u), __uint_as_float(w.w << 16), __uint_as_float(w.w & 0xffff0000u)}; \
                const f32x4 v0 = b0 + gv[bj][0] * acc[(g) >> 1][bj][2 * ((g) & 1) + q][0], v1 = b1 + gv[bj][1] * acc[(g) >> 1][bj][2 * ((g) & 1) + q][1]; \
                *(u32x4*)(out + off + bj * HALF) = ER_PACK(v0, v1); } } } while (0)
            ER_LOADB(0, 0); ER_LOADB(1, 1); asm volatile("" ::: "memory");
#pragma unroll
            for (int bj = 0; bj < 2; ++bj)
#pragma unroll
                for (int n = 0; n < 2; ++n) gv[bj][n] = gv[bj][n] * sc;
            ER_STOREB(0, 0); asm volatile("" ::: "memory"); ER_LOADB(2, 0); asm volatile("" ::: "memory");
            ER_STOREB(1, 1); asm volatile("" ::: "memory"); ER_LOADB(3, 1); asm volatile("" ::: "memory");
            ER_STOREB(2, 0); asm volatile("" ::: "memory");
            ER_STOREB(3, 1);
#undef ER_LOADB
#undef ER_STOREB
        }
#undef ER_OFF
#undef ER_PACK
    }
};
struct EpiSwiglu {
    static constexpr bool PERM = true, AFTER_DRAIN = false;
    bf16_t* O; int ldc;
    __device__ __forceinline__ void operator()(const f32x4 (&acc)[2][2][4][2], const Unit& u, int wr, int wc, int fr, int fq) const {
        const int row0 = u.pm * BM + wr * 64 + fr, col0 = u.pn * HALF + wc * 32 + 8 * fq;
#pragma unroll
        for (int ai = 0; ai < 2; ++ai)
#pragma unroll
            for (int m = 0; m < 4; ++m) { bf16_t* rowp = O + (size_t)(row0 + ai * HALF + m * 16) * ldc + col0;
                float hv[8];
#pragma unroll
                for (int n = 0; n < 2; ++n)
#pragma unroll
                    for (int e = 0; e < 4; ++e) { const float g = acc[ai][0][m][n][e], up = acc[ai][1][m][n][e]; hv[4 * n + e] = g * sigmoidf_(g) * up; }
                u32x4 w; w.x = cvt_pk_bf16(hv[0], hv[1]); w.y = cvt_pk_bf16(hv[2], hv[3]); w.z = cvt_pk_bf16(hv[4], hv[5]); w.w = cvt_pk_bf16(hv[6], hv[7]);
                *(u32x4*)rowp = w; }
    }
};
struct EpiGates {
    static constexpr bool PERM = true, AFTER_DRAIN = false;
    const bf16_t* xr; const float* ba; const float* bx; const float* lamc; unsigned* lu;
    __device__ __forceinline__ void operator()(const f32x4 (&acc)[2][2][4][2], const Unit& u, int wr, int wc, int fr, int fq) const {
        const int row0 = u.pm * BM + wr * 64 + fr, ch0 = u.pn * HALF + wc * 32 + 8 * fq;
        f32x4 bav[2], bxv[2], lcv[2]; const float NL2E = -1.4426950408889634f;
#pragma unroll
        for (int n = 0; n < 2; ++n) { bav[n] = *(const f32x4*)(ba + ch0 + 4 * n); bxv[n] = *(const f32x4*)(bx + ch0 + 4 * n); lcv[n] = *(const f32x4*)(lamc + ch0 + 4 * n); }
        u32x4 xws[2][4];
#pragma unroll
        for (int ai = 0; ai < 2; ++ai)
#pragma unroll
            for (int m = 0; m < 4; ++m) xws[ai][m] = *(const u32x4*)(xr + ((size_t)(ch0 >> 7) * 32768 + (row0 + ai * HALF + m * 16)) * 128 + (ch0 & 127));
        asm volatile("" ::: "memory");
#pragma unroll
        for (int n = 0; n < 2; ++n) { bav[n] = bav[n] * NL2E; bxv[n] = bxv[n] * NL2E; }
#pragma unroll
        for (int ai = 0; ai < 2; ++ai)
#pragma unroll
            for (int m = 0; m < 4; ++m) { const size_t off = (size_t)(row0 + ai * HALF + m * 16) * 512 + ch0;
                const u32x4 xw = xws[ai][m];
                float xv[8]; xv[0] = __uint_as_float(xw.x << 16); xv[1] = __uint_as_float(xw.x & 0xffff0000u); xv[2] = __uint_as_float(xw.y << 16); xv[3] = __uint_as_float(xw.y & 0xffff0000u);
                xv[4] = __uint_as_float(xw.z << 16); xv[5] = __uint_as_float(xw.z & 0xffff0000u); xv[6] = __uint_as_float(xw.w << 16); xv[7] = __uint_as_float(xw.w & 0xffff0000u);
#pragma unroll
                for (int n = 0; n < 2; ++n) { u32x4 pk;
#pragma unroll
                    for (int e = 0; e < 4; ++e) {
                        const float r = __builtin_amdgcn_rcpf(1.0f + __builtin_amdgcn_exp2f(__builtin_fmaf(acc[ai][0][m][n][e], NL2E, bav[n][e])));
                        const float ig = __builtin_amdgcn_rcpf(1.0f + __builtin_amdgcn_exp2f(__builtin_fmaf(acc[ai][1][m][n][e], NL2E, bxv[n][e])));
                        const float l2 = r * lcv[n][e];
                        const float om_e = 1.0f - __builtin_amdgcn_exp2f(l2 + l2);
                        const float xx = l2 * -1.3862943611198906f;
                        const float om = xx < 1.0e-4f ? xx : om_e;
                        pk[e] = cvt_pk_bf16(l2, __builtin_amdgcn_sqrtf(om) * ig * xv[4 * n + e]); }
                    *(u32x4*)(lu + off + 4 * n) = pk; } }
    }
};
__device__ __forceinline__ float clamp448(float v) { return __builtin_amdgcn_fmed3f(v, -448.0f, 448.0f); }
__device__ __forceinline__ unsigned pack4_i8(float a, float b, float c, float d) {
    const unsigned ua = __float_as_uint(__builtin_amdgcn_fmed3f(a, -127.0f, 127.0f) + 12582912.0f), ub = __float_as_uint(__builtin_amdgcn_fmed3f(b, -127.0f, 127.0f) + 12582912.0f);
    const unsigned uc = __float_as_uint(__builtin_amdgcn_fmed3f(c, -127.0f, 127.0f) + 12582912.0f), ud = __float_as_uint(__builtin_amdgcn_fmed3f(d, -127.0f, 127.0f) + 12582912.0f);
    return (ua & 0xffu) | ((ub & 0xffu) << 8) | ((uc & 0xffu) << 16) | (ud << 24); }
__device__ __forceinline__ unsigned pack4_fp8(float a, float b, float c, float d) {
    int w = __builtin_amdgcn_cvt_pk_fp8_f32(clamp448(a), clamp448(b), 0, false); w = __builtin_amdgcn_cvt_pk_fp8_f32(clamp448(c), clamp448(d), w, true); return (unsigned)w; }
struct EpiSwigluF8 {
    static constexpr bool PERM = true, AFTER_DRAIN = false;
    unsigned char* O; int ldc; float sin_, sout;
    __device__ __forceinline__ void operator()(const f32x4 (&acc)[2][2][4][2], const Unit& u, int wr, int wc, int fr, int fq) const {
        const int row0 = u.pm * BM + wr * 64 + fr, col0 = u.pn * HALF + wc * 32 + 8 * fq; const float c1 = -1.4426950408889634f * sin_, ik = 1.0f / (sin_ * sin_ * sout);
#pragma unroll
        for (int ai = 0; ai < 2; ++ai)
#pragma unroll
            for (int m = 0; m < 4; ++m) { unsigned char* rowp = O + (size_t)(row0 + ai * HALF + m * 16) * ldc + col0;
                float hv[8];
#pragma unroll
                for (int n = 0; n < 2; ++n)
#pragma unroll
                    for (int e = 0; e < 4; ++e) { const float ag = acc[ai][0][m][n][e], au = acc[ai][1][m][n][e];
                        hv[4 * n + e] = (ag * au) * __builtin_amdgcn_rcpf(__builtin_fmaf(__builtin_amdgcn_exp2f(ag * c1), ik, ik)); }
                typedef unsigned u32x2_ __attribute__((ext_vector_type(2)));
                *(u32x2_*)rowp = (u32x2_){pack4_fp8(hv[0], hv[1], hv[2], hv[3]), pack4_fp8(hv[4], hv[5], hv[6], hv[7])}; }
    }
};
struct EpiSwigluI8 {
    static constexpr bool PERM = true, AFTER_DRAIN = false;
    unsigned char* O; int ldc; const float* rsc; float wdq, sout;
    __device__ __forceinline__ void operator()(const f32x4 (&acc)[2][2][4][2], const Unit& u, int wr, int wc, int fr, int fq) const {
        const int row0 = u.pm * BM + wr * 64 + fr, col0 = u.pn * HALF + wc * 32 + 8 * fq;
        float rs[2][4];
#pragma unroll
        for (int ai = 0; ai < 2; ++ai)
#pragma unroll
            for (int m = 0; m < 4; ++m) rs[ai][m] = rsc[row0 + ai * HALF + m * 16];
#pragma unroll
        for (int ai = 0; ai < 2; ++ai)
#pragma unroll
            for (int m = 0; m < 4; ++m) { unsigned char* rowp = O + (size_t)(row0 + ai * HALF + m * 16) * ldc + col0;
                const float s = rs[ai][m] * wdq, c1 = -1.4426950408889634f * s, ik = __builtin_amdgcn_rcpf(s * s * sout);
                float hv[8];
#pragma unroll
                for (int n = 0; n < 2; ++n)
#pragma unroll
                    for (int e = 0; e < 4; ++e) { const f32x4 gq = acc[ai][0][m][n], uq = acc[ai][1][m][n]; const float ge = gq[e], ue = uq[e];
                        const float ag = (float)__float_as_int(ge), au = (float)__float_as_int(ue);
                        hv[4 * n + e] = (ag * au) * __builtin_amdgcn_rcpf(__builtin_fmaf(__builtin_amdgcn_exp2f(ag * c1), ik, ik)); }
                typedef unsigned u32x2_ __attribute__((ext_vector_type(2)));
                *(u32x2_*)rowp = (u32x2_){pack4_fp8(hv[0], hv[1], hv[2], hv[3]), pack4_fp8(hv[4], hv[5], hv[6], hv[7])}; }
    }
};
struct EpiBf16S {
    static constexpr bool PERM = true, AFTER_DRAIN = false;
    bf16_t* O; int ldc; float sc;
    __device__ __forceinline__ void operator()(const f32x4 (&acc)[2][2][4][2], const Unit& u, int wr, int wc, int fr, int fq) const {
        const int row0 = u.pm * BM + wr * 64 + fr, col0 = u.pn * BM + wc * 32 + 8 * fq;
#pragma unroll
        for (int ai = 0; ai < 2; ++ai)
#pragma unroll
            for (int m = 0; m < 4; ++m) { bf16_t* rowp = O + (size_t)(row0 + ai * HALF + m * 16) * ldc + col0;
#pragma unroll
                for (int bj = 0; bj < 2; ++bj) { const f32x4 v0 = acc[ai][bj][m][0] * sc, v1 = acc[ai][bj][m][1] * sc;
                    u32x4 w; w.x = cvt_pk_bf16(v0[0], v0[1]); w.y = cvt_pk_bf16(v0[2], v0[3]); w.z = cvt_pk_bf16(v1[0], v1[1]); w.w = cvt_pk_bf16(v1[2], v1[3]);
                    *(u32x4*)(rowp + bj * HALF) = w; } }
    }
};
struct EpiF8S {
    static constexpr bool PERM = true, AFTER_DRAIN = false;
    unsigned char* O; int ldc; float sc;
    __device__ __forceinline__ void operator()(const f32x4 (&acc)[2][2][4][2], const Unit& u, int wr, int wc, int fr, int fq) const {
        const int row0 = u.pm * BM + wr * 64 + fr, col0 = u.pn * BM + wc * 32 + 8 * fq;
        typedef unsigned u32x2_ __attribute__((ext_vector_type(2)));
#pragma unroll
        for (int ai = 0; ai < 2; ++ai)
#pragma unroll
            for (int m = 0; m < 4; ++m) { unsigned char* rowp = O + (size_t)(row0 + ai * HALF + m * 16) * ldc + col0;
#pragma unroll
                for (int bj = 0; bj < 2; ++bj) { const f32x4 v0 = acc[ai][bj][m][0] * sc, v1 = acc[ai][bj][m][1] * sc;
                    *(u32x2_*)(rowp + bj * HALF) = (u32x2_){pack4_fp8(v0[0], v0[1], v0[2], v0[3]), pack4_fp8(v1[0], v1[1], v1[2], v1[3])}; } }
    }
};
struct EpiUp {
    static constexpr bool PERM = true, AFTER_DRAIN = false;
    bf16_t* Q; bf16_t* K; bf16_t* V; const float* qg; const float* kg; const float* cosT; const float* sinT;
    __device__ __forceinline__ static float sum_fq(float s) {
        s += __int_as_float(__builtin_amdgcn_ds_swizzle(__float_as_int(s), (16 << 10) | 0x1f));
        auto rr = __builtin_amdgcn_permlane32_swap(__float_as_uint(s), __float_as_uint(s), false, false); return __uint_as_float(rr[0]) + __uint_as_float(rr[1]); }
    __device__ __forceinline__ void operator()(const f32x4 (&acc)[2][2][4][2], const Unit& u, int wr, int wc, int fr, int fq) const {
        const int t = u.pn, row0 = u.pm * BM + wr * 64 + fr; const float C2 = 0.10206207261596577f * 1.4426950408889634f, EPSN = 1e-6f;
        if (t >= 5) {
            const int col0 = (t - 5) * BM + wc * 32 + 8 * fq;
#pragma unroll
            for (int ai = 0; ai < 2; ++ai)
#pragma unroll
                for (int m = 0; m < 4; ++m) { bf16_t* rowp = V + (size_t)(row0 + ai * HALF + m * 16) * 512 + col0;
#pragma unroll
                    for (int bj = 0; bj < 2; ++bj) { const f32x4 v0 = acc[ai][bj][m][0], v1 = acc[ai][bj][m][1];
                        u32x4 w; w.x = cvt_pk_bf16(v0[0], v0[1]); w.y = cvt_pk_bf16(v0[2], v0[3]); w.z = cvt_pk_bf16(v1[0], v1[1]); w.w = cvt_pk_bf16(v1[2], v1[3]);
                        *(u32x4*)(rowp + bj * HALF) = w; } }
        } else if (t == 2) {
            const f32x4 g1 = *(const f32x4*)(qg + 64 + 4 * fq), g2 = *(const f32x4*)(qg + 80 + 4 * fq);
#pragma unroll
            for (int ai = 0; ai < 2; ++ai) {
                f32x4 csv[4], snv[4];
#pragma unroll
                for (int m = 0; m < 4; ++m) { const int row = row0 + ai * HALF + m * 16; csv[m] = *(const f32x4*)(cosT + (size_t)row * 16 + 4 * fq); snv[m] = *(const f32x4*)(sinT + (size_t)row * 16 + 4 * fq); }
                asm volatile("" ::: "memory");
#pragma unroll
                for (int m = 0; m < 4; ++m) { const int row = row0 + ai * HALF + m * 16;
                    const f32x4 cs = csv[m], sn = snv[m];
#pragma unroll
                    for (int bj = 0; bj < 2; ++bj) { const f32x4 x1 = acc[ai][bj][m][0], x2 = acc[ai][bj][m][1];
                        float ss = (x1[0] * x1[0] + x1[1] * x1[1]) + (x1[2] * x1[2] + x1[3] * x1[3]) + (x2[0] * x2[0] + x2[1] * x2[1]) + (x2[2] * x2[2] + x2[3] * x2[3]);
                        ss = sum_fq(ss); const float rs = __builtin_amdgcn_rsqf(ss * (1.0f / 32.0f) + EPSN);
                        const f32x4 a = x1 * rs * g1, b = x2 * rs * g2; const f32x4 o1 = (a * cs - b * sn) * C2, o2 = (a * sn + b * cs) * C2;
                        bf16_t* qp = Q + (size_t)row * 768 + (4 * bj + wc) * 96 + 64 + 4 * fq;
                        typedef unsigned u32x2_ __attribute__((ext_vector_type(2)));
                        *(u32x2_*)qp = (u32x2_){cvt_pk_bf16(o1[0], o1[1]), cvt_pk_bf16(o1[2], o1[3])}; *(u32x2_*)(qp + 16) = (u32x2_){cvt_pk_bf16(o2[0], o2[1]), cvt_pk_bf16(o2[2], o2[3])}; } } }
        } else {
            const bool isq = t < 2; const int head = 4 * (isq ? t : t - 3) + wc; const float* g = isq ? qg : kg; bf16_t* dst = isq ? Q : K; const float sc = isq ? C2 : 1.0f;
            f32x4 gv[2][2];
#pragma unroll
            for (int bj = 0; bj < 2; ++bj)
#pragma unroll
                for (int n = 0; n < 2; ++n) gv[bj][n] = *(const f32x4*)(g + 32 * bj + 8 * fq + 4 * n);
#pragma unroll
            for (int ai = 0; ai < 2; ++ai)
#pragma unroll
                for (int m = 0; m < 4; ++m) { const int row = row0 + ai * HALF + m * 16; float ss = 0.f;
#pragma unroll
                    for (int bj = 0; bj < 2; ++bj)
#pragma unroll
                        for (int n = 0; n < 2; ++n) { const f32x4 x = acc[ai][bj][m][n]; ss += (x[0] * x[0] + x[1] * x[1]) + (x[2] * x[2] + x[3] * x[3]); }
                    ss = sum_fq(ss); const float rs = sc / __builtin_sqrtf(ss * (1.0f / 64.0f) + EPSN);
                    bf16_t* rowp = dst + (size_t)row * 768 + head * 96 + 8 * fq;
#pragma unroll
                    for (int bj = 0; bj < 2; ++bj) { const f32x4 v0 = acc[ai][bj][m][0] * rs * gv[bj][0], v1 = acc[ai][bj][m][1] * rs * gv[bj][1];
                        u32x4 w; w.x = cvt_pk_bf16(v0[0], v0[1]); w.y = cvt_pk_bf16(v0[2], v0[3]); w.z = cvt_pk_bf16(v1[0], v1[1]); w.w = cvt_pk_bf16(v1[2], v1[3]);
                        *(u32x4*)(rowp + 32 * bj) = w; } }
        }
    }
};
template <class Epi, class Sched, bool ALIGN_EPI = false, bool SP2 = false, bool F8 = false, bool I8 = false>
__device__ __forceinline__ void gemm_phase(PG8_LAS unsigned char* lds, const Gemm g, const Sched& S, const Epi& E) {
    int tid_ = threadIdx.x; asm volatile("" : "+v"(tid_));
    const int tid = tid_, wid = __builtin_amdgcn_readfirstlane(tid >> 6), lane = tid & 63, wr = wid >> 2, wc = wid & 3, fr = lane & 15, fq = lane >> 4;
    const int K = g.K, nt = K / BK;
    unsigned voffA[2], voffB[2];
#pragma unroll
    for (int i = 0; i < 2; ++i) { int R, C; stage_rc(tid * 16 + i * 8192, R, C); const int Rb = Epi::PERM ? ((R & ~31) + perm32(R & 31)) : R;
        voffA[i] = (unsigned)(R * K + C) * 2u; voffB[i] = (unsigned)(Rb * K + C) * 2u; }
    const size_t kstep = (size_t)(BK * 2);
    const size_t hstep = (size_t)HALF * K * 2;
    const size_t tstep = 2 * hstep;
    const unsigned ldsw = (unsigned)wid * 1024u;
    const int aoff = lds_byte(wr * 64 + fr, fq * 8), boff = lds_byte(wc * 32 + fr, fq * 8);
#define PG8_SA(b, h) (((b) * 2 + (h)) * HTB)
#define PG8_SB(b, h) ((4 + (b) * 2 + (h)) * HTB)
#define PG8_STAGE(bufoff, gbase, voff) do { _Pragma("unroll") for (int _i = 0; _i < 2; ++_i) \
        __builtin_amdgcn_global_load_lds((const unsigned*)((const char*)(gbase) + (voff)[_i]), (PG8_LAS unsigned*)(lds + (bufoff) + ldsw + _i * 8192), 16, 0, 0); } while (0)
#define PG8_LDA(dst, b, h) do { _Pragma("unroll") for (int m = 0; m < 4; ++m) _Pragma("unroll") for (int k = 0; k < 2; ++k) dst[m][k] = *(const PG8_LAS bf16x8*)(lds + PG8_SA(b, h) + aoff + m * 2048 + k * 1024); } while (0)
#define PG8_LDB(dst, b, h) do { _Pragma("unroll") for (int n = 0; n < 2; ++n) _Pragma("unroll") for (int k = 0; k < 2; ++k) dst[n][k] = *(const PG8_LAS bf16x8*)(lds + PG8_SB(b, h) + boff + n * 2048 + k * 1024); } while (0)
#define PG8_CAT(x0, x1) __builtin_shufflevector(__builtin_bit_cast(i32x4_, x0), __builtin_bit_cast(i32x4_, x1), 0, 1, 2, 3, 4, 5, 6, 7)
#define PG8_MMA(ai, bj, At, Bt) do { __builtin_amdgcn_s_setprio(1); \
        if constexpr (I8) { _Pragma("unroll") for (int k = 0; k < 2; ++k) _Pragma("unroll") for (int m = 0; m < 4; ++m) _Pragma("unroll") for (int n = 0; n < 2; ++n) \
            asm volatile("v_mfma_i32_16x16x64_i8 %0, %1, %2, %0" : "+v"(acc[ai][bj][m][n]) : "v"(Bt[n][k]), "v"(At[m][k])); } \
        else { _Pragma("unroll") for (int m = 0; m < 4; ++m) _Pragma("unroll") for (int n = 0; n < 2; ++n) { \
        if constexpr (F8) asm volatile("v_mfma_f32_16x16x128_f8f6f4 %0, %1, %2, %0" : "+v"(acc[ai][bj][m][n]) : "v"(PG8_CAT(Bt[n][0], Bt[n][1])), "v"(PG8_CAT(At[m][0], At[m][1])));     \
        else { _Pragma("unroll") for (int k = 0; k < 2; ++k) acc[ai][bj][m][n] = __builtin_amdgcn_mfma_f32_16x16x32_bf16(Bt[n][k], At[m][k], acc[ai][bj][m][n], 0, 0, 0); } } } __builtin_amdgcn_s_setprio(0); } while (0)
#define PG8_MMA0(ai, bj, At, Bt) do { __builtin_amdgcn_s_setprio(1); \
        if constexpr (I8) { _Pragma("unroll") for (int m = 0; m < 4; ++m) _Pragma("unroll") for (int n = 0; n < 2; ++n) asm volatile("v_mfma_i32_16x16x64_i8 %0, %1, %2, 0" : "=&v"(acc[ai][bj][m][n]) : "v"(Bt[n][0]), "v"(At[m][0])); \
            _Pragma("unroll") for (int m = 0; m < 4; ++m) _Pragma("unroll") for (int n = 0; n < 2; ++n) asm volatile("v_mfma_i32_16x16x64_i8 %0, %1, %2, %0" : "+v"(acc[ai][bj][m][n]) : "v"(Bt[n][1]), "v"(At[m][1])); } \
        else { _Pragma("unroll") for (int m = 0; m < 4; ++m) _Pragma("unroll") for (int n = 0; n < 2; ++n) \
            asm volatile("v_mfma_f32_16x16x128_f8f6f4 %0, %1, %2, 0" : "=&v"(acc[ai][bj][m][n]) : "v"(PG8_CAT(Bt[n][0], Bt[n][1])), "v"(PG8_CAT(At[m][0], At[m][1]))); } \
        __builtin_amdgcn_s_setprio(0); } while (0)
#define PG8_MMAZ(ai, bj, At, Bt) do { if (F8 && t == 0) PG8_MMA0(ai, bj, At, Bt); else PG8_MMA(ai, bj, At, Bt); } while (0)
#define PG8_WAIT_V(n) asm volatile("s_waitcnt vmcnt(" #n ")" ::: "memory")
#define PG8_WAIT_L(n) asm volatile("s_waitcnt lgkmcnt(" #n ")" ::: "memory")
#define PG8_BAR __builtin_amdgcn_s_barrier()
#define PG8_SCHED __builtin_amdgcn_sched_barrier(0)
    Unit cur, nxt; int ui = 0;
    if (!S.next(0, cur)) return;
    f32x4 acc[2][2][4][2];
    if constexpr (!F8) {
#pragma unroll
    for (int a = 0; a < 2; ++a)
#pragma unroll
        for (int b = 0; b < 2; ++b)
#pragma unroll
            for (int m = 0; m < 4; ++m)
#pragma unroll
                for (int n = 0; n < 2; ++n) acc[a][b][m][n] = (f32x4){0.f, 0.f, 0.f, 0.f}; }
    bf16x8 At[4][2], B0[2][2], B1[2][2];
    const char* cA = (const char*)g.A + (size_t)cur.pa * tstep; const char* cB = (const char*)g.Bt + (size_t)cur.pb * tstep;
    S.a_ready(cur);
    if constexpr (SP2) {
        PG8_STAGE(PG8_SB(0, 0), cB, voffB); PG8_STAGE(PG8_SB(0, 1), cB + hstep, voffB); PG8_STAGE(PG8_SA(0, 0), cA, voffA); PG8_STAGE(PG8_SA(0, 1), cA + hstep, voffA);
        if (wr == 1) PG8_BAR;
        PG8_WAIT_V(2); PG8_BAR;
        PG8_STAGE(PG8_SB(1, 0), cB + kstep, voffB); PG8_STAGE(PG8_SA(1, 0), cA + kstep, voffA); PG8_STAGE(PG8_SB(1, 1), cB + hstep + kstep, voffB);
        PG8_WAIT_V(6); PG8_BAR;
    } else {
        PG8_STAGE(PG8_SB(0, 0), cB, voffB); PG8_STAGE(PG8_SA(0, 0), cA, voffA); PG8_STAGE(PG8_SB(0, 1), cB + hstep, voffB); PG8_STAGE(PG8_SA(0, 1), cA + hstep, voffA);
        if (wr == 1) PG8_BAR;
        PG8_WAIT_V(4); PG8_BAR;
        PG8_STAGE(PG8_SB(1, 0), cB + kstep, voffB); PG8_STAGE(PG8_SA(1, 0), cA + kstep, voffA); PG8_STAGE(PG8_SB(1, 1), cB + hstep + kstep, voffB);
        PG8_WAIT_V(6); PG8_BAR;
    }
    for (;;) {
        const bool has_next = S.next(ui + 1, nxt);
        const char* nA = has_next ? (const char*)g.A + (size_t)nxt.pa * tstep : cA; const char* nB = has_next ? (const char*)g.Bt + (size_t)nxt.pb * tstep : cB;
        const int ntu = S.ktiles(cur, nt);
        for (int t = 0; t < ntu; t += 2) {
            const bool last = (t == ntu - 2);
            const char* a1 = cA + (size_t)(t + 1) * kstep;
            const char* a2 = last ? nA : cA + (size_t)(t + 2) * kstep; const char* b2 = last ? nB : cB + (size_t)(t + 2) * kstep;
            const char* a3 = a2 + kstep; const char* b3 = b2 + kstep;
            if (last && has_next) S.a_ready(nxt);
            if constexpr (SP2) {
            PG8_LDB(B0, 0, 0); PG8_LDB(B1, 0, 1); PG8_SCHED; PG8_LDA(At, 0, 0); PG8_STAGE(PG8_SA(1, 1), a1 + hstep, voffA);
            PG8_WAIT_V(8); PG8_WAIT_L(0); PG8_BAR; PG8_MMAZ(0, 0, At, B0); PG8_MMAZ(0, 1, At, B1); PG8_BAR; PG8_SCHED;
            PG8_LDA(At, 0, 1); PG8_STAGE(PG8_SB(0, 0), b2, voffB); PG8_STAGE(PG8_SB(0, 1), b2 + hstep, voffB); PG8_STAGE(PG8_SA(0, 0), a2, voffA);
            PG8_WAIT_V(8); PG8_WAIT_L(0); PG8_BAR; PG8_MMAZ(1, 0, At, B0); PG8_MMAZ(1, 1, At, B1); PG8_BAR; PG8_SCHED;
            PG8_LDB(B0, 1, 0); PG8_LDB(B1, 1, 1); PG8_SCHED; PG8_LDA(At, 1, 0); PG8_STAGE(PG8_SA(0, 1), a2 + hstep, voffA);
            PG8_WAIT_V(8); PG8_WAIT_L(0); PG8_BAR; PG8_MMA(0, 0, At, B0); PG8_MMA(0, 1, At, B1); PG8_BAR; PG8_SCHED;
            PG8_LDA(At, 1, 1); PG8_STAGE(PG8_SB(1, 0), b3, voffB); PG8_STAGE(PG8_SB(1, 1), b3 + hstep, voffB); PG8_STAGE(PG8_SA(1, 0), a3, voffA);
            PG8_WAIT_V(8); PG8_WAIT_L(0); PG8_BAR; PG8_MMA(1, 0, At, B0); PG8_MMA(1, 1, At, B1); PG8_BAR; PG8_SCHED;
            } else {
            PG8_LDB(B0, 0, 0); PG8_SCHED; PG8_LDA(At, 0, 0); PG8_STAGE(PG8_SA(1, 1), a1 + hstep, voffA);
            PG8_WAIT_L(8); PG8_BAR; PG8_WAIT_L(0); PG8_MMAZ(0, 0, At, B0); PG8_BAR; PG8_SCHED;
            PG8_LDB(B1, 0, 1); PG8_STAGE(PG8_SB(0, 0), b2, voffB);
            PG8_BAR; PG8_WAIT_L(0); PG8_MMAZ(0, 1, At, B1); PG8_BAR;
            PG8_LDA(At, 0, 1); PG8_STAGE(PG8_SA(0, 0), a2, voffA);
            PG8_BAR; PG8_WAIT_L(0); PG8_MMAZ(1, 0, At, B0); PG8_BAR; PG8_SCHED;
            PG8_STAGE(PG8_SB(0, 1), b2 + hstep, voffB);
            PG8_WAIT_V(6); PG8_BAR; PG8_MMAZ(1, 1, At, B1); PG8_BAR;
            PG8_LDB(B0, 1, 0); PG8_SCHED; PG8_LDA(At, 1, 0); PG8_STAGE(PG8_SA(0, 1), a2 + hstep, voffA);
            PG8_WAIT_L(8); PG8_BAR; PG8_WAIT_L(0); PG8_MMA(0, 0, At, B0); PG8_BAR; PG8_SCHED;
            PG8_LDB(B1, 1, 1); PG8_STAGE(PG8_SB(1, 0), b3, voffB);
            PG8_BAR; PG8_WAIT_L(0); PG8_MMA(0, 1, At, B1); PG8_BAR;
            PG8_LDA(At, 1, 1); PG8_STAGE(PG8_SA(1, 0), a3, voffA);
            PG8_BAR; PG8_WAIT_L(0); PG8_MMA(1, 0, At, B0); PG8_BAR; PG8_SCHED;
            PG8_STAGE(PG8_SB(1, 1), b3 + hstep, voffB);
            PG8_WAIT_V(6); PG8_BAR; PG8_MMA(1, 1, At, B1); PG8_BAR;
            }
        }
        if constexpr (ALIGN_EPI) { if (wr == 0) PG8_BAR; }
        if constexpr (F8) asm volatile("s_nop 15\n\ts_nop 15" ::: "memory");
        if constexpr (!Epi::AFTER_DRAIN) { E(acc, cur, wr, wc, fr, fq); S.done(cur); }
        if (!has_next) break;
        if constexpr (!F8) {
#pragma unroll
        for (int a = 0; a < 2; ++a)
#pragma unroll
            for (int b = 0; b < 2; ++b)
#pragma unroll
                for (int m = 0; m < 4; ++m)
#pragma unroll
                    for (int n = 0; n < 2; ++n) acc[a][b][m][n] = (f32x4){0.f, 0.f, 0.f, 0.f}; }
        cur = nxt; cA = nA; cB = nB; ++ui;
        if constexpr (ALIGN_EPI) { if (wr == 1) PG8_BAR; }
    }
    PG8_WAIT_V(0);
    if constexpr (!ALIGN_EPI) { if (wr == 0) PG8_BAR; }
    PG8_BAR;
    if constexpr (Epi::AFTER_DRAIN) { E.fused(acc, cur, wr, wc, fr, fq, lds, wid, lane); S.done(cur); }
#undef PG8_SA
#undef PG8_SB
#undef PG8_STAGE
#undef PG8_LDA
#undef PG8_LDB
#undef PG8_MMA
#undef PG8_MMA0
#undef PG8_MMAZ
#undef PG8_CAT
#undef PG8_WAIT_V
#undef PG8_WAIT_L
#undef PG8_BAR
#undef PG8_SCHED
}
}

#define GAS __attribute__((address_space(1)))
#define LAS __attribute__((address_space(3)))
typedef unsigned short bf16;
typedef unsigned v4u __attribute__((ext_vector_type(4)));
typedef unsigned v2u __attribute__((ext_vector_type(2)));
typedef float f32x4 __attribute__((ext_vector_type(4)));
typedef short bf16x8 __attribute__((ext_vector_type(8)));
typedef GAS unsigned gu32;
typedef GAS unsigned long long gu64;
#define RLX_AGENT __ATOMIC_RELAXED, __HIP_MEMORY_SCOPE_AGENT
#define LDS_WAIT() asm volatile("s_waitcnt lgkmcnt(0)" ::: "memory")
#define VM_WAIT() asm volatile("s_waitcnt vmcnt(0)" ::: "memory")
__device__ __forceinline__ unsigned long long rt() { return __builtin_amdgcn_s_memrealtime(); }
__device__ __forceinline__ unsigned f2bf(float f) { unsigned u = __builtin_bit_cast(unsigned, f); return (u + 0x7fffu + ((u >> 16) & 1u)) >> 16; }
__device__ __forceinline__ unsigned pk2(float lo, float hi) { return f2bf(lo) | (f2bf(hi) << 16); }

#define XB_TMO      128
#define XB_XCNT(j)  (256  + 64 * (j))
#define XB_XSUB(j)  (1280 + 64 * (j))
#define XB_XGEN(j)  (2304 + 64 * (j))
#define XB_TOP      3328
#define XB_TOPGEN   3392
#define XCD_BAR_WORDS 3456
#define XB_SPIN_CAP (1u << 18)

__device__ __forceinline__ unsigned xb_ld(unsigned* p)              { return __hip_atomic_load(p, __ATOMIC_RELAXED, __HIP_MEMORY_SCOPE_AGENT); }
__device__ __forceinline__ unsigned xb_add(unsigned* p, unsigned v) { return __hip_atomic_fetch_add(p, v, __ATOMIC_RELAXED, __HIP_MEMORY_SCOPE_AGENT); }
__device__ __forceinline__ unsigned xb_xcc_id() { return (unsigned)__builtin_amdgcn_s_getreg((3 << 11) | 20) & 0xFu; }
#define XB_SPIN(cond, bar) do { unsigned _sp = 0; while (cond) { __builtin_amdgcn_s_sleep(1); \
    if ((++_sp & 255u) == 0u) { if (xb_ld(&(bar)[XB_TMO])) break; if (_sp > XB_SPIN_CAP) { atomicAdd(&(bar)[XB_TMO], 1u); break; } } } } while (0)

struct XcdBarrier {
    unsigned* bar; unsigned x;
    volatile LAS unsigned* st;
};

__device__ __forceinline__ XcdBarrier xcd_barrier_post(unsigned* bar, volatile LAS unsigned* st) {
    XcdBarrier b; b.bar = bar; b.x = xb_xcc_id(); b.st = st;
    if (threadIdx.x == 0) (void)xb_add(&bar[XB_XCNT(b.x)], 1u);
    return b;
}
__device__ __forceinline__ void xcd_barrier_complete(unsigned* bar, unsigned x, unsigned& nloc, unsigned& nx) {
    const unsigned G = gridDim.x * gridDim.y * gridDim.z;
    unsigned sum, cnt, mine, sp = 0u;
    for (;;) {
        sum = 0u; cnt = 0u; mine = 0u;
#pragma unroll
        for (unsigned j = 0; j < 16; ++j) { const unsigned c = xb_ld(&bar[XB_XCNT(j)]); sum += c; cnt += (c > 0u) ? 1u : 0u; mine = (j == x) ? c : mine; }
        if (sum == G) break;
        __builtin_amdgcn_s_sleep(1);
        if ((++sp & 255u) == 0u) { if (xb_ld(&bar[XB_TMO])) break; if (sp > XB_SPIN_CAP) { atomicAdd(&bar[XB_TMO], 1u); break; } }
    }
    nloc = mine > 0u ? mine : 1u; nx = cnt > 0u ? cnt : 1u;
}

__device__ __forceinline__ void xcd_barrier(const XcdBarrier& b) {
    asm volatile("s_waitcnt vmcnt(0)" ::: "memory");
    __syncthreads();
    unsigned tid0_ = threadIdx.x; asm volatile("" : "+v"(tid0_));
    if (tid0_ == 0) {
        unsigned* bar = b.bar; unsigned bx = b.x;
        asm volatile("" : "+s"(bar), "+s"(bx));
        __builtin_amdgcn_s_waitcnt(0);
        unsigned nloc = b.st[0], nx = b.st[1];
        if (nloc == 0u) { xcd_barrier_complete(bar, bx, nloc, nx); b.st[0] = nloc; b.st[1] = nx; }
        const unsigned old = xb_add(&bar[XB_XSUB(bx)], 1u);
        const unsigned gen = old / nloc;
        if (old + 1u == (gen + 1u) * nloc) {
            __builtin_amdgcn_fence(__ATOMIC_RELEASE, "agent");
            asm volatile("s_waitcnt vmcnt(0)" ::: "memory");
            const unsigned og = xb_add(&bar[XB_TOP], 1u);
            const unsigned tg = og / nx;
            if (og + 1u == (tg + 1u) * nx) xb_add(&bar[XB_TOPGEN], 1u);
            else XB_SPIN(xb_ld(&bar[XB_TOPGEN]) == tg, bar);
            __builtin_amdgcn_fence(__ATOMIC_ACQUIRE, "agent");
            xb_add(&bar[XB_XGEN(bx)], 1u);
            asm volatile("s_waitcnt vmcnt(0)" ::: "memory");
        } else {
            XB_SPIN(xb_ld(&bar[XB_XGEN(bx)]) == gen, bar);
            __builtin_amdgcn_fence(__ATOMIC_ACQUIRE, "agent");
            asm volatile("s_waitcnt vmcnt(0)" ::: "memory");
        }
    }
    __syncthreads();
}

namespace att_online {
#define ALAS __attribute__((address_space(3)))
typedef unsigned short bf16;
typedef short bf16x8 __attribute__((ext_vector_type(8)));
typedef short s16x4 __attribute__((ext_vector_type(4)));
typedef float f32x16 __attribute__((ext_vector_type(16)));
typedef unsigned u32x4 __attribute__((ext_vector_type(4)));
constexpr int SEQ = 16384, NHEAD = 8;
constexpr int QP = 768, KP = 768, VP = 512, OP = 1024;
constexpr int QHS = 96, KHS = 96, VHS = 64, OHS = 64;
constexpr int NW = 8, QBLK = 32, QB = QBLK * NW, KVBLK = 64, NQB = SEQ / QB;
constexpr int KSLOT = 12288, VSLOT = 8192;
constexpr int L_K = 0, L_V = 2 * KSLOT, L_WS = L_V + 2 * VSLOT, L_OST = L_WS + NW * 64 * 4, L_BYTES = L_OST + NW * 4096;
constexpr float THR = 8.0f;
__device__ __forceinline__ int crow(int r, int hi) { return (r & 3) + 8 * (r >> 2) + 4 * hi; }
__device__ __forceinline__ unsigned cvtpk(float lo, float hi) { unsigned r; asm volatile("v_cvt_pk_bf16_f32 %0, %1, %2" : "=v"(r) : "v"(lo), "v"(hi)); return r; }
__device__ __forceinline__ float pswap_max(float m) { auto rr = __builtin_amdgcn_permlane32_swap(__float_as_uint(m), __float_as_uint(m), false, false); return __builtin_fmaxf(__uint_as_float(rr[0]), __uint_as_float(rr[1])); }
__device__ __forceinline__ float pswap_sum(float m) { auto rr = __builtin_amdgcn_permlane32_swap(__float_as_uint(m), __float_as_uint(m), false, false); return __uint_as_float(rr[0]) + __uint_as_float(rr[1]); }

__device__ __forceinline__ void attn_unit(int b, int h, int qb, const bf16* Q, const bf16* K, const bf16* V, bf16* O, ALAS unsigned char* shm) {
    int tid_ = threadIdx.x; asm volatile("" : "+v"(tid_));
    const int tid = tid_, lane = tid & 63, r32 = lane & 31, hi = lane >> 5; const int wid = __builtin_amdgcn_readfirstlane(tid >> 6);
    const long rowbase = (long)b * SEQ; const int q0 = qb * QB;
    const bf16* Qw = Q + (rowbase + q0 + wid * QBLK) * QP + h * QHS;
    const bf16* Kh = K + rowbase * KP + h * KHS; const bf16* Vh = V + rowbase * VP + h * VHS;
    ALAS float* wsf = (ALAS float*)(shm + L_WS) + wid * 64;
    const bf16* ksrc = Kh + (long)lane * KP + wid * 8;
    const bf16* vsrc = Vh + (long)(16 * (wid & 3) + (lane >> 2)) * VP + (wid >> 2) * 32 + (lane & 3) * 8;
#define ATT_DMA(t, slot) do { \
        __builtin_amdgcn_global_load_lds((const unsigned*)(ksrc + (long)(t) * KVBLK * KP), (ALAS unsigned*)(shm + L_K + (slot) * KSLOT + wid * 1024), 16, 0, 0); \
        if (wid < 4) __builtin_amdgcn_global_load_lds((const unsigned*)(ksrc + (long)(t) * KVBLK * KP + 64), (ALAS unsigned*)(shm + L_K + (slot) * KSLOT + (8 + wid) * 1024), 16, 0, 0); \
        __builtin_amdgcn_global_load_lds((const unsigned*)(vsrc + (long)(t) * KVBLK * VP), (ALAS unsigned*)(shm + L_V + (slot) * VSLOT + wid * 1024), 16, 0, 0); } while (0)
    const int NT = (q0 + QB) / KVBLK;
    ATT_DMA(0, 0);
    bf16x8 qr[6];
#pragma unroll
    for (int d0 = 0; d0 < 6; ++d0) qr[d0] = *(const bf16x8*)(Qw + (long)r32 * QP + d0 * 16 + hi * 8);
    float mhat = 0.f, l_reg = 0.f; f32x16 o[2], negm;
#pragma unroll
    for (int r = 0; r < 16; ++r) { o[0][r] = 0.f; o[1][r] = 0.f; negm[r] = 0.f; }
    const int qrel = wid * QBLK + r32;
    const unsigned vb0 = (unsigned)(uintptr_t)(shm + L_V) + ((lane >> 4) & 1) * 32 + (lane & 3) * 8 + (4 * hi + ((lane & 15) >> 2)) * 64;
    for (int t = 0; t < NT; ++t) {
        const int cur = t & 1;
        asm volatile("s_waitcnt vmcnt(0)" ::: "memory"); __syncthreads();
        if (t + 1 < NT) ATT_DMA(t + 1, cur ^ 1);
        f32x16 p0, p1;
        { const ALAS unsigned char* kb = shm + L_K + cur * KSLOT + hi * 1024 + r32 * 16;
#pragma unroll
          for (int d0 = 0; d0 < 6; ++d0) {
              const bf16x8 b0 = *(const ALAS bf16x8*)(kb + d0 * 2048), b1 = *(const ALAS bf16x8*)(kb + d0 * 2048 + 512);
              if (d0 == 0) { p0 = __builtin_amdgcn_mfma_f32_32x32x16_bf16(b0, qr[0], negm, 0, 0, 0); p1 = __builtin_amdgcn_mfma_f32_32x32x16_bf16(b1, qr[0], negm, 0, 0, 0); }
              else { p0 = __builtin_amdgcn_mfma_f32_32x32x16_bf16(b0, qr[d0], p0, 0, 0, 0); p1 = __builtin_amdgcn_mfma_f32_32x32x16_bf16(b1, qr[d0], p1, 0, 0, 0); } } }
        const int jb = t - (NT - 4);
        if (jb >= 0) { const int kb0 = 64 * jb + 4 * hi;
#pragma unroll
            for (int r = 0; r < 16; ++r) { const int kv = kb0 + (r & 3) + 8 * (r >> 2); if (kv > qrel) p0[r] = -__builtin_inff(); if (kv + 32 > qrel) p1[r] = -__builtin_inff(); } }
        float rm = __builtin_fmaxf(p0[0], p1[0]);
#pragma unroll
        for (int r = 1; r < 16; ++r) rm = __builtin_fmaxf(rm, __builtin_fmaxf(p0[r], p1[r]));
        rm = pswap_max(rm);
        bool resc = false;
        if (t == 0 || __any(rm > THR)) {
            const float dl = (t == 0) ? rm : __builtin_fmaxf(rm, 0.f); mhat += dl;
#pragma unroll
            for (int r = 0; r < 16; ++r) { p0[r] -= dl; p1[r] -= dl; negm[r] = -mhat; }
            if (t != 0) { const float f = __builtin_amdgcn_exp2f(-dl); l_reg *= f; if (hi == 0) wsf[r32] = f; resc = true; }
        }
        float sacc = 0.f;
#pragma unroll
        for (int r = 0; r < 16; ++r) { p0[r] = __builtin_amdgcn_exp2f(p0[r]); p1[r] = __builtin_amdgcn_exp2f(p1[r]); sacc += p0[r] + p1[r]; }
        l_reg += sacc;
        if (resc) { asm volatile("s_waitcnt lgkmcnt(0)" ::: "memory");
#pragma unroll
            for (int r = 0; r < 16; ++r) { const float f = wsf[crow(r, hi)]; o[0][r] *= f; o[1][r] *= f; }
            asm volatile("s_waitcnt lgkmcnt(0)" ::: "memory"); }
        u32x4 pw[4];
#pragma unroll
        for (int k = 0; k < 2; ++k) { pw[k] = (u32x4){cvtpk(p0[8 * k], p0[8 * k + 1]), cvtpk(p0[8 * k + 2], p0[8 * k + 3]), cvtpk(p0[8 * k + 4], p0[8 * k + 5]), cvtpk(p0[8 * k + 6], p0[8 * k + 7])};
            pw[2 + k] = (u32x4){cvtpk(p1[8 * k], p1[8 * k + 1]), cvtpk(p1[8 * k + 2], p1[8 * k + 3]), cvtpk(p1[8 * k + 4], p1[8 * k + 5]), cvtpk(p1[8 * k + 6], p1[8 * k + 7])}; }
        { const unsigned vb = vb0 + cur * VSLOT;
#pragma unroll
          for (int d0 = 0; d0 < 2; ++d0) { s16x4 lo[4], hh[4];
#pragma unroll
              for (int ks = 0; ks < 4; ++ks) {
                  asm volatile("ds_read_b64_tr_b16 %0, %1 offset:%c2" : "=&v"(lo[ks]) : "v"(vb), "i"(d0 * 4096 + ks * 1024) : "memory");
                  asm volatile("ds_read_b64_tr_b16 %0, %1 offset:%c2" : "=&v"(hh[ks]) : "v"(vb), "i"(d0 * 4096 + ks * 1024 + 512) : "memory"); }
              asm volatile("s_waitcnt lgkmcnt(0)" : "+v"(lo[0]), "+v"(lo[1]), "+v"(lo[2]), "+v"(lo[3]), "+v"(hh[0]), "+v"(hh[1]), "+v"(hh[2]), "+v"(hh[3]) :: "memory");
#pragma unroll
              for (int ks = 0; ks < 4; ++ks) { const bf16x8 vf = (bf16x8){lo[ks][0], lo[ks][1], lo[ks][2], lo[ks][3], hh[ks][0], hh[ks][1], hh[ks][2], hh[ks][3]};
                  o[d0] = __builtin_amdgcn_mfma_f32_32x32x16_bf16(__builtin_bit_cast(bf16x8, pw[ks]), vf, o[d0], 0, 0, 0); } } }
    }
    l_reg = pswap_sum(l_reg);
    if (hi == 0) wsf[32 + r32] = l_reg;
    asm volatile("s_waitcnt lgkmcnt(0)" ::: "memory");
    float rli[16];
#pragma unroll
    for (int r = 0; r < 16; ++r) rli[r] = __builtin_amdgcn_rcpf(wsf[32 + crow(r, hi)]);
    bf16* Ow = O + (rowbase + q0 + wid * QBLK) * OP + h * OHS;
    { ALAS bf16* stg = (ALAS bf16*)(shm + L_OST) + wid * 2048;
#pragma unroll
      for (int r = 0; r < 16; ++r) { const int orow = crow(r, hi);
#pragma unroll
          for (int d0 = 0; d0 < 2; ++d0) { const float v = o[d0][r] * rli[r]; unsigned u = __float_as_uint(v); u = (u + 0x7fffu + ((u >> 16) & 1u)) >> 16; stg[orow * 64 + d0 * 32 + r32] = (bf16)u; } }
      asm volatile("s_waitcnt lgkmcnt(0)" ::: "memory");
#pragma unroll
      for (int i = 0; i < 4; ++i) { const int row = i * 8 + (lane >> 3), ch = lane & 7; const u32x4 v = *(const ALAS u32x4*)(stg + row * 64 + ch * 8); *(u32x4*)(Ow + (long)row * OP + ch * 8) = v; } }
    asm volatile("s_waitcnt lgkmcnt(0)" ::: "memory"); __syncthreads();
#undef ATT_DMA
}
#undef ALAS
}

namespace att {
#define ALAS __attribute__((address_space(3)))
typedef unsigned short bf16;
typedef short bf16x8 __attribute__((ext_vector_type(8)));
typedef short s16x4 __attribute__((ext_vector_type(4)));
typedef float f32x16 __attribute__((ext_vector_type(16)));
typedef unsigned u32x4 __attribute__((ext_vector_type(4)));
constexpr int SEQ = 16384, NHEAD = 8;
constexpr int QP = 768, KP = 768, VP = 512, OP = 1024;
constexpr int QHS = 96, KHS = 96, VHS = 64, OHS = 64;
constexpr int NW = 8, QBLK = 32, QB = QBLK * NW, KVBLK = 64, NQB = SEQ / QB;
constexpr int KSLOT = 12288, VSLOT = 8192;
constexpr int L_K = 0, L_V = 2 * KSLOT, L_WS = L_V + 3 * VSLOT, L_OST = L_WS + NW * 64 * 4, L_BYTES = L_OST + NW * 4096;
constexpr float THR = 8.0f;
__device__ __forceinline__ int crow(int r, int hi) { return (r & 3) + 8 * (r >> 2) + 4 * hi; }
__device__ __forceinline__ unsigned cvtpk(float lo, float hi) { typedef float f32x2_t __attribute__((ext_vector_type(2))); typedef __bf16 bf16x2_t __attribute__((ext_vector_type(2)));
    f32x2_t v = {lo, hi}; bf16x2_t b = __builtin_convertvector(v, bf16x2_t); return __builtin_bit_cast(unsigned, b); }
__device__ __forceinline__ float pswap_max(float m) { auto rr = __builtin_amdgcn_permlane32_swap(__float_as_uint(m), __float_as_uint(m), false, false); return __builtin_fmaxf(__uint_as_float(rr[0]), __uint_as_float(rr[1])); }
__device__ __forceinline__ float pswap_sum(float m) { auto rr = __builtin_amdgcn_permlane32_swap(__float_as_uint(m), __float_as_uint(m), false, false); return __uint_as_float(rr[0]) + __uint_as_float(rr[1]); }
typedef short v4i16_t __attribute__((ext_vector_type(4)));
__device__ __forceinline__ s16x4 vtr(const ALAS unsigned char* p) { return __builtin_bit_cast(s16x4, __builtin_amdgcn_ds_read_tr16_b64_v4i16((ALAS v4i16_t*)p)); }
__device__ __forceinline__ void qkt(f32x16& s0, f32x16& s1, const ALAS unsigned char* kb, const bf16x8 (&qr)[6]) {
    const f32x16 c0 = {};
#pragma unroll
    for (int d0 = 0; d0 < 6; ++d0) {
        const bf16x8 b0 = *(const ALAS bf16x8*)(kb + d0 * 2048), b1 = *(const ALAS bf16x8*)(kb + d0 * 2048 + 512);
        if (d0 == 0) { s0 = __builtin_amdgcn_mfma_f32_32x32x16_bf16(b0, qr[0], c0, 0, 0, 0); s1 = __builtin_amdgcn_mfma_f32_32x32x16_bf16(b1, qr[0], c0, 0, 0, 0); }
        else { s0 = __builtin_amdgcn_mfma_f32_32x32x16_bf16(b0, qr[d0], s0, 0, 0, 0); s1 = __builtin_amdgcn_mfma_f32_32x32x16_bf16(b1, qr[d0], s1, 0, 0, 0); } }
}
__device__ __forceinline__ void pv(f32x16 (&o)[2], const ALAS unsigned char* vp, const u32x4 (&pk)[4]) {
#pragma unroll
    for (int ks = 0; ks < 4; ++ks)
#pragma unroll
        for (int d0 = 0; d0 < 2; ++d0) { const s16x4 lo = vtr(vp + d0 * 4096 + ks * 1024), hh = vtr(vp + d0 * 4096 + ks * 1024 + 512);
            const bf16x8 vf = (bf16x8){lo[0], lo[1], lo[2], lo[3], hh[0], hh[1], hh[2], hh[3]};
            o[d0] = __builtin_amdgcn_mfma_f32_32x32x16_bf16(__builtin_bit_cast(bf16x8, pk[ks]), vf, o[d0], 0, 0, 0); }
}

constexpr float ATT_MREF_MAX = 40.0f;
#define ATT_SBAR() __builtin_amdgcn_sched_barrier(0)
#define ATT_PIN(x) asm volatile("" : "+v"(x))
#define ATT_VLOAD(i) do { if (VAR == 1) break; const s16x4 lo_ = vtr(vfrag + ((i) & 1) * 4096 + ((i) >> 1) * 1024), hi_ = vtr(vfrag + ((i) & 1) * 4096 + ((i) >> 1) * 1024 + 512); vfr[i] = (bf16x8){lo_[0], lo_[1], lo_[2], lo_[3], hi_[0], hi_[1], hi_[2], hi_[3]}; } while (0)
#define ATT_KLOAD(j) do { if (QK && VAR != 1) kfr[j] = *(const ALAS bf16x8*)(kfrag + ((j) >> 1) * 2048 + ((j) & 1) * 512); } while (0)
template <bool QK, int VAR = 0>
__device__ __forceinline__ void attn_step(f32x16& c0, f32x16& c1, f32x16& n0, f32x16& n1, u32x4 (&pk)[4], f32x16 (&o)[2], float& l_reg, const bf16x8 (&qr)[6],
                                          const ALAS unsigned char* kfrag, const ALAS unsigned char* vfrag, int jb, int qrel, int hi) {
    if (jb >= 0) { const int kbase = 64 * jb + 4 * hi;
#pragma unroll
        for (int r = 0; r < 16; ++r) { const int kv = kbase + (r & 3) + 8 * (r >> 2); if (kv > qrel) c0[r] = -__builtin_inff(); if (kv + 32 > qrel) c1[r] = -__builtin_inff(); } }
    bf16x8 vfr[8] = {}, kfr[12] = {}; float sa = 0.f, sb = 0.f; const f32x16 zero16 = {};
    ATT_VLOAD(0); ATT_VLOAD(1); ATT_SBAR();
      if (VAR != 4) o[0] = __builtin_amdgcn_mfma_f32_32x32x16_bf16(__builtin_bit_cast(bf16x8, pk[0]), vfr[0], o[0], 0, 0, 0); if (VAR != 2) { c0[0] = __builtin_amdgcn_exp2f(c0[0]); c0[1] = __builtin_amdgcn_exp2f(c0[1]); } ATT_VLOAD(2); ATT_PIN(c0); ATT_SBAR();
      if (VAR != 4) o[1] = __builtin_amdgcn_mfma_f32_32x32x16_bf16(__builtin_bit_cast(bf16x8, pk[0]), vfr[1], o[1], 0, 0, 0); if (VAR != 2) { c0[2] = __builtin_amdgcn_exp2f(c0[2]); c0[3] = __builtin_amdgcn_exp2f(c0[3]); } if (VAR != 2) { sa += c0[0]; sa += c0[1]; } ATT_VLOAD(3); ATT_PIN(c0); ATT_PIN(sa); ATT_SBAR();
      if (VAR != 4) o[0] = __builtin_amdgcn_mfma_f32_32x32x16_bf16(__builtin_bit_cast(bf16x8, pk[1]), vfr[2], o[0], 0, 0, 0); if (VAR != 2) { c0[4] = __builtin_amdgcn_exp2f(c0[4]); c0[5] = __builtin_amdgcn_exp2f(c0[5]); } if (VAR != 2) { sa += c0[2]; sa += c0[3]; } ATT_VLOAD(4); ATT_PIN(c0); ATT_PIN(sa); ATT_SBAR();
      if (VAR != 4) o[1] = __builtin_amdgcn_mfma_f32_32x32x16_bf16(__builtin_bit_cast(bf16x8, pk[1]), vfr[3], o[1], 0, 0, 0); if (VAR != 2) { c0[6] = __builtin_amdgcn_exp2f(c0[6]); c0[7] = __builtin_amdgcn_exp2f(c0[7]); } if (VAR != 2) { sa += c0[4]; sa += c0[5]; } ATT_VLOAD(5); ATT_PIN(c0); ATT_PIN(sa); ATT_SBAR();
      if (VAR != 4) o[0] = __builtin_amdgcn_mfma_f32_32x32x16_bf16(__builtin_bit_cast(bf16x8, pk[2]), vfr[4], o[0], 0, 0, 0); if (VAR != 2) { c0[8] = __builtin_amdgcn_exp2f(c0[8]); c0[9] = __builtin_amdgcn_exp2f(c0[9]); } if (VAR != 2) { sa += c0[6]; sa += c0[7]; } if (VAR != 2) { pk[0].x = cvtpk(c0[0], c0[1]); pk[0].y = cvtpk(c0[2], c0[3]); } ATT_VLOAD(6); ATT_PIN(c0); ATT_PIN(pk[0]); ATT_PIN(sa); ATT_SBAR();
      if (VAR != 4) o[1] = __builtin_amdgcn_mfma_f32_32x32x16_bf16(__builtin_bit_cast(bf16x8, pk[2]), vfr[5], o[1], 0, 0, 0); if (VAR != 2) { c0[10] = __builtin_amdgcn_exp2f(c0[10]); c0[11] = __builtin_amdgcn_exp2f(c0[11]); } if (VAR != 2) { sa += c0[8]; sa += c0[9]; } if (VAR != 2) { pk[0].z = cvtpk(c0[4], c0[5]); pk[0].w = cvtpk(c0[6], c0[7]); } ATT_VLOAD(7); ATT_PIN(c0); ATT_PIN(pk[0]); ATT_PIN(sa); ATT_SBAR();
      if (VAR != 4) o[0] = __builtin_amdgcn_mfma_f32_32x32x16_bf16(__builtin_bit_cast(bf16x8, pk[3]), vfr[6], o[0], 0, 0, 0); if (VAR != 2) { c0[12] = __builtin_amdgcn_exp2f(c0[12]); c0[13] = __builtin_amdgcn_exp2f(c0[13]); } if (VAR != 2) { sa += c0[10]; sa += c0[11]; } ATT_KLOAD(0); ATT_PIN(c0); ATT_PIN(sa); ATT_SBAR();
      if (VAR != 4) o[1] = __builtin_amdgcn_mfma_f32_32x32x16_bf16(__builtin_bit_cast(bf16x8, pk[3]), vfr[7], o[1], 0, 0, 0); if (VAR != 2) { c0[14] = __builtin_amdgcn_exp2f(c0[14]); c0[15] = __builtin_amdgcn_exp2f(c0[15]); } if (VAR != 2) { sa += c0[12]; sa += c0[13]; } ATT_KLOAD(1); ATT_PIN(c0); ATT_PIN(sa); ATT_SBAR();
      if (QK && VAR != 4) n0 = __builtin_amdgcn_mfma_f32_32x32x16_bf16(kfr[0], qr[0], zero16, 0, 0, 0); if (VAR != 2) { c1[0] = __builtin_amdgcn_exp2f(c1[0]); c1[1] = __builtin_amdgcn_exp2f(c1[1]); } if (VAR != 2) { sa += c0[14]; sa += c0[15]; } if (VAR != 2) { pk[1].x = cvtpk(c0[8], c0[9]); pk[1].y = cvtpk(c0[10], c0[11]); } ATT_KLOAD(2); ATT_PIN(c1); ATT_PIN(pk[1]); ATT_PIN(sa); ATT_SBAR();
      if (QK && VAR != 4) n1 = __builtin_amdgcn_mfma_f32_32x32x16_bf16(kfr[1], qr[0], zero16, 0, 0, 0); if (VAR != 2) { c1[2] = __builtin_amdgcn_exp2f(c1[2]); c1[3] = __builtin_amdgcn_exp2f(c1[3]); } if (VAR != 2) { sb += c1[0]; sb += c1[1]; } if (VAR != 2) { pk[1].z = cvtpk(c0[12], c0[13]); pk[1].w = cvtpk(c0[14], c0[15]); } ATT_KLOAD(3); ATT_PIN(c1); ATT_PIN(pk[1]); ATT_PIN(sb); ATT_SBAR();
      if (QK && VAR != 4) n0 = __builtin_amdgcn_mfma_f32_32x32x16_bf16(kfr[2], qr[1], n0, 0, 0, 0); if (VAR != 2) { c1[4] = __builtin_amdgcn_exp2f(c1[4]); c1[5] = __builtin_amdgcn_exp2f(c1[5]); } if (VAR != 2) { sb += c1[2]; sb += c1[3]; } ATT_KLOAD(4); ATT_PIN(c1); ATT_PIN(sb); ATT_SBAR();
      if (QK && VAR != 4) n1 = __builtin_amdgcn_mfma_f32_32x32x16_bf16(kfr[3], qr[1], n1, 0, 0, 0); if (VAR != 2) { c1[6] = __builtin_amdgcn_exp2f(c1[6]); c1[7] = __builtin_amdgcn_exp2f(c1[7]); } if (VAR != 2) { sb += c1[4]; sb += c1[5]; } ATT_KLOAD(5); ATT_PIN(c1); ATT_PIN(sb); ATT_SBAR();
      if (QK && VAR != 4) n0 = __builtin_amdgcn_mfma_f32_32x32x16_bf16(kfr[4], qr[2], n0, 0, 0, 0); if (VAR != 2) { c1[8] = __builtin_amdgcn_exp2f(c1[8]); c1[9] = __builtin_amdgcn_exp2f(c1[9]); } if (VAR != 2) { sb += c1[6]; sb += c1[7]; } if (VAR != 2) { pk[2].x = cvtpk(c1[0], c1[1]); pk[2].y = cvtpk(c1[2], c1[3]); } ATT_KLOAD(6); ATT_PIN(c1); ATT_PIN(pk[2]); ATT_PIN(sb); ATT_SBAR();
      if (QK && VAR != 4) n1 = __builtin_amdgcn_mfma_f32_32x32x16_bf16(kfr[5], qr[2], n1, 0, 0, 0); if (VAR != 2) { c1[10] = __builtin_amdgcn_exp2f(c1[10]); c1[11] = __builtin_amdgcn_exp2f(c1[11]); } if (VAR != 2) { sb += c1[8]; sb += c1[9]; } if (VAR != 2) { pk[2].z = cvtpk(c1[4], c1[5]); pk[2].w = cvtpk(c1[6], c1[7]); } ATT_KLOAD(7); ATT_PIN(c1); ATT_PIN(pk[2]); ATT_PIN(sb); ATT_SBAR();
      if (QK && VAR != 4) n0 = __builtin_amdgcn_mfma_f32_32x32x16_bf16(kfr[6], qr[3], n0, 0, 0, 0); if (VAR != 2) { c1[12] = __builtin_amdgcn_exp2f(c1[12]); c1[13] = __builtin_amdgcn_exp2f(c1[13]); } if (VAR != 2) { sb += c1[10]; sb += c1[11]; } ATT_KLOAD(8); ATT_PIN(c1); ATT_PIN(sb); ATT_SBAR();
      if (QK && VAR != 4) n1 = __builtin_amdgcn_mfma_f32_32x32x16_bf16(kfr[7], qr[3], n1, 0, 0, 0); if (VAR != 2) { c1[14] = __builtin_amdgcn_exp2f(c1[14]); c1[15] = __builtin_amdgcn_exp2f(c1[15]); } if (VAR != 2) { sb += c1[12]; sb += c1[13]; } ATT_KLOAD(9); ATT_PIN(c1); ATT_PIN(sb); ATT_SBAR();
      if (QK && VAR != 4) n0 = __builtin_amdgcn_mfma_f32_32x32x16_bf16(kfr[8], qr[4], n0, 0, 0, 0); if (VAR != 2) { sb += c1[14]; sb += c1[15]; } if (VAR != 2) { pk[3].x = cvtpk(c1[8], c1[9]); pk[3].y = cvtpk(c1[10], c1[11]); } ATT_KLOAD(10); ATT_PIN(pk[3]); ATT_PIN(sb); ATT_SBAR();
      if (QK && VAR != 4) n1 = __builtin_amdgcn_mfma_f32_32x32x16_bf16(kfr[9], qr[4], n1, 0, 0, 0); if (VAR != 2) { pk[3].z = cvtpk(c1[12], c1[13]); pk[3].w = cvtpk(c1[14], c1[15]); } ATT_KLOAD(11); ATT_PIN(pk[3]); ATT_SBAR();
      if (QK && VAR != 4) n0 = __builtin_amdgcn_mfma_f32_32x32x16_bf16(kfr[10], qr[5], n0, 0, 0, 0); ATT_SBAR();
      if (QK && VAR != 4) n1 = __builtin_amdgcn_mfma_f32_32x32x16_bf16(kfr[11], qr[5], n1, 0, 0, 0); ATT_SBAR();
    l_reg += sa + sb;
}
#undef ATT_VLOAD
#undef ATT_KLOAD

template <int VAR = 0>
__device__ __forceinline__ void attn_unit(int b, int h, int qb, const bf16* Q, const bf16* K, const bf16* V, bf16* O, ALAS unsigned char* shm, int OPR = OP) {
    int tid_ = threadIdx.x; asm volatile("" : "+v"(tid_));
    const int tid = tid_, lane = tid & 63, r32 = lane & 31, hi = lane >> 5; const int wid = __builtin_amdgcn_readfirstlane(tid >> 6);
    const long rowbase = (long)b * SEQ; const int q0 = qb * QB;
    const bf16* Qw = Q + (rowbase + q0 + wid * QBLK) * QP + h * QHS;
    const bf16* Kh = K + rowbase * KP + h * KHS; const bf16* Vh = V + rowbase * VP + h * VHS;
    ALAS float* wsf = (ALAS float*)(shm + L_WS) + wid * 64;
    const bf16* ksrc = Kh + (long)lane * KP + wid * 8;
    const bf16* vsrc = Vh + (long)(16 * (wid & 3) + (lane >> 2)) * VP + (wid >> 2) * 32 + (lane & 3) * 8;
#define ATT_DMA_K(t, slot) do { \
        __builtin_amdgcn_global_load_lds((const unsigned*)(ksrc + (long)(t) * KVBLK * KP), (ALAS unsigned*)(shm + L_K + (slot) * KSLOT + wid * 1024), 16, 0, 0); \
        if (wid < 4) __builtin_amdgcn_global_load_lds((const unsigned*)(ksrc + (long)(t) * KVBLK * KP + 64), (ALAS unsigned*)(shm + L_K + (slot) * KSLOT + (8 + wid) * 1024), 16, 0, 0); } while (0)
#define ATT_DMA_V(t, slotoff) __builtin_amdgcn_global_load_lds((const unsigned*)(vsrc + (long)(t) * KVBLK * VP), (ALAS unsigned*)(shm + L_V + (slotoff) + wid * 1024), 16, 0, 0)
    const int NT = (q0 + QB) / KVBLK;
    ATT_DMA_K(0, 0); ATT_DMA_V(0, 0); ATT_DMA_K(1, 1);
    bf16x8 qr[6];
#pragma unroll
    for (int d0 = 0; d0 < 6; ++d0) qr[d0] = *(const bf16x8*)(Qw + (long)r32 * QP + d0 * 16 + hi * 8);
    float l_reg = 0.f; f32x16 o[2];
#pragma unroll
    for (int r = 0; r < 16; ++r) { o[0][r] = 0.f; o[1][r] = 0.f; }
    const int qrel = wid * QBLK + r32;
    const ALAS unsigned char* kb0 = shm + L_K + hi * 1024 + r32 * 16;
    const ALAS unsigned char* vp0 = shm + L_V + ((lane >> 4) & 1) * 32 + (lane & 3) * 8 + (4 * hi + ((lane & 15) >> 2)) * 64;
    asm volatile("s_waitcnt vmcnt(0)" ::: "memory"); __syncthreads();
    f32x16 sA0, sA1, sB0, sB1;
    qkt(sA0, sA1, kb0, qr);
    u32x4 pk[4] = {};
    int vs_prev = 0, vs_cur = 0, vs_next = VSLOT;
#define ATT_TOP(t) do { if (VAR == 3) break; asm volatile("s_waitcnt vmcnt(0)" ::: "memory"); __syncthreads();        \
        if ((t) + 2 < NT) ATT_DMA_K((t) + 2, (t) & 1); if ((t) + 1 < NT) ATT_DMA_V((t) + 1, vs_next); } while (0)
#define ATT_ROT() do { vs_prev = vs_cur; vs_cur = vs_next; vs_next = (vs_next == 2 * VSLOT) ? 0 : vs_next + VSLOT; } while (0)
    int t = 0;
    for (; t < NT - 2; t += 2) {
        ATT_TOP(t);
        attn_step<true, VAR>(sA0, sA1, sB0, sB1, pk, o, l_reg, qr, kb0 + KSLOT, vp0 + vs_prev, t - (NT - 4), qrel, hi);
        ATT_ROT();
        ATT_TOP(t + 1);
        attn_step<true, VAR>(sB0, sB1, sA0, sA1, pk, o, l_reg, qr, kb0, vp0 + vs_prev, t + 1 - (NT - 4), qrel, hi);
        ATT_ROT();
    }
    ATT_TOP(t);
    attn_step<true, VAR>(sA0, sA1, sB0, sB1, pk, o, l_reg, qr, kb0 + KSLOT, vp0 + vs_prev, 2, qrel, hi);
    ATT_ROT();
    ATT_TOP(t + 1);
    attn_step<false, VAR>(sB0, sB1, sA0, sA1, pk, o, l_reg, qr, kb0, vp0 + vs_prev, 3, qrel, hi);
    ATT_ROT();
    pv(o, vp0 + vs_prev, pk);
    l_reg = pswap_sum(l_reg);
    if (hi == 0) wsf[32 + r32] = l_reg;
    float rli[16];
#pragma unroll
    for (int r = 0; r < 16; ++r) rli[r] = __builtin_amdgcn_rcpf(wsf[32 + crow(r, hi)]);
    bf16* Ow = O + (rowbase + q0 + wid * QBLK) * OPR + h * OHS;
    { ALAS bf16* stg = (ALAS bf16*)(shm + L_OST) + wid * 2048;
#pragma unroll
      for (int r = 0; r < 16; ++r) { const int orow = crow(r, hi);
#pragma unroll
          for (int d0 = 0; d0 < 2; ++d0) { const float v = o[d0][r] * rli[r]; unsigned u = __float_as_uint(v); u = (u + 0x7fffu + ((u >> 16) & 1u)) >> 16; stg[orow * 64 + d0 * 32 + r32] = (bf16)u; } }
#pragma unroll
      for (int i = 0; i < 4; ++i) { const int row = i * 8 + (lane >> 3), ch = lane & 7; const u32x4 v = *(const ALAS u32x4*)(stg + row * 64 + ch * 8); *(u32x4*)(Ow + (long)row * OPR + ch * 8) = v; } }
    __syncthreads();
#undef ATT_DMA_K
#undef ATT_DMA_V
#undef ATT_TOP
#undef ATT_ROT
}
#undef ALAS
}

namespace att2 {
#define ALAS __attribute__((address_space(3)))
using att::bf16; using att::bf16x8; using att::s16x4; using att::f32x16; using att::u32x4; using att::crow; using att::cvtpk; using att::pswap_sum; using att::vtr;
constexpr int SEQ = 16384, QP = 768, KP = 768, VP = 512, OP = 1024, QHS = 96, KHS = 96, VHS = 64, OHS = 64;
constexpr int NW = 8, QB = 512, KVBLK = 64, NQB = SEQ / QB;
constexpr int KSLOT = 12288, VSLOT = 8192;
constexpr int L_K = 0, L_V = 2 * KSLOT, L_WS = L_V + 2 * VSLOT, L_OST = L_WS + NW * 64 * 4, L_BYTES = L_OST + NW * 4096;
__device__ __forceinline__ void softmax_pack(f32x16& p0, f32x16& p1, u32x4 (&pk)[4], float& l_reg) {
    float sa = 0.f, sb = 0.f;
#pragma unroll
    for (int r = 0; r < 16; ++r) { p0[r] = __builtin_amdgcn_exp2f(p0[r]); p1[r] = __builtin_amdgcn_exp2f(p1[r]); sa += p0[r]; sb += p1[r]; }
    l_reg += sa + sb;
#pragma unroll
    for (int k = 0; k < 2; ++k) { pk[k] = (u32x4){cvtpk(p0[8 * k], p0[8 * k + 1]), cvtpk(p0[8 * k + 2], p0[8 * k + 3]), cvtpk(p0[8 * k + 4], p0[8 * k + 5]), cvtpk(p0[8 * k + 6], p0[8 * k + 7])};
        pk[2 + k] = (u32x4){cvtpk(p1[8 * k], p1[8 * k + 1]), cvtpk(p1[8 * k + 2], p1[8 * k + 3]), cvtpk(p1[8 * k + 4], p1[8 * k + 5]), cvtpk(p1[8 * k + 6], p1[8 * k + 7])}; }
}
__device__ __forceinline__ void attn_unit(int b, int h, int qb, const bf16* Q, const bf16* K, const bf16* V, bf16* O, ALAS unsigned char* shm) {
    int tid_ = threadIdx.x; asm volatile("" : "+v"(tid_));
    const int tid = tid_, lane = tid & 63, r32 = lane & 31, hi = lane >> 5; const int wid = __builtin_amdgcn_readfirstlane(tid >> 6);
    const long rowbase = (long)b * SEQ; const int q0 = qb * QB;
    const bf16* Qw = Q + (rowbase + q0 + wid * 64) * QP + h * QHS;
    const bf16* Kh = K + rowbase * KP + h * KHS; const bf16* Vh = V + rowbase * VP + h * VHS;
    ALAS float* wsf = (ALAS float*)(shm + L_WS) + wid * 64;
    const bf16* ksrc = Kh + (long)lane * KP + wid * 8;
    const bf16* vsrc = Vh + (long)(16 * (wid & 3) + (lane >> 2)) * VP + (wid >> 2) * 32 + (lane & 3) * 8;
#define ATT_DMA(t, slot) do { \
        __builtin_amdgcn_global_load_lds((const unsigned*)(ksrc + (long)(t) * KVBLK * KP), (ALAS unsigned*)(shm + L_K + (slot) * KSLOT + wid * 1024), 16, 0, 0); \
        if (wid < 4) __builtin_amdgcn_global_load_lds((const unsigned*)(ksrc + (long)(t) * KVBLK * KP + 64), (ALAS unsigned*)(shm + L_K + (slot) * KSLOT + (8 + wid) * 1024), 16, 0, 0); \
        __builtin_amdgcn_global_load_lds((const unsigned*)(vsrc + (long)(t) * KVBLK * VP), (ALAS unsigned*)(shm + L_V + (slot) * VSLOT + wid * 1024), 16, 0, 0); } while (0)
    const int NT = (q0 + QB) / KVBLK;
    ATT_DMA(0, 0);
    bf16x8 qa[6], qb_[6];
#pragma unroll
    for (int d0 = 0; d0 < 6; ++d0) { qa[d0] = *(const bf16x8*)(Qw + (long)r32 * QP + d0 * 16 + hi * 8); qb_[d0] = *(const bf16x8*)(Qw + (long)(32 + r32) * QP + d0 * 16 + hi * 8); }
    float la = 0.f, lb = 0.f; f32x16 oa[2], ob[2];
#pragma unroll
    for (int r = 0; r < 16; ++r) { oa[0][r] = 0.f; oa[1][r] = 0.f; ob[0][r] = 0.f; ob[1][r] = 0.f; }
    const ALAS unsigned char* kb0 = shm + L_K + hi * 1024 + r32 * 16;
    const ALAS unsigned char* vp0 = shm + L_V + ((lane >> 4) & 1) * 32 + (lane & 3) * 8 + (4 * hi + ((lane & 15) >> 2)) * 64;
    for (int t = 0; t < NT; ++t) {
        const int cur = t & 1;
        asm volatile("s_waitcnt vmcnt(0)" ::: "memory"); __syncthreads();
        if (t + 1 < NT) ATT_DMA(t + 1, cur ^ 1);
        const int jb = t - (NT - 8);
        if (jb > wid) continue;
        f32x16 pa0, pa1, pb0, pb1; const f32x16 z16 = {};
        { const ALAS unsigned char* kb = kb0 + cur * KSLOT;
#pragma unroll
          for (int d0 = 0; d0 < 6; ++d0) {
              const bf16x8 k0 = *(const ALAS bf16x8*)(kb + d0 * 2048), k1 = *(const ALAS bf16x8*)(kb + d0 * 2048 + 512);
              pa0 = __builtin_amdgcn_mfma_f32_32x32x16_bf16(k0, qa[d0], d0 == 0 ? z16 : pa0, 0, 0, 0); pa1 = __builtin_amdgcn_mfma_f32_32x32x16_bf16(k1, qa[d0], d0 == 0 ? z16 : pa1, 0, 0, 0);
              pb0 = __builtin_amdgcn_mfma_f32_32x32x16_bf16(k0, qb_[d0], d0 == 0 ? z16 : pb0, 0, 0, 0); pb1 = __builtin_amdgcn_mfma_f32_32x32x16_bf16(k1, qb_[d0], d0 == 0 ? z16 : pb1, 0, 0, 0); } }
        if (jb == wid) {
#pragma unroll
            for (int r = 0; r < 16; ++r) { const int kv = 4 * hi + (r & 3) + 8 * (r >> 2);
                if (kv > r32) pa0[r] = -__builtin_inff();
                pa1[r] = -__builtin_inff();
                if (kv > r32) pb1[r] = -__builtin_inff(); }
        }
        u32x4 pka[4], pkb[4];
        softmax_pack(pa0, pa1, pka, la); softmax_pack(pb0, pb1, pkb, lb);
        { const ALAS unsigned char* vp = vp0 + cur * VSLOT;
#pragma unroll
          for (int ks = 0; ks < 4; ++ks)
#pragma unroll
              for (int d0 = 0; d0 < 2; ++d0) { const s16x4 lo = vtr(vp + d0 * 4096 + ks * 1024), hh = vtr(vp + d0 * 4096 + ks * 1024 + 512);
                  const bf16x8 vf = (bf16x8){lo[0], lo[1], lo[2], lo[3], hh[0], hh[1], hh[2], hh[3]};
                  oa[d0] = __builtin_amdgcn_mfma_f32_32x32x16_bf16(__builtin_bit_cast(bf16x8, pka[ks]), vf, oa[d0], 0, 0, 0);
                  ob[d0] = __builtin_amdgcn_mfma_f32_32x32x16_bf16(__builtin_bit_cast(bf16x8, pkb[ks]), vf, ob[d0], 0, 0, 0); } }
    }
#pragma unroll
    for (int blk = 0; blk < 2; ++blk) {
        float l_reg = pswap_sum(blk == 0 ? la : lb);
        if (hi == 0) wsf[32 + r32] = l_reg;
        float rli[16];
#pragma unroll
        for (int r = 0; r < 16; ++r) rli[r] = __builtin_amdgcn_rcpf(wsf[32 + crow(r, hi)]);
        bf16* Ow = O + (rowbase + q0 + wid * 64 + blk * 32) * OP + h * OHS;
        ALAS bf16* stg = (ALAS bf16*)(shm + L_OST) + wid * 2048;
#pragma unroll
        for (int r = 0; r < 16; ++r) { const int orow = crow(r, hi);
#pragma unroll
            for (int d0 = 0; d0 < 2; ++d0) { const float v = (blk == 0 ? oa[d0][r] : ob[d0][r]) * rli[r]; unsigned u = __float_as_uint(v); u = (u + 0x7fffu + ((u >> 16) & 1u)) >> 16; stg[orow * 64 + d0 * 32 + r32] = (bf16)u; } }
#pragma unroll
        for (int i = 0; i < 4; ++i) { const int row = i * 8 + (lane >> 3), ch = lane & 7; const u32x4 v = *(const ALAS u32x4*)(stg + row * 64 + ch * 8); *(u32x4*)(Ow + (long)row * OP + ch * 8) = v; }
    }
    __syncthreads();
#undef ATT_DMA
}
#undef ALAS
}

namespace att3 {
#define ALAS __attribute__((address_space(3)))
using att::bf16; using att::bf16x8; using att::s16x4; using att::f32x16; using att::u32x4; using att::crow; using att::cvtpk; using att::pswap_sum; using att::vtr;
using att2::softmax_pack;
constexpr int SEQ = 16384, QP = 768, KP = 768, VP = 512, OP = 1024, QHS = 96, KHS = 96, VHS = 64, OHS = 64;
constexpr int NW = 8, QB = 512, KVBLK = 64;
constexpr int KSLOT = 12288, VSLOT = 8192;
constexpr int L_K = 0, L_V = 2 * KSLOT, L_WS = L_V + 2 * VSLOT, L_OST = L_WS + NW * 64 * 4, L_BYTES = L_OST + NW * 4096;
__device__ __forceinline__ void attn_unit(int b, int h, int qb, const bf16* Q, const bf16* K, const bf16* V, bf16* O, ALAS unsigned char* shm) {
    int tid_ = threadIdx.x; asm volatile("" : "+v"(tid_));
    const int tid = tid_, lane = tid & 63, r32 = lane & 31, hi = lane >> 5; const int wid = __builtin_amdgcn_readfirstlane(tid >> 6);
    const long rowbase = (long)b * SEQ; const int q0 = qb * QB;
    const bf16* Qw = Q + (rowbase + q0 + wid * 64) * QP + h * QHS;
    const bf16* Kh = K + rowbase * KP + h * KHS; const bf16* Vh = V + rowbase * VP + h * VHS;
    ALAS float* wsf = (ALAS float*)(shm + L_WS) + wid * 64;
    const unsigned lds0 = (unsigned)(uintptr_t)shm;
    const bf16* ksrc = Kh + (long)lane * KP + wid * 8;
    const int kdelta = (8 + (wid & 3) - wid) * 8;
    const bf16* vsrc = Vh + (long)(16 * (wid & 3) + (lane >> 2)) * VP + (wid >> 2) * 32 + (lane & 3) * 8;
#define GLDS16(gsrc, ldsdst) do { unsigned keep_; asm volatile("s_mov_b32 %0, m0\n\ts_mov_b32 m0, %2\n\ts_nop 0\n\tglobal_load_lds_dwordx4 %1, off\n\ts_mov_b32 m0, %0" : "=&s"(keep_) : "v"(gsrc), "s"(ldsdst) : "memory"); } while (0)
#define DMA_K(t, slot) do { GLDS16(ksrc + (long)(t) * KVBLK * KP, (unsigned)__builtin_amdgcn_readfirstlane(lds0 + L_K + (slot) * KSLOT + wid * 1024)); \
        GLDS16(ksrc + ((long)(t) * KVBLK * KP + kdelta), (unsigned)__builtin_amdgcn_readfirstlane(lds0 + L_K + (slot) * KSLOT + (8 + (wid & 3)) * 1024)); } while (0)
#define DMA_V(t, slot) GLDS16(vsrc + (long)(t) * KVBLK * VP, (unsigned)__builtin_amdgcn_readfirstlane(lds0 + L_V + (slot) * VSLOT + wid * 1024))
#define BAR_W(n) do { asm volatile("s_waitcnt vmcnt(" #n ") lgkmcnt(0)" ::: "memory"); __builtin_amdgcn_s_barrier(); asm volatile("" ::: "memory"); } while (0)
#define BAR1(t) do { if ((t) < NT) BAR_W(1); else BAR_W(0); if ((t) + 1 < NT) DMA_K((t) + 1, ((t) + 1) & 1); } while (0)
#define BAR2(t) do { if ((t) + 1 < NT) BAR_W(2); else BAR_W(0); if ((t) + 1 < NT) DMA_V((t) + 1, ((t) + 1) & 1); } while (0)
    const int NT = (q0 + QB) / KVBLK;
    DMA_K(0, 0); DMA_V(0, 0);
    bf16x8 qa[6], qb_[6];
#pragma unroll
    for (int d0 = 0; d0 < 6; ++d0) { qa[d0] = *(const bf16x8*)(Qw + (long)r32 * QP + d0 * 16 + hi * 8); qb_[d0] = *(const bf16x8*)(Qw + (long)(32 + r32) * QP + d0 * 16 + hi * 8); }
    asm volatile("s_waitcnt vmcnt(0)" ::: "memory");
    float la = 0.f, lb = 0.f; f32x16 oa[2], ob[2];
#pragma unroll
    for (int r = 0; r < 16; ++r) { oa[0][r] = 0.f; oa[1][r] = 0.f; ob[0][r] = 0.f; ob[1][r] = 0.f; }
    const ALAS unsigned char* kb0 = shm + L_K + hi * 1024 + r32 * 16;
    const ALAS unsigned char* vp0 = shm + L_V + ((lane >> 4) & 1) * 32 + (lane & 3) * 8 + (4 * hi + ((lane & 15) >> 2)) * 64;
    f32x16 pa0, pa1, pb0, pb1;
#define ALPHA(t) do { if ((t) - (NT - 8) <= wid) { const ALAS unsigned char* kb = kb0 + ((t) & 1) * KSLOT; const f32x16 z16 = {}; \
        bf16x8 k0n = *(const ALAS bf16x8*)(kb), k1n = *(const ALAS bf16x8*)(kb + 512); \
        _Pragma("unroll") for (int d0 = 0; d0 < 6; ++d0) { const bf16x8 k0 = k0n, k1 = k1n; \
            if (d0 < 5) { k0n = *(const ALAS bf16x8*)(kb + (d0 + 1) * 2048); k1n = *(const ALAS bf16x8*)(kb + (d0 + 1) * 2048 + 512); }     \
            pa0 = __builtin_amdgcn_mfma_f32_32x32x16_bf16(k0, qa[d0], d0 == 0 ? z16 : pa0, 0, 0, 0); pa1 = __builtin_amdgcn_mfma_f32_32x32x16_bf16(k1, qa[d0], d0 == 0 ? z16 : pa1, 0, 0, 0); \
            pb0 = __builtin_amdgcn_mfma_f32_32x32x16_bf16(k0, qb_[d0], d0 == 0 ? z16 : pb0, 0, 0, 0); pb1 = __builtin_amdgcn_mfma_f32_32x32x16_bf16(k1, qb_[d0], d0 == 0 ? z16 : pb1, 0, 0, 0); \
            __builtin_amdgcn_sched_barrier(0); } } } while (0)
#define BETA(t) do { const int jb_ = (t) - (NT - 8); if (jb_ <= wid) { \
        if (jb_ == wid) { _Pragma("unroll") for (int r = 0; r < 16; ++r) { const int kv = 4 * hi + (r & 3) + 8 * (r >> 2); \
            if (kv > r32) pa0[r] = -__builtin_inff(); pa1[r] = -__builtin_inff(); if (kv > r32) pb1[r] = -__builtin_inff(); } } \
        u32x4 pka[4], pkb[4]; softmax_pack(pa0, pa1, pka, la); softmax_pack(pb0, pb1, pkb, lb); \
        const ALAS unsigned char* vp = vp0 + ((t) & 1) * VSLOT; \
        _Pragma("unroll") for (int i_ = 0; i_ < 8; ++i_) { const int ks = i_ >> 1, d0 = i_ & 1; \
            const s16x4 lo = vtr(vp + d0 * 4096 + ks * 1024), hh = vtr(vp + d0 * 4096 + ks * 1024 + 512); \
            const bf16x8 vf = (bf16x8){lo[0], lo[1], lo[2], lo[3], hh[0], hh[1], hh[2], hh[3]}; \
            oa[d0] = __builtin_amdgcn_mfma_f32_32x32x16_bf16(__builtin_bit_cast(bf16x8, pka[ks]), vf, oa[d0], 0, 0, 0); \
            ob[d0] = __builtin_amdgcn_mfma_f32_32x32x16_bf16(__builtin_bit_cast(bf16x8, pkb[ks]), vf, ob[d0], 0, 0, 0); \
            __builtin_amdgcn_sched_barrier(0); } } } while (0)
    if (wid < 4) {
        for (int t = 0; t < NT; ++t) { BAR1(t); ALPHA(t); BAR2(t); BETA(t); }
        BAR1(NT); BAR2(NT);
    } else {
        BAR1(0); BAR2(0); ALPHA(0);
        for (int t = 1; t < NT; ++t) { BAR1(t); BETA(t - 1); BAR2(t); ALPHA(t); }
        BAR1(NT); BETA(NT - 1); BAR2(NT);
    }
#pragma unroll
    for (int blk = 0; blk < 2; ++blk) {
        float l_reg = pswap_sum(blk == 0 ? la : lb);
        if (hi == 0) wsf[32 + r32] = l_reg;
        float rli[16];
#pragma unroll
        for (int r = 0; r < 16; ++r) rli[r] = __builtin_amdgcn_rcpf(wsf[32 + crow(r, hi)]);
        bf16* Ow = O + (rowbase + q0 + wid * 64 + blk * 32) * OP + h * OHS;
        ALAS bf16* stg = (ALAS bf16*)(shm + L_OST) + wid * 2048;
#pragma unroll
        for (int r = 0; r < 16; ++r) { const int orow = crow(r, hi);
#pragma unroll
            for (int d0 = 0; d0 < 2; ++d0) { const float v = (blk == 0 ? oa[d0][r] : ob[d0][r]) * rli[r]; unsigned u = __float_as_uint(v); u = (u + 0x7fffu + ((u >> 16) & 1u)) >> 16; stg[orow * 64 + d0 * 32 + r32] = (bf16)u; } }
#pragma unroll
        for (int i = 0; i < 4; ++i) { const int row = i * 8 + (lane >> 3), ch = lane & 7; const u32x4 v = *(const ALAS u32x4*)(stg + row * 64 + ch * 8); *(u32x4*)(Ow + (long)row * OP + ch * 8) = v; }
    }
    asm volatile("s_waitcnt vmcnt(0) lgkmcnt(0)" ::: "memory"); __syncthreads();
#undef GLDS16
#undef DMA_K
#undef DMA_V
#undef BAR_W
#undef BAR1
#undef BAR2
#undef ALPHA
#undef BETA
}
#undef ALAS
}

constexpr int NB = 2, SEQ = 16384, D = 1024, NTOK = NB * SEQ, DEPTH = 4;
constexpr int INCOLS = 1440, INP = 1536;
constexpr int UPK = 384, UPN = 1792;
constexpr int LRUW = 512;
constexpr int DFF = 2816, NEXP = 8, DFE = 3584;
constexpr int MOE_TILES = (2 * NTOK) / 256 + NEXP;
constexpr float EPS = 1e-6f;
constexpr int NWAVES = 8;

constexpr size_t MiB = 1u << 20;
constexpr size_t WS_CTL = 0, CTL_ZERO_BYTES = 1 * MiB;
constexpr size_t WS_MREF = 6 * MiB + 64 * 1024;
constexpr size_t WS_RSC = 10 * MiB;
constexpr size_t WS_MODP = 1 * MiB;
constexpr size_t WS_MOD = 1 * MiB + 768 * 1024;
constexpr size_t WS_COS = 2 * MiB, WS_SIN = 4 * MiB;
constexpr size_t WS_LAMC = 6 * MiB;
constexpr size_t WS_TOKE = 7 * MiB, WS_TOKR = WS_TOKE + 256 * 1024, WS_TOKW = WS_TOKR + 256 * 1024, WS_TOKP = WS_TOKW + 256 * 1024;
constexpr size_t WS_RTE = 8 * MiB;
constexpr size_t WS_PL = 9 * MiB, WS_HC = 9 * MiB + 512 * 1024;
constexpr size_t WS_WSMALL = 16 * MiB, WSMALL_STRIDE = 8 * MiB;
constexpr size_t WS_WDENSE = 48 * MiB, WDENSE_STRIDE = 17 * MiB;
constexpr size_t WS_WMOE_GU = 82 * MiB, WS_WMOE_D = 194 * MiB;
constexpr size_t WS_H = 250 * MiB;
constexpr size_t WS_Z = 314 * MiB, WS_A2 = 410 * MiB, WS_XR = 866 * MiB, WS_QKV = 466 * MiB, WS_Q = 578 * MiB, WS_K = 626 * MiB, WS_LA = 674 * MiB, WS_XB = 738 * MiB, WS_Y = 802 * MiB;
constexpr size_t WS_HID = 314 * MiB;
constexpr size_t WS_HS = 314 * MiB, WS_Y2 = 314 * MiB, WS_MHID = 446 * MiB;
constexpr size_t WS_END = 908 * MiB;
static_assert(WS_MHID + (size_t)MOE_TILES * 256 * DFE <= WS_XB && WS_LA + (size_t)NTOK * 512 * 4 <= WS_XB && WS_XB + (size_t)NTOK * D * 2 <= WS_Y, "residual stream map");
static_assert(WS_MHID + (size_t)MOE_TILES * 256 * DFE * 2 <= WS_END && WS_HS + (size_t)MOE_TILES * 256 * D * 2 <= WS_MHID && WS_Y2 >= WS_H + (size_t)NTOK * D * 2, "MoE map");
static_assert(WS_HID + (size_t)NTOK * DFF * 2 <= WS_END && WS_Y + (size_t)NTOK * D * 2 <= WS_END, "map");
constexpr int CW_TMO = 0, CW_CODE = 1, CW_BAR = 4096, CW_GCNT = 8192, CW_WMAX = 12288, CW_AGRP = 16384, CW_SCNT = 24576;

constexpr int RING_BYTES = 131072, LDSCTL_OFF = RING_BYTES, MISC_OFF = LDSCTL_OFF + 320, LDS_BYTES = 147456;

struct Frame {
    LAS unsigned char* lds; volatile LAS unsigned* MISC; gu32* ctl;
    int tid, lane, wave, vcu, G, gw, NGW;
    float* out; unsigned char* ws;
    __device__ __forceinline__ void refresh() { int t = threadIdx.x; asm volatile("" : "+v"(t)); tid = t; lane = t & 63; wave = __builtin_amdgcn_readfirstlane(t >> 6); int v = vcu; asm volatile("" : "+s"(v)); vcu = v; gw = v * 8 + wave; }
};
template <int K> __device__ __forceinline__ const void* in_ptr() {
    unsigned long long p; const __attribute__((address_space(4))) void* ka = (const __attribute__((address_space(4))) void*)__builtin_amdgcn_kernarg_segment_ptr();
    asm volatile("s_load_dwordx2 %0, %1, %2\n\ts_waitcnt lgkmcnt(0)" : "=s"(p) : "s"(ka), "i"(8 * K) : "memory");
    return (const void*)p;
}
#define INF(K) ((const float*)in_ptr<K>())
template <class T> __device__ __forceinline__ T* wsp(const Frame& F, size_t off) { asm volatile("" : "+s"(off)); return (T*)(F.ws + off); }
enum { I_X = 0, I_C, I_POS, I_WADA, I_BADA, I_NGAIN, I_WIN, I_LGAIN, I_WQUP, I_WKVUP, I_QGAIN, I_KGAIN, I_CONVW, I_CONVB, I_WA, I_BA, I_WX, I_BX, I_LAM, I_OGAIN, I_WOUT, I_FWG, I_FWU, I_FWD, I_RW, I_MWG, I_MWU, I_MWD };

template <int K> __device__ __forceinline__ float swz_xor(float v) { return __int_as_float(__builtin_amdgcn_ds_swizzle(__float_as_int(v), (K << 10) | 0x1f)); }
__device__ __forceinline__ float wave_sum(float v) {
    v += swz_xor<1>(v); v += swz_xor<2>(v); v += swz_xor<4>(v); v += swz_xor<8>(v); v += swz_xor<16>(v);
    return att::pswap_sum(v);
}
__device__ __forceinline__ float wave_max(float v) {
    v = __builtin_fmaxf(v, swz_xor<1>(v)); v = __builtin_fmaxf(v, swz_xor<2>(v)); v = __builtin_fmaxf(v, swz_xor<4>(v)); v = __builtin_fmaxf(v, swz_xor<8>(v)); v = __builtin_fmaxf(v, swz_xor<16>(v));
    return att::pswap_max(v);
}
__device__ __forceinline__ float bflo(unsigned w) { return __uint_as_float(w << 16); }
__device__ __forceinline__ float bfhi(unsigned w) { return __uint_as_float(w & 0xffff0000u); }
__device__ __forceinline__ float bf1(bf16 v) { return __uint_as_float((unsigned)v << 16); }

__device__ __forceinline__ void transpose_item(const float* W, int ldw, int k0, int n0, bf16* WT, int ldt, int drow0, int dk0, LAS float* scr, int lane, bool ropemap = false) {
    float rv[32];
#pragma unroll
    for (int i = 0; i < 32; ++i) rv[i] = W[(size_t)(k0 + 2 * i + (lane >> 5)) * ldw + n0 + (lane & 31)];
#pragma unroll
    for (int i = 0; i < 32; ++i) scr[(2 * i + (lane >> 5)) * 33 + (lane & 31)] = rv[i];
    LDS_WAIT(); asm volatile("" ::: "memory");
    const int c = lane & 7;
#pragma unroll
    for (int j = 0; j < 4; ++j) { const int n = (lane >> 3) + 8 * j; const LAS float* s = scr + (8 * c) * 33 + n;
        v4u o; o.x = pk2(s[0 * 33], s[1 * 33]); o.y = pk2(s[2 * 33], s[3 * 33]); o.z = pk2(s[4 * 33], s[5 * 33]); o.w = pk2(s[6 * 33], s[7 * 33]);
        const int nd = ropemap ? 8 * ((n & 15) >> 2) + 4 * (n >> 4) + (n & 3) : n;
        *(GAS v4u*)(WT + (size_t)(drow0 + nd) * ldt + dk0 + k0 + 8 * c) = o; }
    LDS_WAIT(); asm volatile("" ::: "memory");
}
__device__ __forceinline__ void transpose_item_f8(const float* W, int ldw, int k0, int n0, unsigned char* WT, int ldt, int drow0, float sc, LAS float* scr, int lane) {
    float rv[32];
#pragma unroll
    for (int i = 0; i < 32; ++i) rv[i] = W[(size_t)(k0 + 2 * i + (lane >> 5)) * ldw + n0 + (lane & 31)];
#pragma unroll
    for (int i = 0; i < 32; ++i) scr[(2 * i + (lane >> 5)) * 33 + (lane & 31)] = rv[i];
    LDS_WAIT(); asm volatile("" ::: "memory");
    const int c = lane & 3;
#pragma unroll
    for (int j = 0; j < 2; ++j) { const int n = (lane >> 2) + 16 * j; const LAS float* s = scr + (16 * c) * 33 + n;
        v4u o; o.x = pg8::pack4_fp8(s[0 * 33] * sc, s[1 * 33] * sc, s[2 * 33] * sc, s[3 * 33] * sc); o.y = pg8::pack4_fp8(s[4 * 33] * sc, s[5 * 33] * sc, s[6 * 33] * sc, s[7 * 33] * sc);
        o.z = pg8::pack4_fp8(s[8 * 33] * sc, s[9 * 33] * sc, s[10 * 33] * sc, s[11 * 33] * sc); o.w = pg8::pack4_fp8(s[12 * 33] * sc, s[13 * 33] * sc, s[14 * 33] * sc, s[15 * 33] * sc);
        *(GAS v4u*)(WT + (size_t)(drow0 + n) * ldt + k0 + 16 * c) = o; }
    LDS_WAIT(); asm volatile("" ::: "memory");
}
__device__ __forceinline__ void transpose_item_i8(const float* W, int ldw, int k0, int n0, unsigned char* WT, int ldt, int drow0, float sc, LAS float* scr, int lane) {
    float rv[32];
#pragma unroll
    for (int i = 0; i < 32; ++i) rv[i] = W[(size_t)(k0 + 2 * i + (lane >> 5)) * ldw + n0 + (lane & 31)];
#pragma unroll
    for (int i = 0; i < 32; ++i) scr[(2 * i + (lane >> 5)) * 33 + (lane & 31)] = rv[i];
    LDS_WAIT(); asm volatile("" ::: "memory");
    const int c = lane & 3;
#pragma unroll
    for (int j = 0; j < 2; ++j) { const int n = (lane >> 2) + 16 * j; const LAS float* s = scr + (16 * c) * 33 + n;
        v4u o; o.x = pg8::pack4_i8(s[0 * 33] * sc, s[1 * 33] * sc, s[2 * 33] * sc, s[3 * 33] * sc); o.y = pg8::pack4_i8(s[4 * 33] * sc, s[5 * 33] * sc, s[6 * 33] * sc, s[7 * 33] * sc);
        o.z = pg8::pack4_i8(s[8 * 33] * sc, s[9 * 33] * sc, s[10 * 33] * sc, s[11 * 33] * sc); o.w = pg8::pack4_i8(s[12 * 33] * sc, s[13 * 33] * sc, s[14 * 33] * sc, s[15 * 33] * sc);
        *(GAS v4u*)(WT + (size_t)(drow0 + n) * ldt + k0 + 16 * c) = o; }
    LDS_WAIT(); asm volatile("" ::: "memory");
}
constexpr bool DENSE0_BF16 = false;
constexpr float SC_H8 = 8.0f, SC_WGU8 = 64.0f, SC_HID8 = 4.0f, SC_WD8 = 128.0f, SC_Y8 = 16.0f;
struct CDesc { const float* W; bf16* WT; int K, N, ldt, roff, dk0, map; float f8sc; };
__device__ __forceinline__ void conv_run(Frame& F, const CDesc& d, int gw0, int ngw) {
    LAS float* scr = (LAS float*)(F.lds + F.wave * 16384);
    const int nblk = d.N / 32, items = (d.K / 64) * nblk;
    for (int it = gw0; it < items; it += ngw) { const int kb = it / nblk, nb = it % nblk, n0 = 32 * nb;
        int drow0 = d.map == 0 ? n0 + d.roff : (d.map == 1 ? (n0 >= 416 ? n0 + 96 : n0) : 256 * (n0 / 128) + (n0 % 128) + d.roff); bool rope = false;
        if (d.map == 3) { const int h = n0 / 96, r = n0 - 96 * h;
            if (r < 64) drow0 = 256 * (h >> 2) + 128 * (r >> 5) + 32 * (h & 3); else { drow0 = 512 + 128 * (h >> 2) + 32 * (h & 3); rope = true; } }
        if (d.map == 4) { const int h = n0 / 128, r = n0 - 128 * h;
            drow0 = r < 64 ? 768 + 256 * (h >> 2) + 128 * (r >> 5) + 32 * (h & 3) : 1280 + 64 * h + (r - 64); }
        if (d.f8sc != 0.f) transpose_item_f8(d.W, d.N, 64 * kb, n0, (unsigned char*)d.WT, d.ldt, drow0, d.f8sc, scr, F.lane);
        else transpose_item(d.W, d.N, 64 * kb, n0, d.WT, d.ldt, drow0, d.dk0, scr, F.lane, rope); }
}
__device__ __forceinline__ CDesc conv_desc(Frame& F, int idx, int moe_j) {
    CDesc d;
    if (idx < 16) { const int l = idx >> 2, m = idx & 3; bf16* base = wsp<bf16>(F, WS_WSMALL + (size_t)l * WSMALL_STRIDE);
        if (m == 0)      d = CDesc{INF(I_WIN) + (size_t)l * D * INCOLS, base, D, INCOLS, D, 0, 0, 1, 0.f};
        else if (m == 1) d = CDesc{INF(I_WQUP) + (size_t)l * 256 * 768, base + 3 * MiB / 2, 256, 768, 256, 0, 0, 3, 0.f};
        else if (m == 2) d = CDesc{INF(I_WKVUP) + (size_t)l * 128 * 1024, base + 3 * MiB / 2, 128, 1024, 256, 768, 0, 4, 0.f};
        else             d = CDesc{INF(I_WOUT) + (size_t)l * D * D, base + 6 * MiB / 2, D, D, D, 0, 0, 0, 0.f};
    } else if (idx < 22) { const int j = (idx - 16) / 3, m = (idx - 16) % 3; bf16* base = wsp<bf16>(F, WS_WDENSE + (size_t)j * WDENSE_STRIDE);
        if (m == 0)      d = CDesc{INF(I_FWG) + (size_t)j * D * DFF, base, D, DFF, D, 0, 0, 2, SC_WGU8};
        else if (m == 1) d = CDesc{INF(I_FWU) + (size_t)j * D * DFF, base, D, DFF, D, 128, 0, 2, SC_WGU8};
        else             d = CDesc{INF(I_FWD) + (size_t)j * DFF * D, base + (size_t)11 * MiB / 2, DFF, D, DFF, 0, 0, 0, SC_WD8};
    } else { const int e = (idx - 22) / 3, m = (idx - 22) % 3; const size_t we = (size_t)(moe_j * NEXP + e) * D * DFE;
        if (m == 0)      d = CDesc{INF(I_MWG) + we, (bf16*)(wsp<unsigned char>(F, WS_WMOE_GU) + (size_t)e * 2 * DFE * D), D, DFE, D, 0, 0, 2, SC_WGU8};
        else if (m == 1) d = CDesc{INF(I_MWU) + we, (bf16*)(wsp<unsigned char>(F, WS_WMOE_GU) + (size_t)e * 2 * DFE * D), D, DFE, D, 128, 0, 2, SC_WGU8};
        else             d = CDesc{INF(I_MWD) + we, (bf16*)(wsp<unsigned char>(F, WS_WMOE_D) + (size_t)e * D * DFE), DFE, D, DFE, 0, 0, 0, SC_WD8};
    }
    return d;
}
__device__ __forceinline__ void convert_range(Frame& F, int lo, int hi, int moe_j) {
    F.refresh();
    for (int idx = lo; idx < hi; ++idx) { if ((idx < 16 && (idx & 3) == 0) || idx == 16 || idx == 17 || idx == 19 || idx == 20) continue;
        const CDesc d = conv_desc(F, idx, moe_j); conv_run(F, d, F.gw, F.NGW); }
}
constexpr int MOE_EARLY_E = 6;
__device__ __forceinline__ void convert_moe_early(Frame& F, int rank, int nshare) {
    F.refresh();
    for (int e = 0; e < MOE_EARLY_E; ++e)
        for (int m = 0; m < 2; ++m) { const CDesc d = conv_desc(F, 22 + 3 * e + m, 1); conv_run(F, d, rank * NWAVES + F.wave, nshare * NWAVES); }
}
__device__ __forceinline__ void convert_moe_first(Frame& F) {
    F.refresh();
    for (int idx = 22; idx < 46; ++idx) { const CDesc d = conv_desc(F, idx, 0); conv_run(F, d, F.gw, F.NGW); }
    __syncthreads();
}
__device__ __forceinline__ void convert_moe_late(Frame& F) {
    F.refresh();
    for (int idx = 22; idx < 46; ++idx) { const int e = (idx - 22) / 3, m = (idx - 22) % 3; if (e < MOE_EARLY_E && m < 2) continue;
        const CDesc d = conv_desc(F, idx, 1); conv_run(F, d, F.gw, F.NGW); }
}
__device__ __forceinline__ void zero_block(Frame& F, bf16* WT, int ldt, int r0, int rows, int c0, int cols) {
    const int cpr = cols / 8, n = rows * cpr;
    v4u zz = (v4u){0u, 0u, 0u, 0u}; asm volatile("" : "+v"(zz));
    for (int i = F.gw * 64 + F.lane; i < n; i += F.NGW * 64) { const int r = i / cpr, cc = i % cpr; *(GAS v4u*)(WT + (size_t)(r0 + r) * ldt + c0 + 8 * cc) = zz; }
}
__device__ __forceinline__ float lane_absmax4(const GAS f32x4* W, int n4, int first, int step) {
    float m = 0.f;
    for (int i0 = first; i0 < n4; i0 += 8 * step) { f32x4 v[8];
#pragma unroll
        for (int u = 0; u < 8; ++u) { const int i = i0 + u * step; v[u] = i < n4 ? W[i] : (f32x4){0.f, 0.f, 0.f, 0.f}; }
#pragma unroll
        for (int u = 0; u < 8; ++u) m = __builtin_fmaxf(__builtin_fmaxf(m, __builtin_fmaxf(__builtin_fabsf(v[u].x), __builtin_fabsf(v[u].y))), __builtin_fmaxf(__builtin_fabsf(v[u].z), __builtin_fabsf(v[u].w))); }
    return m;
}
__device__ __forceinline__ void p0_prologue(Frame& F) {
    F.refresh();
    {
      const float* w_ada = INF(I_WADA); const float* cc = INF(I_C); float* modp = wsp<float>(F, WS_MODP);
      for (int task = F.gw; task < 8 * 4 * 48; task += F.NGW) {
        const int jb = task % 48, kq = (task / 48) % 4, ls = task / 192, j = jb * 64 + F.lane;
        const float* W = w_ada + (size_t)ls * D * 3072 + j; float a0 = 0.f, a1 = 0.f;
        for (int k0 = kq * 256; k0 < kq * 256 + 256; k0 += 32) { float wv[32];
#pragma unroll
            for (int i = 0; i < 32; ++i) wv[i] = W[(size_t)(k0 + i) * 3072];
#pragma unroll
            for (int i = 0; i < 32; ++i) { const float c0 = cc[k0 + i], c1 = cc[D + k0 + i]; a0 += c0 * pg8::sigmoidf_(c0) * wv[i]; a1 += c1 * pg8::sigmoidf_(c1) * wv[i]; } }
        modp[((size_t)(kq * 8 + ls) * 2 + 0) * 3072 + j] = a0; modp[((size_t)(kq * 8 + ls) * 2 + 1) * 3072 + j] = a1;
      } }
    {
      const float* w_in = INF(I_WIN);
      for (int l = 0; l < DEPTH; ++l) { float m = lane_absmax4((const GAS f32x4*)(w_in + (size_t)l * D * INCOLS), D * INCOLS / 4, F.gw * 64 + F.lane, F.NGW * 64);
          m = wave_max(m);
          if (F.lane == 0) __hip_atomic_fetch_max((unsigned*)(F.ctl + CW_WMAX + 64 * l), __float_as_uint(m), __ATOMIC_RELAXED, __HIP_MEMORY_SCOPE_AGENT); } }
    for (int j = 0; j < 2; ++j) { float m = 0.f;
      for (int h = 0; h < 2; ++h) m = __builtin_fmaxf(m, lane_absmax4((const GAS f32x4*)((h ? INF(I_FWU) : INF(I_FWG)) + (size_t)j * D * DFF), D * DFF / 4, F.gw * 64 + F.lane, F.NGW * 64));
      m = wave_max(m);
      if (F.lane == 0) __hip_atomic_fetch_max((unsigned*)(F.ctl + CW_WMAX + 64 * (4 + j)), __float_as_uint(m), __ATOMIC_RELAXED, __HIP_MEMORY_SCOPE_AGENT); }
    {
      const int* positions = (const int*)in_ptr<I_POS>(); float* cosT = wsp<float>(F, WS_COS); float* sinT = wsp<float>(F, WS_SIN);
      for (int i0 = F.gw * 64 + F.lane; i0 < NTOK * 16; i0 += 4 * F.NGW * 64) { int pv[4];
#pragma unroll
        for (int u = 0; u < 4; ++u) { const int i = i0 + u * F.NGW * 64; pv[u] = i < NTOK * 16 ? positions[i >> 4] : 0; }
#pragma unroll
        for (int u = 0; u < 4; ++u) { const int i = i0 + u * F.NGW * 64; if (i >= NTOK * 16) break; const int j = i & 15;
        const float invf = __builtin_amdgcn_exp2f(-(float)j * (13.287712379549449f / 16.0f));
        const float ang = (float)pv[u] * invf;
        const float rev = ang * 0.15915494309189535f; const float fr = rev - __builtin_floorf(rev);
        cosT[i] = __builtin_amdgcn_cosf(fr); sinT[i] = __builtin_amdgcn_sinf(fr); } } }
    {
      const float* lam = INF(I_LAM); float* lamc = wsp<float>(F, WS_LAMC);
      for (int i = F.gw * 64 + F.lane; i < DEPTH * LRUW; i += F.NGW * 64) { const float t = __builtin_amdgcn_exp2f(-1.4426950408889634f * lam[i]); lamc[i] = t < 0.02f ? -8.0f * 1.4426950408889634f * t * (1.0f - t * (0.5f - t * (0.33333334f - 0.25f * t))) : -8.0f * __builtin_amdgcn_logf(1.0f + t); } }
    convert_range(F, 0, F.G == 256 ? 22 : 46, 0);
    for (int l = 0; l < DEPTH; ++l) {
        bf16* Win_t = wsp<bf16>(F, WS_WSMALL + (size_t)l * WSMALL_STRIDE); bf16* Wup_t = Win_t + 3 * MiB / 2; bf16* Wg_t = Win_t + 5 * MiB / 2;
        zero_block(F, Win_t, D / 2, 416, 96, 0, D / 2);
        zero_block(F, Wup_t, 256, 768, 1024, 128, 128);
        const float* w_a = INF(I_WA); const float* w_x = INF(I_WX);
        for (int i8 = F.gw * 64 + F.lane; i8 < 1024 * 16; i8 += F.NGW * 64) {
            const int row = i8 >> 4, kq0 = (i8 & 15) * 8, pn = row >> 8, half = (row >> 7) & 1, ch = 128 * pn + (row & 127), g = ch >> 6, kA0 = 128 * pn + kq0;
            float v[8];
#pragma unroll
            for (int e = 0; e < 8; ++e) v[e] = 0.f;
            if ((kA0 >> 6) == g) { const float* sp = (half ? w_x : w_a) + (((size_t)l * 8 + g) * 64 + (kA0 & 63)) * 64 + (ch & 63);
#pragma unroll
                for (int e = 0; e < 8; ++e) v[e] = sp[(size_t)e * 64]; }
            *(GAS v4u*)(Wg_t + (size_t)row * 128 + kq0) = (v4u){pk2(v[0], v[1]), pk2(v[2], v[3]), pk2(v[4], v[5]), pk2(v[6], v[7])}; }
    }
}
__device__ __forceinline__ void p0_finalise(Frame& F) {
    F.refresh();
    const float* b_ada = INF(I_BADA); const float* modp = wsp<float>(F, WS_MODP); float* mod = wsp<float>(F, WS_MOD);
    for (int i = F.gw * 64 + F.lane; i < 8 * 2 * 3072; i += F.NGW * 64) { const int j = i % 3072, ls = i / 6144;
        float v = b_ada[ls * 3072 + j];
#pragma unroll
        for (int kq = 0; kq < 4; ++kq) v += modp[(size_t)kq * 8 * 2 * 3072 + i];
        mod[i] = v; }
    float wmx[6];
#pragma unroll
    for (int q = 0; q < 6; ++q) wmx[q] = __uint_as_float(__hip_atomic_load((unsigned*)(F.ctl + CW_WMAX + 64 * q), __ATOMIC_RELAXED, __HIP_MEMORY_SCOPE_AGENT));
    if (F.gw == 0 && F.lane < 6) { float v = wmx[0];
#pragma unroll
        for (int q = 1; q < 6; ++q) if (F.lane == q) v = wmx[q];
        wsp<float>(F, WS_MREF)[8 + F.lane] = v * (1.0f / 127.0f); }
    if (F.gw == 0 && F.lane < DEPTH) { const int l = F.lane; const float* qg = INF(I_QGAIN) + l * 96; const float* kg = INF(I_KGAIN) + l * 96; float a = 0.f, bq = 0.f, c = 0.f, d = 0.f;
        for (int i = 0; i < 64; ++i) { a = fmaxf(a, qg[i] * qg[i]); c = fmaxf(c, kg[i] * kg[i]); }
        for (int i = 64; i < 96; ++i) { bq = fmaxf(bq, qg[i] * qg[i]); d = fmaxf(d, kg[i] * kg[i]); }
        wsp<float>(F, WS_MREF)[l] = 1.01f * 0.10206207261596577f * 1.4426950408889634f * sqrtf(64.f * a + 32.f * bq) * sqrtf(64.f * c + 32.f * d); }
    { LAS float* scr = (LAS float*)(F.lds + F.wave * 16384); const int nblk = INCOLS / 32, items = (D / 64) * nblk;
      for (int it = F.gw; it < DEPTH * items; it += F.NGW) { const int l = it / items, r = it - l * items, kb = r / nblk, nb = r - kb * nblk, n0 = 32 * nb;
          float wm = wmx[0];
#pragma unroll
          for (int q = 1; q < 4; ++q) if (l == q) wm = wmx[q];
          transpose_item_i8(INF(I_WIN) + (size_t)l * D * INCOLS, INCOLS, 64 * kb, n0, wsp<unsigned char>(F, WS_WSMALL + (size_t)l * WSMALL_STRIDE), D, n0 >= 416 ? n0 + 96 : n0, 127.0f / __builtin_fmaxf(wm, 1e-30f), scr, F.lane); } }
    { LAS float* scr = (LAS float*)(F.lds + F.wave * 16384); const int nblk = DFF / 32, items = (D / 64) * nblk;
      for (int it = F.gw; it < 4 * items; it += F.NGW) { const int q = it / items, j = q >> 1, h = q & 1, r = it - q * items, kb = r / nblk, nb = r - kb * nblk, n0 = 32 * nb;
          const float wm = j ? wmx[5] : wmx[4];
          transpose_item_i8((h ? INF(I_FWU) : INF(I_FWG)) + (size_t)j * D * DFF, DFF, 64 * kb, n0, wsp<unsigned char>(F, WS_WDENSE + (size_t)j * WDENSE_STRIDE), D, 256 * (n0 / 128) + (n0 % 128) + (h ? 128 : 0), 127.0f / __builtin_fmaxf(wm, 1e-30f), scr, F.lane); } }
}

template <bool COMBINE, bool NORM, bool ROUTER, bool F8H = false, bool I8H = false, bool XB16 = true, bool XO16 = true>
__device__ __forceinline__ void norm_pass(Frame& F, const void* xin_, void* xout_, int ls, int ls_prev, int moe_j) {
    const float* xin = (const float*)xin_; const bf16* xinb = (const bf16*)xin_; float* xout = (float*)xout_; bf16* xoutb = (bf16*)xout_;
    F.refresh();
    LAS float* gs = (LAS float*)(F.lds); LAS float* sh = gs + 2048;
    LAS int* lcnt = (LAS int*)(F.lds + 16384); LAS int* gbase = lcnt + 16; LAS int* ltab = lcnt + 32;
    const int lane = F.lane;
    const float* mod = wsp<float>(F, WS_MOD); bf16* hbuf = wsp<bf16>(F, WS_H); float* rsc_ = wsp<float>(F, WS_RSC);
    int* tok_e = wsp<int>(F, WS_TOKE); int* tok_r = wsp<int>(F, WS_TOKR); float* tok_w = wsp<float>(F, WS_TOKW); const int* tok_p = wsp<int>(F, WS_TOKP); const unsigned char* y2 = wsp<unsigned char>(F, WS_Y2);
    if (NORM) { const float* modl = mod + (size_t)ls * 2 * 3072; const float* ng = INF(I_NGAIN) + (size_t)ls * D;
        float t_ng[4], t_sc[4], t_sh[4];
#pragma unroll
        for (int u = 0; u < 4; ++u) { const int i = F.tid + u * NWAVES * 64, b = i >> 10, j = i & 1023; t_ng[u] = ng[j]; t_sc[u] = modl[b * 3072 + 1024 + j]; t_sh[u] = modl[b * 3072 + j]; }
#pragma unroll
        for (int u = 0; u < 4; ++u) { const int i = F.tid + u * NWAVES * 64; gs[i] = t_ng[u] * (1.0f + t_sc[u]); sh[i] = t_sh[u]; } }
    const float* rw = ROUTER ? INF(I_RW) + (size_t)moe_j * D * 8 : nullptr;
    f32x4 rwa[16], rwb[16];
    if (ROUTER) {
#pragma unroll
        for (int jq = 0; jq < 16; ++jq) { const f32x4* wp = (const f32x4*)(rw + (size_t)(4 * lane + 256 * (jq >> 2) + (jq & 3)) * 8); rwa[jq] = wp[0]; rwb[jq] = wp[1]; } }
    __syncthreads();
    for (int blk = F.vcu; blk < NTOK / 128; blk += F.G) {
        if (ROUTER) { if (F.tid < 8) lcnt[F.tid] = 0; __syncthreads(); }
        f32x4 nx[4]; v2u nxb[4];
        if (XB16) { const GAS v2u* xr = (const GAS v2u*)(xinb + (size_t)(blk * 128 + F.wave * 16) * D) + lane;
#pragma unroll
          for (int j = 0; j < 4; ++j) nxb[j] = xr[64 * j]; }
        else { const GAS f32x4* xr = (const GAS f32x4*)(xin + (size_t)(blk * 128 + F.wave * 16) * D) + lane;
#pragma unroll
          for (int j = 0; j < 4; ++j) nx[j] = xr[64 * j]; }
        for (int i = 0; i < 16; ++i) {
            const int row = blk * 128 + F.wave * 16 + i, b = row >> 14;
            f32x4 v[4];
#pragma unroll
            for (int j = 0; j < 4; ++j) { if (XB16) v[j] = (f32x4){bflo(nxb[j].x), bfhi(nxb[j].x), bflo(nxb[j].y), bfhi(nxb[j].y)}; else v[j] = nx[j]; }
            if (i < 15) {
                if (XB16) { const GAS v2u* xr = (const GAS v2u*)(xinb + (size_t)(row + 1) * D) + lane;
#pragma unroll
                    for (int j = 0; j < 4; ++j) nxb[j] = xr[64 * j]; }
                else { const GAS f32x4* xr = (const GAS f32x4*)(xin + (size_t)(row + 1) * D) + lane;
#pragma unroll
                    for (int j = 0; j < 4; ++j) nx[j] = xr[64 * j]; } }
            if (!XB16 && !COMBINE) { GAS v2u* xob = (GAS v2u*)(xoutb + (size_t)row * D) + lane;
#pragma unroll
                for (int j = 0; j < 4; ++j) xob[64 * j] = (v2u){pk2(v[j].x, v[j].y), pk2(v[j].z, v[j].w)}; }
            if (COMBINE) {
                const int p0 = tok_p[row * 2], p1 = tok_p[row * 2 + 1]; const float w0 = tok_w[row * 2] * (1.0f / SC_Y8), w1 = tok_w[row * 2 + 1] * (1.0f / SC_Y8);
                const float* gp = mod + (size_t)ls_prev * 2 * 3072 + b * 3072 + 2048;
                GAS f32x4* xo = (GAS f32x4*)(xout + (size_t)row * D) + lane; GAS v2u* xob = (GAS v2u*)(xoutb + (size_t)row * D) + lane;
                unsigned yav[4], ybv[4]; f32x4 gvv[4];
#pragma unroll
                for (int j = 0; j < 4; ++j) { yav[j] = *(const unsigned*)(y2 + (size_t)p0 * D + 4 * lane + 256 * j); ybv[j] = *(const unsigned*)(y2 + (size_t)p1 * D + 4 * lane + 256 * j); gvv[j] = *(const f32x4*)(gp + 4 * lane + 256 * j); }
                asm volatile("" ::: "memory");
#pragma unroll
                for (int j = 0; j < 4; ++j) { const f32x4 g = gvv[j]; typedef float f32x2_ __attribute__((ext_vector_type(2)));
                    const f32x2_ a01 = __builtin_amdgcn_cvt_pk_f32_fp8((int)yav[j], false), a23 = __builtin_amdgcn_cvt_pk_f32_fp8((int)yav[j], true), b01 = __builtin_amdgcn_cvt_pk_f32_fp8((int)ybv[j], false), b23 = __builtin_amdgcn_cvt_pk_f32_fp8((int)ybv[j], true);
                    v[j].x += g.x * (w0 * a01.x + w1 * b01.x); v[j].y += g.y * (w0 * a01.y + w1 * b01.y);
                    v[j].z += g.z * (w0 * a23.x + w1 * b23.x); v[j].w += g.w * (w0 * a23.y + w1 * b23.y);
                    if (XO16) { const v2u o2 = (v2u){pk2(v[j].x, v[j].y), pk2(v[j].z, v[j].w)}; xob[64 * j] = o2; v[j] = (f32x4){bflo(o2.x), bfhi(o2.x), bflo(o2.y), bfhi(o2.y)}; }
                    else xo[64 * j] = v[j]; }
            }
            if (NORM) {
                float ss = 0.f;
#pragma unroll
                for (int j = 0; j < 4; ++j) ss += (v[j].x * v[j].x + v[j].y * v[j].y) + (v[j].z * v[j].z + v[j].w * v[j].w);
                const float rstd = 1.0f / sqrtf(wave_sum(ss) * (1.0f / D) + EPS);
                GAS unsigned long long* o8 = (GAS unsigned long long*)(hbuf + (size_t)row * D) + lane;
                GAS unsigned* o4 = (GAS unsigned*)((unsigned char*)hbuf + (size_t)row * D) + lane;
#pragma unroll
                for (int j = 0; j < 4; ++j) { const f32x4 g = *(const LAS f32x4*)(gs + b * 1024 + 4 * lane + 256 * j), s = *(const LAS f32x4*)(sh + b * 1024 + 4 * lane + 256 * j);
                    v[j] = v[j] * rstd * g + s;
                    if (I8H) continue;
                    if (F8H) o4[64 * j] = pg8::pack4_fp8(v[j].x * SC_H8, v[j].y * SC_H8, v[j].z * SC_H8, v[j].w * SC_H8);
                    else o8[64 * j] = (unsigned long long)pk2(v[j].x, v[j].y) | ((unsigned long long)pk2(v[j].z, v[j].w) << 32); }
                if (I8H) { float am = 0.f;
#pragma unroll
                    for (int j = 0; j < 4; ++j) am = __builtin_fmaxf(__builtin_fmaxf(am, __builtin_fmaxf(__builtin_fabsf(v[j].x), __builtin_fabsf(v[j].y))), __builtin_fmaxf(__builtin_fabsf(v[j].z), __builtin_fabsf(v[j].w)));
                    am = __builtin_fmaxf(wave_max(am), 1e-30f); const float qs = 127.0f / am;
#pragma unroll
                    for (int j = 0; j < 4; ++j) o4[64 * j] = pg8::pack4_i8(v[j].x * qs, v[j].y * qs, v[j].z * qs, v[j].w * qs);
                    if (lane == 0) rsc_[row] = am * (1.0f / 127.0f); }
                if (ROUTER) {
                    float lg[8];
#pragma unroll
                    for (int e = 0; e < 8; ++e) lg[e] = 0.f;
#pragma unroll
                    for (int j = 0; j < 4; ++j)
#pragma unroll
                        for (int q = 0; q < 4; ++q) { const float hv = v[j][q]; const f32x4 wa = rwa[4 * j + q], wb = rwb[4 * j + q];
                            lg[0] += hv * wa.x; lg[1] += hv * wa.y; lg[2] += hv * wa.z; lg[3] += hv * wa.w; lg[4] += hv * wb.x; lg[5] += hv * wb.y; lg[6] += hv * wb.z; lg[7] += hv * wb.w; }
#pragma unroll
                    for (int e = 0; e < 8; ++e) lg[e] = wave_sum(lg[e]);
                    int e0 = 0; float v0 = lg[0];
#pragma unroll
                    for (int e = 1; e < 8; ++e) if (lg[e] > v0) { v0 = lg[e]; e0 = e; }
                    int e1 = 0; float v1 = -__builtin_inff();
#pragma unroll
                    for (int e = 0; e < 8; ++e) if (e != e0 && lg[e] > v1) { v1 = lg[e]; e1 = e; }
                    const float w0 = 1.0f / (1.0f + __builtin_amdgcn_exp2f(1.4426950408889634f * (v1 - v0))), w1 = 1.0f - w0;
                    if (lane == 0) { const int r0 = __hip_atomic_fetch_add(lcnt + e0, 1, __ATOMIC_RELAXED, __HIP_MEMORY_SCOPE_WORKGROUP), r1 = __hip_atomic_fetch_add(lcnt + e1, 1, __ATOMIC_RELAXED, __HIP_MEMORY_SCOPE_WORKGROUP);
                        LAS int* lt = ltab + (F.wave * 16 + i) * 8; lt[0] = e0; lt[1] = e1; lt[2] = r0; lt[3] = r1; lt[4] = (int)__float_as_uint(w0); lt[5] = (int)__float_as_uint(w1); }
                }
            }
        }
        if (ROUTER) {
            __syncthreads();
            if (F.tid < 8) gbase[F.tid] = (int)__hip_atomic_fetch_add((unsigned*)(F.ctl + CW_GCNT + 64 * (8 * moe_j + F.tid)), (unsigned)lcnt[F.tid], RLX_AGENT);
            __syncthreads();
            if (F.tid < 128) { const int row = blk * 128 + F.tid; const LAS int* lt = ltab + F.tid * 8; const int e0 = lt[0], e1 = lt[1];
                tok_e[row * 2] = e0; tok_e[row * 2 + 1] = e1; tok_r[row * 2] = gbase[e0] + lt[2]; tok_r[row * 2 + 1] = gbase[e1] + lt[3];
                tok_w[row * 2] = __uint_as_float((unsigned)lt[4]); tok_w[row * 2 + 1] = __uint_as_float((unsigned)lt[5]); }
            __syncthreads();
        }
    }
    __syncthreads();
}

__device__ __forceinline__ void mid_pass(Frame& F, int l) {
    F.refresh();
    const int lane = F.lane;
    const bf16* z = wsp<bf16>(F, WS_Z); bf16* A2 = wsp<bf16>(F, WS_A2); bf16* Kb = wsp<bf16>(F, WS_K); bf16* xrb = wsp<bf16>(F, WS_XR);
    const float* cosT = wsp<float>(F, WS_COS); const float* sinT = wsp<float>(F, WS_SIN);
    const float* lg = INF(I_LGAIN) + l * 384; const f32x4 lgq = *(const f32x4*)(lg + 4 * lane); const f32x4 lgkv = *(const f32x4*)(lg + 256 + 4 * (lane & 31));
    const float* kg = INF(I_KGAIN) + l * 96; const float kg1 = kg[64 + (lane & 15)], kg2 = kg[80 + (lane & 15)];
    const float* conv_w = INF(I_CONVW); const float* conv_b = INF(I_CONVB);
    float cw[4][8], cb[8];
#pragma unroll
    for (int e = 0; e < 8; ++e) { cb[e] = conv_b[l * 512 + 8 * lane + e];
#pragma unroll
        for (int j = 0; j < 4; ++j) cw[j][e] = conv_w[(size_t)(l * 4 + j) * 512 + 8 * lane + e]; }
    struct MidIn { uint2 q2, k2; bf16 x1, x2; v4u xw[4]; float cs, sn; };
    auto mid_load = [&](int row) -> MidIn { MidIn r; const bf16* zr = z + (size_t)row * INP; const int t = row & (SEQ - 1);
        r.q2 = *(const uint2*)(zr + 4 * lane); r.k2 = *(const uint2*)(zr + 256 + 4 * (lane & 31)); r.x1 = zr[384 + (lane & 15)]; r.x2 = zr[400 + (lane & 15)];
#pragma unroll
        for (int j = 0; j < 4; ++j) { if (t - 3 + j >= 0) r.xw[j] = *(const v4u*)(zr + (long)(j - 3) * INP + 512 + 8 * lane); else r.xw[j] = (v4u){0u, 0u, 0u, 0u}; }
        r.cs = cosT[row * 16 + (lane & 15)]; r.sn = sinT[row * 16 + (lane & 15)]; return r; };
    MidIn nxt = mid_load(F.gw < NTOK ? F.gw : 0);
    for (int row = F.gw; row < NTOK; row += F.NGW) {
        const MidIn in = nxt;
        if (row + F.NGW < NTOK) nxt = mid_load(row + F.NGW);
        const float q0 = bflo(in.q2.x), q1 = bfhi(in.q2.x), q2f = bflo(in.q2.y), q3 = bfhi(in.q2.y);
        float ssq = (q0 * q0 + q1 * q1) + (q2f * q2f + q3 * q3);
        const float k0 = bflo(in.k2.x), k1 = bfhi(in.k2.x), k2f = bflo(in.k2.y), k3 = bfhi(in.k2.y);
        float sskv = lane < 32 ? (k0 * k0 + k1 * k1) + (k2f * k2f + k3 * k3) : 0.f;
        const float x1 = bf1(in.x1), x2 = bf1(in.x2);
        float ssr = lane < 16 ? x1 * x1 + x2 * x2 : 0.f;
        ssq = wave_sum(ssq); sskv = wave_sum(sskv); ssr = wave_sum(ssr);
        const float rq = 1.0f / sqrtf(ssq * (1.0f / 256.0f) + EPS), rkv = 1.0f / sqrtf(sskv * (1.0f / 128.0f) + EPS), rr = 1.0f / sqrtf(ssr * (1.0f / 32.0f) + EPS);
        *(uint2*)(A2 + (size_t)row * 256 + 4 * lane) = make_uint2(pk2(q0 * rq * lgq.x, q1 * rq * lgq.y), pk2(q2f * rq * lgq.z, q3 * rq * lgq.w));
        if (lane < 32) *(uint2*)(A2 + (size_t)(NTOK + row) * 256 + 4 * lane) = make_uint2(pk2(k0 * rkv * lgkv.x, k1 * rkv * lgkv.y), pk2(k2f * rkv * lgkv.z, k3 * rkv * lgkv.w));
        if (lane < 16) { const float a = x1 * rr * kg1, bb = x2 * rr * kg2;
            const bf16 o1 = (bf16)f2bf(a * in.cs - bb * in.sn), o2 = (bf16)f2bf(a * in.sn + bb * in.cs); bf16* kr = Kb + (size_t)row * 768 + 64 + lane;
#pragma unroll
            for (int hh = 0; hh < 8; ++hh) { kr[hh * 96] = o1; kr[hh * 96 + 16] = o2; } }
        float acc[8];
#pragma unroll
        for (int e = 0; e < 8; ++e) acc[e] = cb[e];
#pragma unroll
        for (int j = 0; j < 4; ++j) { const v4u xw = in.xw[j];
                acc[0] += cw[j][0] * bflo(xw.x); acc[1] += cw[j][1] * bfhi(xw.x); acc[2] += cw[j][2] * bflo(xw.y); acc[3] += cw[j][3] * bfhi(xw.y);
                acc[4] += cw[j][4] * bflo(xw.z); acc[5] += cw[j][5] * bfhi(xw.z); acc[6] += cw[j][6] * bflo(xw.w); acc[7] += cw[j][7] * bfhi(xw.w); }
        *(v4u*)(xrb + ((size_t)(lane >> 4) * NTOK + row) * 128 + 8 * (lane & 15)) = (v4u){pk2(acc[0], acc[1]), pk2(acc[2], acc[3]), pk2(acc[4], acc[5]), pk2(acc[6], acc[7])};
    }
}

__device__ __forceinline__ void qk_pass(Frame& F, int l) {
    F.refresh();
    const int lane = F.lane, g8 = lane & 7, h8 = lane >> 3, g4 = lane & 3, h4 = (lane >> 2) & 7;
    const float C2 = 0.10206207261596577f * 1.4426950408889634f;
    const bf16* qkv = wsp<bf16>(F, WS_QKV); bf16* Qb = wsp<bf16>(F, WS_Q); bf16* Kb = wsp<bf16>(F, WS_K);
    const float* cosT = wsp<float>(F, WS_COS); const float* sinT = wsp<float>(F, WS_SIN);
    const float* q_gain = INF(I_QGAIN) + l * 96; const float* k_gain = INF(I_KGAIN) + l * 96;
    float qgn[8], kgn[8], qgr[8];
#pragma unroll
    for (int e = 0; e < 8; ++e) { qgn[e] = q_gain[g8 * 8 + e]; kgn[e] = k_gain[g8 * 8 + e]; qgr[e] = q_gain[64 + g4 * 8 + e]; }
    struct QkIn { v4u qn, kn, qp; f32x4 ca, cb, sa, sb; };
    auto qk_load = [&](int row) -> QkIn { QkIn r; const bf16* qr = qkv + (size_t)row * UPN;
        r.qn = *(const v4u*)(qr + h8 * 96 + g8 * 8); r.kn = *(const v4u*)(qr + 768 + h8 * 128 + g8 * 8); r.qp = *(const v4u*)(qr + h4 * 96 + 64 + g4 * 8);
        r.ca = *(const f32x4*)(cosT + row * 16 + (g4 & 1) * 8); r.cb = *(const f32x4*)(cosT + row * 16 + (g4 & 1) * 8 + 4);
        r.sa = *(const f32x4*)(sinT + row * 16 + (g4 & 1) * 8); r.sb = *(const f32x4*)(sinT + row * 16 + (g4 & 1) * 8 + 4); return r; };
    QkIn nxt = qk_load(F.gw < NTOK ? F.gw : 0);
    for (int row = F.gw; row < NTOK; row += F.NGW) {
        const QkIn in = nxt;
        if (row + F.NGW < NTOK) nxt = qk_load(row + F.NGW);
        float v[8], o[8];
#define UP8(dst, w_) do { dst[0] = bflo(w_.x); dst[1] = bfhi(w_.x); dst[2] = bflo(w_.y); dst[3] = bfhi(w_.y); dst[4] = bflo(w_.z); dst[5] = bfhi(w_.z); dst[6] = bflo(w_.w); dst[7] = bfhi(w_.w); } while (0)
#define ST8(p, s) do { *(v4u*)(p) = (v4u){pk2(s[0], s[1]), pk2(s[2], s[3]), pk2(s[4], s[5]), pk2(s[6], s[7])}; } while (0)
        UP8(v, in.qn);
        { float ss = 0.f;
#pragma unroll
          for (int e = 0; e < 8; ++e) ss += v[e] * v[e];
          ss += swz_xor<1>(ss); ss += swz_xor<2>(ss); ss += swz_xor<4>(ss);
          const float rs = C2 / sqrtf(ss * (1.0f / 64.0f) + EPS);
#pragma unroll
          for (int e = 0; e < 8; ++e) o[e] = v[e] * rs * qgn[e];
          ST8(Qb + (size_t)row * 768 + h8 * 96 + g8 * 8, o); }
        UP8(v, in.kn);
        { float ss = 0.f;
#pragma unroll
          for (int e = 0; e < 8; ++e) ss += v[e] * v[e];
          ss += swz_xor<1>(ss); ss += swz_xor<2>(ss); ss += swz_xor<4>(ss);
          const float rs = 1.0f / sqrtf(ss * (1.0f / 64.0f) + EPS);
#pragma unroll
          for (int e = 0; e < 8; ++e) o[e] = v[e] * rs * kgn[e];
          ST8(Kb + (size_t)row * 768 + h8 * 96 + g8 * 8, o); }
        UP8(v, in.qp);
        { float ss = 0.f;
#pragma unroll
          for (int e = 0; e < 8; ++e) ss += v[e] * v[e];
          ss += swz_xor<1>(ss); ss += swz_xor<2>(ss);
          const float rs = 1.0f / sqrtf(ss * (1.0f / 32.0f) + EPS);
#pragma unroll
          for (int e = 0; e < 8; ++e) { const float vn = v[e] * rs * qgr[e]; const float pe = swz_xor<2>(vn);
              const float cs = e < 4 ? in.ca[e & 3] : in.cb[e & 3], sn = e < 4 ? in.sa[e & 3] : in.sb[e & 3];
              o[e] = (g4 < 2 ? vn * cs - pe * sn : pe * sn + vn * cs) * C2; }
          if (lane < 32) ST8(Qb + (size_t)row * 768 + h4 * 96 + 64 + g4 * 8, o); }
#undef UP8
#undef ST8
    }
}

__device__ __forceinline__ void scan_a(Frame& F) {
    F.refresh();
    const int ch = F.tid;
    const unsigned* lu = wsp<unsigned>(F, WS_LA); float* Pl = wsp<float>(F, WS_PL); float* Hc = wsp<float>(F, WS_HC);
    for (int un = F.vcu; un < 256; un += F.G) {
        const size_t r0 = (size_t)un * 128; float S = 0.f, H = 0.f;
        for (int t0 = 0; t0 < 128; t0 += 32) { unsigned w[32];
#pragma unroll
            for (int t = 0; t < 32; ++t) w[t] = lu[(r0 + t0 + t) * LRUW + ch];
#pragma unroll
            for (int t = 0; t < 32; ++t) { const float l2 = bflo(w[t]); H = __builtin_amdgcn_exp2f(l2) * H + bfhi(w[t]); S += l2; } }
        Pl[(size_t)un * LRUW + ch] = S; Hc[(size_t)un * LRUW + ch] = H;
    }
}
__device__ __forceinline__ void scan_arrive(Frame& F, int l) {
    asm volatile("s_waitcnt vmcnt(0)" ::: "memory");
    __syncthreads();
    int t0 = threadIdx.x; asm volatile("" : "+v"(t0));
    if (t0 == 0) { __builtin_amdgcn_fence(__ATOMIC_RELEASE, "agent"); asm volatile("s_waitcnt vmcnt(0)" ::: "memory"); (void)xb_add((unsigned*)(F.ctl + CW_SCNT + 16 * l), 1u); }
}
__device__ __forceinline__ void scan_wait(Frame& F, int l) {
    int t0 = threadIdx.x; asm volatile("" : "+v"(t0));
    if (t0 == 0) { unsigned* bar = (unsigned*)(F.ctl + CW_BAR); unsigned* cnt = (unsigned*)(F.ctl + CW_SCNT + 16 * l);
        XB_SPIN(xb_ld(cnt) < 256u, bar);
        __builtin_amdgcn_fence(__ATOMIC_ACQUIRE, "agent"); asm volatile("s_waitcnt vmcnt(0)" ::: "memory"); }
    __syncthreads();
}
__device__ __forceinline__ float gelu_tanh(float x) {
    const float y = 0.7978845608028654f * (x + 0.044715f * x * x * x);
    return x * __builtin_amdgcn_rcpf(1.0f + __builtin_amdgcn_exp2f(-2.0f * 1.4426950408889634f * y));
}
__device__ __forceinline__ void scan_c(Frame& F, int l) {
    F.refresh();
    const int ch = F.tid, lane = F.lane;
    LAS float* st = (LAS float*)F.lds;
    const unsigned* lu = wsp<unsigned>(F, WS_LA); const float* Pl = wsp<float>(F, WS_PL); const float* Hc = wsp<float>(F, WS_HC);
    const bf16* z = wsp<bf16>(F, WS_Z); bf16* y = wsp<bf16>(F, WS_Y);
    const float* out_gain = INF(I_OGAIN) + l * D + 512;
    float og[8];
#pragma unroll
    for (int e = 0; e < 8; ++e) og[e] = out_gain[8 * lane + e];
    for (int un = F.vcu; un < 256; un += F.G) {
        const int c = un & 127, b = un >> 7; const size_t r0 = (size_t)un * 128;
        unsigned w[32]; bf16 gq[32];
#pragma unroll
        for (int t = 0; t < 32; ++t) { w[t] = lu[(r0 + t) * LRUW + ch]; gq[t] = z[(r0 + t) * INP + 1024 + ch]; }
        float hst = 0.f;
        {
            float plA[16], hcA[16], plB[16], hcB[16];
#define SCC_LOAD(PLv, HCv, c0_) do { _Pragma("unroll") for (int u = 0; u < 16; ++u) { const int cc = (c0_) + u; const size_t o = (size_t)(b * 128 + (cc < c ? cc : 0)) * LRUW + ch; PLv[u] = cc < c ? Pl[o] : 0.f; HCv[u] = cc < c ? Hc[o] : 0.f; } } while (0)
#define SCC_STEP(PLv, HCv) do { _Pragma("unroll") for (int u = 0; u < 16; ++u) hst = __builtin_amdgcn_exp2f(PLv[u]) * hst + HCv[u]; } while (0)
            if (c > 0) SCC_LOAD(plA, hcA, 0);
            for (int c0 = 0; c0 < c; c0 += 32) {
                if (c0 + 16 < c) SCC_LOAD(plB, hcB, c0 + 16);
                SCC_STEP(plA, hcA);
                if (c0 + 16 >= c) break;
                if (c0 + 32 < c) SCC_LOAD(plA, hcA, c0 + 32);
                SCC_STEP(plB, hcB);
            }
#undef SCC_LOAD
#undef SCC_STEP
        }
        for (int sub = 0; sub < 4; ++sub) {
#pragma unroll
            for (int t = 0; t < 32; ++t) { hst = __builtin_amdgcn_exp2f(bflo(w[t])) * hst + bfhi(w[t]); st[t * 512 + ch] = hst * gelu_tanh(bf1(gq[t])); }
            if (sub < 3) {
#pragma unroll
                for (int t = 0; t < 32; ++t) { w[t] = lu[(r0 + (sub + 1) * 32 + t) * LRUW + ch]; gq[t] = z[(r0 + (sub + 1) * 32 + t) * INP + 1024 + ch]; } }
            __syncthreads();
#pragma unroll
            for (int tt = 0; tt < 4; ++tt) { const int t = F.wave * 4 + tt; const size_t row = r0 + sub * 32 + t;
                const f32x4 a = *(const LAS f32x4*)(st + t * 512 + 8 * lane), bq = *(const LAS f32x4*)(st + t * 512 + 8 * lane + 4);
                float ss = (a.x * a.x + a.y * a.y) + (a.z * a.z + a.w * a.w) + (bq.x * bq.x + bq.y * bq.y) + (bq.z * bq.z + bq.w * bq.w);
                const float rs = 1.0f / sqrtf(wave_sum(ss) * (1.0f / 512.0f) + EPS);
                *(v4u*)(y + row * D + 512 + 8 * lane) = (v4u){pk2(a.x * rs * og[0], a.y * rs * og[1]), pk2(a.z * rs * og[2], a.w * rs * og[3]), pk2(bq.x * rs * og[4], bq.y * rs * og[5]), pk2(bq.z * rs * og[6], bq.w * rs * og[7])}; }
            __syncthreads();
        }
    }
}
__device__ __forceinline__ void attn_norm_pass(Frame& F, int l) {
    F.refresh();
    const int lane = F.lane; float og[8];
    const float* out_gain = INF(I_OGAIN) + l * D; bf16* y = wsp<bf16>(F, WS_Y);
#pragma unroll
    for (int e = 0; e < 8; ++e) og[e] = out_gain[8 * lane + e];
    for (int row0 = F.gw; row0 < NTOK; row0 += 4 * F.NGW) {
        v4u wv[4];
#pragma unroll
        for (int r = 0; r < 4; ++r) { const int row = row0 + r * F.NGW; if (row < NTOK) wv[r] = *(const v4u*)(y + (size_t)row * D + 8 * lane); else wv[r] = (v4u){0u, 0u, 0u, 0u}; }
#pragma unroll
        for (int r = 0; r < 4; ++r) { const int row = row0 + r * F.NGW; const v4u w = wv[r];
            const float v0 = bflo(w.x), v1 = bfhi(w.x), v2 = bflo(w.y), v3 = bfhi(w.y), v4 = bflo(w.z), v5 = bfhi(w.z), v6 = bflo(w.w), v7 = bfhi(w.w);
            const float ss = (v0 * v0 + v1 * v1) + (v2 * v2 + v3 * v3) + (v4 * v4 + v5 * v5) + (v6 * v6 + v7 * v7);
            const float rs = 1.0f / sqrtf(wave_sum(ss) * (1.0f / 512.0f) + EPS);
            if (row < NTOK) *(v4u*)(y + (size_t)row * D + 8 * lane) = (v4u){pk2(v0 * rs * og[0], v1 * rs * og[1]), pk2(v2 * rs * og[2], v3 * rs * og[3]), pk2(v4 * rs * og[4], v5 * rs * og[5]), pk2(v6 * rs * og[6], v7 * rs * og[7])}; }
    }
}
__device__ __forceinline__ void attn_group_norm(Frame& F, int l, int b, int h, int qb) {
    asm volatile("s_waitcnt vmcnt(0)" ::: "memory");
    __syncthreads();
    int t0 = threadIdx.x; asm volatile("" : "+v"(t0));
    if (t0 == 0) {
        unsigned* bar = (unsigned*)(F.ctl + CW_BAR); unsigned* cnt = (unsigned*)(F.ctl + CW_AGRP + 16 * ((l * 2 + b) * 32 + qb));
        __builtin_amdgcn_fence(__ATOMIC_RELEASE, "agent");
        asm volatile("s_waitcnt vmcnt(0)" ::: "memory");
        (void)xb_add(cnt, 1u);
        XB_SPIN(xb_ld(cnt) < 8u, bar);
        __builtin_amdgcn_fence(__ATOMIC_ACQUIRE, "agent");
        asm volatile("s_waitcnt vmcnt(0)" ::: "memory");
    }
    __syncthreads();
    F.refresh();
    const int lane = F.lane; float og[8];
    const float* out_gain = INF(I_OGAIN) + l * D; bf16* y = wsp<bf16>(F, WS_Y);
#pragma unroll
    for (int e = 0; e < 8; ++e) og[e] = out_gain[8 * lane + e];
    const size_t row0 = (size_t)b * SEQ + (size_t)qb * 512 + h * 64 + F.wave * 8;
    v4u wv[8];
#pragma unroll
    for (int r = 0; r < 8; ++r) wv[r] = *(const v4u*)(y + (row0 + r) * D + 8 * lane);
#pragma unroll
    for (int r = 0; r < 8; ++r) { const v4u w = wv[r];
        const float v0 = bflo(w.x), v1 = bfhi(w.x), v2 = bflo(w.y), v3 = bfhi(w.y), v4 = bflo(w.z), v5 = bfhi(w.z), v6 = bflo(w.w), v7 = bfhi(w.w);
        const float ss = (v0 * v0 + v1 * v1) + (v2 * v2 + v3 * v3) + (v4 * v4 + v5 * v5) + (v6 * v6 + v7 * v7);
        const float rs = 1.0f / sqrtf(wave_sum(ss) * (1.0f / 512.0f) + EPS);
        *(v4u*)(y + (row0 + r) * D + 8 * lane) = (v4u){pk2(v0 * rs * og[0], v1 * rs * og[1]), pk2(v2 * rs * og[2], v3 * rs * og[3]), pk2(v4 * rs * og[4], v5 * rs * og[5]), pk2(v6 * rs * og[6], v7 * rs * og[7])}; }
}
__device__ __forceinline__ void moe_permute(Frame& F, int moe_j) {
    F.refresh();
    LAS int* sb = (LAS int*)F.lds;
    const int* tok_e = wsp<int>(F, WS_TOKE); const int* tok_r = wsp<int>(F, WS_TOKR); int* tok_p = wsp<int>(F, WS_TOKP); int* rte = wsp<int>(F, WS_RTE);
    const bf16* hbuf = wsp<bf16>(F, WS_H); bf16* hs = wsp<bf16>(F, WS_HS);
    if (F.tid < NEXP) sb[16 + F.tid] = (int)__hip_atomic_load((unsigned*)(F.ctl + CW_GCNT + 64 * (8 * moe_j + F.tid)), RLX_AGENT);
    __syncthreads();
    if (F.tid == 0) { int acc = 0;
        for (int e = 0; e < NEXP; ++e) { const int cnt = sb[16 + e]; sb[e] = acc; acc += (cnt + 255) & ~255; }
        sb[8] = acc; }
    __syncthreads();
    if (blockIdx.x == 0) { const int nrt = sb[8] >> 8;
        for (int i = F.tid; i < nrt; i += NWAVES * 64) { int e = 0;
#pragma unroll
            for (int k = 1; k < NEXP; ++k) if (i * 256 >= sb[k]) e = k;
            rte[i] = e; }
        if (F.tid == 0) rte[511] = nrt; }
    const int lane = F.lane;
    for (int s = F.gw; s < 2 * NTOK; s += F.NGW) { const int t = s >> 1, e = tok_e[s], pos = sb[e] + tok_r[s];
        const GAS v4u* src = (const GAS v4u*)((const unsigned char*)hbuf + (size_t)t * D); GAS v4u* dst = (GAS v4u*)((unsigned char*)hs + (size_t)pos * D);
        dst[lane] = src[lane];
        if (lane == 0) tok_p[s] = pos; }
    for (int j = F.gw; j < NEXP * 256; j += F.NGW) { const int e = j >> 8, i = j & 255, cnt = sb[16 + e], padn = ((cnt + 255) & ~255) - cnt;
        if (i < padn) { v4u zz = (v4u){0u, 0u, 0u, 0u}; asm volatile("" : "+v"(zz));
            GAS v4u* dst = (GAS v4u*)((unsigned char*)hs + (size_t)(sb[e] + cnt + i) * D); dst[lane] = zz; } }
    __syncthreads();
}
struct UpOrder : pg8::StaticOrder {
    __device__ __forceinline__ bool next(int i, pg8::Unit& u) const { if (!pg8::StaticOrder::next(i, u)) return false; u.pa = u.pm + (u.pn >= 3 ? NTOK / 256 : 0); return true; }
    __device__ __forceinline__ int ktiles(const pg8::Unit& u, int nt) const { return u.pn >= 3 ? nt / 2 : nt; } };
struct GateOrder : pg8::StaticOrder {
    __device__ __forceinline__ bool next(int i, pg8::Unit& u) const { if (!pg8::StaticOrder::next(i, u)) return false; u.pa = u.pm + u.pn * (NTOK / 256); return true; } };
struct MoeOrder {
    pg8::StaticOrder so; const int* rte; int pm_off, tpe, rev;
    __device__ __forceinline__ bool next(int i, pg8::Unit& u) const { if (!so.next(i, u)) return false; if (rev) u.pm = so.nM - 1 - u.pm; u.pm += pm_off; u.pa = u.pm; u.pb = rte[u.pm] * tpe + u.pn; return true; }
    __device__ __forceinline__ void a_ready(const pg8::Unit&) const {}
    __device__ __forceinline__ void done(const pg8::Unit&) const {}
    __device__ __forceinline__ int ktiles(const pg8::Unit&, int nt) const { return nt; }
};
struct AttnOrder {
    int v, G;
    __device__ __forceinline__ bool next(int i, int& bh, int& qb) const { const int un = v + (i >> 2) * G; if (un >= 256) return false; const int s = un & 15, k = i & 3; bh = un >> 4; qb = (k == 0) ? s : (k == 1) ? 31 - s : (k == 2) ? 32 + s : 63 - s; return true; }
};

struct Args { const void* in[28]; float* out; unsigned char* ws; };
__global__ void __launch_bounds__(NWAVES * 64, 2) trunk_fwd(Args args) {
    extern __shared__ __attribute__((aligned(16))) unsigned char lds[];
    Frame F;
    F.lds = (LAS unsigned char*)lds; F.MISC = (volatile LAS unsigned*)(F.lds + MISC_OFF);
    F.G = gridDim.x; { const int bx = blockIdx.x; F.vcu = (F.G % 8 == 0) ? (bx % 8) * (F.G / 8) + bx / 8 : bx; }
    F.NGW = F.G * NWAVES; F.refresh();
    F.ws = args.ws; F.out = args.out; F.ctl = (gu32*)(args.ws + WS_CTL);
    for (int u = F.tid; u < (LDS_BYTES - LDSCTL_OFF) / 4; u += NWAVES * 64) ((LAS unsigned*)(F.lds + LDSCTL_OFF))[u] = 0u;
    __syncthreads();
    XcdBarrier bar = xcd_barrier_post((unsigned*)(F.ctl + CW_BAR), F.MISC + 8);
#ifndef PROBE_MASK
#define PROBE_MASK 0u
#endif
    unsigned long long pr_last = PROBE_MASK ? rt() : 0ull, pr_acc = 0ull;
#define GRID_BAR(c) do { xcd_barrier(bar); if (PROBE_MASK) { const unsigned long long now_ = rt(); if ((PROBE_MASK >> (c)) & 1u) pr_acc += now_ - pr_last; pr_last = now_; } } while (0)
    const int cblk = (int)blockIdx.x;
    bf16* const xb = wsp<bf16>(F, WS_XB);

    p0_prologue(F);
    GRID_BAR(0);
    p0_finalise(F);
    GRID_BAR(0);

    for (int l = 0; l < DEPTH; ++l) {
        const int ls1 = 2 * l, ls2 = 2 * l + 1; const bool moe = (l & 1) != 0; const int jj = l >> 1;
        if (l == 0) norm_pass<false, true, false, false, true, false>(F, INF(I_X), xb, ls1, 0, 0);
        else if (l == 2) { norm_pass<true, true, false, false, true>(F, xb, xb, ls1, ls1 - 1, 0); convert_moe_late(F); }
        else norm_pass<false, true, false, false, true>(F, xb, nullptr, ls1, 0, 0);
        GRID_BAR(1);
        { bf16* Win_t = wsp<bf16>(F, WS_WSMALL + (size_t)l * WSMALL_STRIDE);
          pg8::Gemm g{wsp<bf16>(F, WS_H), Win_t, NTOK, INP, D / 2}; pg8::StaticOrder S; S.init(NTOK, INP, F.G, cblk);
          pg8::EpiBf16I8 E{wsp<bf16>(F, WS_Z), INP, wsp<float>(F, WS_RSC), wsp<float>(F, WS_MREF)[8 + l]};
          pg8::gemm_phase<pg8::EpiBf16I8, pg8::StaticOrder, true, true, true, true>(F.lds, g, S, E); }
        GRID_BAR(2);
        mid_pass(F, l);
        GRID_BAR(3);
        { bf16* Wup_t = wsp<bf16>(F, WS_WSMALL + (size_t)l * WSMALL_STRIDE + 3 * MiB);
          int k256 = 256; asm volatile("" : "+s"(k256));
          pg8::Gemm g{wsp<bf16>(F, WS_A2), Wup_t, NTOK, UPN, k256}; UpOrder S; S.init(NTOK, UPN, F.G, cblk);
          pg8::EpiUp E{wsp<bf16>(F, WS_Q), wsp<bf16>(F, WS_K), wsp<bf16>(F, WS_QKV), INF(I_QGAIN) + l * 96, INF(I_KGAIN) + l * 96, wsp<float>(F, WS_COS), wsp<float>(F, WS_SIN)};
          pg8::gemm_phase<pg8::EpiUp, UpOrder, true, true>(F.lds, g, S, E); }
        { bf16* Wg_t = wsp<bf16>(F, WS_WSMALL + (size_t)l * WSMALL_STRIDE + 5 * MiB); const bf16* xrb = wsp<bf16>(F, WS_XR);
          int k128 = 128; asm volatile("" : "+s"(k128));
          pg8::Gemm g{xrb, Wg_t, NTOK, 1024, k128}; GateOrder S; S.init(NTOK, 1024, F.G, cblk);
          pg8::EpiGates E{xrb, INF(I_BA) + l * LRUW, INF(I_BX) + l * LRUW, wsp<float>(F, WS_LAMC) + l * LRUW, wsp<unsigned>(F, WS_LA)};
          pg8::gemm_phase<pg8::EpiGates, GateOrder, true, true>(F.lds, g, S, E); }
        GRID_BAR(4);
        const bool inphase = F.G == 256 && wsp<float>(F, WS_MREF)[l] <= att::ATT_MREF_MAX;
        if (!inphase) { scan_a(F); GRID_BAR(5); }
        { const AttnOrder AO{F.vcu, F.G}; int bh, qb; const bf16* Qb = wsp<bf16>(F, WS_Q); const bf16* Kb = wsp<bf16>(F, WS_K); const bf16* Vb = wsp<bf16>(F, WS_QKV); bf16* yb = wsp<bf16>(F, WS_Y);
          const float mref = wsp<float>(F, WS_MREF)[l];
          if (mref <= att::ATT_MREF_MAX) {
              for (int base = F.vcu; base < 256; base += F.G)
                  for (int i = 0; i < 2; ++i) { int un = base; asm volatile("" : "+s"(un));
                      att2::attn_unit(un >> 7, (un >> 4) & 7, i ? 31 - (un & 15) : (un & 15), Qb, Kb, Vb, yb, F.lds);
                      if (F.G == 256) { int u2 = base; asm volatile("" : "+s"(u2)); attn_group_norm(F, l, u2 >> 7, (u2 >> 4) & 7, i ? 31 - (u2 & 15) : (u2 & 15));
                          if (i == 0) { scan_a(F); scan_arrive(F, l); if (l == 0) convert_moe_first(F); } } }
#ifdef ATT_XVAR
            { bf16* xo = wsp<bf16>(F, (size_t)866 * MiB); for (int i = 0; AO.next(i, bh, qb); ++i) att::attn_unit<ATT_XVAR>(bh >> 3, bh & 7, qb, Qb, Kb, Vb, xo, F.lds, 512); }
#endif
          }
          else {
              for (int base = F.vcu; base < 256; base += F.G)
                  for (int i = 0; i < 4; ++i) { int un = base; asm volatile("" : "+s"(un)); const int s_ = un & 15;
                      att_online::attn_unit(un >> 7, (un >> 4) & 7, i == 0 ? s_ : (i == 1 ? 31 - s_ : (i == 2 ? 32 + s_ : 63 - s_)), Qb, Kb, Vb, yb, F.lds);
                      if (i == 0 && l == 0 && F.G == 256) convert_moe_first(F); } } }
        if (inphase) scan_wait(F, l);
        scan_c(F, l);
        GRID_BAR(6);
        if (!inphase) { attn_norm_pass(F, l); GRID_BAR(7); }
        { bf16* Wout_t = wsp<bf16>(F, WS_WSMALL + (size_t)l * WSMALL_STRIDE + 6 * MiB);
          pg8::Gemm g{wsp<bf16>(F, WS_Y), Wout_t, NTOK, D, D}; pg8::StaticOrder S; S.init(NTOK, D, F.G, cblk);
          pg8::EpiResid E{xb, xb, wsp<float>(F, WS_MOD) + (size_t)ls1 * 2 * 3072 + 2048, 1.0f};
          pg8::gemm_phase<pg8::EpiResid, pg8::StaticOrder, true, true>(F.lds, g, S, E); }
        GRID_BAR(8);
        if (!moe) {
            if (true) {
                norm_pass<false, true, false, false, true>(F, xb, nullptr, ls2, 0, 0);
                GRID_BAR(1);
                { unsigned char* Wgu8 = wsp<unsigned char>(F, WS_WDENSE + (size_t)jj * WDENSE_STRIDE);
                  pg8::Gemm g{wsp<bf16>(F, WS_H), (const bf16*)Wgu8, NTOK, 2 * DFF, D / 2}; pg8::StaticOrder S; S.init(NTOK, 2 * DFF, F.G, cblk);
                  pg8::EpiSwigluI8 E{wsp<unsigned char>(F, WS_HID), DFF, wsp<float>(F, WS_RSC), wsp<float>(F, WS_MREF)[8 + 4 + jj], SC_HID8};
                  pg8::gemm_phase<pg8::EpiSwigluI8, pg8::StaticOrder, true, true, true, true>(F.lds, g, S, E); }
                GRID_BAR(9);
                { unsigned char* Wd8 = wsp<unsigned char>(F, WS_WDENSE + (size_t)jj * WDENSE_STRIDE + 11 * MiB);
                  pg8::Gemm g{wsp<bf16>(F, WS_HID), (const bf16*)Wd8, NTOK, D, DFF / 2}; pg8::StaticOrder S; S.init(NTOK, D, F.G, cblk);
                  pg8::EpiResid E{xb, xb, wsp<float>(F, WS_MOD) + (size_t)ls2 * 2 * 3072 + 2048, 1.0f / (SC_HID8 * SC_WD8)};
                  pg8::gemm_phase<pg8::EpiResid, pg8::StaticOrder, true, true, true>(F.lds, g, S, E); }
                GRID_BAR(10);
            } else {
                norm_pass<false, true, false, true>(F, xb, nullptr, ls2, 0, 0);
                GRID_BAR(1);
                { unsigned char* Wgu8 = wsp<unsigned char>(F, WS_WDENSE + (size_t)jj * WDENSE_STRIDE);
                  pg8::Gemm g{wsp<bf16>(F, WS_H), (const bf16*)Wgu8, NTOK, 2 * DFF, D / 2}; pg8::StaticOrder S; S.init(NTOK, 2 * DFF, F.G, cblk);
                  pg8::EpiSwigluF8 E{wsp<unsigned char>(F, WS_HID), DFF, 1.0f / (SC_H8 * SC_WGU8), SC_HID8};
                  pg8::gemm_phase<pg8::EpiSwigluF8, pg8::StaticOrder, true, true, true>(F.lds, g, S, E); }
                GRID_BAR(9);
                { unsigned char* Wd8 = wsp<unsigned char>(F, WS_WDENSE + (size_t)jj * WDENSE_STRIDE + 11 * MiB);
                  pg8::Gemm g{wsp<bf16>(F, WS_HID), (const bf16*)Wd8, NTOK, D, DFF / 2}; pg8::StaticOrder S; S.init(NTOK, D, F.G, cblk);
                  pg8::EpiResid E{xb, xb, wsp<float>(F, WS_MOD) + (size_t)ls2 * 2 * 3072 + 2048, 1.0f / (SC_HID8 * SC_WD8)};
                  pg8::gemm_phase<pg8::EpiResid, pg8::StaticOrder, true, true, true>(F.lds, g, S, E); }
                GRID_BAR(10);
            }
        } else {
            norm_pass<false, true, true, true>(F, xb, nullptr, ls2, 0, jj);
            GRID_BAR(11);
            moe_permute(F, jj);
            GRID_BAR(12);
            const int* rte = wsp<int>(F, WS_RTE); const int nrt = rte[511];
            { pg8::Gemm g{wsp<bf16>(F, WS_HS), wsp<bf16>(F, WS_WMOE_GU), nrt * 256, 2 * DFE, D / 2}; MoeOrder S; S.so.init(nrt * 256, 2 * DFE, F.G, cblk); S.rte = rte; S.pm_off = 0; S.tpe = 2 * DFE / 256; S.rev = 0;
              pg8::EpiSwigluF8 E{wsp<unsigned char>(F, WS_MHID), DFE, 1.0f / (SC_H8 * SC_WGU8), SC_HID8};
              pg8::gemm_phase<pg8::EpiSwigluF8, MoeOrder, true, true, true>(F.lds, g, S, E); }
            GRID_BAR(13);
            { pg8::Gemm g{wsp<bf16>(F, WS_MHID), wsp<bf16>(F, WS_WMOE_D), nrt * 256, D, DFE / 2}; MoeOrder S; S.so.init(nrt * 256, D, F.G, cblk); S.rte = rte; S.pm_off = 0; S.tpe = D / 256; S.rev = 1;
              pg8::EpiF8S E{wsp<unsigned char>(F, WS_Y2), D, SC_Y8 / (SC_HID8 * SC_WD8)};
              pg8::gemm_phase<pg8::EpiF8S, MoeOrder, true, true, true>(F.lds, g, S, E); }
                        if (jj == 0) { const int nwg = nrt * (D / 256), rem = nwg % F.G, nshare = rem ? F.G - rem : F.G, rank = rem ? cblk - rem : cblk;
                if (rank >= 0) convert_moe_early(F, rank, nshare); }
GRID_BAR(14);
        }
    }
    norm_pass<true, false, false, false, false, true, false>(F, xb, F.out, 0, 2 * (DEPTH - 1) + 1, 0);
    if (PROBE_MASK) { const unsigned long long now_ = rt(); if ((PROBE_MASK >> 15) & 1u) pr_acc += now_ - pr_last; if (blockIdx.x == 0) { while (rt() - now_ < pr_acc) __builtin_amdgcn_s_sleep(8); } }
}

extern "C" void kernel_launch(void* const* d_in, const int* in_sizes, int n_in, void* d_out, int out_size, void* d_ws, size_t ws_size, hipStream_t stream) {
    static int grid = 0;
    if (grid == 0) {
        if (n_in != 28 || out_size != NTOK * D || ws_size < WS_END) { fprintf(stderr, "kernel_launch: unexpected shapes (n_in %d, out %d, ws %zu)\n", n_in, out_size, ws_size); grid = -1; return; }
        int dev = 0, cus = 0, per_cu = 0;
        if (hipGetDevice(&dev) != hipSuccess || hipDeviceGetAttribute(&cus, hipDeviceAttributeMultiprocessorCount, dev) != hipSuccess) { grid = -1; return; }
        if (hipFuncSetAttribute((const void*)trunk_fwd, hipFuncAttributeMaxDynamicSharedMemorySize, LDS_BYTES) != hipSuccess) { fprintf(stderr, "kernel_launch: hipFuncSetAttribute failed\n"); grid = -1; return; }
        if (hipOccupancyMaxActiveBlocksPerMultiprocessor(&per_cu, (const void*)trunk_fwd, NWAVES * 64, LDS_BYTES) != hipSuccess || per_cu < 1) { fprintf(stderr, "kernel_launch: occupancy query reports %d\n", per_cu); per_cu = 1; }
        (void)hipGetLastError();
        grid = cus;
    }
    if (grid < 0) return;
    if (hipMemsetAsync((char*)d_ws + WS_CTL, 0, CTL_ZERO_BYTES, stream) != hipSuccess) return;
    Args a{};
    for (int i = 0; i < 28; ++i) a.in[i] = d_in[i];
    a.out = (float*)d_out; a.ws = (unsigned char*)d_ws;
    hipLaunchKernelGGL(trunk_fwd, dim3(grid), dim3(NWAVES * 64), LDS_BYTES, stream, a);
}
```

```cpp
#include <hip/hip_runtime.h>
#include <cstdio>
#include <cstdint>
namespace pg8 {
#define PG8_LAS __attribute__((address_space(3)))
typedef unsigned short bf16_t;
typedef short bf16x8 __attribute__((ext_vector_type(8)));
typedef float f32x4 __attribute__((ext_vector_type(4)));
typedef unsigned u32x4 __attribute__((ext_vector_type(4)));
typedef int i32x4_ __attribute__((ext_vector_type(4)));
constexpr int BM = 256, BK = 64, HALF = 128, HTB = HALF * BK * 2  , STAGE_BYTES = 8 * HTB, NXCD = 8, WGM = 8;

__host__ __device__ __forceinline__ int lds_byte(int r, int c) { const int st = (r >> 4) * 2 + (c >> 5), rr = r & 15, cc = c & 31, ob = rr * 64 + cc * 2; return st * 1024 + (ob ^ (((ob >> 9) & 1) << 5)); }
__host__ __device__ __forceinline__ void stage_rc(int b, int& R, int& C) { const int st = b / 1024, sb = b % 1024, swz = sb ^ (((sb >> 9) & 1) << 5); R = (st >> 1) * 16 + swz / 64; C = (st & 1) * 32 + (swz % 64) / 2; }
__host__ __device__ __forceinline__ int perm32(int rho) { const int n = rho >> 4, i = rho & 15; return 8 * (i >> 2) + 4 * n + (i & 3); }

struct Unit { int pm, pn, pb, pa, sk; };
struct Gemm { const bf16_t* A; const bf16_t* Bt; int M, N, K; };

struct StaticOrder {
    int nM, nN, nwg, G, c;
    __host__ __device__ void init(int M, int N, int G_, int c_) { nM = M / BM; nN = N / BM; nwg = nM * nN; G = G_; c = c_; }
    __host__ __device__ bool next(int i, Unit& u) const {
        const long L = (long)i * G + c; if (L >= nwg) return false;
        int wgid = (int)L; { const int q = nwg / NXCD, r = nwg % NXCD, xcd = wgid % NXCD, off = wgid / NXCD; wgid = (xcd < r ? xcd * (q + 1) : r * (q + 1) + (xcd - r) * q) + off; }
        const int nig = WGM * nN, gid = wgid / nig, fm = gid * WGM, gsz = (nM - fm) < WGM ? (nM - fm) : WGM;
        u.pm = fm + ((wgid % nig) % gsz); u.pn = (wgid % nig) / gsz; u.pb = u.pn; u.pa = u.pm; u.sk = 0; return true;
    }
    __device__ __forceinline__ void a_ready(const Unit&) const {}
    __device__ __forceinline__ void done(const Unit&) const {}
    __device__ __forceinline__ int ktiles(const Unit&, int nt) const { return nt; }
};

__device__ __forceinline__ unsigned cvt_pk_bf16(float lo, float hi) { unsigned r; asm volatile("v_cvt_pk_bf16_f32 %0, %1, %2" : "=v"(r) : "v"(lo), "v"(hi)); return r; }
typedef float f32x2 __attribute__((ext_vector_type(2)));
__device__ __forceinline__ f32x2 gelu_pk(f32x2 v) {
    const f32x2 av = __builtin_elementwise_abs(v), d = av * 0.2316418882f + 1.0f;
    f32x2 t; t.x = __builtin_amdgcn_rcpf(d.x); t.y = __builtin_amdgcn_rcpf(d.y);
    f32x2 q = t * 0.5307027145f + (-0.7265760135f); q = q * t + 0.7107068705f; q = q * t + (-0.142248368f); q = q * t + 0.127414796f; q = q * t;
    const f32x2 s = (v * v) * (-0.72134752044f);
    f32x2 e; e.x = __builtin_amdgcn_exp2f(s.x); e.y = __builtin_amdgcn_exp2f(s.y);
    const f32x2 m = v * (q * e), r = v - m;
    f32x2 o; o.x = v.x < 0.f ? m.x : r.x; o.y = v.y < 0.f ? m.y : r.y; return o;
}

template <int ACT  > struct EpiBf16 {
    static constexpr bool PERM = true, AFTER_DRAIN = false; static_assert(ACT == 0 || ACT == 1, "EpiBf16: ACT is 0 (none) or 1 (gelu_pk)");
    bf16_t* O; int ldc; const float* bias; int split_cols; size_t split_stride; float scale0;
    __device__ __forceinline__ void operator()(const f32x4 (&acc)[2][2][4][2], const Unit& u, int wr, int wc, int fr, int fq) const {
        const int row0 = u.pm * BM + wr * 64 + fr; int colt = u.pn * BM; bf16_t* base = O;
        float sc = 1.f; if (split_cols) { const int t = colt / split_cols; base += (size_t)t * split_stride; colt -= t * split_cols; if (t == 0) sc = scale0; }
        const int col0 = colt + wc * 32 + 8 * fq, bcol0 = u.pn * BM + wc * 32 + 8 * fq;
        f32x4 bv[2][2];
#pragma unroll
        for (int bj = 0; bj < 2; ++bj)
#pragma unroll
            for (int n = 0; n < 2; ++n) bv[bj][n] = bias ? *(const f32x4*)(bias + bcol0 + bj * HALF + 4 * n) : (f32x4){0.f, 0.f, 0.f, 0.f};
#pragma unroll
        for (int ai = 0; ai < 2; ++ai)
#pragma unroll
            for (int m = 0; m < 4; ++m) { bf16_t* rowp = base + (size_t)(row0 + ai * HALF + m * 16) * ldc + col0;
#pragma unroll
                for (int bj = 0; bj < 2; ++bj) { f32x4 v0 = acc[ai][bj][m][0] + bv[bj][0], v1 = acc[ai][bj][m][1] + bv[bj][1];
                    if (ACT == 1) { f32x2 a = gelu_pk((f32x2){v0[0], v0[1]}), b = gelu_pk((f32x2){v0[2], v0[3]}), c = gelu_pk((f32x2){v1[0], v1[1]}), d = gelu_pk((f32x2){v1[2], v1[3]});
                        v0 = (f32x4){a.x, a.y, b.x, b.y}; v1 = (f32x4){c.x, c.y, d.x, d.y}; }
                    v0 = v0 * sc; v1 = v1 * sc; u32x4 w; w.x = cvt_pk_bf16(v0[0], v0[1]); w.y = cvt_pk_bf16(v0[2], v0[3]); w.z = cvt_pk_bf16(v1[0], v1[1]); w.w = cvt_pk_bf16(v1[2], v1[3]);
                    *(u32x4*)(rowp + bj * HALF) = w; } }
    }
};
struct EpiBf16I8 {
    static constexpr bool PERM = true, AFTER_DRAIN = false;
    bf16_t* O; int ldc; const float* rsc; float wdq;
    __device__ __forceinline__ void operator()(const f32x4 (&acc)[2][2][4][2], const Unit& u, int wr, int wc, int fr, int fq) const {
        const int row0 = u.pm * BM + wr * 64 + fr, col0 = u.pn * BM + wc * 32 + 8 * fq;
        float rs[2][4];
#pragma unroll
        for (int ai = 0; ai < 2; ++ai)
#pragma unroll
            for (int m = 0; m < 4; ++m) rs[ai][m] = rsc[row0 + ai * HALF + m * 16];
#pragma unroll
        for (int ai = 0; ai < 2; ++ai)
#pragma unroll
            for (int m = 0; m < 4; ++m) { bf16_t* rowp = O + (size_t)(row0 + ai * HALF + m * 16) * ldc + col0; const float s = rs[ai][m] * wdq;
#pragma unroll
                for (int bj = 0; bj < 2; ++bj) { float v[8];
#pragma unroll
                    for (int n = 0; n < 2; ++n)
#pragma unroll
                        for (int e = 0; e < 4; ++e) { const f32x4 av = acc[ai][bj][m][n]; const float ae = av[e]; v[4 * n + e] = (float)__float_as_int(ae) * s; }
                    u32x4 w; w.x = cvt_pk_bf16(v[0], v[1]); w.y = cvt_pk_bf16(v[2], v[3]); w.z = cvt_pk_bf16(v[4], v[5]); w.w = cvt_pk_bf16(v[6], v[7]);
                    *(u32x4*)(rowp + bj * HALF) = w; } }
    }
};
__device__ __forceinline__ float bf2f(unsigned short v) { return __uint_as_float((unsigned)v << 16); }
__device__ __forceinline__ float sigmoidf_(float v) { return __builtin_amdgcn_rcpf(1.0f + __builtin_amdgcn_exp2f(-1.4426950408889634f * v)); }
struct EpiResid {
    static constexpr bool PERM = true, AFTER_DRAIN = false;
    const bf16_t* base; bf16_t* out; const float* gate; float sc;
    __device__ __forceinline__ void operator()(const f32x4 (&acc)[2][2][4][2], const Unit& u, int wr, int wc, int fr, int fq) const {
        const int row0 = u.pm * BM + wr * 64 + fr, col0 = u.pn * BM + wc * 32 + 8 * fq;
        const float* gp = gate + (u.pm >= 64 ? 3072 : 0) + col0;
        f32x4 gv[2][2];
#pragma unroll
        for (int bj = 0; bj < 2; ++bj)
#pragma unroll
            for (int n = 0; n < 2; ++n) gv[bj][n] = *(const f32x4*)(gp + bj * HALF + 4 * n);
        asm volatile("" ::: "memory");
#define ER_OFF(g, q) ((size_t)(row0 + ((g) >> 1) * HALF + (2 * ((g) & 1) + (q)) * 16) * 1024 + col0)
#define ER_PACK(v0, v1) (u32x4){cvt_pk_bf16((v0)[0], (v0)[1]), cvt_pk_bf16((v0)[2], (v0)[3]), cvt_pk_bf16((v1)[0], (v1)[1]), cvt_pk_bf16((v1)[2], (v1)[3])}
        {
            u32x4 bw[2][2][2];
#define ER_LOADB(g, buf) do { _Pragma("unroll") for (int q = 0; q < 2; ++q) { const size_t off = ER_OFF(g, q); \
            _Pragma("unroll") for (int bj = 0; bj < 2; ++bj) bw[buf][q][bj] = *(const u32x4*)(base + off + bj * HALF); } } while (0)
#define ER_STOREB(g, buf) do { _Pragma("unroll") for (int q = 0; q < 2; ++q) { const size_t off = ER_OFF(g, q); \
            _Pragma("unroll") for (int bj = 0; bj < 2; ++bj) { const u32x4 w = bw[buf][q][bj]; \
                const f32x4 b0 = (f32x4){__uint_as_float(w.x << 16), __uint_as_float(w.x & 0xffff0000u), __uint_as_float(w.y << 16), __uint_as_float(w.y & 0xffff0000u)}; \
                const f32x4 b1 = (f32x4){__uint_as_float(w.z << 16), __uint_as_float(w.z & 0xffff0000u), __uint_as_float(w.w << 16), __uint_as_float(w.w & 0xffff0000u)}; \
                const f32x4 v0 = b0 + gv[bj][0] * acc[(g) >> 1][bj][2 * ((g) & 1) + q][0], v1 = b1 + gv[bj][1] * acc[(g) >> 1][bj][2 * ((g) & 1) + q][1]; \
                *(u32x4*)(out + off + bj * HALF) = ER_PACK(v0, v1); } } } while (0)
            ER_LOADB(0, 0); ER_LOADB(1, 1); asm volatile("" ::: "memory");
#pragma unroll
            for (int bj = 0; bj < 2; ++bj)
#pragma unroll
                for (int n = 0; n < 2; ++n) gv[bj][n] = gv[bj][n] * sc;
            ER_STOREB(0, 0); asm volatile("" ::: "memory"); ER_LOADB(2, 0); asm volatile("" ::: "memory");
            ER_STOREB(1, 1); asm volatile("" ::: "memory"); ER_LOADB(3, 1); asm volatile("" ::: "memory");
            ER_STOREB(2, 0); asm volatile("" ::: "memory");
            ER_STOREB(3, 1);
#undef ER_LOADB
#undef ER_STOREB
        }
#undef ER_OFF
#undef ER_PACK
    }
};
struct EpiSwiglu {
    static constexpr bool PERM = true, AFTER_DRAIN = false;
    bf16_t* O; int ldc;
    __device__ __forceinline__ void operator()(const f32x4 (&acc)[2][2][4][2], const Unit& u, int wr, int wc, int fr, int fq) const {
        const int row0 = u.pm * BM + wr * 64 + fr, col0 = u.pn * HALF + wc * 32 + 8 * fq;
#pragma unroll
        for (int ai = 0; ai < 2; ++ai)
#pragma unroll
            for (int m = 0; m < 4; ++m) { bf16_t* rowp = O + (size_t)(row0 + ai * HALF + m * 16) * ldc + col0;
                float hv[8];
#pragma unroll
                for (int n = 0; n < 2; ++n)
#pragma unroll
                    for (int e = 0; e < 4; ++e) { const float g = acc[ai][0][m][n][e], up = acc[ai][1][m][n][e]; hv[4 * n + e] = g * sigmoidf_(g) * up; }
                u32x4 w; w.x = cvt_pk_bf16(hv[0], hv[1]); w.y = cvt_pk_bf16(hv[2], hv[3]); w.z = cvt_pk_bf16(hv[4], hv[5]); w.w = cvt_pk_bf16(hv[6], hv[7]);
                *(u32x4*)rowp = w; }
    }
};
struct EpiGates {
    static constexpr bool PERM = true, AFTER_DRAIN = false;
    const bf16_t* xr; const float* ba; const float* bx; const float* lamc; unsigned* lu;
    __device__ __forceinline__ void operator()(const f32x4 (&acc)[2][2][4][2], const Unit& u, int wr, int wc, int fr, int fq) const {
        const int row0 = u.pm * BM + wr * 64 + fr, ch0 = u.pn * HALF + wc * 32 + 8 * fq;
        f32x4 bav[2], bxv[2], lcv[2]; const float NL2E = -1.4426950408889634f;
#pragma unroll
        for (int n = 0; n < 2; ++n) { bav[n] = *(const f32x4*)(ba + ch0 + 4 * n); bxv[n] = *(const f32x4*)(bx + ch0 + 4 * n); lcv[n] = *(const f32x4*)(lamc + ch0 + 4 * n); }
        u32x4 xws[2][4];
#pragma unroll
        for (int ai = 0; ai < 2; ++ai)
#pragma unroll
            for (int m = 0; m < 4; ++m) xws[ai][m] = *(const u32x4*)(xr + ((size_t)(ch0 >> 7) * 32768 + (row0 + ai * HALF + m * 16)) * 128 + (ch0 & 127));
        asm volatile("" ::: "memory");
#pragma unroll
        for (int n = 0; n < 2; ++n) { bav[n] = bav[n] * NL2E; bxv[n] = bxv[n] * NL2E; }
#pragma unroll
        for (int ai = 0; ai < 2; ++ai)
#pragma unroll
            for (int m = 0; m < 4; ++m) { const size_t off = (size_t)(row0 + ai * HALF + m * 16) * 512 + ch0;
                const u32x4 xw = xws[ai][m];
                float xv[8]; xv[0] = __uint_as_float(xw.x << 16); xv[1] = __uint_as_float(xw.x & 0xffff0000u); xv[2] = __uint_as_float(xw.y << 16); xv[3] = __uint_as_float(xw.y & 0xffff0000u);
                xv[4] = __uint_as_float(xw.z << 16); xv[5] = __uint_as_float(xw.z & 0xffff0000u); xv[6] = __uint_as_float(xw.w << 16); xv[7] = __uint_as_float(xw.w & 0xffff0000u);
#pragma unroll
                for (int n = 0; n < 2; ++n) { u32x4 pk;
#pragma unroll
                    for (int e = 0; e < 4; ++e) {
                        const float r = __builtin_amdgcn_rcpf(1.0f + __builtin_amdgcn_exp2f(__builtin_fmaf(acc[ai][0][m][n][e], NL2E, bav[n][e])));
                        const float ig = __builtin_amdgcn_rcpf(1.0f + __builtin_amdgcn_exp2f(__builtin_fmaf(acc[ai][1][m][n][e], NL2E, bxv[n][e])));
                        const float l2 = r * lcv[n][e];
                        const float om_e = 1.0f - __builtin_amdgcn_exp2f(l2 + l2);
                        const float xx = l2 * -1.3862943611198906f;
                        const float om = xx < 1.0e-4f ? xx : om_e;
                        pk[e] = cvt_pk_bf16(l2, __builtin_amdgcn_sqrtf(om) * ig * xv[4 * n + e]); }
                    *(u32x4*)(lu + off + 4 * n) = pk; } }
    }
};
__device__ __forceinline__ float clamp448(float v) { return __builtin_amdgcn_fmed3f(v, -448.0f, 448.0f); }
__device__ __forceinline__ unsigned pack4_i8(float a, float b, float c, float d) {
    const unsigned ua = __float_as_uint(__builtin_amdgcn_fmed3f(a, -127.0f, 127.0f) + 12582912.0f), ub = __float_as_uint(__builtin_amdgcn_fmed3f(b, -127.0f, 127.0f) + 12582912.0f);
    const unsigned uc = __float_as_uint(__builtin_amdgcn_fmed3f(c, -127.0f, 127.0f) + 12582912.0f), ud = __float_as_uint(__builtin_amdgcn_fmed3f(d, -127.0f, 127.0f) + 12582912.0f);
    return (ua & 0xffu) | ((ub & 0xffu) << 8) | ((uc & 0xffu) << 16) | (ud << 24); }
__device__ __forceinline__ unsigned pack4_fp8(float a, float b, float c, float d) {
    int w = __builtin_amdgcn_cvt_pk_fp8_f32(clamp448(a), clamp448(b), 0, false); w = __builtin_amdgcn_cvt_pk_fp8_f32(clamp448(c), clamp448(d), w, true); return (unsigned)w; }
struct EpiSwigluF8 {
    static constexpr bool PERM = true, AFTER_DRAIN = false;
    unsigned char* O; int ldc; float sin_, sout;
    __device__ __forceinline__ void operator()(const f32x4 (&acc)[2][2][4][2], const Unit& u, int wr, int wc, int fr, int fq) const {
        const int row0 = u.pm * BM + wr * 64 + fr, col0 = u.pn * HALF + wc * 32 + 8 * fq; const float c1 = -1.4426950408889634f * sin_, ik = 1.0f / (sin_ * sin_ * sout);
#pragma unroll
        for (int ai = 0; ai < 2; ++ai)
#pragma unroll
            for (int m = 0; m < 4; ++m) { unsigned char* rowp = O + (size_t)(row0 + ai * HALF + m * 16) * ldc + col0;
                float hv[8];
#pragma unroll
                for (int n = 0; n < 2; ++n)
#pragma unroll
                    for (int e = 0; e < 4; ++e) { const float ag = acc[ai][0][m][n][e], au = acc[ai][1][m][n][e];
                        hv[4 * n + e] = (ag * au) * __builtin_amdgcn_rcpf(__builtin_fmaf(__builtin_amdgcn_exp2f(ag * c1), ik, ik)); }
                typedef unsigned u32x2_ __attribute__((ext_vector_type(2)));
                *(u32x2_*)rowp = (u32x2_){pack4_fp8(hv[0], hv[1], hv[2], hv[3]), pack4_fp8(hv[4], hv[5], hv[6], hv[7])}; }
    }
};
struct EpiSwigluI8 {
    static constexpr bool PERM = true, AFTER_DRAIN = false;
    unsigned char* O; int ldc; const float* rsc; float wdq, sout;
    __device__ __forceinline__ void operator()(const f32x4 (&acc)[2][2][4][2], const Unit& u, int wr, int wc, int fr, int fq) const {
        const int row0 = u.pm * BM + wr * 64 + fr, col0 = u.pn * HALF + wc * 32 + 8 * fq;
        float rs[2][4];
#pragma unroll
        for (int ai = 0; ai < 2; ++ai)
#pragma unroll
            for (int m = 0; m < 4; ++m) rs[ai][m] = rsc[row0 + ai * HALF + m * 16];
#pragma unroll
        for (int ai = 0; ai < 2; ++ai)
#pragma unroll
            for (int m = 0; m < 4; ++m) { unsigned char* rowp = O + (size_t)(row0 + ai * HALF + m * 16) * ldc + col0;
                const float s = rs[ai][m] * wdq, c1 = -1.4426950408889634f * s, ik = __builtin_amdgcn_rcpf(s * s * sout);
                float hv[8];
#pragma unroll
                for (int n = 0; n < 2; ++n)
#pragma unroll
                    for (int e = 0; e < 4; ++e) { const f32x4 gq = acc[ai][0][m][n], uq = acc[ai][1][m][n]; const float ge = gq[e], ue = uq[e];
                        const float ag = (float)__float_as_int(ge), au = (float)__float_as_int(ue);
                        hv[4 * n + e] = (ag * au) * __builtin_amdgcn_rcpf(__builtin_fmaf(__builtin_amdgcn_exp2f(ag * c1), ik, ik)); }
                typedef unsigned u32x2_ __attribute__((ext_vector_type(2)));
                *(u32x2_*)rowp = (u32x2_){pack4_fp8(hv[0], hv[1], hv[2], hv[3]), pack4_fp8(hv[4], hv[5], hv[6], hv[7])}; }
    }
};
struct EpiBf16S {
    static constexpr bool PERM = true, AFTER_DRAIN = false;
    bf16_t* O; int ldc; float sc;
    __device__ __forceinline__ void operator()(const f32x4 (&acc)[2][2][4][2], const Unit& u, int wr, int wc, int fr, int fq) const {
        const int row0 = u.pm * BM + wr * 64 + fr, col0 = u.pn * BM + wc * 32 + 8 * fq;
#pragma unroll
        for (int ai = 0; ai < 2; ++ai)
#pragma unroll
            for (int m = 0; m < 4; ++m) { bf16_t* rowp = O + (size_t)(row0 + ai * HALF + m * 16) * ldc + col0;
#pragma unroll
                for (int bj = 0; bj < 2; ++bj) { const f32x4 v0 = acc[ai][bj][m][0] * sc, v1 = acc[ai][bj][m][1] * sc;
                    u32x4 w; w.x = cvt_pk_bf16(v0[0], v0[1]); w.y = cvt_pk_bf16(v0[2], v0[3]); w.z = cvt_pk_bf16(v1[0], v1[1]); w.w = cvt_pk_bf16(v1[2], v1[3]);
                    *(u32x4*)(rowp + bj * HALF) = w; } }
    }
};
struct EpiF8S {
    static constexpr bool PERM = true, AFTER_DRAIN = false;
    unsigned char* O; int ldc; float sc;
    __device__ __forceinline__ void operator()(const f32x4 (&acc)[2][2][4][2], const Unit& u, int wr, int wc, int fr, int fq) const {
        const int row0 = u.pm * BM + wr * 64 + fr, col0 = u.pn * BM + wc * 32 + 8 * fq;
        typedef unsigned u32x2_ __attribute__((ext_vector_type(2)));
#pragma unroll
        for (int ai = 0; ai < 2; ++ai)
#pragma unroll
            for (int m = 0; m < 4; ++m) { unsigned char* rowp = O + (size_t)(row0 + ai * HALF + m * 16) * ldc + col0;
#pragma unroll
                for (int bj = 0; bj < 2; ++bj) { const f32x4 v0 = acc[ai][bj][m][0] * sc, v1 = acc[ai][bj][m][1] * sc;
                    *(u32x2_*)(rowp + bj * HALF) = (u32x2_){pack4_fp8(v0[0], v0[1], v0[2], v0[3]), pack4_fp8(v1[0], v1[1], v1[2], v1[3])}; } }
    }
};
struct EpiUp {
    static constexpr bool PERM = true, AFTER_DRAIN = false;
    bf16_t* Q; bf16_t* K; bf16_t* V; const float* qg; const float* kg; const float* cosT; const float* sinT;
    __device__ __forceinline__ static float sum_fq(float s) {
        s += __int_as_float(__builtin_amdgcn_ds_swizzle(__float_as_int(s), (16 << 10) | 0x1f));
        auto rr = __builtin_amdgcn_permlane32_swap(__float_as_uint(s), __float_as_uint(s), false, false); return __uint_as_float(rr[0]) + __uint_as_float(rr[1]); }
    __device__ __forceinline__ void operator()(const f32x4 (&acc)[2][2][4][2], const Unit& u, int wr, int wc, int fr, int fq) const {
        const int t = u.pn, row0 = u.pm * BM + wr * 64 + fr; const float C2 = 0.10206207261596577f * 1.4426950408889634f, EPSN = 1e-6f;
        if (t >= 5) {
            const int col0 = (t - 5) * BM + wc * 32 + 8 * fq;
#pragma unroll
            for (int ai = 0; ai < 2; ++ai)
#pragma unroll
                for (int m = 0; m < 4; ++m) { bf16_t* rowp = V + (size_t)(row0 + ai * HALF + m * 16) * 512 + col0;
#pragma unroll
                    for (int bj = 0; bj < 2; ++bj) { const f32x4 v0 = acc[ai][bj][m][0], v1 = acc[ai][bj][m][1];
                        u32x4 w; w.x = cvt_pk_bf16(v0[0], v0[1]); w.y = cvt_pk_bf16(v0[2], v0[3]); w.z = cvt_pk_bf16(v1[0], v1[1]); w.w = cvt_pk_bf16(v1[2], v1[3]);
                        *(u32x4*)(rowp + bj * HALF) = w; } }
        } else if (t == 2) {
            const f32x4 g1 = *(const f32x4*)(qg + 64 + 4 * fq), g2 = *(const f32x4*)(qg + 80 + 4 * fq);
#pragma unroll
            for (int ai = 0; ai < 2; ++ai) {
                f32x4 csv[4], snv[4];
#pragma unroll
                for (int m = 0; m < 4; ++m) { const int row = row0 + ai * HALF + m * 16; csv[m] = *(const f32x4*)(cosT + (size_t)row * 16 + 4 * fq); snv[m] = *(const f32x4*)(sinT + (size_t)row * 16 + 4 * fq); }
                asm volatile("" ::: "memory");
#pragma unroll
                for (int m = 0; m < 4; ++m) { const int row = row0 + ai * HALF + m * 16;
                    const f32x4 cs = csv[m], sn = snv[m];
#pragma unroll
                    for (int bj = 0; bj < 2; ++bj) { const f32x4 x1 = acc[ai][bj][m][0], x2 = acc[ai][bj][m][1];
                        float ss = (x1[0] * x1[0] + x1[1] * x1[1]) + (x1[2] * x1[2] + x1[3] * x1[3]) + (x2[0] * x2[0] + x2[1] * x2[1]) + (x2[2] * x2[2] + x2[3] * x2[3]);
                        ss = sum_fq(ss); const float rs = __builtin_amdgcn_rsqf(ss * (1.0f / 32.0f) + EPSN);
                        const f32x4 a = x1 * rs * g1, b = x2 * rs * g2; const f32x4 o1 = (a * cs - b * sn) * C2, o2 = (a * sn + b * cs) * C2;
                        bf16_t* qp = Q + (size_t)row * 768 + (4 * bj + wc) * 96 + 64 + 4 * fq;
                        typedef unsigned u32x2_ __attribute__((ext_vector_type(2)));
                        *(u32x2_*)qp = (u32x2_){cvt_pk_bf16(o1[0], o1[1]), cvt_pk_bf16(o1[2], o1[3])}; *(u32x2_*)(qp + 16) = (u32x2_){cvt_pk_bf16(o2[0], o2[1]), cvt_pk_bf16(o2[2], o2[3])}; } } }
        } else {
            const bool isq = t < 2; const int head = 4 * (isq ? t : t - 3) + wc; const float* g = isq ? qg : kg; bf16_t* dst = isq ? Q : K; const float sc = isq ? C2 : 1.0f;
            f32x4 gv[2][2];
#pragma unroll
            for (int bj = 0; bj < 2; ++bj)
#pragma unroll
                for (int n = 0; n < 2; ++n) gv[bj][n] = *(const f32x4*)(g + 32 * bj + 8 * fq + 4 * n);
#pragma unroll
            for (int ai = 0; ai < 2; ++ai)
#pragma unroll
                for (int m = 0; m < 4; ++m) { const int row = row0 + ai * HALF + m * 16; float ss = 0.f;
#pragma unroll
                    for (int bj = 0; bj < 2; ++bj)
#pragma unroll
                        for (int n = 0; n < 2; ++n) { const f32x4 x = acc[ai][bj][m][n]; ss += (x[0] * x[0] + x[1] * x[1]) + (x[2] * x[2] + x[3] * x[3]); }
                    ss = sum_fq(ss); const float rs = sc / __builtin_sqrtf(ss * (1.0f / 64.0f) + EPSN);
                    bf16_t* rowp = dst + (size_t)row * 768 + head * 96 + 8 * fq;
#pragma unroll
                    for (int bj = 0; bj < 2; ++bj) { const f32x4 v0 = acc[ai][bj][m][0] * rs * gv[bj][0], v1 = acc[ai][bj][m][1] * rs * gv[bj][1];
                        u32x4 w; w.x = cvt_pk_bf16(v0[0], v0[1]); w.y = cvt_pk_bf16(v0[2], v0[3]); w.z = cvt_pk_bf16(v1[0], v1[1]); w.w = cvt_pk_bf16(v1[2], v1[3]);
                        *(u32x4*)(rowp + 32 * bj) = w; } }
        }
    }
};
template <class Epi, class Sched, bool ALIGN_EPI = false, bool SP2 = false, bool F8 = false, bool I8 = false>
__device__ __forceinline__ void gemm_phase(PG8_LAS unsigned char* lds, const Gemm g, const Sched& S, const Epi& E) {
    int tid_ = threadIdx.x; asm volatile("" : "+v"(tid_));
    const int tid = tid_, wid = __builtin_amdgcn_readfirstlane(tid >> 6), lane = tid & 63, wr = wid >> 2, wc = wid & 3, fr = lane & 15, fq = lane >> 4;
    const int K = g.K, nt = K / BK;
    unsigned voffA[2], voffB[2];
#pragma unroll
    for (int i = 0; i < 2; ++i) { int R, C; stage_rc(tid * 16 + i * 8192, R, C); const int Rb = Epi::PERM ? ((R & ~31) + perm32(R & 31)) : R;
        voffA[i] = (unsigned)(R * K + C) * 2u; voffB[i] = (unsigned)(Rb * K + C) * 2u; }
    const size_t kstep = (size_t)(BK * 2);
    const size_t hstep = (size_t)HALF * K * 2;
    const size_t tstep = 2 * hstep;
    const unsigned ldsw = (unsigned)wid * 1024u;
    const int aoff = lds_byte(wr * 64 + fr, fq * 8), boff = lds_byte(wc * 32 + fr, fq * 8);
#define PG8_SA(b, h) (((b) * 2 + (h)) * HTB)
#define PG8_SB(b, h) ((4 + (b) * 2 + (h)) * HTB)
#define PG8_STAGE(bufoff, gbase, voff) do { _Pragma("unroll") for (int _i = 0; _i < 2; ++_i) \
        __builtin_amdgcn_global_load_lds((const unsigned*)((const char*)(gbase) + (voff)[_i]), (PG8_LAS unsigned*)(lds + (bufoff) + ldsw + _i * 8192), 16, 0, 0); } while (0)
#define PG8_LDA(dst, b, h) do { _Pragma("unroll") for (int m = 0; m < 4; ++m) _Pragma("unroll") for (int k = 0; k < 2; ++k) dst[m][k] = *(const PG8_LAS bf16x8*)(lds + PG8_SA(b, h) + aoff + m * 2048 + k * 1024); } while (0)
#define PG8_LDB(dst, b, h) do { _Pragma("unroll") for (int n = 0; n < 2; ++n) _Pragma("unroll") for (int k = 0; k < 2; ++k) dst[n][k] = *(const PG8_LAS bf16x8*)(lds + PG8_SB(b, h) + boff + n * 2048 + k * 1024); } while (0)
#define PG8_CAT(x0, x1) __builtin_shufflevector(__builtin_bit_cast(i32x4_, x0), __builtin_bit_cast(i32x4_, x1), 0, 1, 2, 3, 4, 5, 6, 7)
#define PG8_MMA(ai, bj, At, Bt) do { __builtin_amdgcn_s_setprio(1); \
        if constexpr (I8) { _Pragma("unroll") for (int k = 0; k < 2; ++k) _Pragma("unroll") for (int m = 0; m < 4; ++m) _Pragma("unroll") for (int n = 0; n < 2; ++n) \
            asm volatile("v_mfma_i32_16x16x64_i8 %0, %1, %2, %0" : "+v"(acc[ai][bj][m][n]) : "v"(Bt[n][k]), "v"(At[m][k])); } \
        else { _Pragma("unroll") for (int m = 0; m < 4; ++m) _Pragma("unroll") for (int n = 0; n < 2; ++n) { \
        if constexpr (F8) asm volatile("v_mfma_f32_16x16x128_f8f6f4 %0, %1, %2, %0" : "+v"(acc[ai][bj][m][n]) : "v"(PG8_CAT(Bt[n][0], Bt[n][1])), "v"(PG8_CAT(At[m][0], At[m][1])));     \
        else { _Pragma("unroll") for (int k = 0; k < 2; ++k) acc[ai][bj][m][n] = __builtin_amdgcn_mfma_f32_16x16x32_bf16(Bt[n][k], At[m][k], acc[ai][bj][m][n], 0, 0, 0); } } } __builtin_amdgcn_s_setprio(0); } while (0)
#define PG8_MMA0(ai, bj, At, Bt) do { __builtin_amdgcn_s_setprio(1); \
        if constexpr (I8) { _Pragma("unroll") for (int m = 0; m < 4; ++m) _Pragma("unroll") for (int n = 0; n < 2; ++n) asm volatile("v_mfma_i32_16x16x64_i8 %0, %1, %2, 0" : "=&v"(acc[ai][bj][m][n]) : "v"(Bt[n][0]), "v"(At[m][0])); \
            _Pragma("unroll") for (int m = 0; m < 4; ++m) _Pragma("unroll") for (int n = 0; n < 2; ++n) asm volatile("v_mfma_i32_16x16x64_i8 %0, %1, %2, %0" : "+v"(acc[ai][bj][m][n]) : "v"(Bt[n][1]), "v"(At[m][1])); } \
        else { _Pragma("unroll") for (int m = 0; m < 4; ++m) _Pragma("unroll") for (int n = 0; n < 2; ++n) \
            asm volatile("v_mfma_f32_16x16x128_f8f6f4 %0, %1, %2, 0" : "=&v"(acc[ai][bj][m][n]) : "v"(PG8_CAT(Bt[n][0], Bt[n][1])), "v"(PG8_CAT(At[m][0], At[m][1]))); } \
        __builtin_amdgcn_s_setprio(0); } while (0)
#define PG8_MMAZ(ai, bj, At, Bt) do { if (F8 && t == 0) PG8_MMA0(ai, bj, At, Bt); else PG8_MMA(ai, bj, At, Bt); } while (0)
#define PG8_WAIT_V(n) asm volatile("s_waitcnt vmcnt(" #n ")" ::: "memory")
#define PG8_WAIT_L(n) asm volatile("s_waitcnt lgkmcnt(" #n ")" ::: "memory")
#define PG8_BAR __builtin_amdgcn_s_barrier()
#define PG8_SCHED __builtin_amdgcn_sched_barrier(0)
    Unit cur, nxt; int ui = 0;
    if (!S.next(0, cur)) return;
    f32x4 acc[2][2][4][2];
    if constexpr (!F8) {
#pragma unroll
    for (int a = 0; a < 2; ++a)
#pragma unroll
        for (int b = 0; b < 2; ++b)
#pragma unroll
            for (int m = 0; m < 4; ++m)
#pragma unroll
                for (int n = 0; n < 2; ++n) acc[a][b][m][n] = (f32x4){0.f, 0.f, 0.f, 0.f}; }
    bf16x8 At[4][2], B0[2][2], B1[2][2];
    const char* cA = (const char*)g.A + (size_t)cur.pa * tstep; const char* cB = (const char*)g.Bt + (size_t)cur.pb * tstep;
    S.a_ready(cur);
    if constexpr (SP2) {
        PG8_STAGE(PG8_SB(0, 0), cB, voffB); PG8_STAGE(PG8_SB(0, 1), cB + hstep, voffB); PG8_STAGE(PG8_SA(0, 0), cA, voffA); PG8_STAGE(PG8_SA(0, 1), cA + hstep, voffA);
        if (wr == 1) PG8_BAR;
        PG8_WAIT_V(2); PG8_BAR;
        PG8_STAGE(PG8_SB(1, 0), cB + kstep, voffB); PG8_STAGE(PG8_SA(1, 0), cA + kstep, voffA); PG8_STAGE(PG8_SB(1, 1), cB + hstep + kstep, voffB);
        PG8_WAIT_V(6); PG8_BAR;
    } else {
        PG8_STAGE(PG8_SB(0, 0), cB, voffB); PG8_STAGE(PG8_SA(0, 0), cA, voffA); PG8_STAGE(PG8_SB(0, 1), cB + hstep, voffB); PG8_STAGE(PG8_SA(0, 1), cA + hstep, voffA);
        if (wr == 1) PG8_BAR;
        PG8_WAIT_V(4); PG8_BAR;
        PG8_STAGE(PG8_SB(1, 0), cB + kstep, voffB); PG8_STAGE(PG8_SA(1, 0), cA + kstep, voffA); PG8_STAGE(PG8_SB(1, 1), cB + hstep + kstep, voffB);
        PG8_WAIT_V(6); PG8_BAR;
    }
    for (;;) {
        const bool has_next = S.next(ui + 1, nxt);
        const char* nA = has_next ? (const char*)g.A + (size_t)nxt.pa * tstep : cA; const char* nB = has_next ? (const char*)g.Bt + (size_t)nxt.pb * tstep : cB;
        const int ntu = S.ktiles(cur, nt);
        const bool skip1 = F8 && SP2 && cur.sk != 0;
        for (int t = 0; t < ntu; t += 2) {
            const bool last = (t == ntu - 2);
            const char* a1 = cA + (size_t)(t + 1) * kstep;
            const char* a2 = last ? nA : cA + (size_t)(t + 2) * kstep; const char* b2 = last ? nB : cB + (size_t)(t + 2) * kstep;
            const char* a3 = a2 + kstep; const char* b3 = b2 + kstep;
            if (last && has_next) S.a_ready(nxt);
            if constexpr (SP2) {
            PG8_LDB(B0, 0, 0); PG8_LDB(B1, 0, 1); PG8_SCHED; PG8_LDA(At, 0, 0); PG8_STAGE(PG8_SA(1, 1), a1 + hstep, voffA);
            PG8_WAIT_V(8); PG8_WAIT_L(0); PG8_BAR; PG8_MMAZ(0, 0, At, B0); PG8_MMAZ(0, 1, At, B1); PG8_BAR; PG8_SCHED;
            PG8_LDA(At, 0, 1); PG8_STAGE(PG8_SB(0, 0), b2, voffB); PG8_STAGE(PG8_SB(0, 1), b2 + hstep, voffB); PG8_STAGE(PG8_SA(0, 0), a2, voffA);
            PG8_WAIT_V(8); PG8_WAIT_L(0); PG8_BAR;
            if (!skip1) { PG8_MMAZ(1, 0, At, B0); PG8_MMAZ(1, 1, At, B1); }
            else if (t == 0) {
#pragma unroll
                for (int b = 0; b < 2; ++b)
#pragma unroll
                    for (int m = 0; m < 4; ++m)
#pragma unroll
                        for (int n = 0; n < 2; ++n) acc[1][b][m][n] = (f32x4){0.f, 0.f, 0.f, 0.f}; }
            PG8_BAR; PG8_SCHED;
            PG8_LDB(B0, 1, 0); PG8_LDB(B1, 1, 1); PG8_SCHED; PG8_LDA(At, 1, 0); PG8_STAGE(PG8_SA(0, 1), a2 + hstep, voffA);
            PG8_WAIT_V(8); PG8_WAIT_L(0); PG8_BAR; PG8_MMA(0, 0, At, B0); PG8_MMA(0, 1, At, B1); PG8_BAR; PG8_SCHED;
            PG8_LDA(At, 1, 1); PG8_STAGE(PG8_SB(1, 0), b3, voffB); PG8_STAGE(PG8_SB(1, 1), b3 + hstep, voffB); PG8_STAGE(PG8_SA(1, 0), a3, voffA);
            PG8_WAIT_V(8); PG8_WAIT_L(0); PG8_BAR; if (!skip1) { PG8_MMA(1, 0, At, B0); PG8_MMA(1, 1, At, B1); } PG8_BAR; PG8_SCHED;
            } else {
            PG8_LDB(B0, 0, 0); PG8_SCHED; PG8_LDA(At, 0, 0); PG8_STAGE(PG8_SA(1, 1), a1 + hstep, voffA);
            PG8_WAIT_L(8); PG8_BAR; PG8_WAIT_L(0); PG8_MMAZ(0, 0, At, B0); PG8_BAR; PG8_SCHED;
            PG8_LDB(B1, 0, 1); PG8_STAGE(PG8_SB(0, 0), b2, voffB);
            PG8_BAR; PG8_WAIT_L(0); PG8_MMAZ(0, 1, At, B1); PG8_BAR;
            PG8_LDA(At, 0, 1); PG8_STAGE(PG8_SA(0, 0), a2, voffA);
            PG8_BAR; PG8_WAIT_L(0); PG8_MMAZ(1, 0, At, B0); PG8_BAR; PG8_SCHED;
            PG8_STAGE(PG8_SB(0, 1), b2 + hstep, voffB);
            PG8_WAIT_V(6); PG8_BAR; PG8_MMAZ(1, 1, At, B1); PG8_BAR;
            PG8_LDB(B0, 1, 0); PG8_SCHED; PG8_LDA(At, 1, 0); PG8_STAGE(PG8_SA(0, 1), a2 + hstep, voffA);
            PG8_WAIT_L(8); PG8_BAR; PG8_WAIT_L(0); PG8_MMA(0, 0, At, B0); PG8_BAR; PG8_SCHED;
            PG8_LDB(B1, 1, 1); PG8_STAGE(PG8_SB(1, 0), b3, voffB);
            PG8_BAR; PG8_WAIT_L(0); PG8_MMA(0, 1, At, B1); PG8_BAR;
            PG8_LDA(At, 1, 1); PG8_STAGE(PG8_SA(1, 0), a3, voffA);
            PG8_BAR; PG8_WAIT_L(0); PG8_MMA(1, 0, At, B0); PG8_BAR; PG8_SCHED;
            PG8_STAGE(PG8_SB(1, 1), b3 + hstep, voffB);
            PG8_WAIT_V(6); PG8_BAR; PG8_MMA(1, 1, At, B1); PG8_BAR;
            }
        }
        if constexpr (ALIGN_EPI) { if (wr == 0) PG8_BAR; }
        if constexpr (F8) asm volatile("s_nop 15\n\ts_nop 15" ::: "memory");
        if constexpr (!Epi::AFTER_DRAIN) { E(acc, cur, wr, wc, fr, fq); S.done(cur); }
        if (!has_next) break;
        if constexpr (!F8) {
#pragma unroll
        for (int a = 0; a < 2; ++a)
#pragma unroll
            for (int b = 0; b < 2; ++b)
#pragma unroll
                for (int m = 0; m < 4; ++m)
#pragma unroll
                    for (int n = 0; n < 2; ++n) acc[a][b][m][n] = (f32x4){0.f, 0.f, 0.f, 0.f}; }
        cur = nxt; cA = nA; cB = nB; ++ui;
        if constexpr (ALIGN_EPI) { if (wr == 1) PG8_BAR; }
    }
    PG8_WAIT_V(0);
    if constexpr (!ALIGN_EPI) { if (wr == 0) PG8_BAR; }
    PG8_BAR;
    if constexpr (Epi::AFTER_DRAIN) { E.fused(acc, cur, wr, wc, fr, fq, lds, wid, lane); S.done(cur); }
#undef PG8_SA
#undef PG8_SB
#undef PG8_STAGE
#undef PG8_LDA
#undef PG8_LDB
#undef PG8_MMA
#undef PG8_MMA0
#undef PG8_MMAZ
#undef PG8_CAT
#undef PG8_WAIT_V
#undef PG8_WAIT_L
#undef PG8_BAR
#undef PG8_SCHED
}
}

#define GAS __attribute__((address_space(1)))
#define LAS __attribute__((address_space(3)))
typedef unsigned short bf16;
typedef unsigned v4u __attribute__((ext_vector_type(4)));
typedef unsigned v2u __attribute__((ext_vector_type(2)));
typedef float f32x4 __attribute__((ext_vector_type(4)));
typedef short bf16x8 __attribute__((ext_vector_type(8)));
typedef GAS unsigned gu32;
typedef GAS unsigned long long gu64;
#define RLX_AGENT __ATOMIC_RELAXED, __HIP_MEMORY_SCOPE_AGENT
#define LDS_WAIT() asm volatile("s_waitcnt lgkmcnt(0)" ::: "memory")
#define VM_WAIT() asm volatile("s_waitcnt vmcnt(0)" ::: "memory")
__device__ __forceinline__ unsigned long long rt() { return __builtin_amdgcn_s_memrealtime(); }
__device__ __forceinline__ unsigned f2bf(float f) { unsigned u = __builtin_bit_cast(unsigned, f); return (u + 0x7fffu + ((u >> 16) & 1u)) >> 16; }
__device__ __forceinline__ unsigned pk2(float lo, float hi) { return f2bf(lo) | (f2bf(hi) << 16); }

#define XB_TMO      128
#define XB_XCNT(j)  (256  + 64 * (j))
#define XB_XSUB(j)  (1280 + 64 * (j))
#define XB_XGEN(j)  (2304 + 64 * (j))
#define XB_TOP      3328
#define XB_TOPGEN   3392
#define XCD_BAR_WORDS 3456
#define XB_SPIN_CAP (1u << 18)

__device__ __forceinline__ unsigned xb_ld(unsigned* p)              { return __hip_atomic_load(p, __ATOMIC_RELAXED, __HIP_MEMORY_SCOPE_AGENT); }
__device__ __forceinline__ unsigned xb_add(unsigned* p, unsigned v) { return __hip_atomic_fetch_add(p, v, __ATOMIC_RELAXED, __HIP_MEMORY_SCOPE_AGENT); }
__device__ __forceinline__ unsigned xb_xcc_id() { return (unsigned)__builtin_amdgcn_s_getreg((3 << 11) | 20) & 0xFu; }
#define XB_SPIN(cond, bar) do { unsigned _sp = 0; while (cond) { __builtin_amdgcn_s_sleep(1); \
    if ((++_sp & 255u) == 0u) { if (xb_ld(&(bar)[XB_TMO])) break; if (_sp > XB_SPIN_CAP) { atomicAdd(&(bar)[XB_TMO], 1u); break; } } } } while (0)

struct XcdBarrier {
    unsigned* bar; unsigned x;
    volatile LAS unsigned* st;
};

__device__ __forceinline__ XcdBarrier xcd_barrier_post(unsigned* bar, volatile LAS unsigned* st) {
    XcdBarrier b; b.bar = bar; b.x = xb_xcc_id(); b.st = st;
    if (threadIdx.x == 0) (void)xb_add(&bar[XB_XCNT(b.x)], 1u);
    return b;
}
__device__ __forceinline__ void xcd_barrier_complete(unsigned* bar, unsigned x, unsigned& nloc, unsigned& nx) {
    const unsigned G = gridDim.x * gridDim.y * gridDim.z;
    unsigned sum, cnt, mine, sp = 0u;
    for (;;) {
        sum = 0u; cnt = 0u; mine = 0u;
#pragma unroll
        for (unsigned j = 0; j < 16; ++j) { const unsigned c = xb_ld(&bar[XB_XCNT(j)]); sum += c; cnt += (c > 0u) ? 1u : 0u; mine = (j == x) ? c : mine; }
        if (sum == G) break;
        __builtin_amdgcn_s_sleep(1);
        if ((++sp & 255u) == 0u) { if (xb_ld(&bar[XB_TMO])) break; if (sp > XB_SPIN_CAP) { atomicAdd(&bar[XB_TMO], 1u); break; } }
    }
    nloc = mine > 0u ? mine : 1u; nx = cnt > 0u ? cnt : 1u;
}

__device__ __forceinline__ void xcd_barrier(const XcdBarrier& b) {
    asm volatile("s_waitcnt vmcnt(0)" ::: "memory");
    __syncthreads();
    unsigned tid0_ = threadIdx.x; asm volatile("" : "+v"(tid0_));
    if (tid0_ == 0) {
        unsigned* bar = b.bar; unsigned bx = b.x;
        asm volatile("" : "+s"(bar), "+s"(bx));
        __builtin_amdgcn_s_waitcnt(0);
        unsigned nloc = b.st[0], nx = b.st[1];
        if (nloc == 0u) { xcd_barrier_complete(bar, bx, nloc, nx); b.st[0] = nloc; b.st[1] = nx; }
        const unsigned old = xb_add(&bar[XB_XSUB(bx)], 1u);
        const unsigned gen = old / nloc;
        if (old + 1u == (gen + 1u) * nloc) {
            __builtin_amdgcn_fence(__ATOMIC_RELEASE, "agent");
            asm volatile("s_waitcnt vmcnt(0)" ::: "memory");
            const unsigned og = xb_add(&bar[XB_TOP], 1u);
            const unsigned tg = og / nx;
            if (og + 1u == (tg + 1u) * nx) xb_add(&bar[XB_TOPGEN], 1u);
            else XB_SPIN(xb_ld(&bar[XB_TOPGEN]) == tg, bar);
            __builtin_amdgcn_fence(__ATOMIC_ACQUIRE, "agent");
            xb_add(&bar[XB_XGEN(bx)], 1u);
            asm volatile("s_waitcnt vmcnt(0)" ::: "memory");
        } else {
            XB_SPIN(xb_ld(&bar[XB_XGEN(bx)]) == gen, bar);
            __builtin_amdgcn_fence(__ATOMIC_ACQUIRE, "agent");
            asm volatile("s_waitcnt vmcnt(0)" ::: "memory");
        }
    }
    __syncthreads();
}

namespace att_online {
#define ALAS __attribute__((address_space(3)))
typedef unsigned short bf16;
typedef short bf16x8 __attribute__((ext_vector_type(8)));
typedef short s16x4 __attribute__((ext_vector_type(4)));
typedef float f32x16 __attribute__((ext_vector_type(16)));
typedef unsigned u32x4 __attribute__((ext_vector_type(4)));
constexpr int SEQ = 16384, NHEAD = 8;
constexpr int QP = 768, KP = 768, VP = 512, OP = 1024;
constexpr int QHS = 96, KHS = 96, VHS = 64, OHS = 64;
constexpr int NW = 8, QBLK = 32, QB = QBLK * NW, KVBLK = 64, NQB = SEQ / QB;
constexpr int KSLOT = 12288, VSLOT = 8192;
constexpr int L_K = 0, L_V = 2 * KSLOT, L_WS = L_V + 2 * VSLOT, L_OST = L_WS + NW * 64 * 4, L_BYTES = L_OST + NW * 4096;
constexpr float THR = 8.0f;
__device__ __forceinline__ int crow(int r, int hi) { return (r & 3) + 8 * (r >> 2) + 4 * hi; }
__device__ __forceinline__ unsigned cvtpk(float lo, float hi) { unsigned r; asm volatile("v_cvt_pk_bf16_f32 %0, %1, %2" : "=v"(r) : "v"(lo), "v"(hi)); return r; }
__device__ __forceinline__ float pswap_max(float m) { auto rr = __builtin_amdgcn_permlane32_swap(__float_as_uint(m), __float_as_uint(m), false, false); return __builtin_fmaxf(__uint_as_float(rr[0]), __uint_as_float(rr[1])); }
__device__ __forceinline__ float pswap_sum(float m) { auto rr = __builtin_amdgcn_permlane32_swap(__float_as_uint(m), __float_as_uint(m), false, false); return __uint_as_float(rr[0]) + __uint_as_float(rr[1]); }

__device__ __forceinline__ void attn_unit(int b, int h, int qb, const bf16* Q, const bf16* K, const bf16* V, bf16* O, ALAS unsigned char* shm) {
    int tid_ = threadIdx.x; asm volatile("" : "+v"(tid_));
    const int tid = tid_, lane = tid & 63, r32 = lane & 31, hi = lane >> 5; const int wid = __builtin_amdgcn_readfirstlane(tid >> 6);
    const long rowbase = (long)b * SEQ; const int q0 = qb * QB;
    const bf16* Qw = Q + (rowbase + q0 + wid * QBLK) * QP + h * QHS;
    const bf16* Kh = K + rowbase * KP + h * KHS; const bf16* Vh = V + rowbase * VP + h * VHS;
    ALAS float* wsf = (ALAS float*)(shm + L_WS) + wid * 64;
    const bf16* ksrc = Kh + (long)lane * KP + wid * 8;
    const bf16* vsrc = Vh + (long)(16 * (wid & 3) + (lane >> 2)) * VP + (wid >> 2) * 32 + (lane & 3) * 8;
#define ATT_DMA(t, slot) do { \
        __builtin_amdgcn_global_load_lds((const unsigned*)(ksrc + (long)(t) * KVBLK * KP), (ALAS unsigned*)(shm + L_K + (slot) * KSLOT + wid * 1024), 16, 0, 0); \
        if (wid < 4) __builtin_amdgcn_global_load_lds((const unsigned*)(ksrc + (long)(t) * KVBLK * KP + 64), (ALAS unsigned*)(shm + L_K + (slot) * KSLOT + (8 + wid) * 1024), 16, 0, 0); \
        __builtin_amdgcn_global_load_lds((const unsigned*)(vsrc + (long)(t) * KVBLK * VP), (ALAS unsigned*)(shm + L_V + (slot) * VSLOT + wid * 1024), 16, 0, 0); } while (0)
    const int NT = (q0 + QB) / KVBLK;
    ATT_DMA(0, 0);
    bf16x8 qr[6];
#pragma unroll
    for (int d0 = 0; d0 < 6; ++d0) qr[d0] = *(const bf16x8*)(Qw + (long)r32 * QP + d0 * 16 + hi * 8);
    float mhat = 0.f, l_reg = 0.f; f32x16 o[2], negm;
#pragma unroll
    for (int r = 0; r < 16; ++r) { o[0][r] = 0.f; o[1][r] = 0.f; negm[r] = 0.f; }
    const int qrel = wid * QBLK + r32;
    const unsigned vb0 = (unsigned)(uintptr_t)(shm + L_V) + ((lane >> 4) & 1) * 32 + (lane & 3) * 8 + (4 * hi + ((lane & 15) >> 2)) * 64;
    for (int t = 0; t < NT; ++t) {
        const int cur = t & 1;
        asm volatile("s_waitcnt vmcnt(0)" ::: "memory"); __syncthreads();
        if (t + 1 < NT) ATT_DMA(t + 1, cur ^ 1);
        f32x16 p0, p1;
        { const ALAS unsigned char* kb = shm + L_K + cur * KSLOT + hi * 1024 + r32 * 16;
#pragma unroll
          for (int d0 = 0; d0 < 6; ++d0) {
              const bf16x8 b0 = *(const ALAS bf16x8*)(kb + d0 * 2048), b1 = *(const ALAS bf16x8*)(kb + d0 * 2048 + 512);
              if (d0 == 0) { p0 = __builtin_amdgcn_mfma_f32_32x32x16_bf16(b0, qr[0], negm, 0, 0, 0); p1 = __builtin_amdgcn_mfma_f32_32x32x16_bf16(b1, qr[0], negm, 0, 0, 0); }
              else { p0 = __builtin_amdgcn_mfma_f32_32x32x16_bf16(b0, qr[d0], p0, 0, 0, 0); p1 = __builtin_amdgcn_mfma_f32_32x32x16_bf16(b1, qr[d0], p1, 0, 0, 0); } } }
        const int jb = t - (NT - 4);
        if (jb >= 0) { const int kb0 = 64 * jb + 4 * hi;
#pragma unroll
            for (int r = 0; r < 16; ++r) { const int kv = kb0 + (r & 3) + 8 * (r >> 2); if (kv > qrel) p0[r] = -__builtin_inff(); if (kv + 32 > qrel) p1[r] = -__builtin_inff(); } }
        float rm = __builtin_fmaxf(p0[0], p1[0]);
#pragma unroll
        for (int r = 1; r < 16; ++r) rm = __builtin_fmaxf(rm, __builtin_fmaxf(p0[r], p1[r]));
        rm = pswap_max(rm);
        bool resc = false;
        if (t == 0 || __any(rm > THR)) {
            const float dl = (t == 0) ? rm : __builtin_fmaxf(rm, 0.f); mhat += dl;
#pragma unroll
            for (int r = 0; r < 16; ++r) { p0[r] -= dl; p1[r] -= dl; negm[r] = -mhat; }
            if (t != 0) { const float f = __builtin_amdgcn_exp2f(-dl); l_reg *= f; if (hi == 0) wsf[r32] = f; resc = true; }
        }
        float sacc = 0.f;
#pragma unroll
        for (int r = 0; r < 16; ++r) { p0[r] = __builtin_amdgcn_exp2f(p0[r]); p1[r] = __builtin_amdgcn_exp2f(p1[r]); sacc += p0[r] + p1[r]; }
        l_reg += sacc;
        if (resc) { asm volatile("s_waitcnt lgkmcnt(0)" ::: "memory");
#pragma unroll
            for (int r = 0; r < 16; ++r) { const float f = wsf[crow(r, hi)]; o[0][r] *= f; o[1][r] *= f; }
            asm volatile("s_waitcnt lgkmcnt(0)" ::: "memory"); }
        u32x4 pw[4];
#pragma unroll
        for (int k = 0; k < 2; ++k) { pw[k] = (u32x4){cvtpk(p0[8 * k], p0[8 * k + 1]), cvtpk(p0[8 * k + 2], p0[8 * k + 3]), cvtpk(p0[8 * k + 4], p0[8 * k + 5]), cvtpk(p0[8 * k + 6], p0[8 * k + 7])};
            pw[2 + k] = (u32x4){cvtpk(p1[8 * k], p1[8 * k + 1]), cvtpk(p1[8 * k + 2], p1[8 * k + 3]), cvtpk(p1[8 * k + 4], p1[8 * k + 5]), cvtpk(p1[8 * k + 6], p1[8 * k + 7])}; }
        { const unsigned vb = vb0 + cur * VSLOT;
#pragma unroll
          for (int d0 = 0; d0 < 2; ++d0) { s16x4 lo[4], hh[4];
#pragma unroll
              for (int ks = 0; ks < 4; ++ks) {
                  asm volatile("ds_read_b64_tr_b16 %0, %1 offset:%c2" : "=&v"(lo[ks]) : "v"(vb), "i"(d0 * 4096 + ks * 1024) : "memory");
                  asm volatile("ds_read_b64_tr_b16 %0, %1 offset:%c2" : "=&v"(hh[ks]) : "v"(vb), "i"(d0 * 4096 + ks * 1024 + 512) : "memory"); }
              asm volatile("s_waitcnt lgkmcnt(0)" : "+v"(lo[0]), "+v"(lo[1]), "+v"(lo[2]), "+v"(lo[3]), "+v"(hh[0]), "+v"(hh[1]), "+v"(hh[2]), "+v"(hh[3]) :: "memory");
#pragma unroll
              for (int ks = 0; ks < 4; ++ks) { const bf16x8 vf = (bf16x8){lo[ks][0], lo[ks][1], lo[ks][2], lo[ks][3], hh[ks][0], hh[ks][1], hh[ks][2], hh[ks][3]};
                  o[d0] = __builtin_amdgcn_mfma_f32_32x32x16_bf16(__builtin_bit_cast(bf16x8, pw[ks]), vf, o[d0], 0, 0, 0); } } }
    }
    l_reg = pswap_sum(l_reg);
    if (hi == 0) wsf[32 + r32] = l_reg;
    asm volatile("s_waitcnt lgkmcnt(0)" ::: "memory");
    float rli[16];
#pragma unroll
    for (int r = 0; r < 16; ++r) rli[r] = __builtin_amdgcn_rcpf(wsf[32 + crow(r, hi)]);
    bf16* Ow = O + (rowbase + q0 + wid * QBLK) * OP + h * OHS;
    { ALAS bf16* stg = (ALAS bf16*)(shm + L_OST) + wid * 2048;
#pragma unroll
      for (int r = 0; r < 16; ++r) { const int orow = crow(r, hi);
#pragma unroll
          for (int d0 = 0; d0 < 2; ++d0) { const float v = o[d0][r] * rli[r]; unsigned u = __float_as_uint(v); u = (u + 0x7fffu + ((u >> 16) & 1u)) >> 16; stg[orow * 64 + d0 * 32 + r32] = (bf16)u; } }
      asm volatile("s_waitcnt lgkmcnt(0)" ::: "memory");
#pragma unroll
      for (int i = 0; i < 4; ++i) { const int row = i * 8 + (lane >> 3), ch = lane & 7; const u32x4 v = *(const ALAS u32x4*)(stg + row * 64 + ch * 8); *(u32x4*)(Ow + (long)row * OP + ch * 8) = v; } }
    asm volatile("s_waitcnt lgkmcnt(0)" ::: "memory"); __syncthreads();
#undef ATT_DMA
}
#undef ALAS
}

namespace att {
#define ALAS __attribute__((address_space(3)))
typedef unsigned short bf16;
typedef short bf16x8 __attribute__((ext_vector_type(8)));
typedef short s16x4 __attribute__((ext_vector_type(4)));
typedef float f32x16 __attribute__((ext_vector_type(16)));
typedef unsigned u32x4 __attribute__((ext_vector_type(4)));
constexpr int SEQ = 16384, NHEAD = 8;
constexpr int QP = 768, KP = 768, VP = 512, OP = 1024;
constexpr int QHS = 96, KHS = 96, VHS = 64, OHS = 64;
constexpr int NW = 8, QBLK = 32, QB = QBLK * NW, KVBLK = 64, NQB = SEQ / QB;
constexpr int KSLOT = 12288, VSLOT = 8192;
constexpr int L_K = 0, L_V = 2 * KSLOT, L_WS = L_V + 3 * VSLOT, L_OST = L_WS + NW * 64 * 4, L_BYTES = L_OST + NW * 4096;
constexpr float THR = 8.0f;
__device__ __forceinline__ int crow(int r, int hi) { return (r & 3) + 8 * (r >> 2) + 4 * hi; }
__device__ __forceinline__ unsigned cvtpk(float lo, float hi) { typedef float f32x2_t __attribute__((ext_vector_type(2))); typedef __bf16 bf16x2_t __attribute__((ext_vector_type(2)));
    f32x2_t v = {lo, hi}; bf16x2_t b = __builtin_convertvector(v, bf16x2_t); return __builtin_bit_cast(unsigned, b); }
__device__ __forceinline__ float pswap_max(float m) { auto rr = __builtin_amdgcn_permlane32_swap(__float_as_uint(m), __float_as_uint(m), false, false); return __builtin_fmaxf(__uint_as_float(rr[0]), __uint_as_float(rr[1])); }
__device__ __forceinline__ float pswap_sum(float m) { auto rr = __builtin_amdgcn_permlane32_swap(__float_as_uint(m), __float_as_uint(m), false, false); return __uint_as_float(rr[0]) + __uint_as_float(rr[1]); }
typedef short v4i16_t __attribute__((ext_vector_type(4)));
__device__ __forceinline__ s16x4 vtr(const ALAS unsigned char* p) { return __builtin_bit_cast(s16x4, __builtin_amdgcn_ds_read_tr16_b64_v4i16((ALAS v4i16_t*)p)); }
__device__ __forceinline__ void qkt(f32x16& s0, f32x16& s1, const ALAS unsigned char* kb, const bf16x8 (&qr)[6]) {
    const f32x16 c0 = {};
#pragma unroll
    for (int d0 = 0; d0 < 6; ++d0) {
        const bf16x8 b0 = *(const ALAS bf16x8*)(kb + d0 * 2048), b1 = *(const ALAS bf16x8*)(kb + d0 * 2048 + 512);
        if (d0 == 0) { s0 = __builtin_amdgcn_mfma_f32_32x32x16_bf16(b0, qr[0], c0, 0, 0, 0); s1 = __builtin_amdgcn_mfma_f32_32x32x16_bf16(b1, qr[0], c0, 0, 0, 0); }
        else { s0 = __builtin_amdgcn_mfma_f32_32x32x16_bf16(b0, qr[d0], s0, 0, 0, 0); s1 = __builtin_amdgcn_mfma_f32_32x32x16_bf16(b1, qr[d0], s1, 0, 0, 0); } }
}
__device__ __forceinline__ void pv(f32x16 (&o)[2], const ALAS unsigned char* vp, const u32x4 (&pk)[4]) {
#pragma unroll
    for (int ks = 0; ks < 4; ++ks)
#pragma unroll
        for (int d0 = 0; d0 < 2; ++d0) { const s16x4 lo = vtr(vp + d0 * 4096 + ks * 1024), hh = vtr(vp + d0 * 4096 + ks * 1024 + 512);
            const bf16x8 vf = (bf16x8){lo[0], lo[1], lo[2], lo[3], hh[0], hh[1], hh[2], hh[3]};
            o[d0] = __builtin_amdgcn_mfma_f32_32x32x16_bf16(__builtin_bit_cast(bf16x8, pk[ks]), vf, o[d0], 0, 0, 0); }
}

constexpr float ATT_MREF_MAX = 40.0f;
#define ATT_SBAR() __builtin_amdgcn_sched_barrier(0)
#define ATT_PIN(x) asm volatile("" : "+v"(x))
#define ATT_VLOAD(i) do { if (VAR == 1) break; const s16x4 lo_ = vtr(vfrag + ((i) & 1) * 4096 + ((i) >> 1) * 1024), hi_ = vtr(vfrag + ((i) & 1) * 4096 + ((i) >> 1) * 1024 + 512); vfr[i] = (bf16x8){lo_[0], lo_[1], lo_[2], lo_[3], hi_[0], hi_[1], hi_[2], hi_[3]}; } while (0)
#define ATT_KLOAD(j) do { if (QK && VAR != 1) kfr[j] = *(const ALAS bf16x8*)(kfrag + ((j) >> 1) * 2048 + ((j) & 1) * 512); } while (0)
template <bool QK, int VAR = 0>
__device__ __forceinline__ void attn_step(f32x16& c0, f32x16& c1, f32x16& n0, f32x16& n1, u32x4 (&pk)[4], f32x16 (&o)[2], float& l_reg, const bf16x8 (&qr)[6],
                                          const ALAS unsigned char* kfrag, const ALAS unsigned char* vfrag, int jb, int qrel, int hi) {
    if (jb >= 0) { const int kbase = 64 * jb + 4 * hi;
#pragma unroll
        for (int r = 0; r < 16; ++r) { const int kv = kbase + (r & 3) + 8 * (r >> 2); if (kv > qrel) c0[r] = -__builtin_inff(); if (kv + 32 > qrel) c1[r] = -__builtin_inff(); } }
    bf16x8 vfr[8] = {}, kfr[12] = {}; float sa = 0.f, sb = 0.f; const f32x16 zero16 = {};
    ATT_VLOAD(0); ATT_VLOAD(1); ATT_SBAR();
      if (VAR != 4) o[0] = __builtin_amdgcn_mfma_f32_32x32x16_bf16(__builtin_bit_cast(bf16x8, pk[0]), vfr[0], o[0], 0, 0, 0); if (VAR != 2) { c0[0] = __builtin_amdgcn_exp2f(c0[0]); c0[1] = __builtin_amdgcn_exp2f(c0[1]); } ATT_VLOAD(2); ATT_PIN(c0); ATT_SBAR();
      if (VAR != 4) o[1] = __builtin_amdgcn_mfma_f32_32x32x16_bf16(__builtin_bit_cast(bf16x8, pk[0]), vfr[1], o[1], 0, 0, 0); if (VAR != 2) { c0[2] = __builtin_amdgcn_exp2f(c0[2]); c0[3] = __builtin_amdgcn_exp2f(c0[3]); } if (VAR != 2) { sa += c0[0]; sa += c0[1]; } ATT_VLOAD(3); ATT_PIN(c0); ATT_PIN(sa); ATT_SBAR();
      if (VAR != 4) o[0] = __builtin_amdgcn_mfma_f32_32x32x16_bf16(__builtin_bit_cast(bf16x8, pk[1]), vfr[2], o[0], 0, 0, 0); if (VAR != 2) { c0[4] = __builtin_amdgcn_exp2f(c0[4]); c0[5] = __builtin_amdgcn_exp2f(c0[5]); } if (VAR != 2) { sa += c0[2]; sa += c0[3]; } ATT_VLOAD(4); ATT_PIN(c0); ATT_PIN(sa); ATT_SBAR();
      if (VAR != 4) o[1] = __builtin_amdgcn_mfma_f32_32x32x16_bf16(__builtin_bit_cast(bf16x8, pk[1]), vfr[3], o[1], 0, 0, 0); if (VAR != 2) { c0[6] = __builtin_amdgcn_exp2f(c0[6]); c0[7] = __builtin_amdgcn_exp2f(c0[7]); } if (VAR != 2) { sa += c0[4]; sa += c0[5]; } ATT_VLOAD(5); ATT_PIN(c0); ATT_PIN(sa); ATT_SBAR();
      if (VAR != 4) o[0] = __builtin_amdgcn_mfma_f32_32x32x16_bf16(__builtin_bit_cast(bf16x8, pk[2]), vfr[4], o[0], 0, 0, 0); if (VAR != 2) { c0[8] = __builtin_amdgcn_exp2f(c0[8]); c0[9] = __builtin_amdgcn_exp2f(c0[9]); } if (VAR != 2) { sa += c0[6]; sa += c0[7]; } if (VAR != 2) { pk[0].x = cvtpk(c0[0], c0[1]); pk[0].y = cvtpk(c0[2], c0[3]); } ATT_VLOAD(6); ATT_PIN(c0); ATT_PIN(pk[0]); ATT_PIN(sa); ATT_SBAR();
      if (VAR != 4) o[1] = __builtin_amdgcn_mfma_f32_32x32x16_bf16(__builtin_bit_cast(bf16x8, pk[2]), vfr[5], o[1], 0, 0, 0); if (VAR != 2) { c0[10] = __builtin_amdgcn_exp2f(c0[10]); c0[11] = __builtin_amdgcn_exp2f(c0[11]); } if (VAR != 2) { sa += c0[8]; sa += c0[9]; } if (VAR != 2) { pk[0].z = cvtpk(c0[4], c0[5]); pk[0].w = cvtpk(c0[6], c0[7]); } ATT_VLOAD(7); ATT_PIN(c0); ATT_PIN(pk[0]); ATT_PIN(sa); ATT_SBAR();
      if (VAR != 4) o[0] = __builtin_amdgcn_mfma_f32_32x32x16_bf16(__builtin_bit_cast(bf16x8, pk[3]), vfr[6], o[0], 0, 0, 0); if (VAR != 2) { c0[12] = __builtin_amdgcn_exp2f(c0[12]); c0[13] = __builtin_amdgcn_exp2f(c0[13]); } if (VAR != 2) { sa += c0[10]; sa += c0[11]; } ATT_KLOAD(0); ATT_PIN(c0); ATT_PIN(sa); ATT_SBAR();
      if (VAR != 4) o[1] = __builtin_amdgcn_mfma_f32_32x32x16_bf16(__builtin_bit_cast(bf16x8, pk[3]), vfr[7], o[1], 0, 0, 0); if (VAR != 2) { c0[14] = __builtin_amdgcn_exp2f(c0[14]); c0[15] = __builtin_amdgcn_exp2f(c0[15]); } if (VAR != 2) { sa += c0[12]; sa += c0[13]; } ATT_KLOAD(1); ATT_PIN(c0); ATT_PIN(sa); ATT_SBAR();
      if (QK && VAR != 4) n0 = __builtin_amdgcn_mfma_f32_32x32x16_bf16(kfr[0], qr[0], zero16, 0, 0, 0); if (VAR != 2) { c1[0] = __builtin_amdgcn_exp2f(c1[0]); c1[1] = __builtin_amdgcn_exp2f(c1[1]); } if (VAR != 2) { sa += c0[14]; sa += c0[15]; } if (VAR != 2) { pk[1].x = cvtpk(c0[8], c0[9]); pk[1].y = cvtpk(c0[10], c0[11]); } ATT_KLOAD(2); ATT_PIN(c1); ATT_PIN(pk[1]); ATT_PIN(sa); ATT_SBAR();
      if (QK && VAR != 4) n1 = __builtin_amdgcn_mfma_f32_32x32x16_bf16(kfr[1], qr[0], zero16, 0, 0, 0); if (VAR != 2) { c1[2] = __builtin_amdgcn_exp2f(c1[2]); c1[3] = __builtin_amdgcn_exp2f(c1[3]); } if (VAR != 2) { sb += c1[0]; sb += c1[1]; } if (VAR != 2) { pk[1].z = cvtpk(c0[12], c0[13]); pk[1].w = cvtpk(c0[14], c0[15]); } ATT_KLOAD(3); ATT_PIN(c1); ATT_PIN(pk[1]); ATT_PIN(sb); ATT_SBAR();
      if (QK && VAR != 4) n0 = __builtin_amdgcn_mfma_f32_32x32x16_bf16(kfr[2], qr[1], n0, 0, 0, 0); if (VAR != 2) { c1[4] = __builtin_amdgcn_exp2f(c1[4]); c1[5] = __builtin_amdgcn_exp2f(c1[5]); } if (VAR != 2) { sb += c1[2]; sb += c1[3]; } ATT_KLOAD(4); ATT_PIN(c1); ATT_PIN(sb); ATT_SBAR();
      if (QK && VAR != 4) n1 = __builtin_amdgcn_mfma_f32_32x32x16_bf16(kfr[3], qr[1], n1, 0, 0, 0); if (VAR != 2) { c1[6] = __builtin_amdgcn_exp2f(c1[6]); c1[7] = __builtin_amdgcn_exp2f(c1[7]); } if (VAR != 2) { sb += c1[4]; sb += c1[5]; } ATT_KLOAD(5); ATT_PIN(c1); ATT_PIN(sb); ATT_SBAR();
      if (QK && VAR != 4) n0 = __builtin_amdgcn_mfma_f32_32x32x16_bf16(kfr[4], qr[2], n0, 0, 0, 0); if (VAR != 2) { c1[8] = __builtin_amdgcn_exp2f(c1[8]); c1[9] = __builtin_amdgcn_exp2f(c1[9]); } if (VAR != 2) { sb += c1[6]; sb += c1[7]; } if (VAR != 2) { pk[2].x = cvtpk(c1[0], c1[1]); pk[2].y = cvtpk(c1[2], c1[3]); } ATT_KLOAD(6); ATT_PIN(c1); ATT_PIN(pk[2]); ATT_PIN(sb); ATT_SBAR();
      if (QK && VAR != 4) n1 = __builtin_amdgcn_mfma_f32_32x32x16_bf16(kfr[5], qr[2], n1, 0, 0, 0); if (VAR != 2) { c1[10] = __builtin_amdgcn_exp2f(c1[10]); c1[11] = __builtin_amdgcn_exp2f(c1[11]); } if (VAR != 2) { sb += c1[8]; sb += c1[9]; } if (VAR != 2) { pk[2].z = cvtpk(c1[4], c1[5]); pk[2].w = cvtpk(c1[6], c1[7]); } ATT_KLOAD(7); ATT_PIN(c1); ATT_PIN(pk[2]); ATT_PIN(sb); ATT_SBAR();
      if (QK && VAR != 4) n0 = __builtin_amdgcn_mfma_f32_32x32x16_bf16(kfr[6], qr[3], n0, 0, 0, 0); if (VAR != 2) { c1[12] = __builtin_amdgcn_exp2f(c1[12]); c1[13] = __builtin_amdgcn_exp2f(c1[13]); } if (VAR != 2) { sb += c1[10]; sb += c1[11]; } ATT_KLOAD(8); ATT_PIN(c1); ATT_PIN(sb); ATT_SBAR();
      if (QK && VAR != 4) n1 = __builtin_amdgcn_mfma_f32_32x32x16_bf16(kfr[7], qr[3], n1, 0, 0, 0); if (VAR != 2) { c1[14] = __builtin_amdgcn_exp2f(c1[14]); c1[15] = __builtin_amdgcn_exp2f(c1[15]); } if (VAR != 2) { sb += c1[12]; sb += c1[13]; } ATT_KLOAD(9); ATT_PIN(c1); ATT_PIN(sb); ATT_SBAR();
      if (QK && VAR != 4) n0 = __builtin_amdgcn_mfma_f32_32x32x16_bf16(kfr[8], qr[4], n0, 0, 0, 0); if (VAR != 2) { sb += c1[14]; sb += c1[15]; } if (VAR != 2) { pk[3].x = cvtpk(c1[8], c1[9]); pk[3].y = cvtpk(c1[10], c1[11]); } ATT_KLOAD(10); ATT_PIN(pk[3]); ATT_PIN(sb); ATT_SBAR();
      if (QK && VAR != 4) n1 = __builtin_amdgcn_mfma_f32_32x32x16_bf16(kfr[9], qr[4], n1, 0, 0, 0); if (VAR != 2) { pk[3].z = cvtpk(c1[12], c1[13]); pk[3].w = cvtpk(c1[14], c1[15]); } ATT_KLOAD(11); ATT_PIN(pk[3]); ATT_SBAR();
      if (QK && VAR != 4) n0 = __builtin_amdgcn_mfma_f32_32x32x16_bf16(kfr[10], qr[5], n0, 0, 0, 0); ATT_SBAR();
      if (QK && VAR != 4) n1 = __builtin_amdgcn_mfma_f32_32x32x16_bf16(kfr[11], qr[5], n1, 0, 0, 0); ATT_SBAR();
    l_reg += sa + sb;
}
#undef ATT_VLOAD
#undef ATT_KLOAD

template <int VAR = 0>
__device__ __forceinline__ void attn_unit(int b, int h, int qb, const bf16* Q, const bf16* K, const bf16* V, bf16* O, ALAS unsigned char* shm, int OPR = OP) {
    int tid_ = threadIdx.x; asm volatile("" : "+v"(tid_));
    const int tid = tid_, lane = tid & 63, r32 = lane & 31, hi = lane >> 5; const int wid = __builtin_amdgcn_readfirstlane(tid >> 6);
    const long rowbase = (long)b * SEQ; const int q0 = qb * QB;
    const bf16* Qw = Q + (rowbase + q0 + wid * QBLK) * QP + h * QHS;
    const bf16* Kh = K + rowbase * KP + h * KHS; const bf16* Vh = V + rowbase * VP + h * VHS;
    ALAS float* wsf = (ALAS float*)(shm + L_WS) + wid * 64;
    const bf16* ksrc = Kh + (long)lane * KP + wid * 8;
    const bf16* vsrc = Vh + (long)(16 * (wid & 3) + (lane >> 2)) * VP + (wid >> 2) * 32 + (lane & 3) * 8;
#define ATT_DMA_K(t, slot) do { \
        __builtin_amdgcn_global_load_lds((const unsigned*)(ksrc + (long)(t) * KVBLK * KP), (ALAS unsigned*)(shm + L_K + (slot) * KSLOT + wid * 1024), 16, 0, 0); \
        if (wid < 4) __builtin_amdgcn_global_load_lds((const unsigned*)(ksrc + (long)(t) * KVBLK * KP + 64), (ALAS unsigned*)(shm + L_K + (slot) * KSLOT + (8 + wid) * 1024), 16, 0, 0); } while (0)
#define ATT_DMA_V(t, slotoff) __builtin_amdgcn_global_load_lds((const unsigned*)(vsrc + (long)(t) * KVBLK * VP), (ALAS unsigned*)(shm + L_V + (slotoff) + wid * 1024), 16, 0, 0)
    const int NT = (q0 + QB) / KVBLK;
    ATT_DMA_K(0, 0); ATT_DMA_V(0, 0); ATT_DMA_K(1, 1);
    bf16x8 qr[6];
#pragma unroll
    for (int d0 = 0; d0 < 6; ++d0) qr[d0] = *(const bf16x8*)(Qw + (long)r32 * QP + d0 * 16 + hi * 8);
    float l_reg = 0.f; f32x16 o[2];
#pragma unroll
    for (int r = 0; r < 16; ++r) { o[0][r] = 0.f; o[1][r] = 0.f; }
    const int qrel = wid * QBLK + r32;
    const ALAS unsigned char* kb0 = shm + L_K + hi * 1024 + r32 * 16;
    const ALAS unsigned char* vp0 = shm + L_V + ((lane >> 4) & 1) * 32 + (lane & 3) * 8 + (4 * hi + ((lane & 15) >> 2)) * 64;
    asm volatile("s_waitcnt vmcnt(0)" ::: "memory"); __syncthreads();
    f32x16 sA0, sA1, sB0, sB1;
    qkt(sA0, sA1, kb0, qr);
    u32x4 pk[4] = {};
    int vs_prev = 0, vs_cur = 0, vs_next = VSLOT;
#define ATT_TOP(t) do { if (VAR == 3) break; asm volatile("s_waitcnt vmcnt(0)" ::: "memory"); __syncthreads();        \
        if ((t) + 2 < NT) ATT_DMA_K((t) + 2, (t) & 1); if ((t) + 1 < NT) ATT_DMA_V((t) + 1, vs_next); } while (0)
#define ATT_ROT() do { vs_prev = vs_cur; vs_cur = vs_next; vs_next = (vs_next == 2 * VSLOT) ? 0 : vs_next + VSLOT; } while (0)
    int t = 0;
    for (; t < NT - 2; t += 2) {
        ATT_TOP(t);
        attn_step<true, VAR>(sA0, sA1, sB0, sB1, pk, o, l_reg, qr, kb0 + KSLOT, vp0 + vs_prev, t - (NT - 4), qrel, hi);
        ATT_ROT();
        ATT_TOP(t + 1);
        attn_step<true, VAR>(sB0, sB1, sA0, sA1, pk, o, l_reg, qr, kb0, vp0 + vs_prev, t + 1 - (NT - 4), qrel, hi);
        ATT_ROT();
    }
    ATT_TOP(t);
    attn_step<true, VAR>(sA0, sA1, sB0, sB1, pk, o, l_reg, qr, kb0 + KSLOT, vp0 + vs_prev, 2, qrel, hi);
    ATT_ROT();
    ATT_TOP(t + 1);
    attn_step<false, VAR>(sB0, sB1, sA0, sA1, pk, o, l_reg, qr, kb0, vp0 + vs_prev, 3, qrel, hi);
    ATT_ROT();
    pv(o, vp0 + vs_prev, pk);
    l_reg = pswap_sum(l_reg);
    if (hi == 0) wsf[32 + r32] = l_reg;
    float rli[16];
#pragma unroll
    for (int r = 0; r < 16; ++r) rli[r] = __builtin_amdgcn_rcpf(wsf[32 + crow(r, hi)]);
    bf16* Ow = O + (rowbase + q0 + wid * QBLK) * OPR + h * OHS;
    { ALAS bf16* stg = (ALAS bf16*)(shm + L_OST) + wid * 2048;
#pragma unroll
      for (int r = 0; r < 16; ++r) { const int orow = crow(r, hi);
#pragma unroll
          for (int d0 = 0; d0 < 2; ++d0) { const float v = o[d0][r] * rli[r]; unsigned u = __float_as_uint(v); u = (u + 0x7fffu + ((u >> 16) & 1u)) >> 16; stg[orow * 64 + d0 * 32 + r32] = (bf16)u; } }
#pragma unroll
      for (int i = 0; i < 4; ++i) { const int row = i * 8 + (lane >> 3), ch = lane & 7; const u32x4 v = *(const ALAS u32x4*)(stg + row * 64 + ch * 8); *(u32x4*)(Ow + (long)row * OPR + ch * 8) = v; } }
    __syncthreads();
#undef ATT_DMA_K
#undef ATT_DMA_V
#undef ATT_TOP
#undef ATT_ROT
}
#undef ALAS
}

namespace att2 {
#define ALAS __attribute__((address_space(3)))
using att::bf16; using att::bf16x8; using att::s16x4; using att::f32x16; using att::u32x4; using att::crow; using att::cvtpk; using att::pswap_sum; using att::vtr;
constexpr int SEQ = 16384, QP = 768, KP = 768, VP = 512, OP = 1024, QHS = 96, KHS = 96, VHS = 64, OHS = 64;
constexpr int NW = 8, QB = 512, KVBLK = 64, NQB = SEQ / QB;
constexpr int KSLOT = 12288, VSLOT = 8192;
constexpr int L_K = 0, L_V = 2 * KSLOT, L_WS = L_V + 2 * VSLOT, L_OST = L_WS + NW * 64 * 4, L_BYTES = L_OST + NW * 4096;
__device__ __forceinline__ void softmax_pack(f32x16& p0, f32x16& p1, u32x4 (&pk)[4], float& l_reg) {
    float sa = 0.f, sb = 0.f;
#pragma unroll
    for (int r = 0; r < 16; ++r) { p0[r] = __builtin_amdgcn_exp2f(p0[r]); p1[r] = __builtin_amdgcn_exp2f(p1[r]); sa += p0[r]; sb += p1[r]; }
    l_reg += sa + sb;
#pragma unroll
    for (int k = 0; k < 2; ++k) { pk[k] = (u32x4){cvtpk(p0[8 * k], p0[8 * k + 1]), cvtpk(p0[8 * k + 2], p0[8 * k + 3]), cvtpk(p0[8 * k + 4], p0[8 * k + 5]), cvtpk(p0[8 * k + 6], p0[8 * k + 7])};
        pk[2 + k] = (u32x4){cvtpk(p1[8 * k], p1[8 * k + 1]), cvtpk(p1[8 * k + 2], p1[8 * k + 3]), cvtpk(p1[8 * k + 4], p1[8 * k + 5]), cvtpk(p1[8 * k + 6], p1[8 * k + 7])}; }
}
__device__ __forceinline__ void attn_unit(int b, int h, int qb, const bf16* Q, const bf16* K, const bf16* V, bf16* O, ALAS unsigned char* shm) {
    int tid_ = threadIdx.x; asm volatile("" : "+v"(tid_));
    const int tid = tid_, lane = tid & 63, r32 = lane & 31, hi = lane >> 5; const int wid = __builtin_amdgcn_readfirstlane(tid >> 6);
    const long rowbase = (long)b * SEQ; const int q0 = qb * QB;
    const bf16* Qw = Q + (rowbase + q0 + wid * 64) * QP + h * QHS;
    const bf16* Kh = K + rowbase * KP + h * KHS; const bf16* Vh = V + rowbase * VP + h * VHS;
    ALAS float* wsf = (ALAS float*)(shm + L_WS) + wid * 64;
    const bf16* ksrc = Kh + (long)lane * KP + wid * 8;
    const bf16* vsrc = Vh + (long)(16 * (wid & 3) + (lane >> 2)) * VP + (wid >> 2) * 32 + (lane & 3) * 8;
#define ATT_DMA(t, slot) do { \
        __builtin_amdgcn_global_load_lds((const unsigned*)(ksrc + (long)(t) * KVBLK * KP), (ALAS unsigned*)(shm + L_K + (slot) * KSLOT + wid * 1024), 16, 0, 0); \
        if (wid < 4) __builtin_amdgcn_global_load_lds((const unsigned*)(ksrc + (long)(t) * KVBLK * KP + 64), (ALAS unsigned*)(shm + L_K + (slot) * KSLOT + (8 + wid) * 1024), 16, 0, 0); \
        __builtin_amdgcn_global_load_lds((const unsigned*)(vsrc + (long)(t) * KVBLK * VP), (ALAS unsigned*)(shm + L_V + (slot) * VSLOT + wid * 1024), 16, 0, 0); } while (0)
    const int NT = (q0 + QB) / KVBLK;
    ATT_DMA(0, 0);
    bf16x8 qa[6], qb_[6];
#pragma unroll
    for (int d0 = 0; d0 < 6; ++d0) { qa[d0] = *(const bf16x8*)(Qw + (long)r32 * QP + d0 * 16 + hi * 8); qb_[d0] = *(const bf16x8*)(Qw + (long)(32 + r32) * QP + d0 * 16 + hi * 8); }
    float la = 0.f, lb = 0.f; f32x16 oa[2], ob[2];
#pragma unroll
    for (int r = 0; r < 16; ++r) { oa[0][r] = 0.f; oa[1][r] = 0.f; ob[0][r] = 0.f; ob[1][r] = 0.f; }
    const ALAS unsigned char* kb0 = shm + L_K + hi * 1024 + r32 * 16;
    const ALAS unsigned char* vp0 = shm + L_V + ((lane >> 4) & 1) * 32 + (lane & 3) * 8 + (4 * hi + ((lane & 15) >> 2)) * 64;
    for (int t = 0; t < NT; ++t) {
        const int cur = t & 1;
        asm volatile("s_waitcnt vmcnt(0)" ::: "memory"); __syncthreads();
        if (t + 1 < NT) ATT_DMA(t + 1, cur ^ 1);
        const int jb = t - (NT - 8);
        if (jb > wid) continue;
        f32x16 pa0, pa1, pb0, pb1; const f32x16 z16 = {};
        { const ALAS unsigned char* kb = kb0 + cur * KSLOT;
#pragma unroll
          for (int d0 = 0; d0 < 6; ++d0) {
              const bf16x8 k0 = *(const ALAS bf16x8*)(kb + d0 * 2048), k1 = *(const ALAS bf16x8*)(kb + d0 * 2048 + 512);
              pa0 = __builtin_amdgcn_mfma_f32_32x32x16_bf16(k0, qa[d0], d0 == 0 ? z16 : pa0, 0, 0, 0); pa1 = __builtin_amdgcn_mfma_f32_32x32x16_bf16(k1, qa[d0], d0 == 0 ? z16 : pa1, 0, 0, 0);
              pb0 = __builtin_amdgcn_mfma_f32_32x32x16_bf16(k0, qb_[d0], d0 == 0 ? z16 : pb0, 0, 0, 0); pb1 = __builtin_amdgcn_mfma_f32_32x32x16_bf16(k1, qb_[d0], d0 == 0 ? z16 : pb1, 0, 0, 0); } }
        if (jb == wid) {
#pragma unroll
            for (int r = 0; r < 16; ++r) { const int kv = 4 * hi + (r & 3) + 8 * (r >> 2);
                if (kv > r32) pa0[r] = -__builtin_inff();
                pa1[r] = -__builtin_inff();
                if (kv > r32) pb1[r] = -__builtin_inff(); }
        }
        u32x4 pka[4], pkb[4];
        softmax_pack(pa0, pa1, pka, la); softmax_pack(pb0, pb1, pkb, lb);
        { const ALAS unsigned char* vp = vp0 + cur * VSLOT;
#pragma unroll
          for (int ks = 0; ks < 4; ++ks)
#pragma unroll
              for (int d0 = 0; d0 < 2; ++d0) { const s16x4 lo = vtr(vp + d0 * 4096 + ks * 1024), hh = vtr(vp + d0 * 4096 + ks * 1024 + 512);
                  const bf16x8 vf = (bf16x8){lo[0], lo[1], lo[2], lo[3], hh[0], hh[1], hh[2], hh[3]};
                  oa[d0] = __builtin_amdgcn_mfma_f32_32x32x16_bf16(__builtin_bit_cast(bf16x8, pka[ks]), vf, oa[d0], 0, 0, 0);
                  ob[d0] = __builtin_amdgcn_mfma_f32_32x32x16_bf16(__builtin_bit_cast(bf16x8, pkb[ks]), vf, ob[d0], 0, 0, 0); } }
    }
#pragma unroll
    for (int blk = 0; blk < 2; ++blk) {
        float l_reg = pswap_sum(blk == 0 ? la : lb);
        if (hi == 0) wsf[32 + r32] = l_reg;
        float rli[16];
#pragma unroll
        for (int r = 0; r < 16; ++r) rli[r] = __builtin_amdgcn_rcpf(wsf[32 + crow(r, hi)]);
        bf16* Ow = O + (rowbase + q0 + wid * 64 + blk * 32) * OP + h * OHS;
        ALAS bf16* stg = (ALAS bf16*)(shm + L_OST) + wid * 2048;
#pragma unroll
        for (int r = 0; r < 16; ++r) { const int orow = crow(r, hi);
#pragma unroll
            for (int d0 = 0; d0 < 2; ++d0) { const float v = (blk == 0 ? oa[d0][r] : ob[d0][r]) * rli[r]; unsigned u = __float_as_uint(v); u = (u + 0x7fffu + ((u >> 16) & 1u)) >> 16; stg[orow * 64 + d0 * 32 + r32] = (bf16)u; } }
#pragma unroll
        for (int i = 0; i < 4; ++i) { const int row = i * 8 + (lane >> 3), ch = lane & 7; const u32x4 v = *(const ALAS u32x4*)(stg + row * 64 + ch * 8); *(u32x4*)(Ow + (long)row * OP + ch * 8) = v; }
    }
    __syncthreads();
#undef ATT_DMA
}
#undef ALAS
}

namespace att3 {
#define ALAS __attribute__((address_space(3)))
using att::bf16; using att::bf16x8; using att::s16x4; using att::f32x16; using att::u32x4; using att::crow; using att::cvtpk; using att::pswap_sum; using att::vtr;
using att2::softmax_pack;
constexpr int SEQ = 16384, QP = 768, KP = 768, VP = 512, OP = 1024, QHS = 96, KHS = 96, VHS = 64, OHS = 64;
constexpr int NW = 8, QB = 512, KVBLK = 64;
constexpr int KSLOT = 12288, VSLOT = 8192;
constexpr int L_K = 0, L_V = 2 * KSLOT, L_WS = L_V + 2 * VSLOT, L_OST = L_WS + NW * 64 * 4, L_BYTES = L_OST + NW * 4096;
__device__ __forceinline__ void attn_unit(int b, int h, int qb, const bf16* Q, const bf16* K, const bf16* V, bf16* O, ALAS unsigned char* shm) {
    int tid_ = threadIdx.x; asm volatile("" : "+v"(tid_));
    const int tid = tid_, lane = tid & 63, r32 = lane & 31, hi = lane >> 5; const int wid = __builtin_amdgcn_readfirstlane(tid >> 6);
    const long rowbase = (long)b * SEQ; const int q0 = qb * QB;
    const bf16* Qw = Q + (rowbase + q0 + wid * 64) * QP + h * QHS;
    const bf16* Kh = K + rowbase * KP + h * KHS; const bf16* Vh = V + rowbase * VP + h * VHS;
    ALAS float* wsf = (ALAS float*)(shm + L_WS) + wid * 64;
    const unsigned lds0 = (unsigned)(uintptr_t)shm;
    const bf16* ksrc = Kh + (long)lane * KP + wid * 8;
    const int kdelta = (8 + (wid & 3) - wid) * 8;
    const bf16* vsrc = Vh + (long)(16 * (wid & 3) + (lane >> 2)) * VP + (wid >> 2) * 32 + (lane & 3) * 8;
#define GLDS16(gsrc, ldsdst) do { unsigned keep_; asm volatile("s_mov_b32 %0, m0\n\ts_mov_b32 m0, %2\n\ts_nop 0\n\tglobal_load_lds_dwordx4 %1, off\n\ts_mov_b32 m0, %0" : "=&s"(keep_) : "v"(gsrc), "s"(ldsdst) : "memory"); } while (0)
#define DMA_K(t, slot) do { GLDS16(ksrc + (long)(t) * KVBLK * KP, (unsigned)__builtin_amdgcn_readfirstlane(lds0 + L_K + (slot) * KSLOT + wid * 1024)); \
        GLDS16(ksrc + ((long)(t) * KVBLK * KP + kdelta), (unsigned)__builtin_amdgcn_readfirstlane(lds0 + L_K + (slot) * KSLOT + (8 + (wid & 3)) * 1024)); } while (0)
#define DMA_V(t, slot) GLDS16(vsrc + (long)(t) * KVBLK * VP, (unsigned)__builtin_amdgcn_readfirstlane(lds0 + L_V + (slot) * VSLOT + wid * 1024))
#define BAR_W(n) do { asm volatile("s_waitcnt vmcnt(" #n ") lgkmcnt(0)" ::: "memory"); __builtin_amdgcn_s_barrier(); asm volatile("" ::: "memory"); } while (0)
#define BAR1(t) do { if ((t) < NT) BAR_W(1); else BAR_W(0); if ((t) + 1 < NT) DMA_K((t) + 1, ((t) + 1) & 1); } while (0)
#define BAR2(t) do { if ((t) + 1 < NT) BAR_W(2); else BAR_W(0); if ((t) + 1 < NT) DMA_V((t) + 1, ((t) + 1) & 1); } while (0)
    const int NT = (q0 + QB) / KVBLK;
    DMA_K(0, 0); DMA_V(0, 0);
    bf16x8 qa[6], qb_[6];
#pragma unroll
    for (int d0 = 0; d0 < 6; ++d0) { qa[d0] = *(const bf16x8*)(Qw + (long)r32 * QP + d0 * 16 + hi * 8); qb_[d0] = *(const bf16x8*)(Qw + (long)(32 + r32) * QP + d0 * 16 + hi * 8); }
    asm volatile("s_waitcnt vmcnt(0)" ::: "memory");
    float la = 0.f, lb = 0.f; f32x16 oa[2], ob[2];
#pragma unroll
    for (int r = 0; r < 16; ++r) { oa[0][r] = 0.f; oa[1][r] = 0.f; ob[0][r] = 0.f; ob[1][r] = 0.f; }
    const ALAS unsigned char* kb0 = shm + L_K + hi * 1024 + r32 * 16;
    const ALAS unsigned char* vp0 = shm + L_V + ((lane >> 4) & 1) * 32 + (lane & 3) * 8 + (4 * hi + ((lane & 15) >> 2)) * 64;
    f32x16 pa0, pa1, pb0, pb1;
#define ALPHA(t) do { if ((t) - (NT - 8) <= wid) { const ALAS unsigned char* kb = kb0 + ((t) & 1) * KSLOT; const f32x16 z16 = {}; \
        bf16x8 k0n = *(const ALAS bf16x8*)(kb), k1n = *(const ALAS bf16x8*)(kb + 512); \
        _Pragma("unroll") for (int d0 = 0; d0 < 6; ++d0) { const bf16x8 k0 = k0n, k1 = k1n; \
            if (d0 < 5) { k0n = *(const ALAS bf16x8*)(kb + (d0 + 1) * 2048); k1n = *(const ALAS bf16x8*)(kb + (d0 + 1) * 2048 + 512); }     \
            pa0 = __builtin_amdgcn_mfma_f32_32x32x16_bf16(k0, qa[d0], d0 == 0 ? z16 : pa0, 0, 0, 0); pa1 = __builtin_amdgcn_mfma_f32_32x32x16_bf16(k1, qa[d0], d0 == 0 ? z16 : pa1, 0, 0, 0); \
            pb0 = __builtin_amdgcn_mfma_f32_32x32x16_bf16(k0, qb_[d0], d0 == 0 ? z16 : pb0, 0, 0, 0); pb1 = __builtin_amdgcn_mfma_f32_32x32x16_bf16(k1, qb_[d0], d0 == 0 ? z16 : pb1, 0, 0, 0); \
            __builtin_amdgcn_sched_barrier(0); } } } while (0)
#define BETA(t) do { const int jb_ = (t) - (NT - 8); if (jb_ <= wid) { \
        if (jb_ == wid) { _Pragma("unroll") for (int r = 0; r < 16; ++r) { const int kv = 4 * hi + (r & 3) + 8 * (r >> 2); \
            if (kv > r32) pa0[r] = -__builtin_inff(); pa1[r] = -__builtin_inff(); if (kv > r32) pb1[r] = -__builtin_inff(); } } \
        u32x4 pka[4], pkb[4]; softmax_pack(pa0, pa1, pka, la); softmax_pack(pb0, pb1, pkb, lb); \
        const ALAS unsigned char* vp = vp0 + ((t) & 1) * VSLOT; \
        _Pragma("unroll") for (int i_ = 0; i_ < 8; ++i_) { const int ks = i_ >> 1, d0 = i_ & 1; \
            const s16x4 lo = vtr(vp + d0 * 4096 + ks * 1024), hh = vtr(vp + d0 * 4096 + ks * 1024 + 512); \
            const bf16x8 vf = (bf16x8){lo[0], lo[1], lo[2], lo[3], hh[0], hh[1], hh[2], hh[3]}; \
            oa[d0] = __builtin_amdgcn_mfma_f32_32x32x16_bf16(__builtin_bit_cast(bf16x8, pka[ks]), vf, oa[d0], 0, 0, 0); \
            ob[d0] = __builtin_amdgcn_mfma_f32_32x32x16_bf16(__builtin_bit_cast(bf16x8, pkb[ks]), vf, ob[d0], 0, 0, 0); \
            __builtin_amdgcn_sched_barrier(0); } } } while (0)
    if (wid < 4) {
        for (int t = 0; t < NT; ++t) { BAR1(t); ALPHA(t); BAR2(t); BETA(t); }
        BAR1(NT); BAR2(NT);
    } else {
        BAR1(0); BAR2(0); ALPHA(0);
        for (int t = 1; t < NT; ++t) { BAR1(t); BETA(t - 1); BAR2(t); ALPHA(t); }
        BAR1(NT); BETA(NT - 1); BAR2(NT);
    }
#pragma unroll
    for (int blk = 0; blk < 2; ++blk) {
        float l_reg = pswap_sum(blk == 0 ? la : lb);
        if (hi == 0) wsf[32 + r32] = l_reg;
        float rli[16];
#pragma unroll
        for (int r = 0; r < 16; ++r) rli[r] = __builtin_amdgcn_rcpf(wsf[32 + crow(r, hi)]);
        bf16* Ow = O + (rowbase + q0 + wid * 64 + blk * 32) * OP + h * OHS;
        ALAS bf16* stg = (ALAS bf16*)(shm + L_OST) + wid * 2048;
#pragma unroll
        for (int r = 0; r < 16; ++r) { const int orow = crow(r, hi);
#pragma unroll
            for (int d0 = 0; d0 < 2; ++d0) { const float v = (blk == 0 ? oa[d0][r] : ob[d0][r]) * rli[r]; unsigned u = __float_as_uint(v); u = (u + 0x7fffu + ((u >> 16) & 1u)) >> 16; stg[orow * 64 + d0 * 32 + r32] = (bf16)u; } }
#pragma unroll
        for (int i = 0; i < 4; ++i) { const int row = i * 8 + (lane >> 3), ch = lane & 7; const u32x4 v = *(const ALAS u32x4*)(stg + row * 64 + ch * 8); *(u32x4*)(Ow + (long)row * OP + ch * 8) = v; }
    }
    asm volatile("s_waitcnt vmcnt(0) lgkmcnt(0)" ::: "memory"); __syncthreads();
#undef GLDS16
#undef DMA_K
#undef DMA_V
#undef BAR_W
#undef BAR1
#undef BAR2
#undef ALPHA
#undef BETA
}
#undef ALAS
}

constexpr int NB = 2, SEQ = 16384, D = 1024, NTOK = NB * SEQ, DEPTH = 4;
constexpr int INCOLS = 1440, INP = 1536;
constexpr int UPK = 384, UPN = 1792;
constexpr int LRUW = 512;
constexpr int DFF = 2816, NEXP = 8, DFE = 3584;
constexpr int MOE_TILES = (2 * NTOK) / 256 + NEXP;
constexpr float EPS = 1e-6f;
constexpr int NWAVES = 8;

constexpr size_t MiB = 1u << 20;
constexpr size_t WS_CTL = 0, CTL_ZERO_BYTES = 1 * MiB;
constexpr size_t WS_MREF = 6 * MiB + 64 * 1024;
constexpr size_t WS_RSC = 10 * MiB;
constexpr size_t WS_MODP = 1 * MiB;
constexpr size_t WS_MOD = 1 * MiB + 768 * 1024;
constexpr size_t WS_COS = 2 * MiB, WS_SIN = 4 * MiB;
constexpr size_t WS_LAMC = 6 * MiB;
constexpr size_t WS_TOKE = 7 * MiB, WS_TOKR = WS_TOKE + 256 * 1024, WS_TOKW = WS_TOKR + 256 * 1024, WS_TOKP = WS_TOKW + 256 * 1024;
constexpr size_t WS_RTE = 8 * MiB;
constexpr size_t WS_PL = 9 * MiB, WS_HC = 9 * MiB + 512 * 1024;
constexpr size_t WS_WSMALL = 16 * MiB, WSMALL_STRIDE = 8 * MiB;
constexpr size_t WS_WDENSE = 48 * MiB, WDENSE_STRIDE = 17 * MiB;
constexpr size_t WS_WMOE_GU = 82 * MiB, WS_WMOE_D = 194 * MiB;
constexpr size_t WS_H = 250 * MiB;
constexpr size_t WS_Z = 314 * MiB, WS_A2 = 410 * MiB, WS_XR = 866 * MiB, WS_QKV = 466 * MiB, WS_Q = 578 * MiB, WS_K = 626 * MiB, WS_LA = 674 * MiB, WS_XB = 738 * MiB, WS_Y = 802 * MiB;
constexpr size_t WS_HID = 314 * MiB;
constexpr size_t WS_HS = 314 * MiB, WS_Y2 = 314 * MiB, WS_MHID = 446 * MiB;
constexpr size_t WS_END = 908 * MiB;
static_assert(WS_MHID + (size_t)MOE_TILES * 256 * DFE <= WS_XB && WS_LA + (size_t)NTOK * 512 * 4 <= WS_XB && WS_XB + (size_t)NTOK * D * 2 <= WS_Y, "residual stream map");
static_assert(WS_MHID + (size_t)MOE_TILES * 256 * DFE * 2 <= WS_END && WS_HS + (size_t)MOE_TILES * 256 * D * 2 <= WS_MHID && WS_Y2 >= WS_H + (size_t)NTOK * D * 2, "MoE map");
static_assert(WS_HID + (size_t)NTOK * DFF * 2 <= WS_END && WS_Y + (size_t)NTOK * D * 2 <= WS_END, "map");
constexpr int CW_TMO = 0, CW_CODE = 1, CW_BAR = 4096, CW_GCNT = 8192, CW_WMAX = 12288, CW_AGRP = 16384, CW_SCNT = 24576;

constexpr int RING_BYTES = 131072, LDSCTL_OFF = RING_BYTES, MISC_OFF = LDSCTL_OFF + 320, LDS_BYTES = 147456;

struct Frame {
    LAS unsigned char* lds; volatile LAS unsigned* MISC; gu32* ctl;
    int tid, lane, wave, vcu, G, gw, NGW;
    float* out; unsigned char* ws;
    __device__ __forceinline__ void refresh() { int t = threadIdx.x; asm volatile("" : "+v"(t)); tid = t; lane = t & 63; wave = __builtin_amdgcn_readfirstlane(t >> 6); int v = vcu; asm volatile("" : "+s"(v)); vcu = v; gw = v * 8 + wave; }
};
template <int K> __device__ __forceinline__ const void* in_ptr() {
    unsigned long long p; const __attribute__((address_space(4))) void* ka = (const __attribute__((address_space(4))) void*)__builtin_amdgcn_kernarg_segment_ptr();
    asm volatile("s_load_dwordx2 %0, %1, %2\n\ts_waitcnt lgkmcnt(0)" : "=s"(p) : "s"(ka), "i"(8 * K) : "memory");
    return (const void*)p;
}
#define INF(K) ((const float*)in_ptr<K>())
template <class T> __device__ __forceinline__ T* wsp(const Frame& F, size_t off) { asm volatile("" : "+s"(off)); return (T*)(F.ws + off); }
enum { I_X = 0, I_C, I_POS, I_WADA, I_BADA, I_NGAIN, I_WIN, I_LGAIN, I_WQUP, I_WKVUP, I_QGAIN, I_KGAIN, I_CONVW, I_CONVB, I_WA, I_BA, I_WX, I_BX, I_LAM, I_OGAIN, I_WOUT, I_FWG, I_FWU, I_FWD, I_RW, I_MWG, I_MWU, I_MWD };

template <int K> __device__ __forceinline__ float swz_xor(float v) { return __int_as_float(__builtin_amdgcn_ds_swizzle(__float_as_int(v), (K << 10) | 0x1f)); }
__device__ __forceinline__ float wave_sum(float v) {
    v += swz_xor<1>(v); v += swz_xor<2>(v); v += swz_xor<4>(v); v += swz_xor<8>(v); v += swz_xor<16>(v);
    return att::pswap_sum(v);
}
__device__ __forceinline__ float wave_max(float v) {
    v = __builtin_fmaxf(v, swz_xor<1>(v)); v = __builtin_fmaxf(v, swz_xor<2>(v)); v = __builtin_fmaxf(v, swz_xor<4>(v)); v = __builtin_fmaxf(v, swz_xor<8>(v)); v = __builtin_fmaxf(v, swz_xor<16>(v));
    return att::pswap_max(v);
}
__device__ __forceinline__ float bflo(unsigned w) { return __uint_as_float(w << 16); }
__device__ __forceinline__ float bfhi(unsigned w) { return __uint_as_float(w & 0xffff0000u); }
__device__ __forceinline__ float bf1(bf16 v) { return __uint_as_float((unsigned)v << 16); }

__device__ __forceinline__ void transpose_item(const float* W, int ldw, int k0, int n0, bf16* WT, int ldt, int drow0, int dk0, LAS float* scr, int lane, bool ropemap = false) {
    float rv[32];
#pragma unroll
    for (int i = 0; i < 32; ++i) rv[i] = W[(size_t)(k0 + 2 * i + (lane >> 5)) * ldw + n0 + (lane & 31)];
#pragma unroll
    for (int i = 0; i < 32; ++i) scr[(2 * i + (lane >> 5)) * 33 + (lane & 31)] = rv[i];
    LDS_WAIT(); asm volatile("" ::: "memory");
    const int c = lane & 7;
#pragma unroll
    for (int j = 0; j < 4; ++j) { const int n = (lane >> 3) + 8 * j; const LAS float* s = scr + (8 * c) * 33 + n;
        v4u o; o.x = pk2(s[0 * 33], s[1 * 33]); o.y = pk2(s[2 * 33], s[3 * 33]); o.z = pk2(s[4 * 33], s[5 * 33]); o.w = pk2(s[6 * 33], s[7 * 33]);
        const int nd = ropemap ? 8 * ((n & 15) >> 2) + 4 * (n >> 4) + (n & 3) : n;
        *(GAS v4u*)(WT + (size_t)(drow0 + nd) * ldt + dk0 + k0 + 8 * c) = o; }
    LDS_WAIT(); asm volatile("" ::: "memory");
}
__device__ __forceinline__ void transpose_item_f8(const float* W, int ldw, int k0, int n0, unsigned char* WT, int ldt, int drow0, float sc, LAS float* scr, int lane) {
    float rv[32];
#pragma unroll
    for (int i = 0; i < 32; ++i) rv[i] = W[(size_t)(k0 + 2 * i + (lane >> 5)) * ldw + n0 + (lane & 31)];
#pragma unroll
    for (int i = 0; i < 32; ++i) scr[(2 * i + (lane >> 5)) * 33 + (lane & 31)] = rv[i];
    LDS_WAIT(); asm volatile("" ::: "memory");
    const int c = lane & 3;
#pragma unroll
    for (int j = 0; j < 2; ++j) { const int n = (lane >> 2) + 16 * j; const LAS float* s = scr + (16 * c) * 33 + n;
        v4u o; o.x = pg8::pack4_fp8(s[0 * 33] * sc, s[1 * 33] * sc, s[2 * 33] * sc, s[3 * 33] * sc); o.y = pg8::pack4_fp8(s[4 * 33] * sc, s[5 * 33] * sc, s[6 * 33] * sc, s[7 * 33] * sc);
        o.z = pg8::pack4_fp8(s[8 * 33] * sc, s[9 * 33] * sc, s[10 * 33] * sc, s[11 * 33] * sc); o.w = pg8::pack4_fp8(s[12 * 33] * sc, s[13 * 33] * sc, s[14 * 33] * sc, s[15 * 33] * sc);
        *(GAS v4u*)(WT + (size_t)(drow0 + n) * ldt + k0 + 16 * c) = o; }
    LDS_WAIT(); asm volatile("" ::: "memory");
}
__device__ __forceinline__ void transpose_item_i8(const float* W, int ldw, int k0, int n0, unsigned char* WT, int ldt, int drow0, float sc, LAS float* scr, int lane) {
    float rv[32];
#pragma unroll
    for (int i = 0; i < 32; ++i) rv[i] = W[(size_t)(k0 + 2 * i + (lane >> 5)) * ldw + n0 + (lane & 31)];
#pragma unroll
    for (int i = 0; i < 32; ++i) scr[(2 * i + (lane >> 5)) * 33 + (lane & 31)] = rv[i];
    LDS_WAIT(); asm volatile("" ::: "memory");
    const int c = lane & 3;
#pragma unroll
    for (int j = 0; j < 2; ++j) { const int n = (lane >> 2) + 16 * j; const LAS float* s = scr + (16 * c) * 33 + n;
        v4u o; o.x = pg8::pack4_i8(s[0 * 33] * sc, s[1 * 33] * sc, s[2 * 33] * sc, s[3 * 33] * sc); o.y = pg8::pack4_i8(s[4 * 33] * sc, s[5 * 33] * sc, s[6 * 33] * sc, s[7 * 33] * sc);
        o.z = pg8::pack4_i8(s[8 * 33] * sc, s[9 * 33] * sc, s[10 * 33] * sc, s[11 * 33] * sc); o.w = pg8::pack4_i8(s[12 * 33] * sc, s[13 * 33] * sc, s[14 * 33] * sc, s[15 * 33] * sc);
        *(GAS v4u*)(WT + (size_t)(drow0 + n) * ldt + k0 + 16 * c) = o; }
    LDS_WAIT(); asm volatile("" ::: "memory");
}
constexpr bool DENSE0_BF16 = false;
constexpr float SC_H8 = 8.0f, SC_WGU8 = 64.0f, SC_HID8 = 4.0f, SC_WD8 = 128.0f, SC_Y8 = 16.0f;
struct CDesc { const float* W; bf16* WT; int K, N, ldt, roff, dk0, map; float f8sc; };
__device__ __forceinline__ void conv_run(Frame& F, const CDesc& d, int gw0, int ngw) {
    LAS float* scr = (LAS float*)(F.lds + F.wave * 16384);
    const int nblk = d.N / 32, items = (d.K / 64) * nblk;
    for (int it = gw0; it < items; it += ngw) { const int kb = it / nblk, nb = it % nblk, n0 = 32 * nb;
        int drow0 = d.map == 0 ? n0 + d.roff : (d.map == 1 ? (n0 >= 416 ? n0 + 96 : n0) : 256 * (n0 / 128) + (n0 % 128) + d.roff); bool rope = false;
        if (d.map == 3) { const int h = n0 / 96, r = n0 - 96 * h;
            if (r < 64) drow0 = 256 * (h >> 2) + 128 * (r >> 5) + 32 * (h & 3); else { drow0 = 512 + 128 * (h >> 2) + 32 * (h & 3); rope = true; } }
        if (d.map == 4) { const int h = n0 / 128, r = n0 - 128 * h;
            drow0 = r < 64 ? 768 + 256 * (h >> 2) + 128 * (r >> 5) + 32 * (h & 3) : 1280 + 64 * h + (r - 64); }
        if (d.f8sc != 0.f) transpose_item_f8(d.W, d.N, 64 * kb, n0, (unsigned char*)d.WT, d.ldt, drow0, d.f8sc, scr, F.lane);
        else transpose_item(d.W, d.N, 64 * kb, n0, d.WT, d.ldt, drow0, d.dk0, scr, F.lane, rope); }
}
__device__ __forceinline__ CDesc conv_desc(Frame& F, int idx, int moe_j) {
    CDesc d;
    if (idx < 16) { const int l = idx >> 2, m = idx & 3; bf16* base = wsp<bf16>(F, WS_WSMALL + (size_t)l * WSMALL_STRIDE);
        if (m == 0)      d = CDesc{INF(I_WIN) + (size_t)l * D * INCOLS, base, D, INCOLS, D, 0, 0, 1, 0.f};
        else if (m == 1) d = CDesc{INF(I_WQUP) + (size_t)l * 256 * 768, base + 3 * MiB / 2, 256, 768, 256, 0, 0, 3, 0.f};
        else if (m == 2) d = CDesc{INF(I_WKVUP) + (size_t)l * 128 * 1024, base + 3 * MiB / 2, 128, 1024, 256, 768, 0, 4, 0.f};
        else             d = CDesc{INF(I_WOUT) + (size_t)l * D * D, base + 6 * MiB / 2, D, D, D, 0, 0, 0, 0.f};
    } else if (idx < 22) { const int j = (idx - 16) / 3, m = (idx - 16) % 3; bf16* base = wsp<bf16>(F, WS_WDENSE + (size_t)j * WDENSE_STRIDE);
        if (m == 0)      d = CDesc{INF(I_FWG) + (size_t)j * D * DFF, base, D, DFF, D, 0, 0, 2, SC_WGU8};
        else if (m == 1) d = CDesc{INF(I_FWU) + (size_t)j * D * DFF, base, D, DFF, D, 128, 0, 2, SC_WGU8};
        else             d = CDesc{INF(I_FWD) + (size_t)j * DFF * D, base + (size_t)11 * MiB / 2, DFF, D, DFF, 0, 0, 0, SC_WD8};
    } else { const int e = (idx - 22) / 3, m = (idx - 22) % 3; const size_t we = (size_t)(moe_j * NEXP + e) * D * DFE;
        if (m == 0)      d = CDesc{INF(I_MWG) + we, (bf16*)(wsp<unsigned char>(F, WS_WMOE_GU) + (size_t)e * 2 * DFE * D), D, DFE, D, 0, 0, 2, SC_WGU8};
        else if (m == 1) d = CDesc{INF(I_MWU) + we, (bf16*)(wsp<unsigned char>(F, WS_WMOE_GU) + (size_t)e * 2 * DFE * D), D, DFE, D, 128, 0, 2, SC_WGU8};
        else             d = CDesc{INF(I_MWD) + we, (bf16*)(wsp<unsigned char>(F, WS_WMOE_D) + (size_t)e * D * DFE), DFE, D, DFE, 0, 0, 0, SC_WD8};
    }
    return d;
}
__device__ __forceinline__ void convert_range(Frame& F, int lo, int hi, int moe_j) {
    F.refresh();
    for (int idx = lo; idx < hi; ++idx) { if ((idx < 16 && (idx & 3) == 0) || idx == 16 || idx == 17 || idx == 19 || idx == 20) continue;
        const CDesc d = conv_desc(F, idx, moe_j); conv_run(F, d, F.gw, F.NGW); }
}
constexpr int MOE_EARLY_E = 6;
__device__ __forceinline__ void convert_moe_early(Frame& F, int rank, int nshare) {
    F.refresh();
    for (int e = 0; e < MOE_EARLY_E; ++e)
        for (int m = 0; m < 2; ++m) { const CDesc d = conv_desc(F, 22 + 3 * e + m, 1); conv_run(F, d, rank * NWAVES + F.wave, nshare * NWAVES); }
}
__device__ __forceinline__ void convert_moe_first(Frame& F) {
    F.refresh();
    for (int idx = 22; idx < 46; ++idx) { const CDesc d = conv_desc(F, idx, 0); conv_run(F, d, F.gw, F.NGW); }
    __syncthreads();
}
__device__ __forceinline__ void convert_moe_late(Frame& F) {
    F.refresh();
    for (int idx = 22; idx < 46; ++idx) { const int e = (idx - 22) / 3, m = (idx - 22) % 3; if (e < MOE_EARLY_E && m < 2) continue;
        const CDesc d = conv_desc(F, idx, 1); conv_run(F, d, F.gw, F.NGW); }
}
__device__ __forceinline__ void zero_block(Frame& F, bf16* WT, int ldt, int r0, int rows, int c0, int cols) {
    const int cpr = cols / 8, n = rows * cpr;
    v4u zz = (v4u){0u, 0u, 0u, 0u}; asm volatile("" : "+v"(zz));
    for (int i = F.gw * 64 + F.lane; i < n; i += F.NGW * 64) { const int r = i / cpr, cc = i % cpr; *(GAS v4u*)(WT + (size_t)(r0 + r) * ldt + c0 + 8 * cc) = zz; }
}
__device__ __forceinline__ float lane_absmax4(const GAS f32x4* W, int n4, int first, int step) {
    float m = 0.f;
    for (int i0 = first; i0 < n4; i0 += 8 * step) { f32x4 v[8];
#pragma unroll
        for (int u = 0; u < 8; ++u) { const int i = i0 + u * step; v[u] = i < n4 ? W[i] : (f32x4){0.f, 0.f, 0.f, 0.f}; }
#pragma unroll
        for (int u = 0; u < 8; ++u) m = __builtin_fmaxf(__builtin_fmaxf(m, __builtin_fmaxf(__builtin_fabsf(v[u].x), __builtin_fabsf(v[u].y))), __builtin_fmaxf(__builtin_fabsf(v[u].z), __builtin_fabsf(v[u].w))); }
    return m;
}
__device__ __forceinline__ void p0_prologue(Frame& F) {
    F.refresh();
    {
      const float* w_ada = INF(I_WADA); const float* cc = INF(I_C); float* modp = wsp<float>(F, WS_MODP);
      for (int task = F.gw; task < 8 * 4 * 48; task += F.NGW) {
        const int jb = task % 48, kq = (task / 48) % 4, ls = task / 192, j = jb * 64 + F.lane;
        const float* W = w_ada + (size_t)ls * D * 3072 + j; float a0 = 0.f, a1 = 0.f;
        for (int k0 = kq * 256; k0 < kq * 256 + 256; k0 += 32) { float wv[32];
#pragma unroll
            for (int i = 0; i < 32; ++i) wv[i] = W[(size_t)(k0 + i) * 3072];
#pragma unroll
            for (int i = 0; i < 32; ++i) { const float c0 = cc[k0 + i], c1 = cc[D + k0 + i]; a0 += c0 * pg8::sigmoidf_(c0) * wv[i]; a1 += c1 * pg8::sigmoidf_(c1) * wv[i]; } }
        modp[((size_t)(kq * 8 + ls) * 2 + 0) * 3072 + j] = a0; modp[((size_t)(kq * 8 + ls) * 2 + 1) * 3072 + j] = a1;
      } }
    {
      const float* w_in = INF(I_WIN);
      for (int l = 0; l < DEPTH; ++l) { float m = lane_absmax4((const GAS f32x4*)(w_in + (size_t)l * D * INCOLS), D * INCOLS / 4, F.gw * 64 + F.lane, F.NGW * 64);
          m = wave_max(m);
          if (F.lane == 0) __hip_atomic_fetch_max((unsigned*)(F.ctl + CW_WMAX + 64 * l), __float_as_uint(m), __ATOMIC_RELAXED, __HIP_MEMORY_SCOPE_AGENT); } }
    for (int j = 0; j < 2; ++j) { float m = 0.f;
      for (int h = 0; h < 2; ++h) m = __builtin_fmaxf(m, lane_absmax4((const GAS f32x4*)((h ? INF(I_FWU) : INF(I_FWG)) + (size_t)j * D * DFF), D * DFF / 4, F.gw * 64 + F.lane, F.NGW * 64));
      m = wave_max(m);
      if (F.lane == 0) __hip_atomic_fetch_max((unsigned*)(F.ctl + CW_WMAX + 64 * (4 + j)), __float_as_uint(m), __ATOMIC_RELAXED, __HIP_MEMORY_SCOPE_AGENT); }
    {
      const int* positions = (const int*)in_ptr<I_POS>(); float* cosT = wsp<float>(F, WS_COS); float* sinT = wsp<float>(F, WS_SIN);
      for (int i0 = F.gw * 64 + F.lane; i0 < NTOK * 16; i0 += 4 * F.NGW * 64) { int pv[4];
#pragma unroll
        for (int u = 0; u < 4; ++u) { const int i = i0 + u * F.NGW * 64; pv[u] = i < NTOK * 16 ? positions[i >> 4] : 0; }
#pragma unroll
        for (int u = 0; u < 4; ++u) { const int i = i0 + u * F.NGW * 64; if (i >= NTOK * 16) break; const int j = i & 15;
        const float invf = __builtin_amdgcn_exp2f(-(float)j * (13.287712379549449f / 16.0f));
        const float ang = (float)pv[u] * invf;
        const float rev = ang * 0.15915494309189535f; const float fr = rev - __builtin_floorf(rev);
        cosT[i] = __builtin_amdgcn_cosf(fr); sinT[i] = __builtin_amdgcn_sinf(fr); } } }
    {
      const float* lam = INF(I_LAM); float* lamc = wsp<float>(F, WS_LAMC);
      for (int i = F.gw * 64 + F.lane; i < DEPTH * LRUW; i += F.NGW * 64) { const float t = __builtin_amdgcn_exp2f(-1.4426950408889634f * lam[i]); lamc[i] = t < 0.02f ? -8.0f * 1.4426950408889634f * t * (1.0f - t * (0.5f - t * (0.33333334f - 0.25f * t))) : -8.0f * __builtin_amdgcn_logf(1.0f + t); } }
    convert_range(F, 0, F.G == 256 ? 22 : 46, 0);
    for (int l = 0; l < DEPTH; ++l) {
        bf16* Win_t = wsp<bf16>(F, WS_WSMALL + (size_t)l * WSMALL_STRIDE); bf16* Wup_t = Win_t + 3 * MiB / 2; bf16* Wg_t = Win_t + 5 * MiB / 2;
        zero_block(F, Win_t, D / 2, 416, 96, 0, D / 2);
        zero_block(F, Wup_t, 256, 768, 1024, 128, 128);
        const float* w_a = INF(I_WA); const float* w_x = INF(I_WX);
        for (int i8 = F.gw * 64 + F.lane; i8 < 1024 * 16; i8 += F.NGW * 64) {
            const int row = i8 >> 4, kq0 = (i8 & 15) * 8, pn = row >> 8, half = (row >> 7) & 1, ch = 128 * pn + (row & 127), g = ch >> 6, kA0 = 128 * pn + kq0;
            float v[8];
#pragma unroll
            for (int e = 0; e < 8; ++e) v[e] = 0.f;
            if ((kA0 >> 6) == g) { const float* sp = (half ? w_x : w_a) + (((size_t)l * 8 + g) * 64 + (kA0 & 63)) * 64 + (ch & 63);
#pragma unroll
                for (int e = 0; e < 8; ++e) v[e] = sp[(size_t)e * 64]; }
            *(GAS v4u*)(Wg_t + (size_t)row * 128 + kq0) = (v4u){pk2(v[0], v[1]), pk2(v[2], v[3]), pk2(v[4], v[5]), pk2(v[6], v[7])}; }
    }
}
__device__ __forceinline__ void p0_finalise(Frame& F) {
    F.refresh();
    const float* b_ada = INF(I_BADA); const float* modp = wsp<float>(F, WS_MODP); float* mod = wsp<float>(F, WS_MOD);
    for (int i = F.gw * 64 + F.lane; i < 8 * 2 * 3072; i += F.NGW * 64) { const int j = i % 3072, ls = i / 6144;
        float v = b_ada[ls * 3072 + j];
#pragma unroll
        for (int kq = 0; kq < 4; ++kq) v += modp[(size_t)kq * 8 * 2 * 3072 + i];
        mod[i] = v; }
    float wmx[6];
#pragma unroll
    for (int q = 0; q < 6; ++q) wmx[q] = __uint_as_float(__hip_atomic_load((unsigned*)(F.ctl + CW_WMAX + 64 * q), __ATOMIC_RELAXED, __HIP_MEMORY_SCOPE_AGENT));
    if (F.gw == 0 && F.lane < 6) { float v = wmx[0];
#pragma unroll
        for (int q = 1; q < 6; ++q) if (F.lane == q) v = wmx[q];
        wsp<float>(F, WS_MREF)[8 + F.lane] = v * (1.0f / 127.0f); }
    if (F.gw == 0 && F.lane < DEPTH) { const int l = F.lane; const float* qg = INF(I_QGAIN) + l * 96; const float* kg = INF(I_KGAIN) + l * 96; float a = 0.f, bq = 0.f, c = 0.f, d = 0.f;
        for (int i = 0; i < 64; ++i) { a = fmaxf(a, qg[i] * qg[i]); c = fmaxf(c, kg[i] * kg[i]); }
        for (int i = 64; i < 96; ++i) { bq = fmaxf(bq, qg[i] * qg[i]); d = fmaxf(d, kg[i] * kg[i]); }
        wsp<float>(F, WS_MREF)[l] = 1.01f * 0.10206207261596577f * 1.4426950408889634f * sqrtf(64.f * a + 32.f * bq) * sqrtf(64.f * c + 32.f * d); }
    { LAS float* scr = (LAS float*)(F.lds + F.wave * 16384); const int nblk = INCOLS / 32, items = (D / 64) * nblk;
      for (int it = F.gw; it < DEPTH * items; it += F.NGW) { const int l = it / items, r = it - l * items, kb = r / nblk, nb = r - kb * nblk, n0 = 32 * nb;
          float wm = wmx[0];
#pragma unroll
          for (int q = 1; q < 4; ++q) if (l == q) wm = wmx[q];
          transpose_item_i8(INF(I_WIN) + (size_t)l * D * INCOLS, INCOLS, 64 * kb, n0, wsp<unsigned char>(F, WS_WSMALL + (size_t)l * WSMALL_STRIDE), D, n0 >= 416 ? n0 + 96 : n0, 127.0f / __builtin_fmaxf(wm, 1e-30f), scr, F.lane); } }
    { LAS float* scr = (LAS float*)(F.lds + F.wave * 16384); const int nblk = DFF / 32, items = (D / 64) * nblk;
      for (int it = F.gw; it < 4 * items; it += F.NGW) { const int q = it / items, j = q >> 1, h = q & 1, r = it - q * items, kb = r / nblk, nb = r - kb * nblk, n0 = 32 * nb;
          const float wm = j ? wmx[5] : wmx[4];
          transpose_item_i8((h ? INF(I_FWU) : INF(I_FWG)) + (size_t)j * D * DFF, DFF, 64 * kb, n0, wsp<unsigned char>(F, WS_WDENSE + (size_t)j * WDENSE_STRIDE), D, 256 * (n0 / 128) + (n0 % 128) + (h ? 128 : 0), 127.0f / __builtin_fmaxf(wm, 1e-30f), scr, F.lane); } }
}

template <bool COMBINE, bool NORM, bool ROUTER, bool F8H = false, bool I8H = false, bool XB16 = true, bool XO16 = true>
__device__ __forceinline__ void norm_pass(Frame& F, const void* xin_, void* xout_, int ls, int ls_prev, int moe_j) {
    const float* xin = (const float*)xin_; const bf16* xinb = (const bf16*)xin_; float* xout = (float*)xout_; bf16* xoutb = (bf16*)xout_;
    F.refresh();
    LAS float* gs = (LAS float*)(F.lds); LAS float* sh = gs + 2048;
    LAS int* lcnt = (LAS int*)(F.lds + 16384); LAS int* gbase = lcnt + 16; LAS int* ltab = lcnt + 32;
    const int lane = F.lane;
    const float* mod = wsp<float>(F, WS_MOD); bf16* hbuf = wsp<bf16>(F, WS_H); float* rsc_ = wsp<float>(F, WS_RSC);
    int* tok_e = wsp<int>(F, WS_TOKE); int* tok_r = wsp<int>(F, WS_TOKR); float* tok_w = wsp<float>(F, WS_TOKW); const int* tok_p = wsp<int>(F, WS_TOKP); const unsigned char* y2 = wsp<unsigned char>(F, WS_Y2);
    if (NORM) { const float* modl = mod + (size_t)ls * 2 * 3072; const float* ng = INF(I_NGAIN) + (size_t)ls * D;
        float t_ng[4], t_sc[4], t_sh[4];
#pragma unroll
        for (int u = 0; u < 4; ++u) { const int i = F.tid + u * NWAVES * 64, b = i >> 10, j = i & 1023; t_ng[u] = ng[j]; t_sc[u] = modl[b * 3072 + 1024 + j]; t_sh[u] = modl[b * 3072 + j]; }
#pragma unroll
        for (int u = 0; u < 4; ++u) { const int i = F.tid + u * NWAVES * 64; gs[i] = t_ng[u] * (1.0f + t_sc[u]); sh[i] = t_sh[u]; } }
    const float* rw = ROUTER ? INF(I_RW) + (size_t)moe_j * D * 8 : nullptr;
    f32x4 rwa[16], rwb[16];
    if (ROUTER) {
#pragma unroll
        for (int jq = 0; jq < 16; ++jq) { const f32x4* wp = (const f32x4*)(rw + (size_t)(4 * lane + 256 * (jq >> 2) + (jq & 3)) * 8); rwa[jq] = wp[0]; rwb[jq] = wp[1]; } }
    __syncthreads();
    for (int blk = F.vcu; blk < NTOK / 128; blk += F.G) {
        if (ROUTER) { if (F.tid < 8) lcnt[F.tid] = 0; __syncthreads(); }
        f32x4 nx[4]; v2u nxb[4];
        if (XB16) { const GAS v2u* xr = (const GAS v2u*)(xinb + (size_t)(blk * 128 + F.wave * 16) * D) + lane;
#pragma unroll
          for (int j = 0; j < 4; ++j) nxb[j] = xr[64 * j]; }
        else { const GAS f32x4* xr = (const GAS f32x4*)(xin + (size_t)(blk * 128 + F.wave * 16) * D) + lane;
#pragma unroll
          for (int j = 0; j < 4; ++j) nx[j] = xr[64 * j]; }
        for (int i = 0; i < 16; ++i) {
            const int row = blk * 128 + F.wave * 16 + i, b = row >> 14;
            f32x4 v[4];
#pragma unroll
            for (int j = 0; j < 4; ++j) { if (XB16) v[j] = (f32x4){bflo(nxb[j].x), bfhi(nxb[j].x), bflo(nxb[j].y), bfhi(nxb[j].y)}; else v[j] = nx[j]; }
            if (i < 15) {
                if (XB16) { const GAS v2u* xr = (const GAS v2u*)(xinb + (size_t)(row + 1) * D) + lane;
#pragma unroll
                    for (int j = 0; j < 4; ++j) nxb[j] = xr[64 * j]; }
                else { const GAS f32x4* xr = (const GAS f32x4*)(xin + (size_t)(row + 1) * D) + lane;
#pragma unroll
                    for (int j = 0; j < 4; ++j) nx[j] = xr[64 * j]; } }
            if (!XB16 && !COMBINE) { GAS v2u* xob = (GAS v2u*)(xoutb + (size_t)row * D) + lane;
#pragma unroll
                for (int j = 0; j < 4; ++j) xob[64 * j] = (v2u){pk2(v[j].x, v[j].y), pk2(v[j].z, v[j].w)}; }
            if (COMBINE) {
                const int p0 = tok_p[row * 2], p1 = tok_p[row * 2 + 1]; const float w0 = tok_w[row * 2] * (1.0f / SC_Y8), w1 = tok_w[row * 2 + 1] * (1.0f / SC_Y8);
                const float* gp = mod + (size_t)ls_prev * 2 * 3072 + b * 3072 + 2048;
                GAS f32x4* xo = (GAS f32x4*)(xout + (size_t)row * D) + lane; GAS v2u* xob = (GAS v2u*)(xoutb + (size_t)row * D) + lane;
                unsigned yav[4], ybv[4]; f32x4 gvv[4];
#pragma unroll
                for (int j = 0; j < 4; ++j) { yav[j] = *(const unsigned*)(y2 + (size_t)p0 * D + 4 * lane + 256 * j); ybv[j] = *(const unsigned*)(y2 + (size_t)p1 * D + 4 * lane + 256 * j); gvv[j] = *(const f32x4*)(gp + 4 * lane + 256 * j); }
                asm volatile("" ::: "memory");
#pragma unroll
                for (int j = 0; j < 4; ++j) { const f32x4 g = gvv[j]; typedef float f32x2_ __attribute__((ext_vector_type(2)));
                    const f32x2_ a01 = __builtin_amdgcn_cvt_pk_f32_fp8((int)yav[j], false), a23 = __builtin_amdgcn_cvt_pk_f32_fp8((int)yav[j], true), b01 = __builtin_amdgcn_cvt_pk_f32_fp8((int)ybv[j], false), b23 = __builtin_amdgcn_cvt_pk_f32_fp8((int)ybv[j], true);
                    v[j].x += g.x * (w0 * a01.x + w1 * b01.x); v[j].y += g.y * (w0 * a01.y + w1 * b01.y);
                    v[j].z += g.z * (w0 * a23.x + w1 * b23.x); v[j].w += g.w * (w0 * a23.y + w1 * b23.y);
                    if (XO16) { const v2u o2 = (v2u){pk2(v[j].x, v[j].y), pk2(v[j].z, v[j].w)}; xob[64 * j] = o2; v[j] = (f32x4){bflo(o2.x), bfhi(o2.x), bflo(o2.y), bfhi(o2.y)}; }
                    else xo[64 * j] = v[j]; }
            }
            if (NORM) {
                float ss = 0.f;
#pragma unroll
                for (int j = 0; j < 4; ++j) ss += (v[j].x * v[j].x + v[j].y * v[j].y) + (v[j].z * v[j].z + v[j].w * v[j].w);
                const float rstd = 1.0f / sqrtf(wave_sum(ss) * (1.0f / D) + EPS);
                GAS unsigned long long* o8 = (GAS unsigned long long*)(hbuf + (size_t)row * D) + lane;
                GAS unsigned* o4 = (GAS unsigned*)((unsigned char*)hbuf + (size_t)row * D) + lane;
#pragma unroll
                for (int j = 0; j < 4; ++j) { const f32x4 g = *(const LAS f32x4*)(gs + b * 1024 + 4 * lane + 256 * j), s = *(const LAS f32x4*)(sh + b * 1024 + 4 * lane + 256 * j);
                    v[j] = v[j] * rstd * g + s;
                    if (I8H) continue;
                    if (F8H) o4[64 * j] = pg8::pack4_fp8(v[j].x * SC_H8, v[j].y * SC_H8, v[j].z * SC_H8, v[j].w * SC_H8);
                    else o8[64 * j] = (unsigned long long)pk2(v[j].x, v[j].y) | ((unsigned long long)pk2(v[j].z, v[j].w) << 32); }
                if (I8H) { float am = 0.f;
#pragma unroll
                    for (int j = 0; j < 4; ++j) am = __builtin_fmaxf(__builtin_fmaxf(am, __builtin_fmaxf(__builtin_fabsf(v[j].x), __builtin_fabsf(v[j].y))), __builtin_fmaxf(__builtin_fabsf(v[j].z), __builtin_fabsf(v[j].w)));
                    am = __builtin_fmaxf(wave_max(am), 1e-30f); const float qs = 127.0f / am;
#pragma unroll
                    for (int j = 0; j < 4; ++j) o4[64 * j] = pg8::pack4_i8(v[j].x * qs, v[j].y * qs, v[j].z * qs, v[j].w * qs);
                    if (lane == 0) rsc_[row] = am * (1.0f / 127.0f); }
                if (ROUTER) {
                    float lg[8];
#pragma unroll
                    for (int e = 0; e < 8; ++e) lg[e] = 0.f;
#pragma unroll
                    for (int j = 0; j < 4; ++j)
#pragma unroll
                        for (int q = 0; q < 4; ++q) { const float hv = v[j][q]; const f32x4 wa = rwa[4 * j + q], wb = rwb[4 * j + q];
                            lg[0] += hv * wa.x; lg[1] += hv * wa.y; lg[2] += hv * wa.z; lg[3] += hv * wa.w; lg[4] += hv * wb.x; lg[5] += hv * wb.y; lg[6] += hv * wb.z; lg[7] += hv * wb.w; }
#pragma unroll
                    for (int e = 0; e < 8; ++e) lg[e] = wave_sum(lg[e]);
                    int e0 = 0; float v0 = lg[0];
#pragma unroll
                    for (int e = 1; e < 8; ++e) if (lg[e] > v0) { v0 = lg[e]; e0 = e; }
                    int e1 = 0; float v1 = -__builtin_inff();
#pragma unroll
                    for (int e = 0; e < 8; ++e) if (e != e0 && lg[e] > v1) { v1 = lg[e]; e1 = e; }
                    const float w0 = 1.0f / (1.0f + __builtin_amdgcn_exp2f(1.4426950408889634f * (v1 - v0))), w1 = 1.0f - w0;
                    if (lane == 0) { const int r0 = __hip_atomic_fetch_add(lcnt + e0, 1, __ATOMIC_RELAXED, __HIP_MEMORY_SCOPE_WORKGROUP), r1 = __hip_atomic_fetch_add(lcnt + e1, 1, __ATOMIC_RELAXED, __HIP_MEMORY_SCOPE_WORKGROUP);
                        LAS int* lt = ltab + (F.wave * 16 + i) * 8; lt[0] = e0; lt[1] = e1; lt[2] = r0; lt[3] = r1; lt[4] = (int)__float_as_uint(w0); lt[5] = (int)__float_as_uint(w1); }
                }
            }
        }
        if (ROUTER) {
            __syncthreads();
            if (F.tid < 8) gbase[F.tid] = (int)__hip_atomic_fetch_add((unsigned*)(F.ctl + CW_GCNT + 64 * (8 * moe_j + F.tid)), (unsigned)lcnt[F.tid], RLX_AGENT);
            __syncthreads();
            if (F.tid < 128) { const int row = blk * 128 + F.tid; const LAS int* lt = ltab + F.tid * 8; const int e0 = lt[0], e1 = lt[1];
                tok_e[row * 2] = e0; tok_e[row * 2 + 1] = e1; tok_r[row * 2] = gbase[e0] + lt[2]; tok_r[row * 2 + 1] = gbase[e1] + lt[3];
                tok_w[row * 2] = __uint_as_float((unsigned)lt[4]); tok_w[row * 2 + 1] = __uint_as_float((unsigned)lt[5]); }
            __syncthreads();
        }
    }
    __syncthreads();
}

__device__ __forceinline__ void mid_pass(Frame& F, int l) {
    F.refresh();
    const int lane = F.lane;
    const bf16* z = wsp<bf16>(F, WS_Z); bf16* A2 = wsp<bf16>(F, WS_A2); bf16* Kb = wsp<bf16>(F, WS_K); bf16* xrb = wsp<bf16>(F, WS_XR);
    const float* cosT = wsp<float>(F, WS_COS); const float* sinT = wsp<float>(F, WS_SIN);
    const float* lg = INF(I_LGAIN) + l * 384; const f32x4 lgq = *(const f32x4*)(lg + 4 * lane); const f32x4 lgkv = *(const f32x4*)(lg + 256 + 4 * (lane & 31));
    const float* kg = INF(I_KGAIN) + l * 96; const float kg1 = kg[64 + (lane & 15)], kg2 = kg[80 + (lane & 15)];
    const float* conv_w = INF(I_CONVW); const float* conv_b = INF(I_CONVB);
    float cw[4][8], cb[8];
#pragma unroll
    for (int e = 0; e < 8; ++e) { cb[e] = conv_b[l * 512 + 8 * lane + e];
#pragma unroll
        for (int j = 0; j < 4; ++j) cw[j][e] = conv_w[(size_t)(l * 4 + j) * 512 + 8 * lane + e]; }
    struct MidIn { uint2 q2, k2; bf16 x1, x2; v4u xw[4]; float cs, sn; };
    auto mid_load = [&](int row) -> MidIn { MidIn r; const bf16* zr = z + (size_t)row * INP; const int t = row & (SEQ - 1);
        r.q2 = *(const uint2*)(zr + 4 * lane); r.k2 = *(const uint2*)(zr + 256 + 4 * (lane & 31)); r.x1 = zr[384 + (lane & 15)]; r.x2 = zr[400 + (lane & 15)];
#pragma unroll
        for (int j = 0; j < 4; ++j) { if (t - 3 + j >= 0) r.xw[j] = *(const v4u*)(zr + (long)(j - 3) * INP + 512 + 8 * lane); else r.xw[j] = (v4u){0u, 0u, 0u, 0u}; }
        r.cs = cosT[row * 16 + (lane & 15)]; r.sn = sinT[row * 16 + (lane & 15)]; return r; };
    MidIn nxt = mid_load(F.gw < NTOK ? F.gw : 0);
    for (int row = F.gw; row < NTOK; row += F.NGW) {
        const MidIn in = nxt;
        if (row + F.NGW < NTOK) nxt = mid_load(row + F.NGW);
        const float q0 = bflo(in.q2.x), q1 = bfhi(in.q2.x), q2f = bflo(in.q2.y), q3 = bfhi(in.q2.y);
        float ssq = (q0 * q0 + q1 * q1) + (q2f * q2f + q3 * q3);
        const float k0 = bflo(in.k2.x), k1 = bfhi(in.k2.x), k2f = bflo(in.k2.y), k3 = bfhi(in.k2.y);
        float sskv = lane < 32 ? (k0 * k0 + k1 * k1) + (k2f * k2f + k3 * k3) : 0.f;
        const float x1 = bf1(in.x1), x2 = bf1(in.x2);
        float ssr = lane < 16 ? x1 * x1 + x2 * x2 : 0.f;
        ssq = wave_sum(ssq); sskv = wave_sum(sskv); ssr = wave_sum(ssr);
        const float rq = 1.0f / sqrtf(ssq * (1.0f / 256.0f) + EPS), rkv = 1.0f / sqrtf(sskv * (1.0f / 128.0f) + EPS), rr = 1.0f / sqrtf(ssr * (1.0f / 32.0f) + EPS);
        *(uint2*)(A2 + (size_t)row * 256 + 4 * lane) = make_uint2(pk2(q0 * rq * lgq.x, q1 * rq * lgq.y), pk2(q2f * rq * lgq.z, q3 * rq * lgq.w));
        if (lane < 32) *(uint2*)(A2 + (size_t)(NTOK + row) * 256 + 4 * lane) = make_uint2(pk2(k0 * rkv * lgkv.x, k1 * rkv * lgkv.y), pk2(k2f * rkv * lgkv.z, k3 * rkv * lgkv.w));
        if (lane < 16) { const float a = x1 * rr * kg1, bb = x2 * rr * kg2;
            const bf16 o1 = (bf16)f2bf(a * in.cs - bb * in.sn), o2 = (bf16)f2bf(a * in.sn + bb * in.cs); bf16* kr = Kb + (size_t)row * 768 + 64 + lane;
#pragma unroll
            for (int hh = 0; hh < 8; ++hh) { kr[hh * 96] = o1; kr[hh * 96 + 16] = o2; } }
        float acc[8];
#pragma unroll
        for (int e = 0; e < 8; ++e) acc[e] = cb[e];
#pragma unroll
        for (int j = 0; j < 4; ++j) { const v4u xw = in.xw[j];
                acc[0] += cw[j][0] * bflo(xw.x); acc[1] += cw[j][1] * bfhi(xw.x); acc[2] += cw[j][2] * bflo(xw.y); acc[3] += cw[j][3] * bfhi(xw.y);
                acc[4] += cw[j][4] * bflo(xw.z); acc[5] += cw[j][5] * bfhi(xw.z); acc[6] += cw[j][6] * bflo(xw.w); acc[7] += cw[j][7] * bfhi(xw.w); }
        *(v4u*)(xrb + ((size_t)(lane >> 4) * NTOK + row) * 128 + 8 * (lane & 15)) = (v4u){pk2(acc[0], acc[1]), pk2(acc[2], acc[3]), pk2(acc[4], acc[5]), pk2(acc[6], acc[7])};
    }
}

__device__ __forceinline__ void qk_pass(Frame& F, int l) {
    F.refresh();
    const int lane = F.lane, g8 = lane & 7, h8 = lane >> 3, g4 = lane & 3, h4 = (lane >> 2) & 7;
    const float C2 = 0.10206207261596577f * 1.4426950408889634f;
    const bf16* qkv = wsp<bf16>(F, WS_QKV); bf16* Qb = wsp<bf16>(F, WS_Q); bf16* Kb = wsp<bf16>(F, WS_K);
    const float* cosT = wsp<float>(F, WS_COS); const float* sinT = wsp<float>(F, WS_SIN);
    const float* q_gain = INF(I_QGAIN) + l * 96; const float* k_gain = INF(I_KGAIN) + l * 96;
    float qgn[8], kgn[8], qgr[8];
#pragma unroll
    for (int e = 0; e < 8; ++e) { qgn[e] = q_gain[g8 * 8 + e]; kgn[e] = k_gain[g8 * 8 + e]; qgr[e] = q_gain[64 + g4 * 8 + e]; }
    struct QkIn { v4u qn, kn, qp; f32x4 ca, cb, sa, sb; };
    auto qk_load = [&](int row) -> QkIn { QkIn r; const bf16* qr = qkv + (size_t)row * UPN;
        r.qn = *(const v4u*)(qr + h8 * 96 + g8 * 8); r.kn = *(const v4u*)(qr + 768 + h8 * 128 + g8 * 8); r.qp = *(const v4u*)(qr + h4 * 96 + 64 + g4 * 8);
        r.ca = *(const f32x4*)(cosT + row * 16 + (g4 & 1) * 8); r.cb = *(const f32x4*)(cosT + row * 16 + (g4 & 1) * 8 + 4);
        r.sa = *(const f32x4*)(sinT + row * 16 + (g4 & 1) * 8); r.sb = *(const f32x4*)(sinT + row * 16 + (g4 & 1) * 8 + 4); return r; };
    QkIn nxt = qk_load(F.gw < NTOK ? F.gw : 0);
    for (int row = F.gw; row < NTOK; row += F.NGW) {
        const QkIn in = nxt;
        if (row + F.NGW < NTOK) nxt = qk_load(row + F.NGW);
        float v[8], o[8];
#define UP8(dst, w_) do { dst[0] = bflo(w_.x); dst[1] = bfhi(w_.x); dst[2] = bflo(w_.y); dst[3] = bfhi(w_.y); dst[4] = bflo(w_.z); dst[5] = bfhi(w_.z); dst[6] = bflo(w_.w); dst[7] = bfhi(w_.w); } while (0)
#define ST8(p, s) do { *(v4u*)(p) = (v4u){pk2(s[0], s[1]), pk2(s[2], s[3]), pk2(s[4], s[5]), pk2(s[6], s[7])}; } while (0)
        UP8(v, in.qn);
        { float ss = 0.f;
#pragma unroll
          for (int e = 0; e < 8; ++e) ss += v[e] * v[e];
          ss += swz_xor<1>(ss); ss += swz_xor<2>(ss); ss += swz_xor<4>(ss);
          const float rs = C2 / sqrtf(ss * (1.0f / 64.0f) + EPS);
#pragma unroll
          for (int e = 0; e < 8; ++e) o[e] = v[e] * rs * qgn[e];
          ST8(Qb + (size_t)row * 768 + h8 * 96 + g8 * 8, o); }
        UP8(v, in.kn);
        { float ss = 0.f;
#pragma unroll
          for (int e = 0; e < 8; ++e) ss += v[e] * v[e];
          ss += swz_xor<1>(ss); ss += swz_xor<2>(ss); ss += swz_xor<4>(ss);
          const float rs = 1.0f / sqrtf(ss * (1.0f / 64.0f) + EPS);
#pragma unroll
          for (int e = 0; e < 8; ++e) o[e] = v[e] * rs * kgn[e];
          ST8(Kb + (size_t)row * 768 + h8 * 96 + g8 * 8, o); }
        UP8(v, in.qp);
        { float ss = 0.f;
#pragma unroll
          for (int e = 0; e < 8; ++e) ss += v[e] * v[e];
          ss += swz_xor<1>(ss); ss += swz_xor<2>(ss);
          const float rs = 1.0f / sqrtf(ss * (1.0f / 32.0f) + EPS);
#pragma unroll
          for (int e = 0; e < 8; ++e) { const float vn = v[e] * rs * qgr[e]; const float pe = swz_xor<2>(vn);
              const float cs = e < 4 ? in.ca[e & 3] : in.cb[e & 3], sn = e < 4 ? in.sa[e & 3] : in.sb[e & 3];
              o[e] = (g4 < 2 ? vn * cs - pe * sn : pe * sn + vn * cs) * C2; }
          if (lane < 32) ST8(Qb + (size_t)row * 768 + h4 * 96 + 64 + g4 * 8, o); }
#undef UP8
#undef ST8
    }
}

__device__ __forceinline__ void scan_a(Frame& F) {
    F.refresh();
    const int ch = F.tid;
    const unsigned* lu = wsp<unsigned>(F, WS_LA); float* Pl = wsp<float>(F, WS_PL); float* Hc = wsp<float>(F, WS_HC);
    for (int un = F.vcu; un < 256; un += F.G) {
        const size_t r0 = (size_t)un * 128; float S = 0.f, H = 0.f;
        for (int t0 = 0; t0 < 128; t0 += 32) { unsigned w[32];
#pragma unroll
            for (int t = 0; t < 32; ++t) w[t] = lu[(r0 + t0 + t) * LRUW + ch];
#pragma unroll
            for (int t = 0; t < 32; ++t) { const float l2 = bflo(w[t]); H = __builtin_amdgcn_exp2f(l2) * H + bfhi(w[t]); S += l2; } }
        Pl[(size_t)un * LRUW + ch] = S; Hc[(size_t)un * LRUW + ch] = H;
    }
}
__device__ __forceinline__ void scan_arrive(Frame& F, int l) {
    asm volatile("s_waitcnt vmcnt(0)" ::: "memory");
    __syncthreads();
    int t0 = threadIdx.x; asm volatile("" : "+v"(t0));
    if (t0 == 0) { __builtin_amdgcn_fence(__ATOMIC_RELEASE, "agent"); asm volatile("s_waitcnt vmcnt(0)" ::: "memory"); (void)xb_add((unsigned*)(F.ctl + CW_SCNT + 16 * l), 1u); }
}
__device__ __forceinline__ void scan_wait(Frame& F, int l) {
    int t0 = threadIdx.x; asm volatile("" : "+v"(t0));
    if (t0 == 0) { unsigned* bar = (unsigned*)(F.ctl + CW_BAR); unsigned* cnt = (unsigned*)(F.ctl + CW_SCNT + 16 * l);
        XB_SPIN(xb_ld(cnt) < 256u, bar);
        __builtin_amdgcn_fence(__ATOMIC_ACQUIRE, "agent"); asm volatile("s_waitcnt vmcnt(0)" ::: "memory"); }
    __syncthreads();
}
__device__ __forceinline__ float gelu_tanh(float x) {
    const float y = 0.7978845608028654f * (x + 0.044715f * x * x * x);
    return x * __builtin_amdgcn_rcpf(1.0f + __builtin_amdgcn_exp2f(-2.0f * 1.4426950408889634f * y));
}
__device__ __forceinline__ void scan_c(Frame& F, int l) {
    F.refresh();
    const int ch = F.tid, lane = F.lane;
    LAS float* st = (LAS float*)F.lds;
    const unsigned* lu = wsp<unsigned>(F, WS_LA); const float* Pl = wsp<float>(F, WS_PL); const float* Hc = wsp<float>(F, WS_HC);
    const bf16* z = wsp<bf16>(F, WS_Z); bf16* y = wsp<bf16>(F, WS_Y);
    const float* out_gain = INF(I_OGAIN) + l * D + 512;
    float og[8];
#pragma unroll
    for (int e = 0; e < 8; ++e) og[e] = out_gain[8 * lane + e];
    for (int un = F.vcu; un < 256; un += F.G) {
        const int c = un & 127, b = un >> 7; const size_t r0 = (size_t)un * 128;
        unsigned w[32]; bf16 gq[32];
#pragma unroll
        for (int t = 0; t < 32; ++t) { w[t] = lu[(r0 + t) * LRUW + ch]; gq[t] = z[(r0 + t) * INP + 1024 + ch]; }
        float hst = 0.f;
        {
            float plA[16], hcA[16], plB[16], hcB[16];
#define SCC_LOAD(PLv, HCv, c0_) do { _Pragma("unroll") for (int u = 0; u < 16; ++u) { const int cc = (c0_) + u; const size_t o = (size_t)(b * 128 + (cc < c ? cc : 0)) * LRUW + ch; PLv[u] = cc < c ? Pl[o] : 0.f; HCv[u] = cc < c ? Hc[o] : 0.f; } } while (0)
#define SCC_STEP(PLv, HCv) do { _Pragma("unroll") for (int u = 0; u < 16; ++u) hst = __builtin_amdgcn_exp2f(PLv[u]) * hst + HCv[u]; } while (0)
            if (c > 0) SCC_LOAD(plA, hcA, 0);
            for (int c0 = 0; c0 < c; c0 += 32) {
                if (c0 + 16 < c) SCC_LOAD(plB, hcB, c0 + 16);
                SCC_STEP(plA, hcA);
                if (c0 + 16 >= c) break;
                if (c0 + 32 < c) SCC_LOAD(plA, hcA, c0 + 32);
                SCC_STEP(plB, hcB);
            }
#undef SCC_LOAD
#undef SCC_STEP
        }
        for (int sub = 0; sub < 4; ++sub) {
#pragma unroll
            for (int t = 0; t < 32; ++t) { hst = __builtin_amdgcn_exp2f(bflo(w[t])) * hst + bfhi(w[t]); st[t * 512 + ch] = hst * gelu_tanh(bf1(gq[t])); }
            if (sub < 3) {
#pragma unroll
                for (int t = 0; t < 32; ++t) { w[t] = lu[(r0 + (sub + 1) * 32 + t) * LRUW + ch]; gq[t] = z[(r0 + (sub + 1) * 32 + t) * INP + 1024 + ch]; } }
            __syncthreads();
#pragma unroll
            for (int tt = 0; tt < 4; ++tt) { const int t = F.wave * 4 + tt; const size_t row = r0 + sub * 32 + t;
                const f32x4 a = *(const LAS f32x4*)(st + t * 512 + 8 * lane), bq = *(const LAS f32x4*)(st + t * 512 + 8 * lane + 4);
                float ss = (a.x * a.x + a.y * a.y) + (a.z * a.z + a.w * a.w) + (bq.x * bq.x + bq.y * bq.y) + (bq.z * bq.z + bq.w * bq.w);
                const float rs = 1.0f / sqrtf(wave_sum(ss) * (1.0f / 512.0f) + EPS);
                *(v4u*)(y + row * D + 512 + 8 * lane) = (v4u){pk2(a.x * rs * og[0], a.y * rs * og[1]), pk2(a.z * rs * og[2], a.w * rs * og[3]), pk2(bq.x * rs * og[4], bq.y * rs * og[5]), pk2(bq.z * rs * og[6], bq.w * rs * og[7])}; }
            __syncthreads();
        }
    }
}
__device__ __forceinline__ void attn_norm_pass(Frame& F, int l) {
    F.refresh();
    const int lane = F.lane; float og[8];
    const float* out_gain = INF(I_OGAIN) + l * D; bf16* y = wsp<bf16>(F, WS_Y);
#pragma unroll
    for (int e = 0; e < 8; ++e) og[e] = out_gain[8 * lane + e];
    for (int row0 = F.gw; row0 < NTOK; row0 += 4 * F.NGW) {
        v4u wv[4];
#pragma unroll
        for (int r = 0; r < 4; ++r) { const int row = row0 + r * F.NGW; if (row < NTOK) wv[r] = *(const v4u*)(y + (size_t)row * D + 8 * lane); else wv[r] = (v4u){0u, 0u, 0u, 0u}; }
#pragma unroll
        for (int r = 0; r < 4; ++r) { const int row = row0 + r * F.NGW; const v4u w = wv[r];
            const float v0 = bflo(w.x), v1 = bfhi(w.x), v2 = bflo(w.y), v3 = bfhi(w.y), v4 = bflo(w.z), v5 = bfhi(w.z), v6 = bflo(w.w), v7 = bfhi(w.w);
            const float ss = (v0 * v0 + v1 * v1) + (v2 * v2 + v3 * v3) + (v4 * v4 + v5 * v5) + (v6 * v6 + v7 * v7);
            const float rs = 1.0f / sqrtf(wave_sum(ss) * (1.0f / 512.0f) + EPS);
            if (row < NTOK) *(v4u*)(y + (size_t)row * D + 8 * lane) = (v4u){pk2(v0 * rs * og[0], v1 * rs * og[1]), pk2(v2 * rs * og[2], v3 * rs * og[3]), pk2(v4 * rs * og[4], v5 * rs * og[5]), pk2(v6 * rs * og[6], v7 * rs * og[7])}; }
    }
}
__device__ __forceinline__ void attn_group_norm(Frame& F, int l, int b, int h, int qb) {
    asm volatile("s_waitcnt vmcnt(0)" ::: "memory");
    __syncthreads();
    int t0 = threadIdx.x; asm volatile("" : "+v"(t0));
    if (t0 == 0) {
        unsigned* bar = (unsigned*)(F.ctl + CW_BAR); unsigned* cnt = (unsigned*)(F.ctl + CW_AGRP + 16 * ((l * 2 + b) * 32 + qb));
        __builtin_amdgcn_fence(__ATOMIC_RELEASE, "agent");
        asm volatile("s_waitcnt vmcnt(0)" ::: "memory");
        (void)xb_add(cnt, 1u);
        XB_SPIN(xb_ld(cnt) < 8u, bar);
        __builtin_amdgcn_fence(__ATOMIC_ACQUIRE, "agent");
        asm volatile("s_waitcnt vmcnt(0)" ::: "memory");
    }
    __syncthreads();
    F.refresh();
    const int lane = F.lane; float og[8];
    const float* out_gain = INF(I_OGAIN) + l * D; bf16* y = wsp<bf16>(F, WS_Y);
#pragma unroll
    for (int e = 0; e < 8; ++e) og[e] = out_gain[8 * lane + e];
    const size_t row0 = (size_t)b * SEQ + (size_t)qb * 512 + h * 64 + F.wave * 8;
    v4u wv[8];
#pragma unroll
    for (int r = 0; r < 8; ++r) wv[r] = *(const v4u*)(y + (row0 + r) * D + 8 * lane);
#pragma unroll
    for (int r = 0; r < 8; ++r) { const v4u w = wv[r];
        const float v0 = bflo(w.x), v1 = bfhi(w.x), v2 = bflo(w.y), v3 = bfhi(w.y), v4 = bflo(w.z), v5 = bfhi(w.z), v6 = bflo(w.w), v7 = bfhi(w.w);
        const float ss = (v0 * v0 + v1 * v1) + (v2 * v2 + v3 * v3) + (v4 * v4 + v5 * v5) + (v6 * v6 + v7 * v7);
        const float rs = 1.0f / sqrtf(wave_sum(ss) * (1.0f / 512.0f) + EPS);
        *(v4u*)(y + (row0 + r) * D + 8 * lane) = (v4u){pk2(v0 * rs * og[0], v1 * rs * og[1]), pk2(v2 * rs * og[2], v3 * rs * og[3]), pk2(v4 * rs * og[4], v5 * rs * og[5]), pk2(v6 * rs * og[6], v7 * rs * og[7])}; }
}
__device__ __forceinline__ void moe_permute(Frame& F, int moe_j) {
    F.refresh();
    LAS int* sb = (LAS int*)F.lds;
    const int* tok_e = wsp<int>(F, WS_TOKE); const int* tok_r = wsp<int>(F, WS_TOKR); int* tok_p = wsp<int>(F, WS_TOKP); int* rte = wsp<int>(F, WS_RTE);
    const bf16* hbuf = wsp<bf16>(F, WS_H); bf16* hs = wsp<bf16>(F, WS_HS);
    if (F.tid < NEXP) sb[16 + F.tid] = (int)__hip_atomic_load((unsigned*)(F.ctl + CW_GCNT + 64 * (8 * moe_j + F.tid)), RLX_AGENT);
    __syncthreads();
    if (F.tid == 0) { int acc = 0;
        for (int e = 0; e < NEXP; ++e) { const int cnt = sb[16 + e]; sb[e] = acc; acc += (cnt + 255) & ~255; }
        sb[8] = acc; }
    __syncthreads();
    if (blockIdx.x == 0) { const int nrt = sb[8] >> 8;
        for (int i = F.tid; i < nrt; i += NWAVES * 64) { int e = 0;
#pragma unroll
            for (int k = 1; k < NEXP; ++k) if (i * 256 >= sb[k]) e = k;
            rte[i] = e; const int left = sb[16 + e] - (i * 256 - sb[e]); rte[1024 + i] = left < 256 ? left : 256; }
        if (F.tid == 0) rte[511] = nrt; }
    const int lane = F.lane;
    for (int s = F.gw; s < 2 * NTOK; s += F.NGW) { const int t = s >> 1, e = tok_e[s], pos = sb[e] + tok_r[s];
        const GAS v4u* src = (const GAS v4u*)((const unsigned char*)hbuf + (size_t)t * D); GAS v4u* dst = (GAS v4u*)((unsigned char*)hs + (size_t)pos * D);
        dst[lane] = src[lane];
        if (lane == 0) tok_p[s] = pos; }
    for (int j = F.gw; j < NEXP * 256; j += F.NGW) { const int e = j >> 8, i = j & 255, cnt = sb[16 + e], padn = ((cnt + 255) & ~255) - cnt;
        if (i < padn) { v4u zz = (v4u){0u, 0u, 0u, 0u}; asm volatile("" : "+v"(zz));
            GAS v4u* dst = (GAS v4u*)((unsigned char*)hs + (size_t)(sb[e] + cnt + i) * D); dst[lane] = zz; } }
    __syncthreads();
}
struct UpOrder : pg8::StaticOrder {
    __device__ __forceinline__ bool next(int i, pg8::Unit& u) const { if (!pg8::StaticOrder::next(i, u)) return false; u.pa = u.pm + (u.pn >= 3 ? NTOK / 256 : 0); return true; }
    __device__ __forceinline__ int ktiles(const pg8::Unit& u, int nt) const { return u.pn >= 3 ? nt / 2 : nt; } };
struct GateOrder : pg8::StaticOrder {
    __device__ __forceinline__ bool next(int i, pg8::Unit& u) const { if (!pg8::StaticOrder::next(i, u)) return false; u.pa = u.pm + u.pn * (NTOK / 256); return true; } };
struct MoeOrder {
    pg8::StaticOrder so; const int* rte; const int* rtv; int pm_off, tpe, rev;
    __device__ __forceinline__ bool next(int i, pg8::Unit& u) const { if (!so.next(i, u)) return false; if (rev) u.pm = so.nM - 1 - u.pm; u.pm += pm_off; u.pa = u.pm; u.pb = rte[u.pm] * tpe + u.pn; u.sk = rtv[u.pm] <= 128; return true; }
    __device__ __forceinline__ void a_ready(const pg8::Unit&) const {}
    __device__ __forceinline__ void done(const pg8::Unit&) const {}
    __device__ __forceinline__ int ktiles(const pg8::Unit&, int nt) const { return nt; }
};
struct AttnOrder {
    int v, G;
    __device__ __forceinline__ bool next(int i, int& bh, int& qb) const { const int un = v + (i >> 2) * G; if (un >= 256) return false; const int s = un & 15, k = i & 3; bh = un >> 4; qb = (k == 0) ? s : (k == 1) ? 31 - s : (k == 2) ? 32 + s : 63 - s; return true; }
};

struct Args { const void* in[28]; float* out; unsigned char* ws; };
__global__ void __launch_bounds__(NWAVES * 64, 2) trunk_fwd(Args args) {
    extern __shared__ __attribute__((aligned(16))) unsigned char lds[];
    Frame F;
    F.lds = (LAS unsigned char*)lds; F.MISC = (volatile LAS unsigned*)(F.lds + MISC_OFF);
    F.G = gridDim.x; { const int bx = blockIdx.x; F.vcu = (F.G % 8 == 0) ? (bx % 8) * (F.G / 8) + bx / 8 : bx; }
    F.NGW = F.G * NWAVES; F.refresh();
    F.ws = args.ws; F.out = args.out; F.ctl = (gu32*)(args.ws + WS_CTL);
    for (int u = F.tid; u < (LDS_BYTES - LDSCTL_OFF) / 4; u += NWAVES * 64) ((LAS unsigned*)(F.lds + LDSCTL_OFF))[u] = 0u;
    __syncthreads();
    XcdBarrier bar = xcd_barrier_post((unsigned*)(F.ctl + CW_BAR), F.MISC + 8);
#ifndef PROBE_MASK
#define PROBE_MASK 0u
#endif
    unsigned long long pr_last = PROBE_MASK ? rt() : 0ull, pr_acc = 0ull;
#define GRID_BAR(c) do { xcd_barrier(bar); if (PROBE_MASK) { const unsigned long long now_ = rt(); if ((PROBE_MASK >> (c)) & 1u) pr_acc += now_ - pr_last; pr_last = now_; } } while (0)
    const int cblk = (int)blockIdx.x;
    bf16* const xb = wsp<bf16>(F, WS_XB);

    p0_prologue(F);
    GRID_BAR(0);
    p0_finalise(F);
    GRID_BAR(0);

    for (int l = 0; l < DEPTH; ++l) {
        const int ls1 = 2 * l, ls2 = 2 * l + 1; const bool moe = (l & 1) != 0; const int jj = l >> 1;
        if (l == 0) norm_pass<false, true, false, false, true, false>(F, INF(I_X), xb, ls1, 0, 0);
        else if (l == 2) { norm_pass<true, true, false, false, true>(F, xb, xb, ls1, ls1 - 1, 0); convert_moe_late(F); }
        else norm_pass<false, true, false, false, true>(F, xb, nullptr, ls1, 0, 0);
        GRID_BAR(1);
        { bf16* Win_t = wsp<bf16>(F, WS_WSMALL + (size_t)l * WSMALL_STRIDE);
          pg8::Gemm g{wsp<bf16>(F, WS_H), Win_t, NTOK, INP, D / 2}; pg8::StaticOrder S; S.init(NTOK, INP, F.G, cblk);
          pg8::EpiBf16I8 E{wsp<bf16>(F, WS_Z), INP, wsp<float>(F, WS_RSC), wsp<float>(F, WS_MREF)[8 + l]};
          pg8::gemm_phase<pg8::EpiBf16I8, pg8::StaticOrder, true, true, true, true>(F.lds, g, S, E); }
        GRID_BAR(2);
        mid_pass(F, l);
        GRID_BAR(3);
        { bf16* Wup_t = wsp<bf16>(F, WS_WSMALL + (size_t)l * WSMALL_STRIDE + 3 * MiB);
          int k256 = 256; asm volatile("" : "+s"(k256));
          pg8::Gemm g{wsp<bf16>(F, WS_A2), Wup_t, NTOK, UPN, k256}; UpOrder S; S.init(NTOK, UPN, F.G, cblk);
          pg8::EpiUp E{wsp<bf16>(F, WS_Q), wsp<bf16>(F, WS_K), wsp<bf16>(F, WS_QKV), INF(I_QGAIN) + l * 96, INF(I_KGAIN) + l * 96, wsp<float>(F, WS_COS), wsp<float>(F, WS_SIN)};
          pg8::gemm_phase<pg8::EpiUp, UpOrder, true, true>(F.lds, g, S, E); }
        { bf16* Wg_t = wsp<bf16>(F, WS_WSMALL + (size_t)l * WSMALL_STRIDE + 5 * MiB); const bf16* xrb = wsp<bf16>(F, WS_XR);
          int k128 = 128; asm volatile("" : "+s"(k128));
          pg8::Gemm g{xrb, Wg_t, NTOK, 1024, k128}; GateOrder S; S.init(NTOK, 1024, F.G, cblk);
          pg8::EpiGates E{xrb, INF(I_BA) + l * LRUW, INF(I_BX) + l * LRUW, wsp<float>(F, WS_LAMC) + l * LRUW, wsp<unsigned>(F, WS_LA)};
          pg8::gemm_phase<pg8::EpiGates, GateOrder, true, true>(F.lds, g, S, E); }
        GRID_BAR(4);
        const bool inphase = F.G == 256 && wsp<float>(F, WS_MREF)[l] <= att::ATT_MREF_MAX;
        if (!inphase) { scan_a(F); GRID_BAR(5); }
        { const AttnOrder AO{F.vcu, F.G}; int bh, qb; const bf16* Qb = wsp<bf16>(F, WS_Q); const bf16* Kb = wsp<bf16>(F, WS_K); const bf16* Vb = wsp<bf16>(F, WS_QKV); bf16* yb = wsp<bf16>(F, WS_Y);
          const float mref = wsp<float>(F, WS_MREF)[l];
          if (mref <= att::ATT_MREF_MAX) {
              for (int base = F.vcu; base < 256; base += F.G)
                  for (int i = 0; i < 2; ++i) { int un = base; asm volatile("" : "+s"(un));
                      att2::attn_unit(un >> 7, (un >> 4) & 7, i ? 31 - (un & 15) : (un & 15), Qb, Kb, Vb, yb, F.lds);
                      if (F.G == 256) { int u2 = base; asm volatile("" : "+s"(u2)); attn_group_norm(F, l, u2 >> 7, (u2 >> 4) & 7, i ? 31 - (u2 & 15) : (u2 & 15));
                          if (i == 0) { scan_a(F); scan_arrive(F, l); if (l == 0) convert_moe_first(F); } } }
#ifdef ATT_XVAR
            { bf16* xo = wsp<bf16>(F, (size_t)866 * MiB); for (int i = 0; AO.next(i, bh, qb); ++i) att::attn_unit<ATT_XVAR>(bh >> 3, bh & 7, qb, Qb, Kb, Vb, xo, F.lds, 512); }
#endif
          }
          else {
              for (int base = F.vcu; base < 256; base += F.G)
                  for (int i = 0; i < 4; ++i) { int un = base; asm volatile("" : "+s"(un)); const int s_ = un & 15;
                      att_online::attn_unit(un >> 7, (un >> 4) & 7, i == 0 ? s_ : (i == 1 ? 31 - s_ : (i == 2 ? 32 + s_ : 63 - s_)), Qb, Kb, Vb, yb, F.lds);
                      if (i == 0 && l == 0 && F.G == 256) convert_moe_first(F); } } }
        if (inphase) scan_wait(F, l);
        scan_c(F, l);
        GRID_BAR(6);
        if (!inphase) { attn_norm_pass(F, l); GRID_BAR(7); }
        { bf16* Wout_t = wsp<bf16>(F, WS_WSMALL + (size_t)l * WSMALL_STRIDE + 6 * MiB);
          pg8::Gemm g{wsp<bf16>(F, WS_Y), Wout_t, NTOK, D, D}; pg8::StaticOrder S; S.init(NTOK, D, F.G, cblk);
          pg8::EpiResid E{xb, xb, wsp<float>(F, WS_MOD) + (size_t)ls1 * 2 * 3072 + 2048, 1.0f};
          pg8::gemm_phase<pg8::EpiResid, pg8::StaticOrder, true, true>(F.lds, g, S, E); }
        GRID_BAR(8);
        if (!moe) {
            if (true) {
                norm_pass<false, true, false, false, true>(F, xb, nullptr, ls2, 0, 0);
                GRID_BAR(1);
                { unsigned char* Wgu8 = wsp<unsigned char>(F, WS_WDENSE + (size_t)jj * WDENSE_STRIDE);
                  pg8::Gemm g{wsp<bf16>(F, WS_H), (const bf16*)Wgu8, NTOK, 2 * DFF, D / 2}; pg8::StaticOrder S; S.init(NTOK, 2 * DFF, F.G, cblk);
                  pg8::EpiSwigluI8 E{wsp<unsigned char>(F, WS_HID), DFF, wsp<float>(F, WS_RSC), wsp<float>(F, WS_MREF)[8 + 4 + jj], SC_HID8};
                  pg8::gemm_phase<pg8::EpiSwigluI8, pg8::StaticOrder, true, true, true, true>(F.lds, g, S, E); }
                GRID_BAR(9);
                { unsigned char* Wd8 = wsp<unsigned char>(F, WS_WDENSE + (size_t)jj * WDENSE_STRIDE + 11 * MiB);
                  pg8::Gemm g{wsp<bf16>(F, WS_HID), (const bf16*)Wd8, NTOK, D, DFF / 2}; pg8::StaticOrder S; S.init(NTOK, D, F.G, cblk);
                  pg8::EpiResid E{xb, xb, wsp<float>(F, WS_MOD) + (size_t)ls2 * 2 * 3072 + 2048, 1.0f / (SC_HID8 * SC_WD8)};
                  pg8::gemm_phase<pg8::EpiResid, pg8::StaticOrder, true, true, true>(F.lds, g, S, E); }
                GRID_BAR(10);
            } else {
                norm_pass<false, true, false, true>(F, xb, nullptr, ls2, 0, 0);
                GRID_BAR(1);
                { unsigned char* Wgu8 = wsp<unsigned char>(F, WS_WDENSE + (size_t)jj * WDENSE_STRIDE);
                  pg8::Gemm g{wsp<bf16>(F, WS_H), (const bf16*)Wgu8, NTOK, 2 * DFF, D / 2}; pg8::StaticOrder S; S.init(NTOK, 2 * DFF, F.G, cblk);
                  pg8::EpiSwigluF8 E{wsp<unsigned char>(F, WS_HID), DFF, 1.0f / (SC_H8 * SC_WGU8), SC_HID8};
                  pg8::gemm_phase<pg8::EpiSwigluF8, pg8::StaticOrder, true, true, true>(F.lds, g, S, E); }
                GRID_BAR(9);
                { unsigned char* Wd8 = wsp<unsigned char>(F, WS_WDENSE + (size_t)jj * WDENSE_STRIDE + 11 * MiB);
                  pg8::Gemm g{wsp<bf16>(F, WS_HID), (const bf16*)Wd8, NTOK, D, DFF / 2}; pg8::StaticOrder S; S.init(NTOK, D, F.G, cblk);
                  pg8::EpiResid E{xb, xb, wsp<float>(F, WS_MOD) + (size_t)ls2 * 2 * 3072 + 2048, 1.0f / (SC_HID8 * SC_WD8)};
                  pg8::gemm_phase<pg8::EpiResid, pg8::StaticOrder, true, true, true>(F.lds, g, S, E); }
                GRID_BAR(10);
            }
        } else {
            norm_pass<false, true, true, true>(F, xb, nullptr, ls2, 0, jj);
            GRID_BAR(11);
            moe_permute(F, jj);
            GRID_BAR(12);
            const int* rte = wsp<int>(F, WS_RTE); const int nrt = rte[511];
            { pg8::Gemm g{wsp<bf16>(F, WS_HS), wsp<bf16>(F, WS_WMOE_GU), nrt * 256, 2 * DFE, D / 2}; MoeOrder S; S.so.init(nrt * 256, 2 * DFE, F.G, cblk); S.rte = rte; S.rtv = rte + 1024; S.pm_off = 0; S.tpe = 2 * DFE / 256; S.rev = 0;
              pg8::EpiSwigluF8 E{wsp<unsigned char>(F, WS_MHID), DFE, 1.0f / (SC_H8 * SC_WGU8), SC_HID8};
              pg8::gemm_phase<pg8::EpiSwigluF8, MoeOrder, true, true, true>(F.lds, g, S, E); }
            GRID_BAR(13);
            { pg8::Gemm g{wsp<bf16>(F, WS_MHID), wsp<bf16>(F, WS_WMOE_D), nrt * 256, D, DFE / 2}; MoeOrder S; S.so.init(nrt * 256, D, F.G, cblk); S.rte = rte; S.rtv = rte + 1024; S.pm_off = 0; S.tpe = D / 256; S.rev = 1;
              pg8::EpiF8S E{wsp<unsigned char>(F, WS_Y2), D, SC_Y8 / (SC_HID8 * SC_WD8)};
              pg8::gemm_phase<pg8::EpiF8S, MoeOrder, true, true, true>(F.lds, g, S, E); }
                        if (jj == 0) { const int nwg = nrt * (D / 256), rem = nwg % F.G, nshare = rem ? F.G - rem : F.G, rank = rem ? cblk - rem : cblk;
                if (rank >= 0) convert_moe_early(F, rank, nshare); }
GRID_BAR(14);
        }
    }
    norm_pass<true, false, false, false, false, true, false>(F, xb, F.out, 0, 2 * (DEPTH - 1) + 1, 0);
    if (PROBE_MASK) { const unsigned long long now_ = rt(); if ((PROBE_MASK >> 15) & 1u) pr_acc += now_ - pr_last; if (blockIdx.x == 0) { while (rt() - now_ < pr_acc) __builtin_amdgcn_s_sleep(8); } }
}

extern "C" void kernel_launch(void* const* d_in, const int* in_sizes, int n_in, void* d_out, int out_size, void* d_ws, size_t ws_size, hipStream_t stream) {
    static int grid = 0;
    if (grid == 0) {
        if (n_in != 28 || out_size != NTOK * D || ws_size < WS_END) { fprintf(stderr, "kernel_launch: unexpected shapes (n_in %d, out %d, ws %zu)\n", n_in, out_size, ws_size); grid = -1; return; }
        int dev = 0, cus = 0, per_cu = 0;
        if (hipGetDevice(&dev) != hipSuccess || hipDeviceGetAttribute(&cus, hipDeviceAttributeMultiprocessorCount, dev) != hipSuccess) { grid = -1; return; }
        if (hipFuncSetAttribute((const void*)trunk_fwd, hipFuncAttributeMaxDynamicSharedMemorySize, LDS_BYTES) != hipSuccess) { fprintf(stderr, "kernel_launch: hipFuncSetAttribute failed\n"); grid = -1; return; }
        if (hipOccupancyMaxActiveBlocksPerMultiprocessor(&per_cu, (const void*)trunk_fwd, NWAVES * 64, LDS_BYTES) != hipSuccess || per_cu < 1) { fprintf(stderr, "kernel_launch: occupancy query reports %d\n", per_cu); per_cu = 1; }
        (void)hipGetLastError();
        grid = cus;
    }
    if (grid < 0) return;
    if (hipMemsetAsync((char*)d_ws + WS_CTL, 0, CTL_ZERO_BYTES, stream) != hipSuccess) return;
    Args a{};
    for (int i = 0; i < 28; ++i) a.in[i] = d_in[i];
    a.out = (float*)d_out; a.ws = (unsigned char*)d_ws;
    hipLaunchKernelGGL(trunk_fwd, dim3(grid), dim3(NWAVES * 64), LDS_BYTES, stream, a);
}
```

```cpp
#include <hip/hip_runtime.h>
#include <cstdio>
#include <cstdint>
namespace pg8 {
#define PG8_LAS __attribute__((address_space(3)))
typedef unsigned short bf16_t;
typedef short bf16x8 __attribute__((ext_vector_type(8)));
typedef float f32x4 __attribute__((ext_vector_type(4)));
typedef unsigned u32x4 __attribute__((ext_vector_type(4)));
typedef int i32x4_ __attribute__((ext_vector_type(4)));
constexpr int BM = 256, BK = 64, HALF = 128, HTB = HALF * BK * 2  , STAGE_BYTES = 8 * HTB, NXCD = 8, WGM = 8;

__host__ __device__ __forceinline__ int lds_byte(int r, int c) { const int st = (r >> 4) * 2 + (c >> 5), rr = r & 15, cc = c & 31, ob = rr * 64 + cc * 2; return st * 1024 + (ob ^ (((ob >> 9) & 1) << 5)); }
__host__ __device__ __forceinline__ void stage_rc(int b, int& R, int& C) { const int st = b / 1024, sb = b % 1024, swz = sb ^ (((sb >> 9) & 1) << 5); R = (st >> 1) * 16 + swz / 64; C = (st & 1) * 32 + (swz % 64) / 2; }
__host__ __device__ __forceinline__ int perm32(int rho) { const int n = rho >> 4, i = rho & 15; return 8 * (i >> 2) + 4 * n + (i & 3); }

struct Unit { int pm, pn, pb, pa, sk; };
struct Gemm { const bf16_t* A; const bf16_t* Bt; int M, N, K; };

struct StaticOrder {
    int nM, nN, nwg, G, c;
    __host__ __device__ void init(int M, int N, int G_, int c_) { nM = M / BM; nN = N / BM; nwg = nM * nN; G = G_; c = c_; }
    __host__ __device__ bool next(int i, Unit& u) const {
        const long L = (long)i * G + c; if (L >= nwg) return false;
        int wgid = (int)L; { const int q = nwg / NXCD, r = nwg % NXCD, xcd = wgid % NXCD, off = wgid / NXCD; wgid = (xcd < r ? xcd * (q + 1) : r * (q + 1) + (xcd - r) * q) + off; }
        const int nig = WGM * nN, gid = wgid / nig, fm = gid * WGM, gsz = (nM - fm) < WGM ? (nM - fm) : WGM;
        u.pm = fm + ((wgid % nig) % gsz); u.pn = (wgid % nig) / gsz; u.pb = u.pn; u.pa = u.pm; u.sk = 0; return true;
    }
    __device__ __forceinline__ void a_ready(const Unit&) const {}
    __device__ __forceinline__ void done(const Unit&) const {}
    __device__ __forceinline__ int ktiles(const Unit&, int nt) const { return nt; }
    static constexpr bool KSKIP = false;
};

__device__ __forceinline__ unsigned cvt_pk_bf16(float lo, float hi) { unsigned r; asm volatile("v_cvt_pk_bf16_f32 %0, %1, %2" : "=v"(r) : "v"(lo), "v"(hi)); return r; }
typedef float f32x2 __attribute__((ext_vector_type(2)));
__device__ __forceinline__ f32x2 gelu_pk(f32x2 v) {
    const f32x2 av = __builtin_elementwise_abs(v), d = av * 0.2316418882f + 1.0f;
    f32x2 t; t.x = __builtin_amdgcn_rcpf(d.x); t.y = __builtin_amdgcn_rcpf(d.y);
    f32x2 q = t * 0.5307027145f + (-0.7265760135f); q = q * t + 0.7107068705f; q = q * t + (-0.142248368f); q = q * t + 0.127414796f; q = q * t;
    const f32x2 s = (v * v) * (-0.72134752044f);
    f32x2 e; e.x = __builtin_amdgcn_exp2f(s.x); e.y = __builtin_amdgcn_exp2f(s.y);
    const f32x2 m = v * (q * e), r = v - m;
    f32x2 o; o.x = v.x < 0.f ? m.x : r.x; o.y = v.y < 0.f ? m.y : r.y; return o;
}

template <int ACT  > struct EpiBf16 {
    static constexpr bool PERM = true, AFTER_DRAIN = false; static_assert(ACT == 0 || ACT == 1, "EpiBf16: ACT is 0 (none) or 1 (gelu_pk)");
    bf16_t* O; int ldc; const float* bias; int split_cols; size_t split_stride; float scale0;
    __device__ __forceinline__ void operator()(const f32x4 (&acc)[2][2][4][2], const Unit& u, int wr, int wc, int fr, int fq) const {
        const int row0 = u.pm * BM + wr * 64 + fr; int colt = u.pn * BM; bf16_t* base = O;
        float sc = 1.f; if (split_cols) { const int t = colt / split_cols; base += (size_t)t * split_stride; colt -= t * split_cols; if (t == 0) sc = scale0; }
        const int col0 = colt + wc * 32 + 8 * fq, bcol0 = u.pn * BM + wc * 32 + 8 * fq;
        f32x4 bv[2][2];
#pragma unroll
        for (int bj = 0; bj < 2; ++bj)
#pragma unroll
            for (int n = 0; n < 2; ++n) bv[bj][n] = bias ? *(const f32x4*)(bias + bcol0 + bj * HALF + 4 * n) : (f32x4){0.f, 0.f, 0.f, 0.f};
#pragma unroll
        for (int ai = 0; ai < 2; ++ai)
#pragma unroll
            for (int m = 0; m < 4; ++m) { bf16_t* rowp = base + (size_t)(row0 + ai * HALF + m * 16) * ldc + col0;
#pragma unroll
                for (int bj = 0; bj < 2; ++bj) { f32x4 v0 = acc[ai][bj][m][0] + bv[bj][0], v1 = acc[ai][bj][m][1] + bv[bj][1];
                    if (ACT == 1) { f32x2 a = gelu_pk((f32x2){v0[0], v0[1]}), b = gelu_pk((f32x2){v0[2], v0[3]}), c = gelu_pk((f32x2){v1[0], v1[1]}), d = gelu_pk((f32x2){v1[2], v1[3]});
                        v0 = (f32x4){a.x, a.y, b.x, b.y}; v1 = (f32x4){c.x, c.y, d.x, d.y}; }
                    v0 = v0 * sc; v1 = v1 * sc; u32x4 w; w.x = cvt_pk_bf16(v0[0], v0[1]); w.y = cvt_pk_bf16(v0[2], v0[3]); w.z = cvt_pk_bf16(v1[0], v1[1]); w.w = cvt_pk_bf16(v1[2], v1[3]);
                    *(u32x4*)(rowp + bj * HALF) = w; } }
    }
};
struct EpiBf16I8 {
    static constexpr bool PERM = true, AFTER_DRAIN = false;
    bf16_t* O; int ldc; const float* rsc; float wdq;
    __device__ __forceinline__ void operator()(const f32x4 (&acc)[2][2][4][2], const Unit& u, int wr, int wc, int fr, int fq) const {
        const int row0 = u.pm * BM + wr * 64 + fr, col0 = u.pn * BM + wc * 32 + 8 * fq;
        float rs[2][4];
#pragma unroll
        for (int ai = 0; ai < 2; ++ai)
#pragma unroll
            for (int m = 0; m < 4; ++m) rs[ai][m] = rsc[row0 + ai * HALF + m * 16];
#pragma unroll
        for (int ai = 0; ai < 2; ++ai)
#pragma unroll
            for (int m = 0; m < 4; ++m) { bf16_t* rowp = O + (size_t)(row0 + ai * HALF + m * 16) * ldc + col0; const float s = rs[ai][m] * wdq;
#pragma unroll
                for (int bj = 0; bj < 2; ++bj) { float v[8];
#pragma unroll
                    for (int n = 0; n < 2; ++n)
#pragma unroll
                        for (int e = 0; e < 4; ++e) { const f32x4 av = acc[ai][bj][m][n]; const float ae = av[e]; v[4 * n + e] = (float)__float_as_int(ae) * s; }
                    u32x4 w; w.x = cvt_pk_bf16(v[0], v[1]); w.y = cvt_pk_bf16(v[2], v[3]); w.z = cvt_pk_bf16(v[4], v[5]); w.w = cvt_pk_bf16(v[6], v[7]);
                    *(u32x4*)(rowp + bj * HALF) = w; } }
    }
};
__device__ __forceinline__ float bf2f(unsigned short v) { return __uint_as_float((unsigned)v << 16); }
__device__ __forceinline__ float sigmoidf_(float v) { return __builtin_amdgcn_rcpf(1.0f + __builtin_amdgcn_exp2f(-1.4426950408889634f * v)); }
struct EpiResid {
    static constexpr bool PERM = true, AFTER_DRAIN = false;
    const bf16_t* base; bf16_t* out; const float* gate; float sc;
    __device__ __forceinline__ void operator()(const f32x4 (&acc)[2][2][4][2], const Unit& u, int wr, int wc, int fr, int fq) const {
        const int row0 = u.pm * BM + wr * 64 + fr, col0 = u.pn * BM + wc * 32 + 8 * fq;
        const float* gp = gate + (u.pm >= 64 ? 3072 : 0) + col0;
        f32x4 gv[2][2];
#pragma unroll
        for (int bj = 0; bj < 2; ++bj)
#pragma unroll
            for (int n = 0; n < 2; ++n) gv[bj][n] = *(const f32x4*)(gp + bj * HALF + 4 * n);
        asm volatile("" ::: "memory");
#define ER_OFF(g, q) ((size_t)(row0 + ((g) >> 1) * HALF + (2 * ((g) & 1) + (q)) * 16) * 1024 + col0)
#define ER_PACK(v0, v1) (u32x4){cvt_pk_bf16((v0)[0], (v0)[1]), cvt_pk_bf16((v0)[2], (v0)[3]), cvt_pk_bf16((v1)[0], (v1)[1]), cvt_pk_bf16((v1)[2], (v1)[3])}
        {
            u32x4 bw[2][2][2];
#define ER_LOADB(g, buf) do { _Pragma("unroll") for (int q = 0; q < 2; ++q) { const size_t off = ER_OFF(g, q); \
            _Pragma("unroll") for (int bj = 0; bj < 2; ++bj) bw[buf][q][bj] = *(const u32x4*)(base + off + bj * HALF); } } while (0)
#define ER_STOREB(g, buf) do { _Pragma("unroll") for (int q = 0; q < 2; ++q) { const size_t off = ER_OFF(g, q); \
            _Pragma("unroll") for (int bj = 0; bj < 2; ++bj) { const u32x4 w = bw[buf][q][bj]; \
                const f32x4 b0 = (f32x4){__uint_as_float(w.x << 16), __uint_as_float(w.x & 0xffff0000u), __uint_as_float(w.y << 16), __uint_as_float(w.y & 0xffff0000u)}; \
                const f32x4 b1 = (f32x4){__uint_as_float(w.z << 16), __uint_as_float(w.z & 0xffff0000u), __uint_as_float(w.w << 16), __uint_as_float(w.w & 0xffff0000u)}; \
                const f32x4 v0 = b0 + gv[bj][0] * acc[(g) >> 1][bj][2 * ((g) & 1) + q][0], v1 = b1 + gv[bj][1] * acc[(g) >> 1][bj][2 * ((g) & 1) + q][1]; \
                *(u32x4*)(out + off + bj * HALF) = ER_PACK(v0, v1); } } } while (0)
            ER_LOADB(0, 0); ER_LOADB(1, 1); asm volatile("" ::: "memory");
#pragma unroll
            for (int bj = 0; bj < 2; ++bj)
#pragma unroll
                for (int n = 0; n < 2; ++n) gv[bj][n] = gv[bj][n] * sc;
            ER_STOREB(0, 0); asm volatile("" ::: "memory"); ER_LOADB(2, 0); asm volatile("" ::: "memory");
            ER_STOREB(1, 1); asm volatile("" ::: "memory"); ER_LOADB(3, 1); asm volatile("" ::: "memory");
            ER_STOREB(2, 0); asm volatile("" ::: "memory");
            ER_STOREB(3, 1);
#undef ER_LOADB
#undef ER_STOREB
        }
#undef ER_OFF
#undef ER_PACK
    }
};
struct EpiSwiglu {
    static constexpr bool PERM = true, AFTER_DRAIN = false;
    bf16_t* O; int ldc;
    __device__ __forceinline__ void operator()(const f32x4 (&acc)[2][2][4][2], const Unit& u, int wr, int wc, int fr, int fq) const {
        const int row0 = u.pm * BM + wr * 64 + fr, col0 = u.pn * HALF + wc * 32 + 8 * fq;
#pragma unroll
        for (int ai = 0; ai < 2; ++ai)
#pragma unroll
            for (int m = 0; m < 4; ++m) { bf16_t* rowp = O + (size_t)(row0 + ai * HALF + m * 16) * ldc + col0;
                float hv[8];
#pragma unroll
                for (int n = 0; n < 2; ++n)
#pragma unroll
                    for (int e = 0; e < 4; ++e) { const float g = acc[ai][0][m][n][e], up = acc[ai][1][m][n][e]; hv[4 * n + e] = g * sigmoidf_(g) * up; }
                u32x4 w; w.x = cvt_pk_bf16(hv[0], hv[1]); w.y = cvt_pk_bf16(hv[2], hv[3]); w.z = cvt_pk_bf16(hv[4], hv[5]); w.w = cvt_pk_bf16(hv[6], hv[7]);
                *(u32x4*)rowp = w; }
    }
};
struct EpiGates {
    static constexpr bool PERM = true, AFTER_DRAIN = false;
    const bf16_t* xr; const float* ba; const float* bx; const float* lamc; unsigned* lu;
    __device__ __forceinline__ void operator()(const f32x4 (&acc)[2][2][4][2], const Unit& u, int wr, int wc, int fr, int fq) const {
        const int row0 = u.pm * BM + wr * 64 + fr, ch0 = u.pn * HALF + wc * 32 + 8 * fq;
        f32x4 bav[2], bxv[2], lcv[2]; const float NL2E = -1.4426950408889634f;
#pragma unroll
        for (int n = 0; n < 2; ++n) { bav[n] = *(const f32x4*)(ba + ch0 + 4 * n); bxv[n] = *(const f32x4*)(bx + ch0 + 4 * n); lcv[n] = *(const f32x4*)(lamc + ch0 + 4 * n); }
        u32x4 xws[2][4];
#pragma unroll
        for (int ai = 0; ai < 2; ++ai)
#pragma unroll
            for (int m = 0; m < 4; ++m) xws[ai][m] = *(const u32x4*)(xr + ((size_t)(ch0 >> 7) * 32768 + (row0 + ai * HALF + m * 16)) * 128 + (ch0 & 127));
        asm volatile("" ::: "memory");
#pragma unroll
        for (int n = 0; n < 2; ++n) { bav[n] = bav[n] * NL2E; bxv[n] = bxv[n] * NL2E; }
#pragma unroll
        for (int ai = 0; ai < 2; ++ai)
#pragma unroll
            for (int m = 0; m < 4; ++m) { const size_t off = (size_t)(row0 + ai * HALF + m * 16) * 512 + ch0;
                const u32x4 xw = xws[ai][m];
                float xv[8]; xv[0] = __uint_as_float(xw.x << 16); xv[1] = __uint_as_float(xw.x & 0xffff0000u); xv[2] = __uint_as_float(xw.y << 16); xv[3] = __uint_as_float(xw.y & 0xffff0000u);
                xv[4] = __uint_as_float(xw.z << 16); xv[5] = __uint_as_float(xw.z & 0xffff0000u); xv[6] = __uint_as_float(xw.w << 16); xv[7] = __uint_as_float(xw.w & 0xffff0000u);
#pragma unroll
                for (int n = 0; n < 2; ++n) { u32x4 pk;
#pragma unroll
                    for (int e = 0; e < 4; ++e) {
                        const float r = __builtin_amdgcn_rcpf(1.0f + __builtin_amdgcn_exp2f(__builtin_fmaf(acc[ai][0][m][n][e], NL2E, bav[n][e])));
                        const float ig = __builtin_amdgcn_rcpf(1.0f + __builtin_amdgcn_exp2f(__builtin_fmaf(acc[ai][1][m][n][e], NL2E, bxv[n][e])));
                        const float l2 = r * lcv[n][e];
                        const float om_e = 1.0f - __builtin_amdgcn_exp2f(l2 + l2);
                        const float xx = l2 * -1.3862943611198906f;
                        const float om = xx < 1.0e-4f ? xx : om_e;
                        pk[e] = cvt_pk_bf16(l2, __builtin_amdgcn_sqrtf(om) * ig * xv[4 * n + e]); }
                    *(u32x4*)(lu + off + 4 * n) = pk; } }
    }
};
__device__ __forceinline__ float clamp448(float v) { return __builtin_amdgcn_fmed3f(v, -448.0f, 448.0f); }
__device__ __forceinline__ unsigned pack4_i8(float a, float b, float c, float d) {
    const unsigned ua = __float_as_uint(__builtin_amdgcn_fmed3f(a, -127.0f, 127.0f) + 12582912.0f), ub = __float_as_uint(__builtin_amdgcn_fmed3f(b, -127.0f, 127.0f) + 12582912.0f);
    const unsigned uc = __float_as_uint(__builtin_amdgcn_fmed3f(c, -127.0f, 127.0f) + 12582912.0f), ud = __float_as_uint(__builtin_amdgcn_fmed3f(d, -127.0f, 127.0f) + 12582912.0f);
    return (ua & 0xffu) | ((ub & 0xffu) << 8) | ((uc & 0xffu) << 16) | (ud << 24); }
__device__ __forceinline__ unsigned pack4_fp8(float a, float b, float c, float d) {
    int w = __builtin_amdgcn_cvt_pk_fp8_f32(clamp448(a), clamp448(b), 0, false); w = __builtin_amdgcn_cvt_pk_fp8_f32(clamp448(c), clamp448(d), w, true); return (unsigned)w; }
struct EpiSwigluF8 {
    static constexpr bool PERM = true, AFTER_DRAIN = false;
    unsigned char* O; int ldc; float sin_, sout;
    __device__ __forceinline__ void operator()(const f32x4 (&acc)[2][2][4][2], const Unit& u, int wr, int wc, int fr, int fq) const {
        const int row0 = u.pm * BM + wr * 64 + fr, col0 = u.pn * HALF + wc * 32 + 8 * fq; const float c1 = -1.4426950408889634f * sin_, ik = 1.0f / (sin_ * sin_ * sout);
#pragma unroll
        for (int ai = 0; ai < 2; ++ai)
#pragma unroll
            for (int m = 0; m < 4; ++m) { unsigned char* rowp = O + (size_t)(row0 + ai * HALF + m * 16) * ldc + col0;
                float hv[8];
#pragma unroll
                for (int n = 0; n < 2; ++n)
#pragma unroll
                    for (int e = 0; e < 4; ++e) { const float ag = acc[ai][0][m][n][e], au = acc[ai][1][m][n][e];
                        hv[4 * n + e] = (ag * au) * __builtin_amdgcn_rcpf(__builtin_fmaf(__builtin_amdgcn_exp2f(ag * c1), ik, ik)); }
                typedef unsigned u32x2_ __attribute__((ext_vector_type(2)));
                *(u32x2_*)rowp = (u32x2_){pack4_fp8(hv[0], hv[1], hv[2], hv[3]), pack4_fp8(hv[4], hv[5], hv[6], hv[7])}; }
    }
};
struct EpiSwigluI8 {
    static constexpr bool PERM = true, AFTER_DRAIN = false;
    unsigned char* O; int ldc; const float* rsc; float wdq, sout;
    __device__ __forceinline__ void operator()(const f32x4 (&acc)[2][2][4][2], const Unit& u, int wr, int wc, int fr, int fq) const {
        const int row0 = u.pm * BM + wr * 64 + fr, col0 = u.pn * HALF + wc * 32 + 8 * fq;
        float rs[2][4];
#pragma unroll
        for (int ai = 0; ai < 2; ++ai)
#pragma unroll
            for (int m = 0; m < 4; ++m) rs[ai][m] = rsc[row0 + ai * HALF + m * 16];
#pragma unroll
        for (int ai = 0; ai < 2; ++ai)
#pragma unroll
            for (int m = 0; m < 4; ++m) { unsigned char* rowp = O + (size_t)(row0 + ai * HALF + m * 16) * ldc + col0;
                const float s = rs[ai][m] * wdq, c1 = -1.4426950408889634f * s, ik = __builtin_amdgcn_rcpf(s * s * sout);
                float hv[8];
#pragma unroll
                for (int n = 0; n < 2; ++n)
#pragma unroll
                    for (int e = 0; e < 4; ++e) { const f32x4 gq = acc[ai][0][m][n], uq = acc[ai][1][m][n]; const float ge = gq[e], ue = uq[e];
                        const float ag = (float)__float_as_int(ge), au = (float)__float_as_int(ue);
                        hv[4 * n + e] = (ag * au) * __builtin_amdgcn_rcpf(__builtin_fmaf(__builtin_amdgcn_exp2f(ag * c1), ik, ik)); }
                typedef unsigned u32x2_ __attribute__((ext_vector_type(2)));
                *(u32x2_*)rowp = (u32x2_){pack4_fp8(hv[0], hv[1], hv[2], hv[3]), pack4_fp8(hv[4], hv[5], hv[6], hv[7])}; }
    }
};
struct EpiBf16S {
    static constexpr bool PERM = true, AFTER_DRAIN = false;
    bf16_t* O; int ldc; float sc;
    __device__ __forceinline__ void operator()(const f32x4 (&acc)[2][2][4][2], const Unit& u, int wr, int wc, int fr, int fq) const {
        const int row0 = u.pm * BM + wr * 64 + fr, col0 = u.pn * BM + wc * 32 + 8 * fq;
#pragma unroll
        for (int ai = 0; ai < 2; ++ai)
#pragma unroll
            for (int m = 0; m < 4; ++m) { bf16_t* rowp = O + (size_t)(row0 + ai * HALF + m * 16) * ldc + col0;
#pragma unroll
                for (int bj = 0; bj < 2; ++bj) { const f32x4 v0 = acc[ai][bj][m][0] * sc, v1 = acc[ai][bj][m][1] * sc;
                    u32x4 w; w.x = cvt_pk_bf16(v0[0], v0[1]); w.y = cvt_pk_bf16(v0[2], v0[3]); w.z = cvt_pk_bf16(v1[0], v1[1]); w.w = cvt_pk_bf16(v1[2], v1[3]);
                    *(u32x4*)(rowp + bj * HALF) = w; } }
    }
};
struct EpiF8S {
    static constexpr bool PERM = true, AFTER_DRAIN = false;
    unsigned char* O; int ldc; float sc;
    __device__ __forceinline__ void operator()(const f32x4 (&acc)[2][2][4][2], const Unit& u, int wr, int wc, int fr, int fq) const {
        const int row0 = u.pm * BM + wr * 64 + fr, col0 = u.pn * BM + wc * 32 + 8 * fq;
        typedef unsigned u32x2_ __attribute__((ext_vector_type(2)));
#pragma unroll
        for (int ai = 0; ai < 2; ++ai)
#pragma unroll
            for (int m = 0; m < 4; ++m) { unsigned char* rowp = O + (size_t)(row0 + ai * HALF + m * 16) * ldc + col0;
#pragma unroll
                for (int bj = 0; bj < 2; ++bj) { const f32x4 v0 = acc[ai][bj][m][0] * sc, v1 = acc[ai][bj][m][1] * sc;
                    *(u32x2_*)(rowp + bj * HALF) = (u32x2_){pack4_fp8(v0[0], v0[1], v0[2], v0[3]), pack4_fp8(v1[0], v1[1], v1[2], v1[3])}; } }
    }
};
struct EpiUp {
    static constexpr bool PERM = true, AFTER_DRAIN = false;
    bf16_t* Q; bf16_t* K; bf16_t* V; const float* qg; const float* kg; const float* cosT; const float* sinT;
    __device__ __forceinline__ static float sum_fq(float s) {
        s += __int_as_float(__builtin_amdgcn_ds_swizzle(__float_as_int(s), (16 << 10) | 0x1f));
        auto rr = __builtin_amdgcn_permlane32_swap(__float_as_uint(s), __float_as_uint(s), false, false); return __uint_as_float(rr[0]) + __uint_as_float(rr[1]); }
    __device__ __forceinline__ void operator()(const f32x4 (&acc)[2][2][4][2], const Unit& u, int wr, int wc, int fr, int fq) const {
        const int t = u.pn, row0 = u.pm * BM + wr * 64 + fr; const float C2 = 0.10206207261596577f * 1.4426950408889634f, EPSN = 1e-6f;
        if (t >= 5) {
            const int col0 = (t - 5) * BM + wc * 32 + 8 * fq;
#pragma unroll
            for (int ai = 0; ai < 2; ++ai)
#pragma unroll
                for (int m = 0; m < 4; ++m) { bf16_t* rowp = V + (size_t)(row0 + ai * HALF + m * 16) * 512 + col0;
#pragma unroll
                    for (int bj = 0; bj < 2; ++bj) { const f32x4 v0 = acc[ai][bj][m][0], v1 = acc[ai][bj][m][1];
                        u32x4 w; w.x = cvt_pk_bf16(v0[0], v0[1]); w.y = cvt_pk_bf16(v0[2], v0[3]); w.z = cvt_pk_bf16(v1[0], v1[1]); w.w = cvt_pk_bf16(v1[2], v1[3]);
                        *(u32x4*)(rowp + bj * HALF) = w; } }
        } else if (t == 2) {
            const f32x4 g1 = *(const f32x4*)(qg + 64 + 4 * fq), g2 = *(const f32x4*)(qg + 80 + 4 * fq);
#pragma unroll
            for (int ai = 0; ai < 2; ++ai) {
                f32x4 csv[4], snv[4];
#pragma unroll
                for (int m = 0; m < 4; ++m) { const int row = row0 + ai * HALF + m * 16; csv[m] = *(const f32x4*)(cosT + (size_t)row * 16 + 4 * fq); snv[m] = *(const f32x4*)(sinT + (size_t)row * 16 + 4 * fq); }
                asm volatile("" ::: "memory");
#pragma unroll
                for (int m = 0; m < 4; ++m) { const int row = row0 + ai * HALF + m * 16;
                    const f32x4 cs = csv[m], sn = snv[m];
#pragma unroll
                    for (int bj = 0; bj < 2; ++bj) { const f32x4 x1 = acc[ai][bj][m][0], x2 = acc[ai][bj][m][1];
                        float ss = (x1[0] * x1[0] + x1[1] * x1[1]) + (x1[2] * x1[2] + x1[3] * x1[3]) + (x2[0] * x2[0] + x2[1] * x2[1]) + (x2[2] * x2[2] + x2[3] * x2[3]);
                        ss = sum_fq(ss); const float rs = __builtin_amdgcn_rsqf(ss * (1.0f / 32.0f) + EPSN);
                        const f32x4 a = x1 * rs * g1, b = x2 * rs * g2; const f32x4 o1 = (a * cs - b * sn) * C2, o2 = (a * sn + b * cs) * C2;
                        bf16_t* qp = Q + (size_t)row * 768 + (4 * bj + wc) * 96 + 64 + 4 * fq;
                        typedef unsigned u32x2_ __attribute__((ext_vector_type(2)));
                        *(u32x2_*)qp = (u32x2_){cvt_pk_bf16(o1[0], o1[1]), cvt_pk_bf16(o1[2], o1[3])}; *(u32x2_*)(qp + 16) = (u32x2_){cvt_pk_bf16(o2[0], o2[1]), cvt_pk_bf16(o2[2], o2[3])}; } } }
        } else {
            const bool isq = t < 2; const int head = 4 * (isq ? t : t - 3) + wc; const float* g = isq ? qg : kg; bf16_t* dst = isq ? Q : K; const float sc = isq ? C2 : 1.0f;
            f32x4 gv[2][2];
#pragma unroll
            for (int bj = 0; bj < 2; ++bj)
#pragma unroll
                for (int n = 0; n < 2; ++n) gv[bj][n] = *(const f32x4*)(g + 32 * bj + 8 * fq + 4 * n);
#pragma unroll
            for (int ai = 0; ai < 2; ++ai)
#pragma unroll
                for (int m = 0; m < 4; ++m) { const int row = row0 + ai * HALF + m * 16; float ss = 0.f;
#pragma unroll
                    for (int bj = 0; bj < 2; ++bj)
#pragma unroll
                        for (int n = 0; n < 2; ++n) { const f32x4 x = acc[ai][bj][m][n]; ss += (x[0] * x[0] + x[1] * x[1]) + (x[2] * x[2] + x[3] * x[3]); }
                    ss = sum_fq(ss); const float rs = sc * __builtin_amdgcn_rsqf(ss * (1.0f / 64.0f) + EPSN);
                    bf16_t* rowp = dst + (size_t)row * 768 + head * 96 + 8 * fq;
#pragma unroll
                    for (int bj = 0; bj < 2; ++bj) { const f32x4 v0 = acc[ai][bj][m][0] * rs * gv[bj][0], v1 = acc[ai][bj][m][1] * rs * gv[bj][1];
                        u32x4 w; w.x = cvt_pk_bf16(v0[0], v0[1]); w.y = cvt_pk_bf16(v0[2], v0[3]); w.z = cvt_pk_bf16(v1[0], v1[1]); w.w = cvt_pk_bf16(v1[2], v1[3]);
                        *(u32x4*)(rowp + 32 * bj) = w; } }
        }
    }
};
template <class Epi, class Sched, bool ALIGN_EPI = false, bool SP2 = false, bool F8 = false, bool I8 = false>
__device__ __forceinline__ void gemm_phase(PG8_LAS unsigned char* lds, const Gemm g, const Sched& S, const Epi& E) {
    int tid_ = threadIdx.x; asm volatile("" : "+v"(tid_));
    const int tid = tid_, wid = __builtin_amdgcn_readfirstlane(tid >> 6), lane = tid & 63, wr = wid >> 2, wc = wid & 3, fr = lane & 15, fq = lane >> 4;
    const int K = g.K, nt = K / BK;
    unsigned voffA[2], voffB[2];
#pragma unroll
    for (int i = 0; i < 2; ++i) { int R, C; stage_rc(tid * 16 + i * 8192, R, C); const int Rb = Epi::PERM ? ((R & ~31) + perm32(R & 31)) : R;
        voffA[i] = (unsigned)(R * K + C) * 2u; voffB[i] = (unsigned)(Rb * K + C) * 2u; }
    const size_t kstep = (size_t)(BK * 2);
    const size_t hstep = (size_t)HALF * K * 2;
    const size_t tstep = 2 * hstep;
    const unsigned ldsw = (unsigned)wid * 1024u;
    const int aoff = lds_byte(wr * 64 + fr, fq * 8), boff = lds_byte(wc * 32 + fr, fq * 8);
#define PG8_SA(b, h) (((b) * 2 + (h)) * HTB)
#define PG8_SB(b, h) ((4 + (b) * 2 + (h)) * HTB)
#define PG8_STAGE(bufoff, gbase, voff) do { _Pragma("unroll") for (int _i = 0; _i < 2; ++_i) \
        __builtin_amdgcn_global_load_lds((const unsigned*)((const char*)(gbase) + (voff)[_i]), (PG8_LAS unsigned*)(lds + (bufoff) + ldsw + _i * 8192), 16, 0, 0); } while (0)
#define PG8_LDA(dst, b, h) do { _Pragma("unroll") for (int m = 0; m < 4; ++m) _Pragma("unroll") for (int k = 0; k < 2; ++k) dst[m][k] = *(const PG8_LAS bf16x8*)(lds + PG8_SA(b, h) + aoff + m * 2048 + k * 1024); } while (0)
#define PG8_LDB(dst, b, h) do { _Pragma("unroll") for (int n = 0; n < 2; ++n) _Pragma("unroll") for (int k = 0; k < 2; ++k) dst[n][k] = *(const PG8_LAS bf16x8*)(lds + PG8_SB(b, h) + boff + n * 2048 + k * 1024); } while (0)
#define PG8_CAT(x0, x1) __builtin_shufflevector(__builtin_bit_cast(i32x4_, x0), __builtin_bit_cast(i32x4_, x1), 0, 1, 2, 3, 4, 5, 6, 7)
#define PG8_MMA(ai, bj, At, Bt) do { __builtin_amdgcn_s_setprio(1); \
        if constexpr (I8) { _Pragma("unroll") for (int k = 0; k < 2; ++k) _Pragma("unroll") for (int m = 0; m < 4; ++m) _Pragma("unroll") for (int n = 0; n < 2; ++n) \
            asm volatile("v_mfma_i32_16x16x64_i8 %0, %1, %2, %0" : "+v"(acc[ai][bj][m][n]) : "v"(Bt[n][k]), "v"(At[m][k])); } \
        else { _Pragma("unroll") for (int m = 0; m < 4; ++m) _Pragma("unroll") for (int n = 0; n < 2; ++n) { \
        if constexpr (F8) asm volatile("v_mfma_f32_16x16x128_f8f6f4 %0, %1, %2, %0" : "+v"(acc[ai][bj][m][n]) : "v"(PG8_CAT(Bt[n][0], Bt[n][1])), "v"(PG8_CAT(At[m][0], At[m][1])));     \
        else { _Pragma("unroll") for (int k = 0; k < 2; ++k) acc[ai][bj][m][n] = __builtin_amdgcn_mfma_f32_16x16x32_bf16(Bt[n][k], At[m][k], acc[ai][bj][m][n], 0, 0, 0); } } } __builtin_amdgcn_s_setprio(0); } while (0)
#define PG8_MMA0(ai, bj, At, Bt) do { __builtin_amdgcn_s_setprio(1); \
        if constexpr (I8) { _Pragma("unroll") for (int m = 0; m < 4; ++m) _Pragma("unroll") for (int n = 0; n < 2; ++n) asm volatile("v_mfma_i32_16x16x64_i8 %0, %1, %2, 0" : "=&v"(acc[ai][bj][m][n]) : "v"(Bt[n][0]), "v"(At[m][0])); \
            _Pragma("unroll") for (int m = 0; m < 4; ++m) _Pragma("unroll") for (int n = 0; n < 2; ++n) asm volatile("v_mfma_i32_16x16x64_i8 %0, %1, %2, %0" : "+v"(acc[ai][bj][m][n]) : "v"(Bt[n][1]), "v"(At[m][1])); } \
        else { _Pragma("unroll") for (int m = 0; m < 4; ++m) _Pragma("unroll") for (int n = 0; n < 2; ++n) \
            asm volatile("v_mfma_f32_16x16x128_f8f6f4 %0, %1, %2, 0" : "=&v"(acc[ai][bj][m][n]) : "v"(PG8_CAT(Bt[n][0], Bt[n][1])), "v"(PG8_CAT(At[m][0], At[m][1]))); } \
        __builtin_amdgcn_s_setprio(0); } while (0)
#define PG8_MMAZ(ai, bj, At, Bt) do { if (F8 && t == 0) PG8_MMA0(ai, bj, At, Bt); else PG8_MMA(ai, bj, At, Bt); } while (0)
#define PG8_WAIT_V(n) asm volatile("s_waitcnt vmcnt(" #n ")" ::: "memory")
#define PG8_WAIT_L(n) asm volatile("s_waitcnt lgkmcnt(" #n ")" ::: "memory")
#define PG8_BAR __builtin_amdgcn_s_barrier()
#define PG8_SCHED __builtin_amdgcn_sched_barrier(0)
    Unit cur, nxt; int ui = 0;
    if (!S.next(0, cur)) return;
    f32x4 acc[2][2][4][2];
    if constexpr (!F8) {
#pragma unroll
    for (int a = 0; a < 2; ++a)
#pragma unroll
        for (int b = 0; b < 2; ++b)
#pragma unroll
            for (int m = 0; m < 4; ++m)
#pragma unroll
                for (int n = 0; n < 2; ++n) acc[a][b][m][n] = (f32x4){0.f, 0.f, 0.f, 0.f}; }
    bf16x8 At[4][2], B0[2][2], B1[2][2];
    const char* cA = (const char*)g.A + (size_t)cur.pa * tstep; const char* cB = (const char*)g.Bt + (size_t)cur.pb * tstep;
    S.a_ready(cur);
    if constexpr (SP2) {
        PG8_STAGE(PG8_SB(0, 0), cB, voffB); PG8_STAGE(PG8_SB(0, 1), cB + hstep, voffB); PG8_STAGE(PG8_SA(0, 0), cA, voffA); PG8_STAGE(PG8_SA(0, 1), cA + hstep, voffA);
        if (wr == 1) PG8_BAR;
        PG8_WAIT_V(2); PG8_BAR;
        PG8_STAGE(PG8_SB(1, 0), cB + kstep, voffB); PG8_STAGE(PG8_SA(1, 0), cA + kstep, voffA); PG8_STAGE(PG8_SB(1, 1), cB + hstep + kstep, voffB);
        PG8_WAIT_V(6); PG8_BAR;
    } else {
        PG8_STAGE(PG8_SB(0, 0), cB, voffB); PG8_STAGE(PG8_SA(0, 0), cA, voffA); PG8_STAGE(PG8_SB(0, 1), cB + hstep, voffB); PG8_STAGE(PG8_SA(0, 1), cA + hstep, voffA);
        if (wr == 1) PG8_BAR;
        PG8_WAIT_V(4); PG8_BAR;
        PG8_STAGE(PG8_SB(1, 0), cB + kstep, voffB); PG8_STAGE(PG8_SA(1, 0), cA + kstep, voffA); PG8_STAGE(PG8_SB(1, 1), cB + hstep + kstep, voffB);
        PG8_WAIT_V(6); PG8_BAR;
    }
    for (;;) {
        const bool has_next = S.next(ui + 1, nxt);
        const char* nA = has_next ? (const char*)g.A + (size_t)nxt.pa * tstep : cA; const char* nB = has_next ? (const char*)g.Bt + (size_t)nxt.pb * tstep : cB;
        const int ntu = S.ktiles(cur, nt);
        const bool skip1 = F8 && SP2 && cur.sk != 0;
        const bool ka = !Sched::KSKIP || wc < 2, kb = !Sched::KSKIP || wc >= 2;
        for (int t = 0; t < ntu; t += 2) {
            const bool last = (t == ntu - 2);
            const char* a1 = cA + (size_t)(t + 1) * kstep;
            const char* a2 = last ? nA : cA + (size_t)(t + 2) * kstep; const char* b2 = last ? nB : cB + (size_t)(t + 2) * kstep;
            const char* a3 = a2 + kstep; const char* b3 = b2 + kstep;
            if (last && has_next) S.a_ready(nxt);
            if constexpr (SP2) {
            PG8_LDB(B0, 0, 0); PG8_LDB(B1, 0, 1); PG8_SCHED; PG8_LDA(At, 0, 0); PG8_STAGE(PG8_SA(1, 1), a1 + hstep, voffA);
            PG8_WAIT_V(8); PG8_WAIT_L(0); PG8_BAR; if (ka) { PG8_MMAZ(0, 0, At, B0); PG8_MMAZ(0, 1, At, B1); } PG8_BAR; PG8_SCHED;
            PG8_LDA(At, 0, 1); PG8_STAGE(PG8_SB(0, 0), b2, voffB); PG8_STAGE(PG8_SB(0, 1), b2 + hstep, voffB); PG8_STAGE(PG8_SA(0, 0), a2, voffA);
            PG8_WAIT_V(8); PG8_WAIT_L(0); PG8_BAR;
            if (!skip1) { if (ka) { PG8_MMAZ(1, 0, At, B0); PG8_MMAZ(1, 1, At, B1); } }
            else if (t == 0) {
#pragma unroll
                for (int b = 0; b < 2; ++b)
#pragma unroll
                    for (int m = 0; m < 4; ++m)
#pragma unroll
                        for (int n = 0; n < 2; ++n) acc[1][b][m][n] = (f32x4){0.f, 0.f, 0.f, 0.f}; }
            PG8_BAR; PG8_SCHED;
            PG8_LDB(B0, 1, 0); PG8_LDB(B1, 1, 1); PG8_SCHED; PG8_LDA(At, 1, 0); PG8_STAGE(PG8_SA(0, 1), a2 + hstep, voffA);
            PG8_WAIT_V(8); PG8_WAIT_L(0); PG8_BAR; if (kb) { PG8_MMA(0, 0, At, B0); PG8_MMA(0, 1, At, B1); } PG8_BAR; PG8_SCHED;
            PG8_LDA(At, 1, 1); PG8_STAGE(PG8_SB(1, 0), b3, voffB); PG8_STAGE(PG8_SB(1, 1), b3 + hstep, voffB); PG8_STAGE(PG8_SA(1, 0), a3, voffA);
            PG8_WAIT_V(8); PG8_WAIT_L(0); PG8_BAR; if (!skip1 && kb) { PG8_MMA(1, 0, At, B0); PG8_MMA(1, 1, At, B1); } PG8_BAR; PG8_SCHED;
            } else {
            PG8_LDB(B0, 0, 0); PG8_SCHED; PG8_LDA(At, 0, 0); PG8_STAGE(PG8_SA(1, 1), a1 + hstep, voffA);
            PG8_WAIT_L(8); PG8_BAR; PG8_WAIT_L(0); PG8_MMAZ(0, 0, At, B0); PG8_BAR; PG8_SCHED;
            PG8_LDB(B1, 0, 1); PG8_STAGE(PG8_SB(0, 0), b2, voffB);
            PG8_BAR; PG8_WAIT_L(0); PG8_MMAZ(0, 1, At, B1); PG8_BAR;
            PG8_LDA(At, 0, 1); PG8_STAGE(PG8_SA(0, 0), a2, voffA);
            PG8_BAR; PG8_WAIT_L(0); PG8_MMAZ(1, 0, At, B0); PG8_BAR; PG8_SCHED;
            PG8_STAGE(PG8_SB(0, 1), b2 + hstep, voffB);
            PG8_WAIT_V(6); PG8_BAR; PG8_MMAZ(1, 1, At, B1); PG8_BAR;
            PG8_LDB(B0, 1, 0); PG8_SCHED; PG8_LDA(At, 1, 0); PG8_STAGE(PG8_SA(0, 1), a2 + hstep, voffA);
            PG8_WAIT_L(8); PG8_BAR; PG8_WAIT_L(0); PG8_MMA(0, 0, At, B0); PG8_BAR; PG8_SCHED;
            PG8_LDB(B1, 1, 1); PG8_STAGE(PG8_SB(1, 0), b3, voffB);
            PG8_BAR; PG8_WAIT_L(0); PG8_MMA(0, 1, At, B1); PG8_BAR;
            PG8_LDA(At, 1, 1); PG8_STAGE(PG8_SA(1, 0), a3, voffA);
            PG8_BAR; PG8_WAIT_L(0); PG8_MMA(1, 0, At, B0); PG8_BAR; PG8_SCHED;
            PG8_STAGE(PG8_SB(1, 1), b3 + hstep, voffB);
            PG8_WAIT_V(6); PG8_BAR; PG8_MMA(1, 1, At, B1); PG8_BAR;
            }
        }
        if constexpr (ALIGN_EPI) { if (wr == 0) PG8_BAR; }
        if constexpr (F8) asm volatile("s_nop 15\n\ts_nop 15" ::: "memory");
        if constexpr (!Epi::AFTER_DRAIN) { E(acc, cur, wr, wc, fr, fq); S.done(cur); }
        if (!has_next) break;
        if constexpr (!F8) {
#pragma unroll
        for (int a = 0; a < 2; ++a)
#pragma unroll
            for (int b = 0; b < 2; ++b)
#pragma unroll
                for (int m = 0; m < 4; ++m)
#pragma unroll
                    for (int n = 0; n < 2; ++n) acc[a][b][m][n] = (f32x4){0.f, 0.f, 0.f, 0.f}; }
        cur = nxt; cA = nA; cB = nB; ++ui;
        if constexpr (ALIGN_EPI) { if (wr == 1) PG8_BAR; }
    }
    PG8_WAIT_V(0);
    if constexpr (!ALIGN_EPI) { if (wr == 0) PG8_BAR; }
    PG8_BAR;
    if constexpr (Epi::AFTER_DRAIN) { E.fused(acc, cur, wr, wc, fr, fq, lds, wid, lane); S.done(cur); }
#undef PG8_SA
#undef PG8_SB
#undef PG8_STAGE
#undef PG8_LDA
#undef PG8_LDB
#undef PG8_MMA
#undef PG8_MMA0
#undef PG8_MMAZ
#undef PG8_CAT
#undef PG8_WAIT_V
#undef PG8_WAIT_L
#undef PG8_BAR
#undef PG8_SCHED
}
}

#define GAS __attribute__((address_space(1)))
#define LAS __attribute__((address_space(3)))
typedef unsigned short bf16;
typedef unsigned v4u __attribute__((ext_vector_type(4)));
typedef unsigned v2u __attribute__((ext_vector_type(2)));
typedef float f32x4 __attribute__((ext_vector_type(4)));
typedef short bf16x8 __attribute__((ext_vector_type(8)));
typedef GAS unsigned gu32;
typedef GAS unsigned long long gu64;
#define RLX_AGENT __ATOMIC_RELAXED, __HIP_MEMORY_SCOPE_AGENT
#define LDS_WAIT() asm volatile("s_waitcnt lgkmcnt(0)" ::: "memory")
#define VM_WAIT() asm volatile("s_waitcnt vmcnt(0)" ::: "memory")
__device__ __forceinline__ unsigned long long rt() { return __builtin_amdgcn_s_memrealtime(); }
__device__ __forceinline__ unsigned f2bf(float f) { unsigned u = __builtin_bit_cast(unsigned, f); return (u + 0x7fffu + ((u >> 16) & 1u)) >> 16; }
__device__ __forceinline__ unsigned pk2(float lo, float hi) { return f2bf(lo) | (f2bf(hi) << 16); }

#define XB_TMO      128
#define XB_XCNT(j)  (256  + 64 * (j))
#define XB_XSUB(j)  (1280 + 64 * (j))
#define XB_XGEN(j)  (2304 + 64 * (j))
#define XB_TOP      3328
#define XB_TOPGEN   3392
#define XCD_BAR_WORDS 3456
#define XB_SPIN_CAP (1u << 18)

__device__ __forceinline__ unsigned xb_ld(unsigned* p)              { return __hip_atomic_load(p, __ATOMIC_RELAXED, __HIP_MEMORY_SCOPE_AGENT); }
__device__ __forceinline__ unsigned xb_add(unsigned* p, unsigned v) { return __hip_atomic_fetch_add(p, v, __ATOMIC_RELAXED, __HIP_MEMORY_SCOPE_AGENT); }
__device__ __forceinline__ unsigned xb_xcc_id() { return (unsigned)__builtin_amdgcn_s_getreg((3 << 11) | 20) & 0xFu; }
#define XB_SPIN(cond, bar) do { unsigned _sp = 0; while (cond) { __builtin_amdgcn_s_sleep(1); \
    if ((++_sp & 255u) == 0u) { if (xb_ld(&(bar)[XB_TMO])) break; if (_sp > XB_SPIN_CAP) { atomicAdd(&(bar)[XB_TMO], 1u); break; } } } } while (0)

struct XcdBarrier {
    unsigned* bar; unsigned x;
    volatile LAS unsigned* st;
};

__device__ __forceinline__ XcdBarrier xcd_barrier_post(unsigned* bar, volatile LAS unsigned* st) {
    XcdBarrier b; b.bar = bar; b.x = xb_xcc_id(); b.st = st;
    if (threadIdx.x == 0) (void)xb_add(&bar[XB_XCNT(b.x)], 1u);
    return b;
}
__device__ __forceinline__ void xcd_barrier_complete(unsigned* bar, unsigned x, unsigned& nloc, unsigned& nx) {
    const unsigned G = gridDim.x * gridDim.y * gridDim.z;
    unsigned sum, cnt, mine, sp = 0u;
    for (;;) {
        sum = 0u; cnt = 0u; mine = 0u;
#pragma unroll
        for (unsigned j = 0; j < 16; ++j) { const unsigned c = xb_ld(&bar[XB_XCNT(j)]); sum += c; cnt += (c > 0u) ? 1u : 0u; mine = (j == x) ? c : mine; }
        if (sum == G) break;
        __builtin_amdgcn_s_sleep(1);
        if ((++sp & 255u) == 0u) { if (xb_ld(&bar[XB_TMO])) break; if (sp > XB_SPIN_CAP) { atomicAdd(&bar[XB_TMO], 1u); break; } }
    }
    nloc = mine > 0u ? mine : 1u; nx = cnt > 0u ? cnt : 1u;
}

__device__ __forceinline__ void xcd_barrier(const XcdBarrier& b) {
    asm volatile("s_waitcnt vmcnt(0)" ::: "memory");
    __syncthreads();
    unsigned tid0_ = threadIdx.x; asm volatile("" : "+v"(tid0_));
    if (tid0_ == 0) {
        unsigned* bar = b.bar; unsigned bx = b.x;
        asm volatile("" : "+s"(bar), "+s"(bx));
        __builtin_amdgcn_s_waitcnt(0);
        unsigned nloc = b.st[0], nx = b.st[1];
        if (nloc == 0u) { xcd_barrier_complete(bar, bx, nloc, nx); b.st[0] = nloc; b.st[1] = nx; }
        const unsigned old = xb_add(&bar[XB_XSUB(bx)], 1u);
        const unsigned gen = old / nloc;
        if (old + 1u == (gen + 1u) * nloc) {
            __builtin_amdgcn_fence(__ATOMIC_RELEASE, "agent");
            asm volatile("s_waitcnt vmcnt(0)" ::: "memory");
            const unsigned og = xb_add(&bar[XB_TOP], 1u);
            const unsigned tg = og / nx;
            if (og + 1u == (tg + 1u) * nx) xb_add(&bar[XB_TOPGEN], 1u);
            else XB_SPIN(xb_ld(&bar[XB_TOPGEN]) == tg, bar);
            __builtin_amdgcn_fence(__ATOMIC_ACQUIRE, "agent");
            xb_add(&bar[XB_XGEN(bx)], 1u);
            asm volatile("s_waitcnt vmcnt(0)" ::: "memory");
        } else {
            XB_SPIN(xb_ld(&bar[XB_XGEN(bx)]) == gen, bar);
            __builtin_amdgcn_fence(__ATOMIC_ACQUIRE, "agent");
            asm volatile("s_waitcnt vmcnt(0)" ::: "memory");
        }
    }
    __syncthreads();
}

namespace att_online {
#define ALAS __attribute__((address_space(3)))
typedef unsigned short bf16;
typedef short bf16x8 __attribute__((ext_vector_type(8)));
typedef short s16x4 __attribute__((ext_vector_type(4)));
typedef float f32x16 __attribute__((ext_vector_type(16)));
typedef unsigned u32x4 __attribute__((ext_vector_type(4)));
constexpr int SEQ = 16384, NHEAD = 8;
constexpr int QP = 768, KP = 768, VP = 512, OP = 1024;
constexpr int QHS = 96, KHS = 96, VHS = 64, OHS = 64;
constexpr int NW = 8, QBLK = 32, QB = QBLK * NW, KVBLK = 64, NQB = SEQ / QB;
constexpr int KSLOT = 12288, VSLOT = 8192;
constexpr int L_K = 0, L_V = 2 * KSLOT, L_WS = L_V + 2 * VSLOT, L_OST = L_WS + NW * 64 * 4, L_BYTES = L_OST + NW * 4096;
constexpr float THR = 8.0f;
__device__ __forceinline__ int crow(int r, int hi) { return (r & 3) + 8 * (r >> 2) + 4 * hi; }
__device__ __forceinline__ unsigned cvtpk(float lo, float hi) { unsigned r; asm volatile("v_cvt_pk_bf16_f32 %0, %1, %2" : "=v"(r) : "v"(lo), "v"(hi)); return r; }
__device__ __forceinline__ float pswap_max(float m) { auto rr = __builtin_amdgcn_permlane32_swap(__float_as_uint(m), __float_as_uint(m), false, false); return __builtin_fmaxf(__uint_as_float(rr[0]), __uint_as_float(rr[1])); }
__device__ __forceinline__ float pswap_sum(float m) { auto rr = __builtin_amdgcn_permlane32_swap(__float_as_uint(m), __float_as_uint(m), false, false); return __uint_as_float(rr[0]) + __uint_as_float(rr[1]); }

__device__ __forceinline__ void attn_unit(int b, int h, int qb, const bf16* Q, const bf16* K, const bf16* V, bf16* O, ALAS unsigned char* shm) {
    int tid_ = threadIdx.x; asm volatile("" : "+v"(tid_));
    const int tid = tid_, lane = tid & 63, r32 = lane & 31, hi = lane >> 5; const int wid = __builtin_amdgcn_readfirstlane(tid >> 6);
    const long rowbase = (long)b * SEQ; const int q0 = qb * QB;
    const bf16* Qw = Q + (rowbase + q0 + wid * QBLK) * QP + h * QHS;
    const bf16* Kh = K + rowbase * KP + h * KHS; const bf16* Vh = V + rowbase * VP + h * VHS;
    ALAS float* wsf = (ALAS float*)(shm + L_WS) + wid * 64;
    const bf16* ksrc = Kh + (long)lane * KP + wid * 8;
    const bf16* vsrc = Vh + (long)(16 * (wid & 3) + (lane >> 2)) * VP + (wid >> 2) * 32 + (lane & 3) * 8;
#define ATT_DMA(t, slot) do { \
        __builtin_amdgcn_global_load_lds((const unsigned*)(ksrc + (long)(t) * KVBLK * KP), (ALAS unsigned*)(shm + L_K + (slot) * KSLOT + wid * 1024), 16, 0, 0); \
        if (wid < 4) __builtin_amdgcn_global_load_lds((const unsigned*)(ksrc + (long)(t) * KVBLK * KP + 64), (ALAS unsigned*)(shm + L_K + (slot) * KSLOT + (8 + wid) * 1024), 16, 0, 0); \
        __builtin_amdgcn_global_load_lds((const unsigned*)(vsrc + (long)(t) * KVBLK * VP), (ALAS unsigned*)(shm + L_V + (slot) * VSLOT + wid * 1024), 16, 0, 0); } while (0)
    const int NT = (q0 + QB) / KVBLK;
    ATT_DMA(0, 0);
    bf16x8 qr[6];
#pragma unroll
    for (int d0 = 0; d0 < 6; ++d0) qr[d0] = *(const bf16x8*)(Qw + (long)r32 * QP + d0 * 16 + hi * 8);
    float mhat = 0.f, l_reg = 0.f; f32x16 o[2], negm;
#pragma unroll
    for (int r = 0; r < 16; ++r) { o[0][r] = 0.f; o[1][r] = 0.f; negm[r] = 0.f; }
    const int qrel = wid * QBLK + r32;
    const unsigned vb0 = (unsigned)(uintptr_t)(shm + L_V) + ((lane >> 4) & 1) * 32 + (lane & 3) * 8 + (4 * hi + ((lane & 15) >> 2)) * 64;
    for (int t = 0; t < NT; ++t) {
        const int cur = t & 1;
        asm volatile("s_waitcnt vmcnt(0)" ::: "memory"); __syncthreads();
        if (t + 1 < NT) ATT_DMA(t + 1, cur ^ 1);
        f32x16 p0, p1;
        { const ALAS unsigned char* kb = shm + L_K + cur * KSLOT + hi * 1024 + r32 * 16;
#pragma unroll
          for (int d0 = 0; d0 < 6; ++d0) {
              const bf16x8 b0 = *(const ALAS bf16x8*)(kb + d0 * 2048), b1 = *(const ALAS bf16x8*)(kb + d0 * 2048 + 512);
              if (d0 == 0) { p0 = __builtin_amdgcn_mfma_f32_32x32x16_bf16(b0, qr[0], negm, 0, 0, 0); p1 = __builtin_amdgcn_mfma_f32_32x32x16_bf16(b1, qr[0], negm, 0, 0, 0); }
              else { p0 = __builtin_amdgcn_mfma_f32_32x32x16_bf16(b0, qr[d0], p0, 0, 0, 0); p1 = __builtin_amdgcn_mfma_f32_32x32x16_bf16(b1, qr[d0], p1, 0, 0, 0); } } }
        const int jb = t - (NT - 4);
        if (jb >= 0) { const int kb0 = 64 * jb + 4 * hi;
#pragma unroll
            for (int r = 0; r < 16; ++r) { const int kv = kb0 + (r & 3) + 8 * (r >> 2); if (kv > qrel) p0[r] = -__builtin_inff(); if (kv + 32 > qrel) p1[r] = -__builtin_inff(); } }
        float rm = __builtin_fmaxf(p0[0], p1[0]);
#pragma unroll
        for (int r = 1; r < 16; ++r) rm = __builtin_fmaxf(rm, __builtin_fmaxf(p0[r], p1[r]));
        rm = pswap_max(rm);
        bool resc = false;
        if (t == 0 || __any(rm > THR)) {
            const float dl = (t == 0) ? rm : __builtin_fmaxf(rm, 0.f); mhat += dl;
#pragma unroll
            for (int r = 0; r < 16; ++r) { p0[r] -= dl; p1[r] -= dl; negm[r] = -mhat; }
            if (t != 0) { const float f = __builtin_amdgcn_exp2f(-dl); l_reg *= f; if (hi == 0) wsf[r32] = f; resc = true; }
        }
        float sacc = 0.f;
#pragma unroll
        for (int r = 0; r < 16; ++r) { p0[r] = __builtin_amdgcn_exp2f(p0[r]); p1[r] = __builtin_amdgcn_exp2f(p1[r]); sacc += p0[r] + p1[r]; }
        l_reg += sacc;
        if (resc) { asm volatile("s_waitcnt lgkmcnt(0)" ::: "memory");
#pragma unroll
            for (int r = 0; r < 16; ++r) { const float f = wsf[crow(r, hi)]; o[0][r] *= f; o[1][r] *= f; }
            asm volatile("s_waitcnt lgkmcnt(0)" ::: "memory"); }
        u32x4 pw[4];
#pragma unroll
        for (int k = 0; k < 2; ++k) { pw[k] = (u32x4){cvtpk(p0[8 * k], p0[8 * k + 1]), cvtpk(p0[8 * k + 2], p0[8 * k + 3]), cvtpk(p0[8 * k + 4], p0[8 * k + 5]), cvtpk(p0[8 * k + 6], p0[8 * k + 7])};
            pw[2 + k] = (u32x4){cvtpk(p1[8 * k], p1[8 * k + 1]), cvtpk(p1[8 * k + 2], p1[8 * k + 3]), cvtpk(p1[8 * k + 4], p1[8 * k + 5]), cvtpk(p1[8 * k + 6], p1[8 * k + 7])}; }
        { const unsigned vb = vb0 + cur * VSLOT;
#pragma unroll
          for (int d0 = 0; d0 < 2; ++d0) { s16x4 lo[4], hh[4];
#pragma unroll
              for (int ks = 0; ks < 4; ++ks) {
                  asm volatile("ds_read_b64_tr_b16 %0, %1 offset:%c2" : "=&v"(lo[ks]) : "v"(vb), "i"(d0 * 4096 + ks * 1024) : "memory");
                  asm volatile("ds_read_b64_tr_b16 %0, %1 offset:%c2" : "=&v"(hh[ks]) : "v"(vb), "i"(d0 * 4096 + ks * 1024 + 512) : "memory"); }
              asm volatile("s_waitcnt lgkmcnt(0)" : "+v"(lo[0]), "+v"(lo[1]), "+v"(lo[2]), "+v"(lo[3]), "+v"(hh[0]), "+v"(hh[1]), "+v"(hh[2]), "+v"(hh[3]) :: "memory");
#pragma unroll
              for (int ks = 0; ks < 4; ++ks) { const bf16x8 vf = (bf16x8){lo[ks][0], lo[ks][1], lo[ks][2], lo[ks][3], hh[ks][0], hh[ks][1], hh[ks][2], hh[ks][3]};
                  o[d0] = __builtin_amdgcn_mfma_f32_32x32x16_bf16(__builtin_bit_cast(bf16x8, pw[ks]), vf, o[d0], 0, 0, 0); } } }
    }
    l_reg = pswap_sum(l_reg);
    if (hi == 0) wsf[32 + r32] = l_reg;
    asm volatile("s_waitcnt lgkmcnt(0)" ::: "memory");
    float rli[16];
#pragma unroll
    for (int r = 0; r < 16; ++r) rli[r] = __builtin_amdgcn_rcpf(wsf[32 + crow(r, hi)]);
    bf16* Ow = O + (rowbase + q0 + wid * QBLK) * OP + h * OHS;
    { ALAS bf16* stg = (ALAS bf16*)(shm + L_OST) + wid * 2048;
#pragma unroll
      for (int r = 0; r < 16; ++r) { const int orow = crow(r, hi);
#pragma unroll
          for (int d0 = 0; d0 < 2; ++d0) { const float v = o[d0][r] * rli[r]; unsigned u = __float_as_uint(v); u = (u + 0x7fffu + ((u >> 16) & 1u)) >> 16; stg[orow * 64 + d0 * 32 + r32] = (bf16)u; } }
      asm volatile("s_waitcnt lgkmcnt(0)" ::: "memory");
#pragma unroll
      for (int i = 0; i < 4; ++i) { const int row = i * 8 + (lane >> 3), ch = lane & 7; const u32x4 v = *(const ALAS u32x4*)(stg + row * 64 + ch * 8); *(u32x4*)(Ow + (long)row * OP + ch * 8) = v; } }
    asm volatile("s_waitcnt lgkmcnt(0)" ::: "memory"); __syncthreads();
#undef ATT_DMA
}
#undef ALAS
}

namespace att {
#define ALAS __attribute__((address_space(3)))
typedef unsigned short bf16;
typedef short bf16x8 __attribute__((ext_vector_type(8)));
typedef short s16x4 __attribute__((ext_vector_type(4)));
typedef float f32x16 __attribute__((ext_vector_type(16)));
typedef unsigned u32x4 __attribute__((ext_vector_type(4)));
constexpr int SEQ = 16384, NHEAD = 8;
constexpr int QP = 768, KP = 768, VP = 512, OP = 1024;
constexpr int QHS = 96, KHS = 96, VHS = 64, OHS = 64;
constexpr int NW = 8, QBLK = 32, QB = QBLK * NW, KVBLK = 64, NQB = SEQ / QB;
constexpr int KSLOT = 12288, VSLOT = 8192;
constexpr int L_K = 0, L_V = 2 * KSLOT, L_WS = L_V + 3 * VSLOT, L_OST = L_WS + NW * 64 * 4, L_BYTES = L_OST + NW * 4096;
constexpr float THR = 8.0f;
__device__ __forceinline__ int crow(int r, int hi) { return (r & 3) + 8 * (r >> 2) + 4 * hi; }
__device__ __forceinline__ unsigned cvtpk(float lo, float hi) { typedef float f32x2_t __attribute__((ext_vector_type(2))); typedef __bf16 bf16x2_t __attribute__((ext_vector_type(2)));
    f32x2_t v = {lo, hi}; bf16x2_t b = __builtin_convertvector(v, bf16x2_t); return __builtin_bit_cast(unsigned, b); }
__device__ __forceinline__ float pswap_max(float m) { auto rr = __builtin_amdgcn_permlane32_swap(__float_as_uint(m), __float_as_uint(m), false, false); return __builtin_fmaxf(__uint_as_float(rr[0]), __uint_as_float(rr[1])); }
__device__ __forceinline__ float pswap_sum(float m) { auto rr = __builtin_amdgcn_permlane32_swap(__float_as_uint(m), __float_as_uint(m), false, false); return __uint_as_float(rr[0]) + __uint_as_float(rr[1]); }
typedef short v4i16_t __attribute__((ext_vector_type(4)));
__device__ __forceinline__ s16x4 vtr(const ALAS unsigned char* p) { return __builtin_bit_cast(s16x4, __builtin_amdgcn_ds_read_tr16_b64_v4i16((ALAS v4i16_t*)p)); }
__device__ __forceinline__ void qkt(f32x16& s0, f32x16& s1, const ALAS unsigned char* kb, const bf16x8 (&qr)[6]) {
    const f32x16 c0 = {};
#pragma unroll
    for (int d0 = 0; d0 < 6; ++d0) {
        const bf16x8 b0 = *(const ALAS bf16x8*)(kb + d0 * 2048), b1 = *(const ALAS bf16x8*)(kb + d0 * 2048 + 512);
        if (d0 == 0) { s0 = __builtin_amdgcn_mfma_f32_32x32x16_bf16(b0, qr[0], c0, 0, 0, 0); s1 = __builtin_amdgcn_mfma_f32_32x32x16_bf16(b1, qr[0], c0, 0, 0, 0); }
        else { s0 = __builtin_amdgcn_mfma_f32_32x32x16_bf16(b0, qr[d0], s0, 0, 0, 0); s1 = __builtin_amdgcn_mfma_f32_32x32x16_bf16(b1, qr[d0], s1, 0, 0, 0); } }
}
__device__ __forceinline__ void pv(f32x16 (&o)[2], const ALAS unsigned char* vp, const u32x4 (&pk)[4]) {
#pragma unroll
    for (int ks = 0; ks < 4; ++ks)
#pragma unroll
        for (int d0 = 0; d0 < 2; ++d0) { const s16x4 lo = vtr(vp + d0 * 4096 + ks * 1024), hh = vtr(vp + d0 * 4096 + ks * 1024 + 512);
            const bf16x8 vf = (bf16x8){lo[0], lo[1], lo[2], lo[3], hh[0], hh[1], hh[2], hh[3]};
            o[d0] = __builtin_amdgcn_mfma_f32_32x32x16_bf16(__builtin_bit_cast(bf16x8, pk[ks]), vf, o[d0], 0, 0, 0); }
}

constexpr float ATT_MREF_MAX = 40.0f;
#define ATT_SBAR() __builtin_amdgcn_sched_barrier(0)
#define ATT_PIN(x) asm volatile("" : "+v"(x))
#define ATT_VLOAD(i) do { if (VAR == 1) break; const s16x4 lo_ = vtr(vfrag + ((i) & 1) * 4096 + ((i) >> 1) * 1024), hi_ = vtr(vfrag + ((i) & 1) * 4096 + ((i) >> 1) * 1024 + 512); vfr[i] = (bf16x8){lo_[0], lo_[1], lo_[2], lo_[3], hi_[0], hi_[1], hi_[2], hi_[3]}; } while (0)
#define ATT_KLOAD(j) do { if (QK && VAR != 1) kfr[j] = *(const ALAS bf16x8*)(kfrag + ((j) >> 1) * 2048 + ((j) & 1) * 512); } while (0)
template <bool QK, int VAR = 0>
__device__ __forceinline__ void attn_step(f32x16& c0, f32x16& c1, f32x16& n0, f32x16& n1, u32x4 (&pk)[4], f32x16 (&o)[2], float& l_reg, const bf16x8 (&qr)[6],
                                          const ALAS unsigned char* kfrag, const ALAS unsigned char* vfrag, int jb, int qrel, int hi) {
    if (jb >= 0) { const int kbase = 64 * jb + 4 * hi;
#pragma unroll
        for (int r = 0; r < 16; ++r) { const int kv = kbase + (r & 3) + 8 * (r >> 2); if (kv > qrel) c0[r] = -__builtin_inff(); if (kv + 32 > qrel) c1[r] = -__builtin_inff(); } }
    bf16x8 vfr[8] = {}, kfr[12] = {}; float sa = 0.f, sb = 0.f; const f32x16 zero16 = {};
    ATT_VLOAD(0); ATT_VLOAD(1); ATT_SBAR();
      if (VAR != 4) o[0] = __builtin_amdgcn_mfma_f32_32x32x16_bf16(__builtin_bit_cast(bf16x8, pk[0]), vfr[0], o[0], 0, 0, 0); if (VAR != 2) { c0[0] = __builtin_amdgcn_exp2f(c0[0]); c0[1] = __builtin_amdgcn_exp2f(c0[1]); } ATT_VLOAD(2); ATT_PIN(c0); ATT_SBAR();
      if (VAR != 4) o[1] = __builtin_amdgcn_mfma_f32_32x32x16_bf16(__builtin_bit_cast(bf16x8, pk[0]), vfr[1], o[1], 0, 0, 0); if (VAR != 2) { c0[2] = __builtin_amdgcn_exp2f(c0[2]); c0[3] = __builtin_amdgcn_exp2f(c0[3]); } if (VAR != 2) { sa += c0[0]; sa += c0[1]; } ATT_VLOAD(3); ATT_PIN(c0); ATT_PIN(sa); ATT_SBAR();
      if (VAR != 4) o[0] = __builtin_amdgcn_mfma_f32_32x32x16_bf16(__builtin_bit_cast(bf16x8, pk[1]), vfr[2], o[0], 0, 0, 0); if (VAR != 2) { c0[4] = __builtin_amdgcn_exp2f(c0[4]); c0[5] = __builtin_amdgcn_exp2f(c0[5]); } if (VAR != 2) { sa += c0[2]; sa += c0[3]; } ATT_VLOAD(4); ATT_PIN(c0); ATT_PIN(sa); ATT_SBAR();
      if (VAR != 4) o[1] = __builtin_amdgcn_mfma_f32_32x32x16_bf16(__builtin_bit_cast(bf16x8, pk[1]), vfr[3], o[1], 0, 0, 0); if (VAR != 2) { c0[6] = __builtin_amdgcn_exp2f(c0[6]); c0[7] = __builtin_amdgcn_exp2f(c0[7]); } if (VAR != 2) { sa += c0[4]; sa += c0[5]; } ATT_VLOAD(5); ATT_PIN(c0); ATT_PIN(sa); ATT_SBAR();
      if (VAR != 4) o[0] = __builtin_amdgcn_mfma_f32_32x32x16_bf16(__builtin_bit_cast(bf16x8, pk[2]), vfr[4], o[0], 0, 0, 0); if (VAR != 2) { c0[8] = __builtin_amdgcn_exp2f(c0[8]); c0[9] = __builtin_amdgcn_exp2f(c0[9]); } if (VAR != 2) { sa += c0[6]; sa += c0[7]; } if (VAR != 2) { pk[0].x = cvtpk(c0[0], c0[1]); pk[0].y = cvtpk(c0[2], c0[3]); } ATT_VLOAD(6); ATT_PIN(c0); ATT_PIN(pk[0]); ATT_PIN(sa); ATT_SBAR();
      if (VAR != 4) o[1] = __builtin_amdgcn_mfma_f32_32x32x16_bf16(__builtin_bit_cast(bf16x8, pk[2]), vfr[5], o[1], 0, 0, 0); if (VAR != 2) { c0[10] = __builtin_amdgcn_exp2f(c0[10]); c0[11] = __builtin_amdgcn_exp2f(c0[11]); } if (VAR != 2) { sa += c0[8]; sa += c0[9]; } if (VAR != 2) { pk[0].z = cvtpk(c0[4], c0[5]); pk[0].w = cvtpk(c0[6], c0[7]); } ATT_VLOAD(7); ATT_PIN(c0); ATT_PIN(pk[0]); ATT_PIN(sa); ATT_SBAR();
      if (VAR != 4) o[0] = __builtin_amdgcn_mfma_f32_32x32x16_bf16(__builtin_bit_cast(bf16x8, pk[3]), vfr[6], o[0], 0, 0, 0); if (VAR != 2) { c0[12] = __builtin_amdgcn_exp2f(c0[12]); c0[13] = __builtin_amdgcn_exp2f(c0[13]); } if (VAR != 2) { sa += c0[10]; sa += c0[11]; } ATT_KLOAD(0); ATT_PIN(c0); ATT_PIN(sa); ATT_SBAR();
      if (VAR != 4) o[1] = __builtin_amdgcn_mfma_f32_32x32x16_bf16(__builtin_bit_cast(bf16x8, pk[3]), vfr[7], o[1], 0, 0, 0); if (VAR != 2) { c0[14] = __builtin_amdgcn_exp2f(c0[14]); c0[15] = __builtin_amdgcn_exp2f(c0[15]); } if (VAR != 2) { sa += c0[12]; sa += c0[13]; } ATT_KLOAD(1); ATT_PIN(c0); ATT_PIN(sa); ATT_SBAR();
      if (QK && VAR != 4) n0 = __builtin_amdgcn_mfma_f32_32x32x16_bf16(kfr[0], qr[0], zero16, 0, 0, 0); if (VAR != 2) { c1[0] = __builtin_amdgcn_exp2f(c1[0]); c1[1] = __builtin_amdgcn_exp2f(c1[1]); } if (VAR != 2) { sa += c0[14]; sa += c0[15]; } if (VAR != 2) { pk[1].x = cvtpk(c0[8], c0[9]); pk[1].y = cvtpk(c0[10], c0[11]); } ATT_KLOAD(2); ATT_PIN(c1); ATT_PIN(pk[1]); ATT_PIN(sa); ATT_SBAR();
      if (QK && VAR != 4) n1 = __builtin_amdgcn_mfma_f32_32x32x16_bf16(kfr[1], qr[0], zero16, 0, 0, 0); if (VAR != 2) { c1[2] = __builtin_amdgcn_exp2f(c1[2]); c1[3] = __builtin_amdgcn_exp2f(c1[3]); } if (VAR != 2) { sb += c1[0]; sb += c1[1]; } if (VAR != 2) { pk[1].z = cvtpk(c0[12], c0[13]); pk[1].w = cvtpk(c0[14], c0[15]); } ATT_KLOAD(3); ATT_PIN(c1); ATT_PIN(pk[1]); ATT_PIN(sb); ATT_SBAR();
      if (QK && VAR != 4) n0 = __builtin_amdgcn_mfma_f32_32x32x16_bf16(kfr[2], qr[1], n0, 0, 0, 0); if (VAR != 2) { c1[4] = __builtin_amdgcn_exp2f(c1[4]); c1[5] = __builtin_amdgcn_exp2f(c1[5]); } if (VAR != 2) { sb += c1[2]; sb += c1[3]; } ATT_KLOAD(4); ATT_PIN(c1); ATT_PIN(sb); ATT_SBAR();
      if (QK && VAR != 4) n1 = __builtin_amdgcn_mfma_f32_32x32x16_bf16(kfr[3], qr[1], n1, 0, 0, 0); if (VAR != 2) { c1[6] = __builtin_amdgcn_exp2f(c1[6]); c1[7] = __builtin_amdgcn_exp2f(c1[7]); } if (VAR != 2) { sb += c1[4]; sb += c1[5]; } ATT_KLOAD(5); ATT_PIN(c1); ATT_PIN(sb); ATT_SBAR();
      if (QK && VAR != 4) n0 = __builtin_amdgcn_mfma_f32_32x32x16_bf16(kfr[4], qr[2], n0, 0, 0, 0); if (VAR != 2) { c1[8] = __builtin_amdgcn_exp2f(c1[8]); c1[9] = __builtin_amdgcn_exp2f(c1[9]); } if (VAR != 2) { sb += c1[6]; sb += c1[7]; } if (VAR != 2) { pk[2].x = cvtpk(c1[0], c1[1]); pk[2].y = cvtpk(c1[2], c1[3]); } ATT_KLOAD(6); ATT_PIN(c1); ATT_PIN(pk[2]); ATT_PIN(sb); ATT_SBAR();
      if (QK && VAR != 4) n1 = __builtin_amdgcn_mfma_f32_32x32x16_bf16(kfr[5], qr[2], n1, 0, 0, 0); if (VAR != 2) { c1[10] = __builtin_amdgcn_exp2f(c1[10]); c1[11] = __builtin_amdgcn_exp2f(c1[11]); } if (VAR != 2) { sb += c1[8]; sb += c1[9]; } if (VAR != 2) { pk[2].z = cvtpk(c1[4], c1[5]); pk[2].w = cvtpk(c1[6], c1[7]); } ATT_KLOAD(7); ATT_PIN(c1); ATT_PIN(pk[2]); ATT_PIN(sb); ATT_SBAR();
      if (QK && VAR != 4) n0 = __builtin_amdgcn_mfma_f32_32x32x16_bf16(kfr[6], qr[3], n0, 0, 0, 0); if (VAR != 2) { c1[12] = __builtin_amdgcn_exp2f(c1[12]); c1[13] = __builtin_amdgcn_exp2f(c1[13]); } if (VAR != 2) { sb += c1[10]; sb += c1[11]; } ATT_KLOAD(8); ATT_PIN(c1); ATT_PIN(sb); ATT_SBAR();
      if (QK && VAR != 4) n1 = __builtin_amdgcn_mfma_f32_32x32x16_bf16(kfr[7], qr[3], n1, 0, 0, 0); if (VAR != 2) { c1[14] = __builtin_amdgcn_exp2f(c1[14]); c1[15] = __builtin_amdgcn_exp2f(c1[15]); } if (VAR != 2) { sb += c1[12]; sb += c1[13]; } ATT_KLOAD(9); ATT_PIN(c1); ATT_PIN(sb); ATT_SBAR();
      if (QK && VAR != 4) n0 = __builtin_amdgcn_mfma_f32_32x32x16_bf16(kfr[8], qr[4], n0, 0, 0, 0); if (VAR != 2) { sb += c1[14]; sb += c1[15]; } if (VAR != 2) { pk[3].x = cvtpk(c1[8], c1[9]); pk[3].y = cvtpk(c1[10], c1[11]); } ATT_KLOAD(10); ATT_PIN(pk[3]); ATT_PIN(sb); ATT_SBAR();
      if (QK && VAR != 4) n1 = __builtin_amdgcn_mfma_f32_32x32x16_bf16(kfr[9], qr[4], n1, 0, 0, 0); if (VAR != 2) { pk[3].z = cvtpk(c1[12], c1[13]); pk[3].w = cvtpk(c1[14], c1[15]); } ATT_KLOAD(11); ATT_PIN(pk[3]); ATT_SBAR();
      if (QK && VAR != 4) n0 = __builtin_amdgcn_mfma_f32_32x32x16_bf16(kfr[10], qr[5], n0, 0, 0, 0); ATT_SBAR();
      if (QK && VAR != 4) n1 = __builtin_amdgcn_mfma_f32_32x32x16_bf16(kfr[11], qr[5], n1, 0, 0, 0); ATT_SBAR();
    l_reg += sa + sb;
}
#undef ATT_VLOAD
#undef ATT_KLOAD

template <int VAR = 0>
__device__ __forceinline__ void attn_unit(int b, int h, int qb, const bf16* Q, const bf16* K, const bf16* V, bf16* O, ALAS unsigned char* shm, int OPR = OP) {
    int tid_ = threadIdx.x; asm volatile("" : "+v"(tid_));
    const int tid = tid_, lane = tid & 63, r32 = lane & 31, hi = lane >> 5; const int wid = __builtin_amdgcn_readfirstlane(tid >> 6);
    const long rowbase = (long)b * SEQ; const int q0 = qb * QB;
    const bf16* Qw = Q + (rowbase + q0 + wid * QBLK) * QP + h * QHS;
    const bf16* Kh = K + rowbase * KP + h * KHS; const bf16* Vh = V + rowbase * VP + h * VHS;
    ALAS float* wsf = (ALAS float*)(shm + L_WS) + wid * 64;
    const bf16* ksrc = Kh + (long)lane * KP + wid * 8;
    const bf16* vsrc = Vh + (long)(16 * (wid & 3) + (lane >> 2)) * VP + (wid >> 2) * 32 + (lane & 3) * 8;
#define ATT_DMA_K(t, slot) do { \
        __builtin_amdgcn_global_load_lds((const unsigned*)(ksrc + (long)(t) * KVBLK * KP), (ALAS unsigned*)(shm + L_K + (slot) * KSLOT + wid * 1024), 16, 0, 0); \
        if (wid < 4) __builtin_amdgcn_global_load_lds((const unsigned*)(ksrc + (long)(t) * KVBLK * KP + 64), (ALAS unsigned*)(shm + L_K + (slot) * KSLOT + (8 + wid) * 1024), 16, 0, 0); } while (0)
#define ATT_DMA_V(t, slotoff) __builtin_amdgcn_global_load_lds((const unsigned*)(vsrc + (long)(t) * KVBLK * VP), (ALAS unsigned*)(shm + L_V + (slotoff) + wid * 1024), 16, 0, 0)
    const int NT = (q0 + QB) / KVBLK;
    ATT_DMA_K(0, 0); ATT_DMA_V(0, 0); ATT_DMA_K(1, 1);
    bf16x8 qr[6];
#pragma unroll
    for (int d0 = 0; d0 < 6; ++d0) qr[d0] = *(const bf16x8*)(Qw + (long)r32 * QP + d0 * 16 + hi * 8);
    float l_reg = 0.f; f32x16 o[2];
#pragma unroll
    for (int r = 0; r < 16; ++r) { o[0][r] = 0.f; o[1][r] = 0.f; }
    const int qrel = wid * QBLK + r32;
    const ALAS unsigned char* kb0 = shm + L_K + hi * 1024 + r32 * 16;
    const ALAS unsigned char* vp0 = shm + L_V + ((lane >> 4) & 1) * 32 + (lane & 3) * 8 + (4 * hi + ((lane & 15) >> 2)) * 64;
    asm volatile("s_waitcnt vmcnt(0)" ::: "memory"); __syncthreads();
    f32x16 sA0, sA1, sB0, sB1;
    qkt(sA0, sA1, kb0, qr);
    u32x4 pk[4] = {};
    int vs_prev = 0, vs_cur = 0, vs_next = VSLOT;
#define ATT_TOP(t) do { if (VAR == 3) break; asm volatile("s_waitcnt vmcnt(0)" ::: "memory"); __syncthreads();        \
        if ((t) + 2 < NT) ATT_DMA_K((t) + 2, (t) & 1); if ((t) + 1 < NT) ATT_DMA_V((t) + 1, vs_next); } while (0)
#define ATT_ROT() do { vs_prev = vs_cur; vs_cur = vs_next; vs_next = (vs_next == 2 * VSLOT) ? 0 : vs_next + VSLOT; } while (0)
    int t = 0;
    for (; t < NT - 2; t += 2) {
        ATT_TOP(t);
        attn_step<true, VAR>(sA0, sA1, sB0, sB1, pk, o, l_reg, qr, kb0 + KSLOT, vp0 + vs_prev, t - (NT - 4), qrel, hi);
        ATT_ROT();
        ATT_TOP(t + 1);
        attn_step<true, VAR>(sB0, sB1, sA0, sA1, pk, o, l_reg, qr, kb0, vp0 + vs_prev, t + 1 - (NT - 4), qrel, hi);
        ATT_ROT();
    }
    ATT_TOP(t);
    attn_step<true, VAR>(sA0, sA1, sB0, sB1, pk, o, l_reg, qr, kb0 + KSLOT, vp0 + vs_prev, 2, qrel, hi);
    ATT_ROT();
    ATT_TOP(t + 1);
    attn_step<false, VAR>(sB0, sB1, sA0, sA1, pk, o, l_reg, qr, kb0, vp0 + vs_prev, 3, qrel, hi);
    ATT_ROT();
    pv(o, vp0 + vs_prev, pk);
    l_reg = pswap_sum(l_reg);
    if (hi == 0) wsf[32 + r32] = l_reg;
    float rli[16];
#pragma unroll
    for (int r = 0; r < 16; ++r) rli[r] = __builtin_amdgcn_rcpf(wsf[32 + crow(r, hi)]);
    bf16* Ow = O + (rowbase + q0 + wid * QBLK) * OPR + h * OHS;
    { ALAS bf16* stg = (ALAS bf16*)(shm + L_OST) + wid * 2048;
#pragma unroll
      for (int r = 0; r < 16; ++r) { const int orow = crow(r, hi);
#pragma unroll
          for (int d0 = 0; d0 < 2; ++d0) { const float v = o[d0][r] * rli[r]; unsigned u = __float_as_uint(v); u = (u + 0x7fffu + ((u >> 16) & 1u)) >> 16; stg[orow * 64 + d0 * 32 + r32] = (bf16)u; } }
#pragma unroll
      for (int i = 0; i < 4; ++i) { const int row = i * 8 + (lane >> 3), ch = lane & 7; const u32x4 v = *(const ALAS u32x4*)(stg + row * 64 + ch * 8); *(u32x4*)(Ow + (long)row * OPR + ch * 8) = v; } }
    __syncthreads();
#undef ATT_DMA_K
#undef ATT_DMA_V
#undef ATT_TOP
#undef ATT_ROT
}
#undef ALAS
}

namespace att2 {
#define ALAS __attribute__((address_space(3)))
using att::bf16; using att::bf16x8; using att::s16x4; using att::f32x16; using att::u32x4; using att::crow; using att::cvtpk; using att::pswap_sum; using att::vtr;
constexpr int SEQ = 16384, QP = 768, KP = 768, VP = 512, OP = 1024, QHS = 96, KHS = 96, VHS = 64, OHS = 64;
constexpr int NW = 8, QB = 512, KVBLK = 64, NQB = SEQ / QB;
constexpr int KSLOT = 12288, VSLOT = 8192;
constexpr int L_K = 0, L_V = 2 * KSLOT, L_WS = L_V + 2 * VSLOT, L_OST = L_WS + NW * 64 * 4, L_BYTES = L_OST + NW * 4096;
__device__ __forceinline__ void softmax_pack(f32x16& p0, f32x16& p1, u32x4 (&pk)[4], float& l_reg) {
    float sa = 0.f, sb = 0.f;
#pragma unroll
    for (int r = 0; r < 16; ++r) { p0[r] = __builtin_amdgcn_exp2f(p0[r]); p1[r] = __builtin_amdgcn_exp2f(p1[r]); sa += p0[r]; sb += p1[r]; }
    l_reg += sa + sb;
#pragma unroll
    for (int k = 0; k < 2; ++k) { pk[k] = (u32x4){cvtpk(p0[8 * k], p0[8 * k + 1]), cvtpk(p0[8 * k + 2], p0[8 * k + 3]), cvtpk(p0[8 * k + 4], p0[8 * k + 5]), cvtpk(p0[8 * k + 6], p0[8 * k + 7])};
        pk[2 + k] = (u32x4){cvtpk(p1[8 * k], p1[8 * k + 1]), cvtpk(p1[8 * k + 2], p1[8 * k + 3]), cvtpk(p1[8 * k + 4], p1[8 * k + 5]), cvtpk(p1[8 * k + 6], p1[8 * k + 7])}; }
}
__device__ __forceinline__ void attn_unit(int b, int h, int qb, const bf16* Q, const bf16* K, const bf16* V, bf16* O, ALAS unsigned char* shm, float* SS = nullptr, unsigned* gcnt = nullptr, unsigned* gbar = nullptr, const float* ogain = nullptr) {
    int tid_ = threadIdx.x; asm volatile("" : "+v"(tid_));
    const int tid = tid_, lane = tid & 63, r32 = lane & 31, hi = lane >> 5; const int wid = __builtin_amdgcn_readfirstlane(tid >> 6);
    const long rowbase = (long)b * SEQ; const int q0 = qb * QB;
    const bf16* Qw = Q + (rowbase + q0 + wid * 64) * QP + h * QHS;
    const bf16* Kh = K + rowbase * KP + h * KHS; const bf16* Vh = V + rowbase * VP + h * VHS;
    ALAS float* wsf = (ALAS float*)(shm + L_WS) + wid * 64;
    const bf16* ksrc = Kh + (long)lane * KP + wid * 8;
    const bf16* vsrc = Vh + (long)(16 * (wid & 3) + (lane >> 2)) * VP + (wid >> 2) * 32 + (lane & 3) * 8;
#define ATT_DMA(t, slot) do { \
        __builtin_amdgcn_global_load_lds((const unsigned*)(ksrc + (long)(t) * KVBLK * KP), (ALAS unsigned*)(shm + L_K + (slot) * KSLOT + wid * 1024), 16, 0, 0); \
        if (wid < 4) __builtin_amdgcn_global_load_lds((const unsigned*)(ksrc + (long)(t) * KVBLK * KP + 64), (ALAS unsigned*)(shm + L_K + (slot) * KSLOT + (8 + wid) * 1024), 16, 0, 0); \
        __builtin_amdgcn_global_load_lds((const unsigned*)(vsrc + (long)(t) * KVBLK * VP), (ALAS unsigned*)(shm + L_V + (slot) * VSLOT + wid * 1024), 16, 0, 0); } while (0)
    const int NT = (q0 + QB) / KVBLK;
    ATT_DMA(0, 0);
    bf16x8 qa[6], qb_[6];
#pragma unroll
    for (int d0 = 0; d0 < 6; ++d0) { qa[d0] = *(const bf16x8*)(Qw + (long)r32 * QP + d0 * 16 + hi * 8); qb_[d0] = *(const bf16x8*)(Qw + (long)(32 + r32) * QP + d0 * 16 + hi * 8); }
    float la = 0.f, lb = 0.f; f32x16 oa[2], ob[2];
#pragma unroll
    for (int r = 0; r < 16; ++r) { oa[0][r] = 0.f; oa[1][r] = 0.f; ob[0][r] = 0.f; ob[1][r] = 0.f; }
    const ALAS unsigned char* kb0 = shm + L_K + hi * 1024 + r32 * 16;
    const ALAS unsigned char* vp0 = shm + L_V + ((lane >> 4) & 1) * 32 + (lane & 3) * 8 + (4 * hi + ((lane & 15) >> 2)) * 64;
    for (int t = 0; t < NT; ++t) {
        const int cur = t & 1;
        asm volatile("s_waitcnt vmcnt(0)" ::: "memory"); __syncthreads();
        if (t + 1 < NT) ATT_DMA(t + 1, cur ^ 1);
        const int jb = t - (NT - 8);
        if (jb > wid) continue;
        f32x16 pa0, pa1, pb0, pb1; const f32x16 z16 = {};
        { const ALAS unsigned char* kb = kb0 + cur * KSLOT;
#pragma unroll
          for (int d0 = 0; d0 < 6; ++d0) {
              const bf16x8 k0 = *(const ALAS bf16x8*)(kb + d0 * 2048), k1 = *(const ALAS bf16x8*)(kb + d0 * 2048 + 512);
              pa0 = __builtin_amdgcn_mfma_f32_32x32x16_bf16(k0, qa[d0], d0 == 0 ? z16 : pa0, 0, 0, 0); pa1 = __builtin_amdgcn_mfma_f32_32x32x16_bf16(k1, qa[d0], d0 == 0 ? z16 : pa1, 0, 0, 0);
              pb0 = __builtin_amdgcn_mfma_f32_32x32x16_bf16(k0, qb_[d0], d0 == 0 ? z16 : pb0, 0, 0, 0); pb1 = __builtin_amdgcn_mfma_f32_32x32x16_bf16(k1, qb_[d0], d0 == 0 ? z16 : pb1, 0, 0, 0); } }
        if (jb == wid) {
#pragma unroll
            for (int r = 0; r < 16; ++r) { const int kv = 4 * hi + (r & 3) + 8 * (r >> 2);
                if (kv > r32) pa0[r] = -__builtin_inff();
                pa1[r] = -__builtin_inff();
                if (kv > r32) pb1[r] = -__builtin_inff(); }
        }
        u32x4 pka[4], pkb[4];
        softmax_pack(pa0, pa1, pka, la); softmax_pack(pb0, pb1, pkb, lb);
        { const ALAS unsigned char* vp = vp0 + cur * VSLOT;
#pragma unroll
          for (int ks = 0; ks < 4; ++ks)
#pragma unroll
              for (int d0 = 0; d0 < 2; ++d0) { const s16x4 lo = vtr(vp + d0 * 4096 + ks * 1024), hh = vtr(vp + d0 * 4096 + ks * 1024 + 512);
                  const bf16x8 vf = (bf16x8){lo[0], lo[1], lo[2], lo[3], hh[0], hh[1], hh[2], hh[3]};
                  oa[d0] = __builtin_amdgcn_mfma_f32_32x32x16_bf16(__builtin_bit_cast(bf16x8, pka[ks]), vf, oa[d0], 0, 0, 0);
                  ob[d0] = __builtin_amdgcn_mfma_f32_32x32x16_bf16(__builtin_bit_cast(bf16x8, pkb[ks]), vf, ob[d0], 0, 0, 0); } }
    }
    u32x4 held[2][4];
#pragma unroll
    for (int blk = 0; blk < 2; ++blk) {
        float l_reg = pswap_sum(blk == 0 ? la : lb);
        if (hi == 0) wsf[32 + r32] = l_reg;
        float rli[16];
#pragma unroll
        for (int r = 0; r < 16; ++r) rli[r] = __builtin_amdgcn_rcpf(wsf[32 + crow(r, hi)]);
        bf16* Ow = O + (rowbase + q0 + wid * 64 + blk * 32) * OP + h * OHS;
        ALAS bf16* stg = (ALAS bf16*)(shm + L_OST) + wid * 2048;
#pragma unroll
        for (int r = 0; r < 16; ++r) { const int orow = crow(r, hi);
#pragma unroll
            for (int d0 = 0; d0 < 2; ++d0) { const float v = (blk == 0 ? oa[d0][r] : ob[d0][r]) * rli[r]; unsigned u = __float_as_uint(v); u = (u + 0x7fffu + ((u >> 16) & 1u)) >> 16; stg[orow * 64 + d0 * 32 + r32] = (bf16)u; } }
#pragma unroll
        for (int i = 0; i < 4; ++i) { const int row = i * 8 + (lane >> 3), ch = lane & 7; const u32x4 v = *(const ALAS u32x4*)(stg + row * 64 + ch * 8);
            if (!SS) *(u32x4*)(Ow + (long)row * OP + ch * 8) = v;
            else { held[blk][i] = v; float s2 = 0.f;
#pragma unroll
                for (int e = 0; e < 4; ++e) { const float lo = __uint_as_float(v[e] << 16), hf = __uint_as_float(v[e] & 0xffff0000u); s2 += lo * lo + hf * hf; }
                s2 += __int_as_float(__builtin_amdgcn_ds_swizzle(__float_as_int(s2), (1 << 10) | 0x1f)); s2 += __int_as_float(__builtin_amdgcn_ds_swizzle(__float_as_int(s2), (2 << 10) | 0x1f)); s2 += __int_as_float(__builtin_amdgcn_ds_swizzle(__float_as_int(s2), (4 << 10) | 0x1f));
                if (ch == 0) SS[(rowbase + q0 + wid * 64 + blk * 32 + row) * 8 + h] = s2; } }
    }
    if (SS) {
        asm volatile("s_waitcnt vmcnt(0)" ::: "memory"); __syncthreads();
        if (tid == 0) { __builtin_amdgcn_fence(__ATOMIC_RELEASE, "agent"); asm volatile("s_waitcnt vmcnt(0)" ::: "memory"); (void)xb_add(gcnt, 1u);
            XB_SPIN(xb_ld(gcnt) < 8u, gbar);
            __builtin_amdgcn_fence(__ATOMIC_ACQUIRE, "agent"); asm volatile("s_waitcnt vmcnt(0)" ::: "memory"); }
        __syncthreads();
        const int ch = lane & 7; typedef float f32x4_ __attribute__((ext_vector_type(4)));
        const f32x4_ g0 = *(const f32x4_*)(ogain + h * 64 + ch * 8), g1 = *(const f32x4_*)(ogain + h * 64 + ch * 8 + 4);
#pragma unroll
        for (int blk = 0; blk < 2; ++blk) { bf16* Ow = O + (rowbase + q0 + wid * 64 + blk * 32) * OP + h * OHS;
            f32x4_ sa[4], sb[4];
#pragma unroll
            for (int i = 0; i < 4; ++i) { const long grow = rowbase + q0 + wid * 64 + blk * 32 + i * 8 + (lane >> 3); sa[i] = *(const f32x4_*)(SS + grow * 8); sb[i] = *(const f32x4_*)(SS + grow * 8 + 4); }
#pragma unroll
            for (int i = 0; i < 4; ++i) { const int row = i * 8 + (lane >> 3); const u32x4 v = held[blk][i];
                const float tot = ((sa[i][0] + sa[i][1]) + (sa[i][2] + sa[i][3])) + ((sb[i][0] + sb[i][1]) + (sb[i][2] + sb[i][3]));
                const float rs = __builtin_amdgcn_rsqf(tot * (1.0f / 512.0f) + 1e-6f);
                float x[8];
#pragma unroll
                for (int e = 0; e < 4; ++e) { x[2 * e] = __uint_as_float(v[e] << 16) * rs; x[2 * e + 1] = __uint_as_float(v[e] & 0xffff0000u) * rs; }
                const u32x4 w = (u32x4){cvtpk(x[0] * g0[0], x[1] * g0[1]), cvtpk(x[2] * g0[2], x[3] * g0[3]), cvtpk(x[4] * g1[0], x[5] * g1[1]), cvtpk(x[6] * g1[2], x[7] * g1[3])};
                *(u32x4*)(Ow + (long)row * OP + ch * 8) = w; } }
    }
    __syncthreads();
#undef ATT_DMA
}
#undef ALAS
}

namespace att3 {
#define ALAS __attribute__((address_space(3)))
using att::bf16; using att::bf16x8; using att::s16x4; using att::f32x16; using att::u32x4; using att::crow; using att::cvtpk; using att::pswap_sum; using att::vtr;
using att2::softmax_pack;
constexpr int SEQ = 16384, QP = 768, KP = 768, VP = 512, OP = 1024, QHS = 96, KHS = 96, VHS = 64, OHS = 64;
constexpr int NW = 8, QB = 512, KVBLK = 64;
constexpr int KSLOT = 12288, VSLOT = 8192;
constexpr int L_K = 0, L_V = 2 * KSLOT, L_WS = L_V + 2 * VSLOT, L_OST = L_WS + NW * 64 * 4, L_BYTES = L_OST + NW * 4096;
__device__ __forceinline__ void attn_unit(int b, int h, int qb, const bf16* Q, const bf16* K, const bf16* V, bf16* O, ALAS unsigned char* shm) {
    int tid_ = threadIdx.x; asm volatile("" : "+v"(tid_));
    const int tid = tid_, lane = tid & 63, r32 = lane & 31, hi = lane >> 5; const int wid = __builtin_amdgcn_readfirstlane(tid >> 6);
    const long rowbase = (long)b * SEQ; const int q0 = qb * QB;
    const bf16* Qw = Q + (rowbase + q0 + wid * 64) * QP + h * QHS;
    const bf16* Kh = K + rowbase * KP + h * KHS; const bf16* Vh = V + rowbase * VP + h * VHS;
    ALAS float* wsf = (ALAS float*)(shm + L_WS) + wid * 64;
    const unsigned lds0 = (unsigned)(uintptr_t)shm;
    const bf16* ksrc = Kh + (long)lane * KP + wid * 8;
    const int kdelta = (8 + (wid & 3) - wid) * 8;
    const bf16* vsrc = Vh + (long)(16 * (wid & 3) + (lane >> 2)) * VP + (wid >> 2) * 32 + (lane & 3) * 8;
#define GLDS16(gsrc, ldsdst) do { unsigned keep_; asm volatile("s_mov_b32 %0, m0\n\ts_mov_b32 m0, %2\n\ts_nop 0\n\tglobal_load_lds_dwordx4 %1, off\n\ts_mov_b32 m0, %0" : "=&s"(keep_) : "v"(gsrc), "s"(ldsdst) : "memory"); } while (0)
#define DMA_K(t, slot) do { GLDS16(ksrc + (long)(t) * KVBLK * KP, (unsigned)__builtin_amdgcn_readfirstlane(lds0 + L_K + (slot) * KSLOT + wid * 1024)); \
        GLDS16(ksrc + ((long)(t) * KVBLK * KP + kdelta), (unsigned)__builtin_amdgcn_readfirstlane(lds0 + L_K + (slot) * KSLOT + (8 + (wid & 3)) * 1024)); } while (0)
#define DMA_V(t, slot) GLDS16(vsrc + (long)(t) * KVBLK * VP, (unsigned)__builtin_amdgcn_readfirstlane(lds0 + L_V + (slot) * VSLOT + wid * 1024))
#define BAR_W(n) do { asm volatile("s_waitcnt vmcnt(" #n ") lgkmcnt(0)" ::: "memory"); __builtin_amdgcn_s_barrier(); asm volatile("" ::: "memory"); } while (0)
#define BAR1(t) do { if ((t) < NT) BAR_W(1); else BAR_W(0); if ((t) + 1 < NT) DMA_K((t) + 1, ((t) + 1) & 1); } while (0)
#define BAR2(t) do { if ((t) + 1 < NT) BAR_W(2); else BAR_W(0); if ((t) + 1 < NT) DMA_V((t) + 1, ((t) + 1) & 1); } while (0)
    const int NT = (q0 + QB) / KVBLK;
    DMA_K(0, 0); DMA_V(0, 0);
    bf16x8 qa[6], qb_[6];
#pragma unroll
    for (int d0 = 0; d0 < 6; ++d0) { qa[d0] = *(const bf16x8*)(Qw + (long)r32 * QP + d0 * 16 + hi * 8); qb_[d0] = *(const bf16x8*)(Qw + (long)(32 + r32) * QP + d0 * 16 + hi * 8); }
    asm volatile("s_waitcnt vmcnt(0)" ::: "memory");
    float la = 0.f, lb = 0.f; f32x16 oa[2], ob[2];
#pragma unroll
    for (int r = 0; r < 16; ++r) { oa[0][r] = 0.f; oa[1][r] = 0.f; ob[0][r] = 0.f; ob[1][r] = 0.f; }
    const ALAS unsigned char* kb0 = shm + L_K + hi * 1024 + r32 * 16;
    const ALAS unsigned char* vp0 = shm + L_V + ((lane >> 4) & 1) * 32 + (lane & 3) * 8 + (4 * hi + ((lane & 15) >> 2)) * 64;
    f32x16 pa0, pa1, pb0, pb1;
#define ALPHA(t) do { if ((t) - (NT - 8) <= wid) { const ALAS unsigned char* kb = kb0 + ((t) & 1) * KSLOT; const f32x16 z16 = {}; \
        bf16x8 k0n = *(const ALAS bf16x8*)(kb), k1n = *(const ALAS bf16x8*)(kb + 512); \
        _Pragma("unroll") for (int d0 = 0; d0 < 6; ++d0) { const bf16x8 k0 = k0n, k1 = k1n; \
            if (d0 < 5) { k0n = *(const ALAS bf16x8*)(kb + (d0 + 1) * 2048); k1n = *(const ALAS bf16x8*)(kb + (d0 + 1) * 2048 + 512); }     \
            pa0 = __builtin_amdgcn_mfma_f32_32x32x16_bf16(k0, qa[d0], d0 == 0 ? z16 : pa0, 0, 0, 0); pa1 = __builtin_amdgcn_mfma_f32_32x32x16_bf16(k1, qa[d0], d0 == 0 ? z16 : pa1, 0, 0, 0); \
            pb0 = __builtin_amdgcn_mfma_f32_32x32x16_bf16(k0, qb_[d0], d0 == 0 ? z16 : pb0, 0, 0, 0); pb1 = __builtin_amdgcn_mfma_f32_32x32x16_bf16(k1, qb_[d0], d0 == 0 ? z16 : pb1, 0, 0, 0); \
            __builtin_amdgcn_sched_barrier(0); } } } while (0)
#define BETA(t) do { const int jb_ = (t) - (NT - 8); if (jb_ <= wid) { \
        if (jb_ == wid) { _Pragma("unroll") for (int r = 0; r < 16; ++r) { const int kv = 4 * hi + (r & 3) + 8 * (r >> 2); \
            if (kv > r32) pa0[r] = -__builtin_inff(); pa1[r] = -__builtin_inff(); if (kv > r32) pb1[r] = -__builtin_inff(); } } \
        u32x4 pka[4], pkb[4]; softmax_pack(pa0, pa1, pka, la); softmax_pack(pb0, pb1, pkb, lb); \
        const ALAS unsigned char* vp = vp0 + ((t) & 1) * VSLOT; \
        _Pragma("unroll") for (int i_ = 0; i_ < 8; ++i_) { const int ks = i_ >> 1, d0 = i_ & 1; \
            const s16x4 lo = vtr(vp + d0 * 4096 + ks * 1024), hh = vtr(vp + d0 * 4096 + ks * 1024 + 512); \
            const bf16x8 vf = (bf16x8){lo[0], lo[1], lo[2], lo[3], hh[0], hh[1], hh[2], hh[3]}; \
            oa[d0] = __builtin_amdgcn_mfma_f32_32x32x16_bf16(__builtin_bit_cast(bf16x8, pka[ks]), vf, oa[d0], 0, 0, 0); \
            ob[d0] = __builtin_amdgcn_mfma_f32_32x32x16_bf16(__builtin_bit_cast(bf16x8, pkb[ks]), vf, ob[d0], 0, 0, 0); \
            __builtin_amdgcn_sched_barrier(0); } } } while (0)
    if (wid < 4) {
        for (int t = 0; t < NT; ++t) { BAR1(t); ALPHA(t); BAR2(t); BETA(t); }
        BAR1(NT); BAR2(NT);
    } else {
        BAR1(0); BAR2(0); ALPHA(0);
        for (int t = 1; t < NT; ++t) { BAR1(t); BETA(t - 1); BAR2(t); ALPHA(t); }
        BAR1(NT); BETA(NT - 1); BAR2(NT);
    }
#pragma unroll
    for (int blk = 0; blk < 2; ++blk) {
        float l_reg = pswap_sum(blk == 0 ? la : lb);
        if (hi == 0) wsf[32 + r32] = l_reg;
        float rli[16];
#pragma unroll
        for (int r = 0; r < 16; ++r) rli[r] = __builtin_amdgcn_rcpf(wsf[32 + crow(r, hi)]);
        bf16* Ow = O + (rowbase + q0 + wid * 64 + blk * 32) * OP + h * OHS;
        ALAS bf16* stg = (ALAS bf16*)(shm + L_OST) + wid * 2048;
#pragma unroll
        for (int r = 0; r < 16; ++r) { const int orow = crow(r, hi);
#pragma unroll
            for (int d0 = 0; d0 < 2; ++d0) { const float v = (blk == 0 ? oa[d0][r] : ob[d0][r]) * rli[r]; unsigned u = __float_as_uint(v); u = (u + 0x7fffu + ((u >> 16) & 1u)) >> 16; stg[orow * 64 + d0 * 32 + r32] = (bf16)u; } }
#pragma unroll
        for (int i = 0; i < 4; ++i) { const int row = i * 8 + (lane >> 3), ch = lane & 7; const u32x4 v = *(const ALAS u32x4*)(stg + row * 64 + ch * 8); *(u32x4*)(Ow + (long)row * OP + ch * 8) = v; }
    }
    asm volatile("s_waitcnt vmcnt(0) lgkmcnt(0)" ::: "memory"); __syncthreads();
#undef GLDS16
#undef DMA_K
#undef DMA_V
#undef BAR_W
#undef BAR1
#undef BAR2
#undef ALPHA
#undef BETA
}
#undef ALAS
}

constexpr int NB = 2, SEQ = 16384, D = 1024, NTOK = NB * SEQ, DEPTH = 4;
constexpr int INCOLS = 1440, INP = 1536;
constexpr int UPK = 384, UPN = 1792;
constexpr int LRUW = 512;
constexpr int DFF = 2816, NEXP = 8, DFE = 3584;
constexpr int MOE_TILES = (2 * NTOK) / 256 + NEXP;
constexpr float EPS = 1e-6f;
constexpr int NWAVES = 8;

constexpr size_t MiB = 1u << 20;
constexpr size_t WS_CTL = 0, CTL_ZERO_BYTES = 1 * MiB;
constexpr size_t WS_MREF = 6 * MiB + 64 * 1024;
constexpr size_t WS_RSC = 10 * MiB;
constexpr size_t WS_MODP = 1 * MiB;
constexpr size_t WS_MOD = 1 * MiB + 768 * 1024;
constexpr size_t WS_COS = 2 * MiB, WS_SIN = 4 * MiB;
constexpr size_t WS_LAMC = 6 * MiB;
constexpr size_t WS_TOKE = 7 * MiB, WS_TOKR = WS_TOKE + 256 * 1024, WS_TOKW = WS_TOKR + 256 * 1024, WS_TOKP = WS_TOKW + 256 * 1024;
constexpr size_t WS_RTE = 8 * MiB;
constexpr size_t WS_SS = 12 * MiB;
constexpr size_t WS_PL = 9 * MiB, WS_HC = 9 * MiB + 512 * 1024;
constexpr size_t WS_WSMALL = 16 * MiB, WSMALL_STRIDE = 8 * MiB;
constexpr size_t WS_WDENSE = 48 * MiB, WDENSE_STRIDE = 17 * MiB;
constexpr size_t WS_WMOE_GU = 82 * MiB, WS_WMOE_D = 194 * MiB;
constexpr size_t WS_H = 250 * MiB;
constexpr size_t WS_Z = 314 * MiB, WS_A2 = 410 * MiB, WS_XR = 866 * MiB, WS_QKV = 466 * MiB, WS_Q = 578 * MiB, WS_K = 626 * MiB, WS_LA = 674 * MiB, WS_XB = 738 * MiB, WS_Y = 802 * MiB;
constexpr size_t WS_HID = 314 * MiB;
constexpr size_t WS_HS = 314 * MiB, WS_Y2 = 314 * MiB, WS_MHID = 446 * MiB;
constexpr size_t WS_END = 908 * MiB;
static_assert(WS_MHID + (size_t)MOE_TILES * 256 * DFE <= WS_XB && WS_LA + (size_t)NTOK * 512 * 4 <= WS_XB && WS_XB + (size_t)NTOK * D * 2 <= WS_Y, "residual stream map");
static_assert(WS_MHID + (size_t)MOE_TILES * 256 * DFE * 2 <= WS_END && WS_HS + (size_t)MOE_TILES * 256 * D * 2 <= WS_MHID && WS_Y2 >= WS_H + (size_t)NTOK * D * 2, "MoE map");
static_assert(WS_HID + (size_t)NTOK * DFF * 2 <= WS_END && WS_Y + (size_t)NTOK * D * 2 <= WS_END, "map");
constexpr int CW_TMO = 0, CW_CODE = 1, CW_BAR = 4096, CW_GCNT = 8192, CW_WMAX = 12288, CW_AGRP = 16384, CW_SCNT = 24576;

constexpr int RING_BYTES = 131072, LDSCTL_OFF = RING_BYTES, MISC_OFF = LDSCTL_OFF + 320, LDS_BYTES = 147456;

struct Frame {
    LAS unsigned char* lds; volatile LAS unsigned* MISC; gu32* ctl;
    int tid, lane, wave, vcu, G, gw, NGW;
    float* out; unsigned char* ws;
    __device__ __forceinline__ void refresh() { int t = threadIdx.x; asm volatile("" : "+v"(t)); tid = t; lane = t & 63; wave = __builtin_amdgcn_readfirstlane(t >> 6); int v = vcu; asm volatile("" : "+s"(v)); vcu = v; gw = v * 8 + wave; }
};
template <int K> __device__ __forceinline__ const void* in_ptr() {
    unsigned long long p; const __attribute__((address_space(4))) void* ka = (const __attribute__((address_space(4))) void*)__builtin_amdgcn_kernarg_segment_ptr();
    asm volatile("s_load_dwordx2 %0, %1, %2\n\ts_waitcnt lgkmcnt(0)" : "=s"(p) : "s"(ka), "i"(8 * K) : "memory");
    return (const void*)p;
}
#define INF(K) ((const float*)in_ptr<K>())
template <class T> __device__ __forceinline__ T* wsp(const Frame& F, size_t off) { asm volatile("" : "+s"(off)); return (T*)(F.ws + off); }
enum { I_X = 0, I_C, I_POS, I_WADA, I_BADA, I_NGAIN, I_WIN, I_LGAIN, I_WQUP, I_WKVUP, I_QGAIN, I_KGAIN, I_CONVW, I_CONVB, I_WA, I_BA, I_WX, I_BX, I_LAM, I_OGAIN, I_WOUT, I_FWG, I_FWU, I_FWD, I_RW, I_MWG, I_MWU, I_MWD };

template <int K> __device__ __forceinline__ float swz_xor(float v) { return __int_as_float(__builtin_amdgcn_ds_swizzle(__float_as_int(v), (K << 10) | 0x1f)); }
template <int CTRL> __device__ __forceinline__ float dpp_f(float v) { return __int_as_float(__builtin_amdgcn_update_dpp(0, __float_as_int(v), CTRL, 0xF, 0xF, true)); }
__device__ __forceinline__ float wave_sum(float v) {
    v += dpp_f<0xB1>(v); v += dpp_f<0x4E>(v); v += dpp_f<0x124>(v); v += dpp_f<0x128>(v); v += swz_xor<16>(v);
    return att::pswap_sum(v);
}
__device__ __forceinline__ float wave_max(float v) {
    v = __builtin_fmaxf(v, dpp_f<0xB1>(v)); v = __builtin_fmaxf(v, dpp_f<0x4E>(v)); v = __builtin_fmaxf(v, dpp_f<0x124>(v)); v = __builtin_fmaxf(v, dpp_f<0x128>(v)); v = __builtin_fmaxf(v, swz_xor<16>(v));
    return att::pswap_max(v);
}
__device__ __forceinline__ float bflo(unsigned w) { return __uint_as_float(w << 16); }
__device__ __forceinline__ float bfhi(unsigned w) { return __uint_as_float(w & 0xffff0000u); }
__device__ __forceinline__ float bf1(bf16 v) { return __uint_as_float((unsigned)v << 16); }

__device__ __forceinline__ void transpose_item(const float* W, int ldw, int k0, int n0, bf16* WT, int ldt, int drow0, int dk0, LAS float* scr, int lane, bool ropemap = false) {
    float rv[32];
#pragma unroll
    for (int i = 0; i < 32; ++i) rv[i] = W[(size_t)(k0 + 2 * i + (lane >> 5)) * ldw + n0 + (lane & 31)];
#pragma unroll
    for (int i = 0; i < 32; ++i) scr[(2 * i + (lane >> 5)) * 33 + (lane & 31)] = rv[i];
    LDS_WAIT(); asm volatile("" ::: "memory");
    const int c = lane & 7;
#pragma unroll
    for (int j = 0; j < 4; ++j) { const int n = (lane >> 3) + 8 * j; const LAS float* s = scr + (8 * c) * 33 + n;
        v4u o; o.x = pk2(s[0 * 33], s[1 * 33]); o.y = pk2(s[2 * 33], s[3 * 33]); o.z = pk2(s[4 * 33], s[5 * 33]); o.w = pk2(s[6 * 33], s[7 * 33]);
        const int nd = ropemap ? 8 * ((n & 15) >> 2) + 4 * (n >> 4) + (n & 3) : n;
        *(GAS v4u*)(WT + (size_t)(drow0 + nd) * ldt + dk0 + k0 + 8 * c) = o; }
    LDS_WAIT(); asm volatile("" ::: "memory");
}
__device__ __forceinline__ void transpose_item_f8(const float* W, int ldw, int k0, int n0, unsigned char* WT, int ldt, int drow0, float sc, LAS float* scr, int lane) {
    float rv[32];
#pragma unroll
    for (int i = 0; i < 32; ++i) rv[i] = W[(size_t)(k0 + 2 * i + (lane >> 5)) * ldw + n0 + (lane & 31)];
#pragma unroll
    for (int i = 0; i < 32; ++i) scr[(2 * i + (lane >> 5)) * 33 + (lane & 31)] = rv[i];
    LDS_WAIT(); asm volatile("" ::: "memory");
    const int c = lane & 3;
#pragma unroll
    for (int j = 0; j < 2; ++j) { const int n = (lane >> 2) + 16 * j; const LAS float* s = scr + (16 * c) * 33 + n;
        v4u o; o.x = pg8::pack4_fp8(s[0 * 33] * sc, s[1 * 33] * sc, s[2 * 33] * sc, s[3 * 33] * sc); o.y = pg8::pack4_fp8(s[4 * 33] * sc, s[5 * 33] * sc, s[6 * 33] * sc, s[7 * 33] * sc);
        o.z = pg8::pack4_fp8(s[8 * 33] * sc, s[9 * 33] * sc, s[10 * 33] * sc, s[11 * 33] * sc); o.w = pg8::pack4_fp8(s[12 * 33] * sc, s[13 * 33] * sc, s[14 * 33] * sc, s[15 * 33] * sc);
        *(GAS v4u*)(WT + (size_t)(drow0 + n) * ldt + k0 + 16 * c) = o; }
    LDS_WAIT(); asm volatile("" ::: "memory");
}
__device__ __forceinline__ void transpose_item_i8(const float* W, int ldw, int k0, int n0, unsigned char* WT, int ldt, int drow0, float sc, LAS float* scr, int lane) {
    float rv[32];
#pragma unroll
    for (int i = 0; i < 32; ++i) rv[i] = W[(size_t)(k0 + 2 * i + (lane >> 5)) * ldw + n0 + (lane & 31)];
#pragma unroll
    for (int i = 0; i < 32; ++i) scr[(2 * i + (lane >> 5)) * 33 + (lane & 31)] = rv[i];
    LDS_WAIT(); asm volatile("" ::: "memory");
    const int c = lane & 3;
#pragma unroll
    for (int j = 0; j < 2; ++j) { const int n = (lane >> 2) + 16 * j; const LAS float* s = scr + (16 * c) * 33 + n;
        v4u o; o.x = pg8::pack4_i8(s[0 * 33] * sc, s[1 * 33] * sc, s[2 * 33] * sc, s[3 * 33] * sc); o.y = pg8::pack4_i8(s[4 * 33] * sc, s[5 * 33] * sc, s[6 * 33] * sc, s[7 * 33] * sc);
        o.z = pg8::pack4_i8(s[8 * 33] * sc, s[9 * 33] * sc, s[10 * 33] * sc, s[11 * 33] * sc); o.w = pg8::pack4_i8(s[12 * 33] * sc, s[13 * 33] * sc, s[14 * 33] * sc, s[15 * 33] * sc);
        *(GAS v4u*)(WT + (size_t)(drow0 + n) * ldt + k0 + 16 * c) = o; }
    LDS_WAIT(); asm volatile("" ::: "memory");
}
constexpr bool DENSE0_BF16 = false;
constexpr float SC_H8 = 8.0f, SC_WGU8 = 64.0f, SC_HID8 = 4.0f, SC_WD8 = 128.0f, SC_Y8 = 16.0f;
struct CDesc { const float* W; bf16* WT; int K, N, ldt, roff, dk0, map; float f8sc; };
__device__ __forceinline__ void conv_run(Frame& F, const CDesc& d, int gw0, int ngw) {
    LAS float* scr = (LAS float*)(F.lds + F.wave * 16384);
    const int nblk = d.N / 32, items = (d.K / 64) * nblk;
    for (int it = gw0; it < items; it += ngw) { const int kb = it / nblk, nb = it % nblk, n0 = 32 * nb;
        int drow0 = d.map == 0 ? n0 + d.roff : (d.map == 1 ? (n0 >= 416 ? n0 + 96 : n0) : 256 * (n0 / 128) + (n0 % 128) + d.roff); bool rope = false;
        if (d.map == 3) { const int h = n0 / 96, r = n0 - 96 * h;
            if (r < 64) drow0 = 256 * (h >> 2) + 128 * (r >> 5) + 32 * (h & 3); else { drow0 = 512 + 128 * (h >> 2) + 32 * (h & 3); rope = true; } }
        if (d.map == 4) { const int h = n0 / 128, r = n0 - 128 * h;
            drow0 = r < 64 ? 768 + 256 * (h >> 2) + 128 * (r >> 5) + 32 * (h & 3) : 1280 + 64 * h + (r - 64); }
        if (d.f8sc != 0.f) transpose_item_f8(d.W, d.N, 64 * kb, n0, (unsigned char*)d.WT, d.ldt, drow0, d.f8sc, scr, F.lane);
        else transpose_item(d.W, d.N, 64 * kb, n0, d.WT, d.ldt, drow0, d.dk0, scr, F.lane, rope); }
}
__device__ __forceinline__ CDesc conv_desc(Frame& F, int idx, int moe_j) {
    CDesc d;
    if (idx < 16) { const int l = idx >> 2, m = idx & 3; bf16* base = wsp<bf16>(F, WS_WSMALL + (size_t)l * WSMALL_STRIDE);
        if (m == 0)      d = CDesc{INF(I_WIN) + (size_t)l * D * INCOLS, base, D, INCOLS, D, 0, 0, 1, 0.f};
        else if (m == 1) d = CDesc{INF(I_WQUP) + (size_t)l * 256 * 768, base + 3 * MiB / 2, 256, 768, 256, 0, 0, 3, 0.f};
        else if (m == 2) d = CDesc{INF(I_WKVUP) + (size_t)l * 128 * 1024, base + 3 * MiB / 2, 128, 1024, 256, 768, 0, 4, 0.f};
        else             d = CDesc{INF(I_WOUT) + (size_t)l * D * D, base + 6 * MiB / 2, D, D, D, 0, 0, 0, 0.f};
    } else if (idx < 22) { const int j = (idx - 16) / 3, m = (idx - 16) % 3; bf16* base = wsp<bf16>(F, WS_WDENSE + (size_t)j * WDENSE_STRIDE);
        if (m == 0)      d = CDesc{INF(I_FWG) + (size_t)j * D * DFF, base, D, DFF, D, 0, 0, 2, SC_WGU8};
        else if (m == 1) d = CDesc{INF(I_FWU) + (size_t)j * D * DFF, base, D, DFF, D, 128, 0, 2, SC_WGU8};
        else             d = CDesc{INF(I_FWD) + (size_t)j * DFF * D, base + (size_t)11 * MiB / 2, DFF, D, DFF, 0, 0, 0, SC_WD8};
    } else { const int e = (idx - 22) / 3, m = (idx - 22) % 3; const size_t we = (size_t)(moe_j * NEXP + e) * D * DFE;
        if (m == 0)      d = CDesc{INF(I_MWG) + we, (bf16*)(wsp<unsigned char>(F, WS_WMOE_GU) + (size_t)e * 2 * DFE * D), D, DFE, D, 0, 0, 2, SC_WGU8};
        else if (m == 1) d = CDesc{INF(I_MWU) + we, (bf16*)(wsp<unsigned char>(F, WS_WMOE_GU) + (size_t)e * 2 * DFE * D), D, DFE, D, 128, 0, 2, SC_WGU8};
        else             d = CDesc{INF(I_MWD) + we, (bf16*)(wsp<unsigned char>(F, WS_WMOE_D) + (size_t)e * D * DFE), DFE, D, DFE, 0, 0, 0, SC_WD8};
    }
    return d;
}
__device__ __forceinline__ void convert_range(Frame& F, int lo, int hi, int moe_j) {
    F.refresh();
    for (int idx = lo; idx < hi; ++idx) { if ((idx < 16 && (idx & 3) == 0) || idx == 16 || idx == 17 || idx == 19 || idx == 20) continue;
        const CDesc d = conv_desc(F, idx, moe_j); conv_run(F, d, F.gw, F.NGW); }
}
constexpr int MOE_EARLY_E = 6;
__device__ __forceinline__ void convert_moe_early(Frame& F, int rank, int nshare) {
    F.refresh();
    for (int e = 0; e < MOE_EARLY_E; ++e)
        for (int m = 0; m < 2; ++m) { const CDesc d = conv_desc(F, 22 + 3 * e + m, 1); conv_run(F, d, rank * NWAVES + F.wave, nshare * NWAVES); }
}
__device__ __forceinline__ void convert_moe_first(Frame& F) {
    F.refresh();
    for (int idx = 22; idx < 46; ++idx) { const CDesc d = conv_desc(F, idx, 0); conv_run(F, d, F.gw, F.NGW); }
    __syncthreads();
}
__device__ __forceinline__ void convert_moe_late(Frame& F) {
    F.refresh();
    for (int idx = 22; idx < 46; ++idx) { const int e = (idx - 22) / 3, m = (idx - 22) % 3; if (e < MOE_EARLY_E && m < 2) continue;
        const CDesc d = conv_desc(F, idx, 1); conv_run(F, d, F.gw, F.NGW); }
}
__device__ __forceinline__ void zero_block(Frame& F, bf16* WT, int ldt, int r0, int rows, int c0, int cols) {
    const int cpr = cols / 8, n = rows * cpr;
    v4u zz = (v4u){0u, 0u, 0u, 0u}; asm volatile("" : "+v"(zz));
    for (int i = F.gw * 64 + F.lane; i < n; i += F.NGW * 64) { const int r = i / cpr, cc = i % cpr; *(GAS v4u*)(WT + (size_t)(r0 + r) * ldt + c0 + 8 * cc) = zz; }
}
__device__ __forceinline__ float lane_absmax4(const GAS f32x4* W, int n4, int first, int step) {
    float m = 0.f;
    for (int i0 = first; i0 < n4; i0 += 8 * step) { f32x4 v[8];
#pragma unroll
        for (int u = 0; u < 8; ++u) { const int i = i0 + u * step; v[u] = i < n4 ? W[i] : (f32x4){0.f, 0.f, 0.f, 0.f}; }
#pragma unroll
        for (int u = 0; u < 8; ++u) m = __builtin_fmaxf(__builtin_fmaxf(m, __builtin_fmaxf(__builtin_fabsf(v[u].x), __builtin_fabsf(v[u].y))), __builtin_fmaxf(__builtin_fabsf(v[u].z), __builtin_fabsf(v[u].w))); }
    return m;
}
__device__ __forceinline__ void p0_prologue(Frame& F) {
    F.refresh();
    {
      const float* w_ada = INF(I_WADA); const float* cc = INF(I_C); float* modp = wsp<float>(F, WS_MODP);
      for (int task = F.gw; task < 8 * 4 * 48; task += F.NGW) {
        const int jb = task % 48, kq = (task / 48) % 4, ls = task / 192, j = jb * 64 + F.lane;
        const float* W = w_ada + (size_t)ls * D * 3072 + j; float a0 = 0.f, a1 = 0.f;
        for (int k0 = kq * 256; k0 < kq * 256 + 256; k0 += 32) { float wv[32];
#pragma unroll
            for (int i = 0; i < 32; ++i) wv[i] = W[(size_t)(k0 + i) * 3072];
#pragma unroll
            for (int i = 0; i < 32; ++i) { const float c0 = cc[k0 + i], c1 = cc[D + k0 + i]; a0 += c0 * pg8::sigmoidf_(c0) * wv[i]; a1 += c1 * pg8::sigmoidf_(c1) * wv[i]; } }
        modp[((size_t)(kq * 8 + ls) * 2 + 0) * 3072 + j] = a0; modp[((size_t)(kq * 8 + ls) * 2 + 1) * 3072 + j] = a1;
      } }
    {
      const float* w_in = INF(I_WIN);
      for (int l = 0; l < DEPTH; ++l) { float m = lane_absmax4((const GAS f32x4*)(w_in + (size_t)l * D * INCOLS), D * INCOLS / 4, F.gw * 64 + F.lane, F.NGW * 64);
          m = wave_max(m);
          if (F.lane == 0) __hip_atomic_fetch_max((unsigned*)(F.ctl + CW_WMAX + 64 * l), __float_as_uint(m), __ATOMIC_RELAXED, __HIP_MEMORY_SCOPE_AGENT); } }
    for (int j = 0; j < 2; ++j) { float m = 0.f;
      for (int h = 0; h < 2; ++h) m = __builtin_fmaxf(m, lane_absmax4((const GAS f32x4*)((h ? INF(I_FWU) : INF(I_FWG)) + (size_t)j * D * DFF), D * DFF / 4, F.gw * 64 + F.lane, F.NGW * 64));
      m = wave_max(m);
      if (F.lane == 0) __hip_atomic_fetch_max((unsigned*)(F.ctl + CW_WMAX + 64 * (4 + j)), __float_as_uint(m), __ATOMIC_RELAXED, __HIP_MEMORY_SCOPE_AGENT); }
    {
      const int* positions = (const int*)in_ptr<I_POS>(); float* cosT = wsp<float>(F, WS_COS); float* sinT = wsp<float>(F, WS_SIN);
      for (int i0 = F.gw * 64 + F.lane; i0 < NTOK * 16; i0 += 4 * F.NGW * 64) { int pv[4];
#pragma unroll
        for (int u = 0; u < 4; ++u) { const int i = i0 + u * F.NGW * 64; pv[u] = i < NTOK * 16 ? positions[i >> 4] : 0; }
#pragma unroll
        for (int u = 0; u < 4; ++u) { const int i = i0 + u * F.NGW * 64; if (i >= NTOK * 16) break; const int j = i & 15;
        const float invf = __builtin_amdgcn_exp2f(-(float)j * (13.287712379549449f / 16.0f));
        const float ang = (float)pv[u] * invf;
        const float rev = ang * 0.15915494309189535f; const float fr = rev - __builtin_floorf(rev);
        cosT[i] = __builtin_amdgcn_cosf(fr); sinT[i] = __builtin_amdgcn_sinf(fr); } } }
    {
      const float* lam = INF(I_LAM); float* lamc = wsp<float>(F, WS_LAMC);
      for (int i = F.gw * 64 + F.lane; i < DEPTH * LRUW; i += F.NGW * 64) { const float t = __builtin_amdgcn_exp2f(-1.4426950408889634f * lam[i]); lamc[i] = t < 0.02f ? -8.0f * 1.4426950408889634f * t * (1.0f - t * (0.5f - t * (0.33333334f - 0.25f * t))) : -8.0f * __builtin_amdgcn_logf(1.0f + t); } }
    convert_range(F, 0, F.G == 256 ? 22 : 46, 0);
    for (int l = 0; l < DEPTH; ++l) {
        bf16* Win_t = wsp<bf16>(F, WS_WSMALL + (size_t)l * WSMALL_STRIDE); bf16* Wup_t = Win_t + 3 * MiB / 2; bf16* Wg_t = Win_t + 5 * MiB / 2;
        zero_block(F, Win_t, D / 2, 416, 96, 0, D / 2);
        zero_block(F, Wup_t, 256, 768, 1024, 128, 128);
        const float* w_a = INF(I_WA); const float* w_x = INF(I_WX);
        for (int i8 = F.gw * 64 + F.lane; i8 < 1024 * 16; i8 += F.NGW * 64) {
            const int row = i8 >> 4, kq0 = (i8 & 15) * 8, pn = row >> 8, half = (row >> 7) & 1, ch = 128 * pn + (row & 127), g = ch >> 6, kA0 = 128 * pn + kq0;
            float v[8];
#pragma unroll
            for (int e = 0; e < 8; ++e) v[e] = 0.f;
            if ((kA0 >> 6) == g) { const float* sp = (half ? w_x : w_a) + (((size_t)l * 8 + g) * 64 + (kA0 & 63)) * 64 + (ch & 63);
#pragma unroll
                for (int e = 0; e < 8; ++e) v[e] = sp[(size_t)e * 64]; }
            *(GAS v4u*)(Wg_t + (size_t)row * 128 + kq0) = (v4u){pk2(v[0], v[1]), pk2(v[2], v[3]), pk2(v[4], v[5]), pk2(v[6], v[7])}; }
    }
}
__device__ __forceinline__ void p0_finalise(Frame& F) {
    F.refresh();
    const float* b_ada = INF(I_BADA); const float* modp = wsp<float>(F, WS_MODP); float* mod = wsp<float>(F, WS_MOD);
    for (int i = F.gw * 64 + F.lane; i < 8 * 2 * 3072; i += F.NGW * 64) { const int j = i % 3072, ls = i / 6144;
        float v = b_ada[ls * 3072 + j];
#pragma unroll
        for (int kq = 0; kq < 4; ++kq) v += modp[(size_t)kq * 8 * 2 * 3072 + i];
        mod[i] = v; }
    float wmx[6];
#pragma unroll
    for (int q = 0; q < 6; ++q) wmx[q] = __uint_as_float(__hip_atomic_load((unsigned*)(F.ctl + CW_WMAX + 64 * q), __ATOMIC_RELAXED, __HIP_MEMORY_SCOPE_AGENT));
    if (F.gw == 0 && F.lane < 6) { float v = wmx[0];
#pragma unroll
        for (int q = 1; q < 6; ++q) if (F.lane == q) v = wmx[q];
        wsp<float>(F, WS_MREF)[8 + F.lane] = v * (1.0f / 127.0f); }
    if (F.gw == 0 && F.lane < DEPTH) { const int l = F.lane; const float* qg = INF(I_QGAIN) + l * 96; const float* kg = INF(I_KGAIN) + l * 96; float a = 0.f, bq = 0.f, c = 0.f, d = 0.f;
        for (int i = 0; i < 64; ++i) { a = fmaxf(a, qg[i] * qg[i]); c = fmaxf(c, kg[i] * kg[i]); }
        for (int i = 64; i < 96; ++i) { bq = fmaxf(bq, qg[i] * qg[i]); d = fmaxf(d, kg[i] * kg[i]); }
        wsp<float>(F, WS_MREF)[l] = 1.01f * 0.10206207261596577f * 1.4426950408889634f * sqrtf(64.f * a + 32.f * bq) * sqrtf(64.f * c + 32.f * d); }
    { LAS float* scr = (LAS float*)(F.lds + F.wave * 16384); const int nblk = INCOLS / 32, items = (D / 64) * nblk;
      for (int it = F.gw; it < DEPTH * items; it += F.NGW) { const int l = it / items, r = it - l * items, kb = r / nblk, nb = r - kb * nblk, n0 = 32 * nb;
          float wm = wmx[0];
#pragma unroll
          for (int q = 1; q < 4; ++q) if (l == q) wm = wmx[q];
          transpose_item_i8(INF(I_WIN) + (size_t)l * D * INCOLS, INCOLS, 64 * kb, n0, wsp<unsigned char>(F, WS_WSMALL + (size_t)l * WSMALL_STRIDE), D, n0 >= 416 ? n0 + 96 : n0, 127.0f / __builtin_fmaxf(wm, 1e-30f), scr, F.lane); } }
    { LAS float* scr = (LAS float*)(F.lds + F.wave * 16384); const int nblk = DFF / 32, items = (D / 64) * nblk;
      for (int it = F.gw; it < 4 * items; it += F.NGW) { const int q = it / items, j = q >> 1, h = q & 1, r = it - q * items, kb = r / nblk, nb = r - kb * nblk, n0 = 32 * nb;
          const float wm = j ? wmx[5] : wmx[4];
          transpose_item_i8((h ? INF(I_FWU) : INF(I_FWG)) + (size_t)j * D * DFF, DFF, 64 * kb, n0, wsp<unsigned char>(F, WS_WDENSE + (size_t)j * WDENSE_STRIDE), D, 256 * (n0 / 128) + (n0 % 128) + (h ? 128 : 0), 127.0f / __builtin_fmaxf(wm, 1e-30f), scr, F.lane); } }
}

template <bool COMBINE, bool NORM, bool ROUTER, bool F8H = false, bool I8H = false, bool XB16 = true, bool XO16 = true>
__device__ __forceinline__ void norm_pass(Frame& F, const void* xin_, void* xout_, int ls, int ls_prev, int moe_j) {
    const float* xin = (const float*)xin_; const bf16* xinb = (const bf16*)xin_; float* xout = (float*)xout_; bf16* xoutb = (bf16*)xout_;
    F.refresh();
    LAS float* gs = (LAS float*)(F.lds); LAS float* sh = gs + 2048;
    LAS int* lcnt = (LAS int*)(F.lds + 16384); LAS int* gbase = lcnt + 16; LAS int* ltab = lcnt + 32;
    const int lane = F.lane;
    const float* mod = wsp<float>(F, WS_MOD); bf16* hbuf = wsp<bf16>(F, WS_H); float* rsc_ = wsp<float>(F, WS_RSC);
    int* tok_e = wsp<int>(F, WS_TOKE); int* tok_r = wsp<int>(F, WS_TOKR); float* tok_w = wsp<float>(F, WS_TOKW); const int* tok_p = wsp<int>(F, WS_TOKP); const unsigned char* y2 = wsp<unsigned char>(F, WS_Y2);
    if (NORM) { const float* modl = mod + (size_t)ls * 2 * 3072; const float* ng = INF(I_NGAIN) + (size_t)ls * D;
        float t_ng[4], t_sc[4], t_sh[4];
#pragma unroll
        for (int u = 0; u < 4; ++u) { const int i = F.tid + u * NWAVES * 64, b = i >> 10, j = i & 1023; t_ng[u] = ng[j]; t_sc[u] = modl[b * 3072 + 1024 + j]; t_sh[u] = modl[b * 3072 + j]; }
#pragma unroll
        for (int u = 0; u < 4; ++u) { const int i = F.tid + u * NWAVES * 64; gs[i] = t_ng[u] * (1.0f + t_sc[u]); sh[i] = t_sh[u]; } }
    const float* rw = ROUTER ? INF(I_RW) + (size_t)moe_j * D * 8 : nullptr;
    f32x4 rwa[16], rwb[16];
    if (ROUTER) {
#pragma unroll
        for (int jq = 0; jq < 16; ++jq) { const f32x4* wp = (const f32x4*)(rw + (size_t)(4 * lane + 256 * (jq >> 2) + (jq & 3)) * 8); rwa[jq] = wp[0]; rwb[jq] = wp[1]; } }
    __syncthreads();
    for (int blk = F.vcu; blk < NTOK / 128; blk += F.G) {
        if (ROUTER) { if (F.tid < 8) lcnt[F.tid] = 0; __syncthreads(); }
        f32x4 nx[4]; v2u nxb[4];
        if (XB16) { const GAS v2u* xr = (const GAS v2u*)(xinb + (size_t)(blk * 128 + F.wave * 16) * D) + lane;
#pragma unroll
          for (int j = 0; j < 4; ++j) nxb[j] = xr[64 * j]; }
        else { const GAS f32x4* xr = (const GAS f32x4*)(xin + (size_t)(blk * 128 + F.wave * 16) * D) + lane;
#pragma unroll
          for (int j = 0; j < 4; ++j) nx[j] = xr[64 * j]; }
        int np0 = 0, np1 = 0; float nw0 = 0.f, nw1 = 0.f;
        if (COMBINE) { const int r0_ = blk * 128 + F.wave * 16; np0 = tok_p[r0_ * 2]; np1 = tok_p[r0_ * 2 + 1]; nw0 = tok_w[r0_ * 2]; nw1 = tok_w[r0_ * 2 + 1]; }
#pragma unroll 2
        for (int i = 0; i < 16; ++i) {
            const int row = blk * 128 + F.wave * 16 + i, b = row >> 14;
            const int cp0 = np0, cp1 = np1; const float cw0 = nw0, cw1 = nw1;
            f32x4 v[4];
#pragma unroll
            for (int j = 0; j < 4; ++j) { if (XB16) v[j] = (f32x4){bflo(nxb[j].x), bfhi(nxb[j].x), bflo(nxb[j].y), bfhi(nxb[j].y)}; else v[j] = nx[j]; }
            if (i < 15) {
                if (COMBINE) { np0 = tok_p[(row + 1) * 2]; np1 = tok_p[(row + 1) * 2 + 1]; nw0 = tok_w[(row + 1) * 2]; nw1 = tok_w[(row + 1) * 2 + 1]; }
                if (XB16) { const GAS v2u* xr = (const GAS v2u*)(xinb + (size_t)(row + 1) * D) + lane;
#pragma unroll
                    for (int j = 0; j < 4; ++j) nxb[j] = xr[64 * j]; }
                else { const GAS f32x4* xr = (const GAS f32x4*)(xin + (size_t)(row + 1) * D) + lane;
#pragma unroll
                    for (int j = 0; j < 4; ++j) nx[j] = xr[64 * j]; } }
            if (!XB16 && !COMBINE) { GAS v2u* xob = (GAS v2u*)(xoutb + (size_t)row * D) + lane;
#pragma unroll
                for (int j = 0; j < 4; ++j) xob[64 * j] = (v2u){pk2(v[j].x, v[j].y), pk2(v[j].z, v[j].w)}; }
            if (COMBINE) {
                const int p0 = cp0, p1 = cp1; const float w0 = cw0 * (1.0f / SC_Y8), w1 = cw1 * (1.0f / SC_Y8);
                const float* gp = mod + (size_t)ls_prev * 2 * 3072 + b * 3072 + 2048;
                GAS f32x4* xo = (GAS f32x4*)(xout + (size_t)row * D) + lane; GAS v2u* xob = (GAS v2u*)(xoutb + (size_t)row * D) + lane;
                unsigned yav[4], ybv[4]; f32x4 gvv[4];
#pragma unroll
                for (int j = 0; j < 4; ++j) { yav[j] = *(const unsigned*)(y2 + (size_t)p0 * D + 4 * lane + 256 * j); ybv[j] = *(const unsigned*)(y2 + (size_t)p1 * D + 4 * lane + 256 * j); gvv[j] = *(const f32x4*)(gp + 4 * lane + 256 * j); }
                asm volatile("" ::: "memory");
#pragma unroll
                for (int j = 0; j < 4; ++j) { const f32x4 g = gvv[j]; typedef float f32x2_ __attribute__((ext_vector_type(2)));
                    const f32x2_ a01 = __builtin_amdgcn_cvt_pk_f32_fp8((int)yav[j], false), a23 = __builtin_amdgcn_cvt_pk_f32_fp8((int)yav[j], true), b01 = __builtin_amdgcn_cvt_pk_f32_fp8((int)ybv[j], false), b23 = __builtin_amdgcn_cvt_pk_f32_fp8((int)ybv[j], true);
                    v[j].x += g.x * (w0 * a01.x + w1 * b01.x); v[j].y += g.y * (w0 * a01.y + w1 * b01.y);
                    v[j].z += g.z * (w0 * a23.x + w1 * b23.x); v[j].w += g.w * (w0 * a23.y + w1 * b23.y);
                    if (XO16) { const v2u o2 = (v2u){pk2(v[j].x, v[j].y), pk2(v[j].z, v[j].w)}; xob[64 * j] = o2; v[j] = (f32x4){bflo(o2.x), bfhi(o2.x), bflo(o2.y), bfhi(o2.y)}; }
                    else xo[64 * j] = v[j]; }
            }
            if (NORM) {
                float ss = 0.f;
#pragma unroll
                for (int j = 0; j < 4; ++j) ss += (v[j].x * v[j].x + v[j].y * v[j].y) + (v[j].z * v[j].z + v[j].w * v[j].w);
                const float rstd = __builtin_amdgcn_rsqf(wave_sum(ss) * (1.0f / D) + EPS);
                GAS unsigned long long* o8 = (GAS unsigned long long*)(hbuf + (size_t)row * D) + lane;
                GAS unsigned* o4 = (GAS unsigned*)((unsigned char*)hbuf + (size_t)row * D) + lane;
#pragma unroll
                for (int j = 0; j < 4; ++j) { const f32x4 g = *(const LAS f32x4*)(gs + b * 1024 + 4 * lane + 256 * j), s = *(const LAS f32x4*)(sh + b * 1024 + 4 * lane + 256 * j);
                    v[j] = v[j] * rstd * g + s;
                    if (I8H) continue;
                    if (F8H) o4[64 * j] = pg8::pack4_fp8(v[j].x * SC_H8, v[j].y * SC_H8, v[j].z * SC_H8, v[j].w * SC_H8);
                    else o8[64 * j] = (unsigned long long)pk2(v[j].x, v[j].y) | ((unsigned long long)pk2(v[j].z, v[j].w) << 32); }
                if (I8H) { float am = 0.f;
#pragma unroll
                    for (int j = 0; j < 4; ++j) am = __builtin_fmaxf(__builtin_fmaxf(am, __builtin_fmaxf(__builtin_fabsf(v[j].x), __builtin_fabsf(v[j].y))), __builtin_fmaxf(__builtin_fabsf(v[j].z), __builtin_fabsf(v[j].w)));
                    am = __builtin_fmaxf(wave_max(am), 1e-30f); const float qs = 127.0f / am;
#pragma unroll
                    for (int j = 0; j < 4; ++j) o4[64 * j] = pg8::pack4_i8(v[j].x * qs, v[j].y * qs, v[j].z * qs, v[j].w * qs);
                    if (lane == 0) rsc_[row] = am * (1.0f / 127.0f); }
                if (ROUTER) {
                    float lg[8];
#pragma unroll
                    for (int e = 0; e < 8; ++e) lg[e] = 0.f;
#pragma unroll
                    for (int j = 0; j < 4; ++j)
#pragma unroll
                        for (int q = 0; q < 4; ++q) { const float hv = v[j][q]; const f32x4 wa = rwa[4 * j + q], wb = rwb[4 * j + q];
                            lg[0] += hv * wa.x; lg[1] += hv * wa.y; lg[2] += hv * wa.z; lg[3] += hv * wa.w; lg[4] += hv * wb.x; lg[5] += hv * wb.y; lg[6] += hv * wb.z; lg[7] += hv * wb.w; }
#pragma unroll
                    for (int e = 0; e < 8; ++e) lg[e] = wave_sum(lg[e]);
                    int e0 = 0; float v0 = lg[0];
#pragma unroll
                    for (int e = 1; e < 8; ++e) if (lg[e] > v0) { v0 = lg[e]; e0 = e; }
                    int e1 = 0; float v1 = -__builtin_inff();
#pragma unroll
                    for (int e = 0; e < 8; ++e) if (e != e0 && lg[e] > v1) { v1 = lg[e]; e1 = e; }
                    const float w0 = 1.0f / (1.0f + __builtin_amdgcn_exp2f(1.4426950408889634f * (v1 - v0))), w1 = 1.0f - w0;
                    if (lane == 0) { const int r0 = __hip_atomic_fetch_add(lcnt + e0, 1, __ATOMIC_RELAXED, __HIP_MEMORY_SCOPE_WORKGROUP), r1 = __hip_atomic_fetch_add(lcnt + e1, 1, __ATOMIC_RELAXED, __HIP_MEMORY_SCOPE_WORKGROUP);
                        LAS int* lt = ltab + (F.wave * 16 + i) * 8; lt[0] = e0; lt[1] = e1; lt[2] = r0; lt[3] = r1; lt[4] = (int)__float_as_uint(w0); lt[5] = (int)__float_as_uint(w1); }
                }
            }
        }
        if (ROUTER) {
            __syncthreads();
            if (F.tid < 8) gbase[F.tid] = (int)__hip_atomic_fetch_add((unsigned*)(F.ctl + CW_GCNT + 64 * (8 * moe_j + F.tid)), (unsigned)lcnt[F.tid], RLX_AGENT);
            __syncthreads();
            if (F.tid < 128) { const int row = blk * 128 + F.tid; const LAS int* lt = ltab + F.tid * 8; const int e0 = lt[0], e1 = lt[1];
                tok_e[row * 2] = e0; tok_e[row * 2 + 1] = e1; tok_r[row * 2] = gbase[e0] + lt[2]; tok_r[row * 2 + 1] = gbase[e1] + lt[3];
                tok_w[row * 2] = __uint_as_float((unsigned)lt[4]); tok_w[row * 2 + 1] = __uint_as_float((unsigned)lt[5]); }
            __syncthreads();
        }
    }
    __syncthreads();
}

__device__ __forceinline__ void mid_pass(Frame& F, int l) {
    F.refresh();
    const int lane = F.lane;
    const bf16* z = wsp<bf16>(F, WS_Z); bf16* A2 = wsp<bf16>(F, WS_A2); bf16* Kb = wsp<bf16>(F, WS_K); bf16* xrb = wsp<bf16>(F, WS_XR);
    const float* cosT = wsp<float>(F, WS_COS); const float* sinT = wsp<float>(F, WS_SIN);
    const float* lg = INF(I_LGAIN) + l * 384; const f32x4 lgq = *(const f32x4*)(lg + 4 * lane); const f32x4 lgkv = *(const f32x4*)(lg + 256 + 4 * (lane & 31));
    const float* kg = INF(I_KGAIN) + l * 96; const float kg1 = kg[64 + (lane & 15)], kg2 = kg[80 + (lane & 15)];
    const float* conv_w = INF(I_CONVW); const float* conv_b = INF(I_CONVB);
    float cw[4][8], cb[8];
#pragma unroll
    for (int e = 0; e < 8; ++e) { cb[e] = conv_b[l * 512 + 8 * lane + e];
#pragma unroll
        for (int j = 0; j < 4; ++j) cw[j][e] = conv_w[(size_t)(l * 4 + j) * 512 + 8 * lane + e]; }
    struct MidIn { uint2 q2, k2; bf16 x1, x2; v4u xw[4]; float cs, sn; };
    auto mid_load = [&](int row) -> MidIn { MidIn r; const bf16* zr = z + (size_t)row * INP; const int t = row & (SEQ - 1);
        r.q2 = *(const uint2*)(zr + 4 * lane); r.k2 = *(const uint2*)(zr + 256 + 4 * (lane & 31)); r.x1 = zr[384 + (lane & 15)]; r.x2 = zr[400 + (lane & 15)];
#pragma unroll
        for (int j = 0; j < 4; ++j) { if (t - 3 + j >= 0) r.xw[j] = *(const v4u*)(zr + (long)(j - 3) * INP + 512 + 8 * lane); else r.xw[j] = (v4u){0u, 0u, 0u, 0u}; }
        r.cs = cosT[row * 16 + (lane & 15)]; r.sn = sinT[row * 16 + (lane & 15)]; return r; };
    MidIn nxt = mid_load(F.gw < NTOK ? F.gw : 0);
#pragma unroll 2
    for (int row = F.gw; row < NTOK; row += F.NGW) {
        const MidIn in = nxt;
        if (row + F.NGW < NTOK) nxt = mid_load(row + F.NGW);
        const float q0 = bflo(in.q2.x), q1 = bfhi(in.q2.x), q2f = bflo(in.q2.y), q3 = bfhi(in.q2.y);
        float ssq = (q0 * q0 + q1 * q1) + (q2f * q2f + q3 * q3);
        const float k0 = bflo(in.k2.x), k1 = bfhi(in.k2.x), k2f = bflo(in.k2.y), k3 = bfhi(in.k2.y);
        float sskv = lane < 32 ? (k0 * k0 + k1 * k1) + (k2f * k2f + k3 * k3) : 0.f;
        const float x1 = bf1(in.x1), x2 = bf1(in.x2);
        float ssr = lane < 16 ? x1 * x1 + x2 * x2 : 0.f;
        ssq = wave_sum(ssq); sskv = wave_sum(sskv); ssr = wave_sum(ssr);
        const float rq = __builtin_amdgcn_rsqf(ssq * (1.0f / 256.0f) + EPS), rkv = __builtin_amdgcn_rsqf(sskv * (1.0f / 128.0f) + EPS), rr = __builtin_amdgcn_rsqf(ssr * (1.0f / 32.0f) + EPS);
        *(uint2*)(A2 + (size_t)row * 256 + 4 * lane) = make_uint2(pk2(q0 * rq * lgq.x, q1 * rq * lgq.y), pk2(q2f * rq * lgq.z, q3 * rq * lgq.w));
        if (lane < 32) *(uint2*)(A2 + (size_t)(NTOK + row) * 256 + 4 * lane) = make_uint2(pk2(k0 * rkv * lgkv.x, k1 * rkv * lgkv.y), pk2(k2f * rkv * lgkv.z, k3 * rkv * lgkv.w));
        {
            const float a = x1 * rr * kg1, bb = x2 * rr * kg2;
            const unsigned w = f2bf(a * in.cs - bb * in.sn) | (f2bf(a * in.sn + bb * in.cs) << 16);
            const int q = lane & 3, src0 = ((lane & 48) | ((q & 1) * 8)) * 4; const unsigned sh = (q & 2) ? 16u : 0u;
            unsigned g[8];
#pragma unroll
            for (int e = 0; e < 8; ++e) g[e] = (unsigned)__builtin_amdgcn_ds_bpermute(src0 + 4 * e, (int)w);
            v4u o; o.x = ((g[0] >> sh) & 0xffffu) | ((g[1] >> sh) << 16); o.y = ((g[2] >> sh) & 0xffffu) | ((g[3] >> sh) << 16); o.z = ((g[4] >> sh) & 0xffffu) | ((g[5] >> sh) << 16); o.w = ((g[6] >> sh) & 0xffffu) | ((g[7] >> sh) << 16);
            if (lane < 32) *(v4u*)(Kb + (size_t)row * 768 + (lane >> 2) * 96 + 64 + 8 * q) = o; }
        float acc[8];
#pragma unroll
        for (int e = 0; e < 8; ++e) acc[e] = cb[e];
#pragma unroll
        for (int j = 0; j < 4; ++j) { const v4u xw = in.xw[j];
                acc[0] += cw[j][0] * bflo(xw.x); acc[1] += cw[j][1] * bfhi(xw.x); acc[2] += cw[j][2] * bflo(xw.y); acc[3] += cw[j][3] * bfhi(xw.y);
                acc[4] += cw[j][4] * bflo(xw.z); acc[5] += cw[j][5] * bfhi(xw.z); acc[6] += cw[j][6] * bflo(xw.w); acc[7] += cw[j][7] * bfhi(xw.w); }
        *(v4u*)(xrb + ((size_t)(lane >> 4) * NTOK + row) * 128 + 8 * (lane & 15)) = (v4u){pk2(acc[0], acc[1]), pk2(acc[2], acc[3]), pk2(acc[4], acc[5]), pk2(acc[6], acc[7])};
    }
}

__device__ __forceinline__ void qk_pass(Frame& F, int l) {
    F.refresh();
    const int lane = F.lane, g8 = lane & 7, h8 = lane >> 3, g4 = lane & 3, h4 = (lane >> 2) & 7;
    const float C2 = 0.10206207261596577f * 1.4426950408889634f;
    const bf16* qkv = wsp<bf16>(F, WS_QKV); bf16* Qb = wsp<bf16>(F, WS_Q); bf16* Kb = wsp<bf16>(F, WS_K);
    const float* cosT = wsp<float>(F, WS_COS); const float* sinT = wsp<float>(F, WS_SIN);
    const float* q_gain = INF(I_QGAIN) + l * 96; const float* k_gain = INF(I_KGAIN) + l * 96;
    float qgn[8], kgn[8], qgr[8];
#pragma unroll
    for (int e = 0; e < 8; ++e) { qgn[e] = q_gain[g8 * 8 + e]; kgn[e] = k_gain[g8 * 8 + e]; qgr[e] = q_gain[64 + g4 * 8 + e]; }
    struct QkIn { v4u qn, kn, qp; f32x4 ca, cb, sa, sb; };
    auto qk_load = [&](int row) -> QkIn { QkIn r; const bf16* qr = qkv + (size_t)row * UPN;
        r.qn = *(const v4u*)(qr + h8 * 96 + g8 * 8); r.kn = *(const v4u*)(qr + 768 + h8 * 128 + g8 * 8); r.qp = *(const v4u*)(qr + h4 * 96 + 64 + g4 * 8);
        r.ca = *(const f32x4*)(cosT + row * 16 + (g4 & 1) * 8); r.cb = *(const f32x4*)(cosT + row * 16 + (g4 & 1) * 8 + 4);
        r.sa = *(const f32x4*)(sinT + row * 16 + (g4 & 1) * 8); r.sb = *(const f32x4*)(sinT + row * 16 + (g4 & 1) * 8 + 4); return r; };
    QkIn nxt = qk_load(F.gw < NTOK ? F.gw : 0);
    for (int row = F.gw; row < NTOK; row += F.NGW) {
        const QkIn in = nxt;
        if (row + F.NGW < NTOK) nxt = qk_load(row + F.NGW);
        float v[8], o[8];
#define UP8(dst, w_) do { dst[0] = bflo(w_.x); dst[1] = bfhi(w_.x); dst[2] = bflo(w_.y); dst[3] = bfhi(w_.y); dst[4] = bflo(w_.z); dst[5] = bfhi(w_.z); dst[6] = bflo(w_.w); dst[7] = bfhi(w_.w); } while (0)
#define ST8(p, s) do { *(v4u*)(p) = (v4u){pk2(s[0], s[1]), pk2(s[2], s[3]), pk2(s[4], s[5]), pk2(s[6], s[7])}; } while (0)
        UP8(v, in.qn);
        { float ss = 0.f;
#pragma unroll
          for (int e = 0; e < 8; ++e) ss += v[e] * v[e];
          ss += swz_xor<1>(ss); ss += swz_xor<2>(ss); ss += swz_xor<4>(ss);
          const float rs = C2 / sqrtf(ss * (1.0f / 64.0f) + EPS);
#pragma unroll
          for (int e = 0; e < 8; ++e) o[e] = v[e] * rs * qgn[e];
          ST8(Qb + (size_t)row * 768 + h8 * 96 + g8 * 8, o); }
        UP8(v, in.kn);
        { float ss = 0.f;
#pragma unroll
          for (int e = 0; e < 8; ++e) ss += v[e] * v[e];
          ss += swz_xor<1>(ss); ss += swz_xor<2>(ss); ss += swz_xor<4>(ss);
          const float rs = __builtin_amdgcn_rsqf(ss * (1.0f / 64.0f) + EPS);
#pragma unroll
          for (int e = 0; e < 8; ++e) o[e] = v[e] * rs * kgn[e];
          ST8(Kb + (size_t)row * 768 + h8 * 96 + g8 * 8, o); }
        UP8(v, in.qp);
        { float ss = 0.f;
#pragma unroll
          for (int e = 0; e < 8; ++e) ss += v[e] * v[e];
          ss += swz_xor<1>(ss); ss += swz_xor<2>(ss);
          const float rs = __builtin_amdgcn_rsqf(ss * (1.0f / 32.0f) + EPS);
#pragma unroll
          for (int e = 0; e < 8; ++e) { const float vn = v[e] * rs * qgr[e]; const float pe = swz_xor<2>(vn);
              const float cs = e < 4 ? in.ca[e & 3] : in.cb[e & 3], sn = e < 4 ? in.sa[e & 3] : in.sb[e & 3];
              o[e] = (g4 < 2 ? vn * cs - pe * sn : pe * sn + vn * cs) * C2; }
          if (lane < 32) ST8(Qb + (size_t)row * 768 + h4 * 96 + 64 + g4 * 8, o); }
#undef UP8
#undef ST8
    }
}

__device__ __forceinline__ void scan_a(Frame& F) {
    F.refresh();
    const int ch = F.tid;
    const unsigned* lu = wsp<unsigned>(F, WS_LA); float* Pl = wsp<float>(F, WS_PL); float* Hc = wsp<float>(F, WS_HC);
    for (int un = F.vcu; un < 256; un += F.G) {
        const size_t r0 = (size_t)un * 128; float S = 0.f, H = 0.f;
        for (int t0 = 0; t0 < 128; t0 += 32) { unsigned w[32];
#pragma unroll
            for (int t = 0; t < 32; ++t) w[t] = lu[(r0 + t0 + t) * LRUW + ch];
#pragma unroll
            for (int t = 0; t < 32; ++t) { const float l2 = bflo(w[t]); H = __builtin_amdgcn_exp2f(l2) * H + bfhi(w[t]); S += l2; } }
        Pl[(size_t)un * LRUW + ch] = S; Hc[(size_t)un * LRUW + ch] = H;
    }
}
__device__ __forceinline__ void scan_arrive(Frame& F, int l) {
    asm volatile("s_waitcnt vmcnt(0)" ::: "memory");
    __syncthreads();
    int t0 = threadIdx.x; asm volatile("" : "+v"(t0));
    if (t0 == 0) { __builtin_amdgcn_fence(__ATOMIC_RELEASE, "agent"); asm volatile("s_waitcnt vmcnt(0)" ::: "memory"); (void)xb_add((unsigned*)(F.ctl + CW_SCNT + 16 * l), 1u); }
}
__device__ __forceinline__ void scan_wait(Frame& F, int l) {
    int t0 = threadIdx.x; asm volatile("" : "+v"(t0));
    if (t0 == 0) { unsigned* bar = (unsigned*)(F.ctl + CW_BAR); unsigned* cnt = (unsigned*)(F.ctl + CW_SCNT + 16 * l);
        XB_SPIN(xb_ld(cnt) < 256u, bar);
        __builtin_amdgcn_fence(__ATOMIC_ACQUIRE, "agent"); asm volatile("s_waitcnt vmcnt(0)" ::: "memory"); }
    __syncthreads();
}
__device__ __forceinline__ float gelu_tanh(float x) {
    const float y = 0.7978845608028654f * (x + 0.044715f * x * x * x);
    return x * __builtin_amdgcn_rcpf(1.0f + __builtin_amdgcn_exp2f(-2.0f * 1.4426950408889634f * y));
}
__device__ __forceinline__ void scan_c(Frame& F, int l) {
    F.refresh();
    const int ch = F.tid, lane = F.lane;
    LAS float* st = (LAS float*)F.lds;
    const unsigned* lu = wsp<unsigned>(F, WS_LA); const float* Pl = wsp<float>(F, WS_PL); const float* Hc = wsp<float>(F, WS_HC);
    const bf16* z = wsp<bf16>(F, WS_Z); bf16* y = wsp<bf16>(F, WS_Y);
    const float* out_gain = INF(I_OGAIN) + l * D + 512;
    float og[8];
#pragma unroll
    for (int e = 0; e < 8; ++e) og[e] = out_gain[8 * lane + e];
    for (int un = F.vcu; un < 256; un += F.G) {
        const int c = un & 127, b = un >> 7; const size_t r0 = (size_t)un * 128;
        unsigned w[32]; bf16 gq[32];
#pragma unroll
        for (int t = 0; t < 32; ++t) { w[t] = lu[(r0 + t) * LRUW + ch]; gq[t] = z[(r0 + t) * INP + 1024 + ch]; }
        float hst = 0.f;
        {
            float plA[16], hcA[16], plB[16], hcB[16];
#define SCC_LOAD(PLv, HCv, c0_) do { _Pragma("unroll") for (int u = 0; u < 16; ++u) { const int cc = (c0_) + u; const size_t o = (size_t)(b * 128 + (cc < c ? cc : 0)) * LRUW + ch; PLv[u] = cc < c ? Pl[o] : 0.f; HCv[u] = cc < c ? Hc[o] : 0.f; } } while (0)
#define SCC_STEP(PLv, HCv) do { _Pragma("unroll") for (int u = 0; u < 16; ++u) hst = __builtin_amdgcn_exp2f(PLv[u]) * hst + HCv[u]; } while (0)
            if (c > 0) SCC_LOAD(plA, hcA, 0);
            for (int c0 = 0; c0 < c; c0 += 32) {
                if (c0 + 16 < c) SCC_LOAD(plB, hcB, c0 + 16);
                SCC_STEP(plA, hcA);
                if (c0 + 16 >= c) break;
                if (c0 + 32 < c) SCC_LOAD(plA, hcA, c0 + 32);
                SCC_STEP(plB, hcB);
            }
#undef SCC_LOAD
#undef SCC_STEP
        }
        for (int sub = 0; sub < 4; ++sub) {
#pragma unroll
            for (int t = 0; t < 32; ++t) { hst = __builtin_amdgcn_exp2f(bflo(w[t])) * hst + bfhi(w[t]); st[t * 512 + ch] = hst * gelu_tanh(bf1(gq[t])); }
            if (sub < 3) {
#pragma unroll
                for (int t = 0; t < 32; ++t) { w[t] = lu[(r0 + (sub + 1) * 32 + t) * LRUW + ch]; gq[t] = z[(r0 + (sub + 1) * 32 + t) * INP + 1024 + ch]; } }
            __syncthreads();
#pragma unroll
            for (int tt = 0; tt < 4; ++tt) { const int t = F.wave * 4 + tt; const size_t row = r0 + sub * 32 + t;
                const f32x4 a = *(const LAS f32x4*)(st + t * 512 + 8 * lane), bq = *(const LAS f32x4*)(st + t * 512 + 8 * lane + 4);
                float ss = (a.x * a.x + a.y * a.y) + (a.z * a.z + a.w * a.w) + (bq.x * bq.x + bq.y * bq.y) + (bq.z * bq.z + bq.w * bq.w);
                const float rs = __builtin_amdgcn_rsqf(wave_sum(ss) * (1.0f / 512.0f) + EPS);
                *(v4u*)(y + row * D + 512 + 8 * lane) = (v4u){pk2(a.x * rs * og[0], a.y * rs * og[1]), pk2(a.z * rs * og[2], a.w * rs * og[3]), pk2(bq.x * rs * og[4], bq.y * rs * og[5]), pk2(bq.z * rs * og[6], bq.w * rs * og[7])}; }
            __syncthreads();
        }
    }
}
__device__ __forceinline__ void attn_norm_pass(Frame& F, int l) {
    F.refresh();
    const int lane = F.lane; float og[8];
    const float* out_gain = INF(I_OGAIN) + l * D; bf16* y = wsp<bf16>(F, WS_Y);
#pragma unroll
    for (int e = 0; e < 8; ++e) og[e] = out_gain[8 * lane + e];
    for (int row0 = F.gw; row0 < NTOK; row0 += 4 * F.NGW) {
        v4u wv[4];
#pragma unroll
        for (int r = 0; r < 4; ++r) { const int row = row0 + r * F.NGW; if (row < NTOK) wv[r] = *(const v4u*)(y + (size_t)row * D + 8 * lane); else wv[r] = (v4u){0u, 0u, 0u, 0u}; }
#pragma unroll
        for (int r = 0; r < 4; ++r) { const int row = row0 + r * F.NGW; const v4u w = wv[r];
            const float v0 = bflo(w.x), v1 = bfhi(w.x), v2 = bflo(w.y), v3 = bfhi(w.y), v4 = bflo(w.z), v5 = bfhi(w.z), v6 = bflo(w.w), v7 = bfhi(w.w);
            const float ss = (v0 * v0 + v1 * v1) + (v2 * v2 + v3 * v3) + (v4 * v4 + v5 * v5) + (v6 * v6 + v7 * v7);
            const float rs = __builtin_amdgcn_rsqf(wave_sum(ss) * (1.0f / 512.0f) + EPS);
            if (row < NTOK) *(v4u*)(y + (size_t)row * D + 8 * lane) = (v4u){pk2(v0 * rs * og[0], v1 * rs * og[1]), pk2(v2 * rs * og[2], v3 * rs * og[3]), pk2(v4 * rs * og[4], v5 * rs * og[5]), pk2(v6 * rs * og[6], v7 * rs * og[7])}; }
    }
}
__device__ __forceinline__ void attn_group_norm(Frame& F, int l, int b, int h, int qb) {
    asm volatile("s_waitcnt vmcnt(0)" ::: "memory");
    __syncthreads();
    int t0 = threadIdx.x; asm volatile("" : "+v"(t0));
    if (t0 == 0) {
        unsigned* bar = (unsigned*)(F.ctl + CW_BAR); unsigned* cnt = (unsigned*)(F.ctl + CW_AGRP + 16 * ((l * 2 + b) * 32 + qb));
        __builtin_amdgcn_fence(__ATOMIC_RELEASE, "agent");
        asm volatile("s_waitcnt vmcnt(0)" ::: "memory");
        (void)xb_add(cnt, 1u);
        XB_SPIN(xb_ld(cnt) < 8u, bar);
        __builtin_amdgcn_fence(__ATOMIC_ACQUIRE, "agent");
        asm volatile("s_waitcnt vmcnt(0)" ::: "memory");
    }
    __syncthreads();
    F.refresh();
    const int lane = F.lane; float og[8];
    const float* out_gain = INF(I_OGAIN) + l * D; bf16* y = wsp<bf16>(F, WS_Y);
#pragma unroll
    for (int e = 0; e < 8; ++e) og[e] = out_gain[8 * lane + e];
    const size_t row0 = (size_t)b * SEQ + (size_t)qb * 512 + h * 64 + F.wave * 8;
    v4u wv[8];
#pragma unroll
    for (int r = 0; r < 8; ++r) wv[r] = *(const v4u*)(y + (row0 + r) * D + 8 * lane);
#pragma unroll
    for (int r = 0; r < 8; ++r) { const v4u w = wv[r];
        const float v0 = bflo(w.x), v1 = bfhi(w.x), v2 = bflo(w.y), v3 = bfhi(w.y), v4 = bflo(w.z), v5 = bfhi(w.z), v6 = bflo(w.w), v7 = bfhi(w.w);
        const float ss = (v0 * v0 + v1 * v1) + (v2 * v2 + v3 * v3) + (v4 * v4 + v5 * v5) + (v6 * v6 + v7 * v7);
        const float rs = __builtin_amdgcn_rsqf(wave_sum(ss) * (1.0f / 512.0f) + EPS);
        *(v4u*)(y + (row0 + r) * D + 8 * lane) = (v4u){pk2(v0 * rs * og[0], v1 * rs * og[1]), pk2(v2 * rs * og[2], v3 * rs * og[3]), pk2(v4 * rs * og[4], v5 * rs * og[5]), pk2(v6 * rs * og[6], v7 * rs * og[7])}; }
}
__device__ __forceinline__ void moe_permute(Frame& F, int moe_j) {
    F.refresh();
    LAS int* sb = (LAS int*)F.lds;
    const int* tok_e = wsp<int>(F, WS_TOKE); const int* tok_r = wsp<int>(F, WS_TOKR); int* tok_p = wsp<int>(F, WS_TOKP); int* rte = wsp<int>(F, WS_RTE);
    const bf16* hbuf = wsp<bf16>(F, WS_H); bf16* hs = wsp<bf16>(F, WS_HS);
    if (F.tid < NEXP) sb[16 + F.tid] = (int)__hip_atomic_load((unsigned*)(F.ctl + CW_GCNT + 64 * (8 * moe_j + F.tid)), RLX_AGENT);
    __syncthreads();
    if (F.tid == 0) { int acc = 0;
        for (int e = 0; e < NEXP; ++e) { const int cnt = sb[16 + e]; sb[e] = acc; acc += (cnt + 255) & ~255; }
        sb[8] = acc; }
    __syncthreads();
    if (blockIdx.x == 0) { const int nrt = sb[8] >> 8;
        for (int i = F.tid; i < nrt; i += NWAVES * 64) { int e = 0;
#pragma unroll
            for (int k = 1; k < NEXP; ++k) if (i * 256 >= sb[k]) e = k;
            rte[i] = e; const int left = sb[16 + e] - (i * 256 - sb[e]); rte[1024 + i] = left < 256 ? left : 256; }
        if (F.tid == 0) rte[511] = nrt; }
    const int lane = F.lane;
    for (int s0 = F.gw; s0 < 2 * NTOK; s0 += 8 * F.NGW) { int ev[8], rv[8]; v4u rowv[8];
#pragma unroll
        for (int u = 0; u < 8; ++u) { const int s = s0 + u * F.NGW; const bool ok = s < 2 * NTOK; ev[u] = ok ? tok_e[s] : 0; rv[u] = ok ? tok_r[s] : 0; }
#pragma unroll
        for (int u = 0; u < 8; ++u) { const int s = s0 + u * F.NGW; const int t = (s < 2 * NTOK ? s : 0) >> 1; rowv[u] = ((const GAS v4u*)((const unsigned char*)hbuf + (size_t)t * D))[lane]; }
        asm volatile("" ::: "memory");
#pragma unroll
        for (int u = 0; u < 8; ++u) { const int s = s0 + u * F.NGW; if (s < 2 * NTOK) { const int pos = sb[ev[u]] + rv[u];
            ((GAS v4u*)((unsigned char*)hs + (size_t)pos * D))[lane] = rowv[u];
            if (lane == 0) tok_p[s] = pos; } } }
    for (int j = F.gw; j < NEXP * 256; j += F.NGW) { const int e = j >> 8, i = j & 255, cnt = sb[16 + e], padn = ((cnt + 255) & ~255) - cnt;
        if (i < padn) { v4u zz = (v4u){0u, 0u, 0u, 0u}; asm volatile("" : "+v"(zz));
            GAS v4u* dst = (GAS v4u*)((unsigned char*)hs + (size_t)(sb[e] + cnt + i) * D); dst[lane] = zz; } }
    __syncthreads();
}
struct UpOrder : pg8::StaticOrder {
    __device__ __forceinline__ bool next(int i, pg8::Unit& u) const { if (!pg8::StaticOrder::next(i, u)) return false; u.pa = u.pm + (u.pn >= 3 ? NTOK / 256 : 0); return true; }
    __device__ __forceinline__ int ktiles(const pg8::Unit& u, int nt) const { return u.pn >= 3 ? nt / 2 : nt; } };
struct GateOrder : pg8::StaticOrder {
    __device__ __forceinline__ bool next(int i, pg8::Unit& u) const { if (!pg8::StaticOrder::next(i, u)) return false; u.pa = u.pm + u.pn * (NTOK / 256); return true; }
    static constexpr bool KSKIP = true; };
struct MoeOrder {
    pg8::StaticOrder so; const int* rte; const int* rtv; int pm_off, tpe, rev;
    __device__ __forceinline__ bool next(int i, pg8::Unit& u) const { if (!so.next(i, u)) return false; if (rev) u.pm = so.nM - 1 - u.pm; u.pm += pm_off; u.pa = u.pm; u.pb = rte[u.pm] * tpe + u.pn; u.sk = rtv[u.pm] <= 128; return true; }
    __device__ __forceinline__ void a_ready(const pg8::Unit&) const {}
    __device__ __forceinline__ void done(const pg8::Unit&) const {}
    __device__ __forceinline__ int ktiles(const pg8::Unit&, int nt) const { return nt; }
    static constexpr bool KSKIP = false;
};
struct AttnOrder {
    int v, G;
    __device__ __forceinline__ bool next(int i, int& bh, int& qb) const { const int un = v + (i >> 2) * G; if (un >= 256) return false; const int s = un & 15, k = i & 3; bh = un >> 4; qb = (k == 0) ? s : (k == 1) ? 31 - s : (k == 2) ? 32 + s : 63 - s; return true; }
};

struct Args { const void* in[28]; float* out; unsigned char* ws; };
__global__ void __launch_bounds__(NWAVES * 64, 2) trunk_fwd(Args args) {
    extern __shared__ __attribute__((aligned(16))) unsigned char lds[];
    Frame F;
    F.lds = (LAS unsigned char*)lds; F.MISC = (volatile LAS unsigned*)(F.lds + MISC_OFF);
    F.G = gridDim.x; { const int bx = blockIdx.x; F.vcu = (F.G % 8 == 0) ? (bx % 8) * (F.G / 8) + bx / 8 : bx; }
    F.NGW = F.G * NWAVES; F.refresh();
    F.ws = args.ws; F.out = args.out; F.ctl = (gu32*)(args.ws + WS_CTL);
    for (int u = F.tid; u < (LDS_BYTES - LDSCTL_OFF) / 4; u += NWAVES * 64) ((LAS unsigned*)(F.lds + LDSCTL_OFF))[u] = 0u;
    __syncthreads();
    XcdBarrier bar = xcd_barrier_post((unsigned*)(F.ctl + CW_BAR), F.MISC + 8);
#ifndef PROBE_MASK
#define PROBE_MASK 0u
#endif
    unsigned long long pr_last = PROBE_MASK ? rt() : 0ull, pr_acc = 0ull;
#define GRID_BAR(c) do { xcd_barrier(bar); if (PROBE_MASK) { const unsigned long long now_ = rt(); if ((PROBE_MASK >> (c)) & 1u) pr_acc += now_ - pr_last; pr_last = now_; } } while (0)
    const int cblk = (int)blockIdx.x;
    bf16* const xb = wsp<bf16>(F, WS_XB);

    p0_prologue(F);
    GRID_BAR(0);
    p0_finalise(F);
    GRID_BAR(0);

    for (int l = 0; l < DEPTH; ++l) {
        const int ls1 = 2 * l, ls2 = 2 * l + 1; const bool moe = (l & 1) != 0; const int jj = l >> 1;
        if (l == 0) norm_pass<false, true, false, false, true, false>(F, INF(I_X), xb, ls1, 0, 0);
        else if (l == 2) { norm_pass<true, true, false, false, true>(F, xb, xb, ls1, ls1 - 1, 0); convert_moe_late(F); }
        else norm_pass<false, true, false, false, true>(F, xb, nullptr, ls1, 0, 0);
        GRID_BAR(1);
        { bf16* Win_t = wsp<bf16>(F, WS_WSMALL + (size_t)l * WSMALL_STRIDE);
          pg8::Gemm g{wsp<bf16>(F, WS_H), Win_t, NTOK, INP, D / 2}; pg8::StaticOrder S; S.init(NTOK, INP, F.G, cblk);
          pg8::EpiBf16I8 E{wsp<bf16>(F, WS_Z), INP, wsp<float>(F, WS_RSC), wsp<float>(F, WS_MREF)[8 + l]};
          pg8::gemm_phase<pg8::EpiBf16I8, pg8::StaticOrder, true, true, true, true>(F.lds, g, S, E); }
        GRID_BAR(2);
        mid_pass(F, l);
        GRID_BAR(3);
        { bf16* Wup_t = wsp<bf16>(F, WS_WSMALL + (size_t)l * WSMALL_STRIDE + 3 * MiB);
          int k256 = 256; asm volatile("" : "+s"(k256));
          pg8::Gemm g{wsp<bf16>(F, WS_A2), Wup_t, NTOK, UPN, k256}; UpOrder S; S.init(NTOK, UPN, F.G, cblk);
          pg8::EpiUp E{wsp<bf16>(F, WS_Q), wsp<bf16>(F, WS_K), wsp<bf16>(F, WS_QKV), INF(I_QGAIN) + l * 96, INF(I_KGAIN) + l * 96, wsp<float>(F, WS_COS), wsp<float>(F, WS_SIN)};
          pg8::gemm_phase<pg8::EpiUp, UpOrder, true, true>(F.lds, g, S, E); }
        { bf16* Wg_t = wsp<bf16>(F, WS_WSMALL + (size_t)l * WSMALL_STRIDE + 5 * MiB); const bf16* xrb = wsp<bf16>(F, WS_XR);
          int k128 = 128; asm volatile("" : "+s"(k128));
          pg8::Gemm g{xrb, Wg_t, NTOK, 1024, k128}; GateOrder S; S.init(NTOK, 1024, F.G, cblk);
          pg8::EpiGates E{xrb, INF(I_BA) + l * LRUW, INF(I_BX) + l * LRUW, wsp<float>(F, WS_LAMC) + l * LRUW, wsp<unsigned>(F, WS_LA)};
          pg8::gemm_phase<pg8::EpiGates, GateOrder, true, true>(F.lds, g, S, E); }
        GRID_BAR(4);
        const bool inphase = F.G == 256 && wsp<float>(F, WS_MREF)[l] <= att::ATT_MREF_MAX;
        if (!inphase) { scan_a(F); GRID_BAR(5); }
        { const AttnOrder AO{F.vcu, F.G}; int bh, qb; const bf16* Qb = wsp<bf16>(F, WS_Q); const bf16* Kb = wsp<bf16>(F, WS_K); const bf16* Vb = wsp<bf16>(F, WS_QKV); bf16* yb = wsp<bf16>(F, WS_Y);
          const float mref = wsp<float>(F, WS_MREF)[l];
          if (mref <= att::ATT_MREF_MAX) {
              for (int base = F.vcu; base < 256; base += F.G)
                  for (int i = 0; i < 2; ++i) { int un = base; asm volatile("" : "+s"(un));
                      { const int b_ = un >> 7, h_ = (un >> 4) & 7, qb_ = i ? 31 - (un & 15) : (un & 15);
                        if (F.G == 256) att2::attn_unit(b_, h_, qb_, Qb, Kb, Vb, yb, F.lds, wsp<float>(F, WS_SS), (unsigned*)(F.ctl + CW_AGRP + 16 * ((l * 2 + b_) * 32 + qb_)), (unsigned*)(F.ctl + CW_BAR), INF(I_OGAIN) + l * D);
                        else att2::attn_unit(b_, h_, qb_, Qb, Kb, Vb, yb, F.lds); }
                      if (F.G == 256) {
                          if (i == 0) { scan_a(F); scan_arrive(F, l); if (l == 0) convert_moe_first(F); } } }
#ifdef ATT_XVAR
            { bf16* xo = wsp<bf16>(F, (size_t)866 * MiB); for (int i = 0; AO.next(i, bh, qb); ++i) att::attn_unit<ATT_XVAR>(bh >> 3, bh & 7, qb, Qb, Kb, Vb, xo, F.lds, 512); }
#endif
          }
          else {
              for (int base = F.vcu; base < 256; base += F.G)
                  for (int i = 0; i < 4; ++i) { int un = base; asm volatile("" : "+s"(un)); const int s_ = un & 15;
                      att_online::attn_unit(un >> 7, (un >> 4) & 7, i == 0 ? s_ : (i == 1 ? 31 - s_ : (i == 2 ? 32 + s_ : 63 - s_)), Qb, Kb, Vb, yb, F.lds);
                      if (i == 0 && l == 0 && F.G == 256) convert_moe_first(F); } } }
        if (inphase) scan_wait(F, l);
        scan_c(F, l);
        GRID_BAR(6);
        if (!inphase) { attn_norm_pass(F, l); GRID_BAR(7); }
        { bf16* Wout_t = wsp<bf16>(F, WS_WSMALL + (size_t)l * WSMALL_STRIDE + 6 * MiB);
          pg8::Gemm g{wsp<bf16>(F, WS_Y), Wout_t, NTOK, D, D}; pg8::StaticOrder S; S.init(NTOK, D, F.G, cblk);
          pg8::EpiResid E{xb, xb, wsp<float>(F, WS_MOD) + (size_t)ls1 * 2 * 3072 + 2048, 1.0f};
          pg8::gemm_phase<pg8::EpiResid, pg8::StaticOrder, true, true>(F.lds, g, S, E); }
        GRID_BAR(8);
        if (!moe) {
            if (true) {
                norm_pass<false, true, false, false, true>(F, xb, nullptr, ls2, 0, 0);
                GRID_BAR(1);
                { unsigned char* Wgu8 = wsp<unsigned char>(F, WS_WDENSE + (size_t)jj * WDENSE_STRIDE);
                  pg8::Gemm g{wsp<bf16>(F, WS_H), (const bf16*)Wgu8, NTOK, 2 * DFF, D / 2}; pg8::StaticOrder S; S.init(NTOK, 2 * DFF, F.G, cblk);
                  pg8::EpiSwigluI8 E{wsp<unsigned char>(F, WS_HID), DFF, wsp<float>(F, WS_RSC), wsp<float>(F, WS_MREF)[8 + 4 + jj], SC_HID8};
                  pg8::gemm_phase<pg8::EpiSwigluI8, pg8::StaticOrder, true, true, true, true>(F.lds, g, S, E); }
                GRID_BAR(9);
                { unsigned char* Wd8 = wsp<unsigned char>(F, WS_WDENSE + (size_t)jj * WDENSE_STRIDE + 11 * MiB);
                  pg8::Gemm g{wsp<bf16>(F, WS_HID), (const bf16*)Wd8, NTOK, D, DFF / 2}; pg8::StaticOrder S; S.init(NTOK, D, F.G, cblk);
                  pg8::EpiResid E{xb, xb, wsp<float>(F, WS_MOD) + (size_t)ls2 * 2 * 3072 + 2048, 1.0f / (SC_HID8 * SC_WD8)};
                  pg8::gemm_phase<pg8::EpiResid, pg8::StaticOrder, true, true, true>(F.lds, g, S, E); }
                GRID_BAR(10);
            } else {
                norm_pass<false, true, false, true>(F, xb, nullptr, ls2, 0, 0);
                GRID_BAR(1);
                { unsigned char* Wgu8 = wsp<unsigned char>(F, WS_WDENSE + (size_t)jj * WDENSE_STRIDE);
                  pg8::Gemm g{wsp<bf16>(F, WS_H), (const bf16*)Wgu8, NTOK, 2 * DFF, D / 2}; pg8::StaticOrder S; S.init(NTOK, 2 * DFF, F.G, cblk);
                  pg8::EpiSwigluF8 E{wsp<unsigned char>(F, WS_HID), DFF, 1.0f / (SC_H8 * SC_WGU8), SC_HID8};
                  pg8::gemm_phase<pg8::EpiSwigluF8, pg8::StaticOrder, true, true, true>(F.lds, g, S, E); }
                GRID_BAR(9);
                { unsigned char* Wd8 = wsp<unsigned char>(F, WS_WDENSE + (size_t)jj * WDENSE_STRIDE + 11 * MiB);
                  pg8::Gemm g{wsp<bf16>(F, WS_HID), (const bf16*)Wd8, NTOK, D, DFF / 2}; pg8::StaticOrder S; S.init(NTOK, D, F.G, cblk);
                  pg8::EpiResid E{xb, xb, wsp<float>(F, WS_MOD) + (size_t)ls2 * 2 * 3072 + 2048, 1.0f / (SC_HID8 * SC_WD8)};
                  pg8::gemm_phase<pg8::EpiResid, pg8::StaticOrder, true, true, true>(F.lds, g, S, E); }
                GRID_BAR(10);
            }
        } else {
            norm_pass<false, true, true, true>(F, xb, nullptr, ls2, 0, jj);
            GRID_BAR(11);
            moe_permute(F, jj);
            GRID_BAR(12);
            const int* rte = wsp<int>(F, WS_RTE); const int nrt = rte[511];
            { pg8::Gemm g{wsp<bf16>(F, WS_HS), wsp<bf16>(F, WS_WMOE_GU), nrt * 256, 2 * DFE, D / 2}; MoeOrder S; S.so.init(nrt * 256, 2 * DFE, F.G, cblk); S.rte = rte; S.rtv = rte + 1024; S.pm_off = 0; S.tpe = 2 * DFE / 256; S.rev = 0;
              pg8::EpiSwigluF8 E{wsp<unsigned char>(F, WS_MHID), DFE, 1.0f / (SC_H8 * SC_WGU8), SC_HID8};
              pg8::gemm_phase<pg8::EpiSwigluF8, MoeOrder, true, true, true>(F.lds, g, S, E); }
            GRID_BAR(13);
            { pg8::Gemm g{wsp<bf16>(F, WS_MHID), wsp<bf16>(F, WS_WMOE_D), nrt * 256, D, DFE / 2}; MoeOrder S; S.so.init(nrt * 256, D, F.G, cblk); S.rte = rte; S.rtv = rte + 1024; S.pm_off = 0; S.tpe = D / 256; S.rev = 1;
              pg8::EpiF8S E{wsp<unsigned char>(F, WS_Y2), D, SC_Y8 / (SC_HID8 * SC_WD8)};
              pg8::gemm_phase<pg8::EpiF8S, MoeOrder, true, true, true>(F.lds, g, S, E); }
                        if (jj == 0) { const int nwg = nrt * (D / 256), rem = nwg % F.G, nshare = rem ? F.G - rem : F.G, rank = rem ? cblk - rem : cblk;
                if (rank >= 0) convert_moe_early(F, rank, nshare); }
GRID_BAR(14);
        }
    }
    norm_pass<true, false, false, false, false, true, false>(F, xb, F.out, 0, 2 * (DEPTH - 1) + 1, 0);
    if (PROBE_MASK) { const unsigned long long now_ = rt(); if ((PROBE_MASK >> 15) & 1u) pr_acc += now_ - pr_last; if (blockIdx.x == 0) { while (rt() - now_ < pr_acc) __builtin_amdgcn_s_sleep(8); } }
}

extern "C" void kernel_launch(void* const* d_in, const int* in_sizes, int n_in, void* d_out, int out_size, void* d_ws, size_t ws_size, hipStream_t stream) {
    static int grid = 0;
    if (grid == 0) {
        if (n_in != 28 || out_size != NTOK * D || ws_size < WS_END) { fprintf(stderr, "kernel_launch: unexpected shapes (n_in %d, out %d, ws %zu)\n", n_in, out_size, ws_size); grid = -1; return; }
        int dev = 0, cus = 0, per_cu = 0;
        if (hipGetDevice(&dev) != hipSuccess || hipDeviceGetAttribute(&cus, hipDeviceAttributeMultiprocessorCount, dev) != hipSuccess) { grid = -1; return; }
        if (hipFuncSetAttribute((const void*)trunk_fwd, hipFuncAttributeMaxDynamicSharedMemorySize, LDS_BYTES) != hipSuccess) { fprintf(stderr, "kernel_launch: hipFuncSetAttribute failed\n"); grid = -1; return; }
        if (hipOccupancyMaxActiveBlocksPerMultiprocessor(&per_cu, (const void*)trunk_fwd, NWAVES * 64, LDS_BYTES) != hipSuccess || per_cu < 1) { fprintf(stderr, "kernel_launch: occupancy query reports %d\n", per_cu); per_cu = 1; }
        (void)hipGetLastError();
        grid = cus;
    }
    if (grid < 0) return;
    if (hipMemsetAsync((char*)d_ws + WS_CTL, 0, CTL_ZERO_BYTES, stream) != hipSuccess) return;
    Args a{};
    for (int i = 0; i < 28; ++i) a.in[i] = d_in[i];
    a.out = (float*)d_out; a.ws = (unsigned char*)d_ws;
    hipLaunchKernelGGL(trunk_fwd, dim3(grid), dim3(NWAVES * 64), LDS_BYTES, stream, a);
}
```
